# Optimizing an MI355X kernel written in HIP

```python
import math
import jax, jax.numpy as jnp
from jax import lax
import numpy as np


D_MODEL = 1024
BATCH = 8
SEQ = 8192
DEPTH = 4

CTX_LEN = 256
GRID_W = 64

W_A = D_MODEL // 4
A_GROUPS = 4
A_CHUNK = 128
W_B = D_MODEL // 4
CONV_W = 3
HEAD_DIM = 64
W_C = D_MODEL // 2
N_HEADS = W_C // HEAD_DIM
N_KV = 2
WINDOW = 128
BLOCK = 128
MIX_WIDTH = W_A + W_B + W_C
ROPE_BASE = 10000.0
QUARTER = HEAD_DIM // 4
ATTN_SCALE = HEAD_DIM ** -0.5
EPS = 1e-6

SPLITS = (W_A, 2 * W_A, 2 * W_A + W_B, 2 * W_A + 2 * W_B, 2 * W_A + 3 * W_B,
          2 * W_A + 3 * W_B + W_C, 2 * W_A + 3 * W_B + W_C + N_KV * HEAD_DIM)
KV_START = 2 * W_A + 3 * W_B + W_C
IN_COLS = KV_START + 2 * N_KV * HEAD_DIM

N_EXPERTS = 16
N_GROUPS = 4
EXPERTS_PER_GROUP = N_EXPERTS // N_GROUPS
TOP_K = 2
D_EXPERT = 512

kernel_name = "hybrid_parallel_mixer_diffusion_trunk"


def rms_norm(x, g):
    xf = x.astype(jnp.float32)
    y = xf * lax.rsqrt(jnp.mean(xf * xf, axis=-1, keepdims=True) + EPS)
    return (y * g.astype(jnp.float32)).astype(x.dtype)


def modulation(cvec, w_mod, b_mod):
    m = (jax.nn.silu(cvec) @ w_mod + b_mod)[:, None, :]
    return jnp.split(m, 6, axis=-1)


def axial_rope_tables(n, dtype):
    rows = n // GRID_W
    row = jnp.repeat(jnp.arange(rows, dtype=jnp.float32), GRID_W)
    col = jnp.tile(jnp.arange(GRID_W, dtype=jnp.float32), rows)
    inv = ROPE_BASE ** (-jnp.arange(QUARTER, dtype=jnp.float32) / QUARTER)
    ang = jnp.stack([row[:, None] * inv, col[:, None] * inv], axis=1)
    ang = ang[:, None]
    return jnp.cos(ang).astype(dtype), jnp.sin(ang).astype(dtype)


def apply_axial_rope(t, cos, sin):
    tr = t.reshape(t.shape[:-1] + (2, 2, QUARTER))
    t1, t2 = tr[..., 0, :], tr[..., 1, :]
    o1 = t1 * cos - t2 * sin
    o2 = t2 * cos + t1 * sin
    return jnp.stack([o1, o2], axis=-2).reshape(t.shape)


def chunk_gmlp(u, v, g_v, w_s, b_s):
    b_, n, _ = u.shape
    u = jax.nn.gelu(u)
    v = rms_norm(jax.nn.gelu(v), g_v)
    v = v.reshape(b_, n // A_CHUNK, A_CHUNK, A_GROUPS, W_A // A_GROUPS)
    s = jnp.einsum('hpq,bcqhd->bcphd', w_s, v) + b_s.T[None, None, :, :, None]
    return u * s.reshape(b_, n, W_A)


def short_gated_conv(bg, cg, h, w_conv):
    z = cg * h
    n = z.shape[1]
    zp = jnp.pad(z, ((0, 0), (1, 1), (0, 0)))
    y = zp[:, :n] * w_conv[0] + zp[:, 1:n + 1] * w_conv[1] + zp[:, 2:] * w_conv[2]
    return bg * y


def context_attention(q, k, v, sink):
    b_, L = q.shape[:2]
    g = N_HEADS // N_KV
    qg = q.reshape(b_, L, N_KV, g, HEAD_DIM)
    s = jnp.einsum('bqkgd,bskd->bkgqs', qg, k, preferred_element_type=jnp.float32) * ATTN_SCALE
    s_sink = jnp.broadcast_to(sink.astype(jnp.float32).reshape(1, N_KV, g, 1, 1), s.shape[:-1] + (1,))
    p = jax.nn.softmax(jnp.concatenate([s, s_sink], axis=-1), axis=-1)[..., :L].astype(v.dtype)
    o = jnp.einsum('bkgqs,bskd->bqkgd', p, v)
    return o.reshape(b_, L, N_HEADS * HEAD_DIM)


def window_attention(q, k, v, k_ctx, v_ctx, sink):
    b_, n = q.shape[:2]
    nb = n // BLOCK
    g = N_HEADS // N_KV
    L = k_ctx.shape[1]
    nl = 3 * BLOCK
    qb = q.reshape(b_, nb, BLOCK, N_KV, g, HEAD_DIM)

    def band(t):
        tp = jnp.pad(t.reshape(b_, nb, BLOCK, N_KV, HEAD_DIM), ((0, 0), (1, 1), (0, 0), (0, 0), (0, 0)))
        return jnp.concatenate([tp[:, :-2], tp[:, 1:-1], tp[:, 2:]], axis=2)

    kb, vb = band(k), band(v)
    s_loc = jnp.einsum('bnqkgd,bnskd->bnkgqs', qb, kb, preferred_element_type=jnp.float32) * ATTN_SCALE
    blk = jnp.arange(nb)[:, None, None]
    qpos = blk * BLOCK + jnp.arange(BLOCK)[None, :, None]
    kpos = (blk - 1) * BLOCK + jnp.arange(nl)[None, None, :]
    valid = (jnp.abs(qpos - kpos) <= WINDOW) & (kpos >= 0) & (kpos < n)
    s_loc = jnp.where(valid[None, :, None, None], s_loc, -jnp.inf)
    s_ctx = jnp.einsum('bnqkgd,bskd->bnkgqs', qb, k_ctx, preferred_element_type=jnp.float32) * ATTN_SCALE
    s_sink = jnp.broadcast_to(sink.astype(jnp.float32).reshape(1, 1, N_KV, g, 1, 1), s_ctx.shape[:-1] + (1,))
    p = jax.nn.softmax(jnp.concatenate([s_loc, s_ctx, s_sink], axis=-1), axis=-1).astype(v.dtype)
    o = (jnp.einsum('bnkgqs,bnskd->bnqkgd', p[..., :nl], vb)
         + jnp.einsum('bnkgqs,bskd->bnqkgd', p[..., nl:nl + L], v_ctx))
    return o.reshape(b_, n, N_HEADS * HEAD_DIM)


def grouped_moe(h, router_w, router_b, w_gate, w_up, w_down):
    n = h.shape[0]
    scores = jax.nn.sigmoid(jnp.einsum('nd,de->ne', h, router_w, preferred_element_type=jnp.float32))
    sel = (scores + router_b.astype(jnp.float32)).reshape(n, N_GROUPS, EXPERTS_PER_GROUP)
    group_score = jnp.sum(lax.top_k(sel, TOP_K)[0], axis=-1)
    best_group = jnp.argmax(group_score, axis=-1)
    in_group = jnp.take_along_axis(sel, best_group[:, None, None], axis=1)[:, 0]
    _, top_idx = lax.top_k(in_group, TOP_K)
    expert_idx = best_group[:, None] * EXPERTS_PER_GROUP + top_idx
    w = jnp.take_along_axis(scores, expert_idx, axis=-1)
    w = w / jnp.sum(w, axis=-1, keepdims=True)
    gates = jnp.sum(jax.nn.one_hot(expert_idx, N_EXPERTS, dtype=jnp.float32) * w[..., None], axis=1).astype(h.dtype)
    out = jnp.zeros_like(h)
    for e in range(N_EXPERTS):
        a = jax.nn.silu(h @ w_gate[e]) * (h @ w_up[e])
        out = out + gates[:, e:e + 1] * (a @ w_down[e])
    return out


def trunk_layer(x, xc, mod_x, mod_c, norm1_g, norm2_g, w_in, gmlp_g, w_s, b_s, conv_w, sink,
                w_out, router_w, router_b, w_gate, w_up, w_down, cos, sin, ctx_out):
    b_, n, d = x.shape
    L = xc.shape[1]
    sh1, sc1, g1, sh2, sc2, g2 = mod_x
    csh1, csc1, cg1, csh2, csc2, cg2 = mod_c

    hx = rms_norm(x, norm1_g) * (1 + sc1) + sh1
    hc = rms_norm(xc, norm1_g) * (1 + csc1) + csh1
    ux, vx, bx, cx, zx, qx, kx, vvx = jnp.split(hx @ w_in, SPLITS, axis=-1)
    qx = apply_axial_rope(qx.reshape(b_, n, N_HEADS, HEAD_DIM), cos, sin)
    kx = apply_axial_rope(kx.reshape(b_, n, N_KV, HEAD_DIM), cos, sin)
    vvx = vvx.reshape(b_, n, N_KV, HEAD_DIM)
    if ctx_out:
        uc, vc, bc, cc, zc, qc, kc, vvc = jnp.split(hc @ w_in, SPLITS, axis=-1)
    else:
        kc, vvc = jnp.split(hc @ w_in[:, KV_START:], 2, axis=-1)
    kc = kc.reshape(b_, L, N_KV, HEAD_DIM)
    vvc = vvc.reshape(b_, L, N_KV, HEAD_DIM)

    mix_x = jnp.concatenate([
        chunk_gmlp(ux, vx, gmlp_g, w_s, b_s),
        short_gated_conv(bx, cx, zx, conv_w),
        window_attention(qx, kx, vvx, kc, vvc, sink)], axis=-1) @ w_out
    x = x + g1 * mix_x
    if ctx_out:
        mix_c = jnp.concatenate([
            chunk_gmlp(uc, vc, gmlp_g, w_s, b_s),
            short_gated_conv(bc, cc, zc, conv_w),
            context_attention(qc.reshape(b_, L, N_HEADS, HEAD_DIM), kc, vvc, sink)], axis=-1) @ w_out
        xc = xc + cg1 * mix_c

    h2x = rms_norm(x, norm2_g) * (1 + sc2) + sh2
    if ctx_out:
        h2c = rms_norm(xc, norm2_g) * (1 + csc2) + csh2
        tokens = jnp.concatenate([h2x.reshape(-1, d), h2c.reshape(-1, d)], axis=0)
        y = grouped_moe(tokens, router_w, router_b, w_gate, w_up, w_down)
        x = x + g2 * y[:b_ * n].reshape(b_, n, d)
        xc = xc + cg2 * y[b_ * n:].reshape(b_, L, d)
    else:
        y = grouped_moe(h2x.reshape(-1, d), router_w, router_b, w_gate, w_up, w_down)
        x = x + g2 * y.reshape(b_, n, d)
    return x, xc


def setup_inputs(seed: int = 0) -> dict:
    key = jax.random.key(seed)
    ks = jax.random.split(key, 24)
    f32 = jnp.float32

    def nrm(k, shape, s):
        return jax.random.normal(k, shape, f32) * s

    return {
        "x": nrm(ks[0], (BATCH, SEQ, D_MODEL), 1.0),
        "c": nrm(ks[1], (BATCH, D_MODEL), 1.0),
        "ctx": nrm(ks[2], (BATCH, CTX_LEN, D_MODEL), 1.0),
        "c_ctx": nrm(ks[3], (D_MODEL,), 1.0),
        "w_mod": nrm(ks[4], (DEPTH, D_MODEL, 6 * D_MODEL), 0.5 * D_MODEL ** -0.5),
        "b_mod": nrm(ks[5], (DEPTH, 6 * D_MODEL), 0.02),
        "norm1_g": 1.0 + nrm(ks[6], (DEPTH, D_MODEL), 0.02),
        "norm2_g": 1.0 + nrm(ks[7], (DEPTH, D_MODEL), 0.02),
        "w_in": nrm(ks[8], (DEPTH, D_MODEL, IN_COLS), D_MODEL ** -0.5),
        "gmlp_g": 1.0 + nrm(ks[9], (DEPTH, W_A), 0.02),
        "w_s": nrm(ks[10], (DEPTH, A_GROUPS, A_CHUNK, A_CHUNK), A_CHUNK ** -0.5),
        "b_s": nrm(ks[11], (DEPTH, A_GROUPS, A_CHUNK), 0.02),
        "conv_w": nrm(ks[12], (DEPTH, CONV_W, W_B), CONV_W ** -0.5),
        "attn_sink": nrm(ks[13], (DEPTH, N_HEADS), 0.5),
        "w_out": nrm(ks[14], (DEPTH, MIX_WIDTH, D_MODEL), MIX_WIDTH ** -0.5),
        "router_w": nrm(ks[15], (D_MODEL, N_EXPERTS), D_MODEL ** -0.5),
        "router_b": nrm(ks[16], (N_EXPERTS,), 0.01),
        "w_gate": nrm(ks[17], (DEPTH, N_EXPERTS, D_MODEL, D_EXPERT), D_MODEL ** -0.5),
        "w_up": nrm(ks[18], (DEPTH, N_EXPERTS, D_MODEL, D_EXPERT), D_MODEL ** -0.5),
        "w_down": nrm(ks[19], (DEPTH, N_EXPERTS, D_EXPERT, D_MODEL), D_EXPERT ** -0.5),
        "final_g": 1.0 + nrm(ks[20], (D_MODEL,), 0.02),
    }


def reference(x, c, ctx, c_ctx, w_mod, b_mod, norm1_g, norm2_g, w_in, gmlp_g, w_s, b_s, conv_w,
              attn_sink, w_out, router_w, router_b, w_gate, w_up, w_down, final_g):
    n = x.shape[1]
    cos, sin = axial_rope_tables(n, x.dtype)
    xc = ctx
    for layer in range(DEPTH):
        mod_x = modulation(c, w_mod[layer], b_mod[layer])
        mod_c = modulation(c_ctx[None], w_mod[layer], b_mod[layer])
        x, xc = trunk_layer(x, xc, mod_x, mod_c, norm1_g[layer], norm2_g[layer], w_in[layer],
                            gmlp_g[layer], w_s[layer], b_s[layer], conv_w[layer], attn_sink[layer],
                            w_out[layer], router_w, router_b, w_gate[layer], w_up[layer], w_down[layer],
                            cos, sin, layer < DEPTH - 1)
    return rms_norm(x, final_g)
```

```cpp
#include <hip/hip_runtime.h>
#include <stdint.h>
#include <cstdio>

constexpr int D = 1024, NB = 8, SEQ = 8192, DEPTH = 4, CTXL = 256;
constexpr int ML = NB * SEQ;
constexpr int MC = NB * CTXL;
constexpr int MT = ML + MC;
constexpr int INC = 2048;
constexpr int C_U = 0, C_V = 256, C_BG = 512, C_CG = 768, C_Z = 1024, C_Q = 1280, C_K = 1792, C_VV = 1920;
constexpr int NE = 16, DE = 512, NCLS = 24;
constexpr float EPS = 1e-6f;
constexpr float QSCALE = 0.125f * 1.4426950408889634f;
constexpr float LOG2E = 1.4426950408889634f;

typedef unsigned short bf16_t;
typedef float f32x4 __attribute__((ext_vector_type(4)));
typedef unsigned u32x4 __attribute__((ext_vector_type(4)));
typedef unsigned u32x2 __attribute__((ext_vector_type(2)));

__device__ __forceinline__ float bf2f(bf16_t v) { return __uint_as_float((unsigned)v << 16); }
__device__ __forceinline__ bf16_t f2bf(float f) { unsigned u = __float_as_uint(f); return (bf16_t)((u + 0x7fffu + ((u >> 16) & 1u)) >> 16); }
__device__ __forceinline__ unsigned pk2(float lo, float hi) { return (unsigned)f2bf(lo) | ((unsigned)f2bf(hi) << 16); }
__device__ __forceinline__ float gelu_tanh(float x) { const float y = 0.7978845608028654f * (x + 0.044715f * x * x * x); return x / (1.0f + __expf(-2.0f * y)); }
__device__ __forceinline__ float silu_f(float x) { return x / (1.0f + __expf(-x)); }
__device__ __forceinline__ float wave_sum(float v) {
#pragma unroll
    for (int o = 1; o < 64; o <<= 1) v += __shfl_xor(v, o);
    return v;
}

constexpr size_t MiB = 1u << 20;
constexpr size_t WS_CTL = 0;
constexpr size_t WS_MOD = 1 * MiB;
constexpr size_t WS_ROPE = 2 * MiB;
constexpr size_t WS_TOK = 3 * MiB;
constexpr size_t WS_XC = 5 * MiB;
constexpr size_t WS_LISTE = 13 * MiB;
constexpr size_t WS_LISTC = 18 * MiB;
constexpr size_t WS_VN = 25 * MiB;
constexpr size_t WS_WIN = 64 * MiB, WS_WOUT = 80 * MiB, WS_WGU = 88 * MiB, WS_WD = 216 * MiB;
constexpr size_t WS_H = 280 * MiB;
constexpr size_t WS_MIX = 412 * MiB;
constexpr size_t WS_PROJ = 544 * MiB;
constexpr size_t WS_END = 808 * MiB;
constexpr int CW_CNTE = 1024;
constexpr int CW_CNTC = 2048;

struct Tok { unsigned ids; float wlo, whi; unsigned pad; };

struct Ptrs {
    const float *x, *c, *ctx, *c_ctx, *w_mod, *b_mod, *norm1_g, *norm2_g, *w_in, *gmlp_g, *w_s, *b_s, *conv_w, *sink, *w_out, *router_w, *router_b, *w_gate, *w_up, *w_down, *final_g;
    float* out; unsigned char* ws;
};
__device__ __forceinline__ int modrow(int m) { return m < ML ? (m >> 13) : 8; }

__global__ void __launch_bounds__(256) k_mod(Ptrs P) {
    __shared__ float s[9][D];
    const int l = blockIdx.y, n = blockIdx.x * 256 + threadIdx.x;
    for (int i = threadIdx.x; i < 9 * D; i += 256) { const int j = i / D, k = i % D; const float v = j < 8 ? P.c[j * D + k] : P.c_ctx[k]; s[j][k] = silu_f(v); }
    __syncthreads();
    float acc[9];
#pragma unroll
    for (int j = 0; j < 9; ++j) acc[j] = 0.f;
    const float* w = P.w_mod + (size_t)l * D * 6144 + n;
    for (int k = 0; k < D; ++k) { const float wv = w[(size_t)k * 6144];
#pragma unroll
        for (int j = 0; j < 9; ++j) acc[j] += s[j][k] * wv; }
    float* mod = (float*)(P.ws + WS_MOD);
    const float b = P.b_mod[l * 6144 + n];
#pragma unroll
    for (int j = 0; j < 9; ++j) mod[((size_t)l * 9 + j) * 6144 + n] = acc[j] + b;
}
__global__ void k_rope_table(Ptrs P) {
    const int i = threadIdx.x & 15, pos = blockIdx.x * 16 + (threadIdx.x >> 4);
    float* tab = (float*)(P.ws + WS_ROPE);
    const float inv = powf(10000.0f, -(float)i / 16.0f), ang = (float)pos * inv;
    tab[pos * 16 + i] = cosf(ang); tab[2048 + pos * 16 + i] = sinf(ang);
}

template <int WHICH> __global__ void __launch_bounds__(256) k_norm(Ptrs P, int l, int Mrows, const float* xl, const float* xc) {
    const int lane = threadIdx.x & 63, m = blockIdx.x * 4 + (threadIdx.x >> 6);
    if (m >= Mrows) return;
    const float* xr = m < ML ? xl + (size_t)m * D : xc + (size_t)(m - ML) * D;
    const float* mod = (const float*)(P.ws + WS_MOD) + ((size_t)l * 9 + modrow(m)) * 6144;
    const float* sh = mod + (WHICH == 1 ? 0 : 3072); const float* sc = mod + (WHICH == 1 ? 1024 : 4096);
    const float* g = (WHICH == 1 ? P.norm1_g : P.norm2_g) + l * D;
    f32x4 v[4]; float ss = 0.f;
#pragma unroll
    for (int j = 0; j < 4; ++j) { v[j] = *(const f32x4*)(xr + 4 * lane + 256 * j); ss += v[j].x * v[j].x + v[j].y * v[j].y + v[j].z * v[j].z + v[j].w * v[j].w; }
    const float rinv = rsqrtf(wave_sum(ss) * (1.0f / D) + EPS);
    bf16_t* H = (bf16_t*)(P.ws + WS_H) + (size_t)m * D;
    float lg[16];
#pragma unroll
    for (int e = 0; e < 16; ++e) lg[e] = 0.f;
#pragma unroll
    for (int j = 0; j < 4; ++j) { const int c = 4 * lane + 256 * j;
        const f32x4 gg = *(const f32x4*)(g + c), s1 = *(const f32x4*)(sc + c), s0 = *(const f32x4*)(sh + c);
        f32x4 h; h.x = v[j].x * rinv * gg.x * (1.f + s1.x) + s0.x; h.y = v[j].y * rinv * gg.y * (1.f + s1.y) + s0.y; h.z = v[j].z * rinv * gg.z * (1.f + s1.z) + s0.z; h.w = v[j].w * rinv * gg.w * (1.f + s1.w) + s0.w;
        u32x2 o; o.x = pk2(h.x, h.y); o.y = pk2(h.z, h.w); *(u32x2*)(H + c) = o;
        if (WHICH == 2) {
#pragma unroll
            for (int i = 0; i < 4; ++i) { const float hv = i == 0 ? h.x : i == 1 ? h.y : i == 2 ? h.z : h.w; const float* rw = P.router_w + (size_t)(c + i) * 16;
#pragma unroll
                for (int e4 = 0; e4 < 4; ++e4) { const f32x4 r = *(const f32x4*)(rw + 4 * e4); lg[4 * e4] += hv * r.x; lg[4 * e4 + 1] += hv * r.y; lg[4 * e4 + 2] += hv * r.z; lg[4 * e4 + 3] += hv * r.w; } }
        }
    }
    if (WHICH == 2) {
#pragma unroll
        for (int e = 0; e < 16; ++e) lg[e] = wave_sum(lg[e]);
        if (lane == 0) {
            float sco[16], sel[16];
#pragma unroll
            for (int e = 0; e < 16; ++e) { sco[e] = 1.0f / (1.0f + __expf(-lg[e])); sel[e] = sco[e] + P.router_b[e]; }
            int bg = 0; float bgs = -1e30f; int ba = 0, bb = 1; float sa = 0.f, sb = 0.f;
#pragma unroll
            for (int gI = 0; gI < 4; ++gI) {
                int i1 = 0; float v1 = sel[gI * 4], c1 = sco[gI * 4];
#pragma unroll
                for (int i = 1; i < 4; ++i) if (sel[gI * 4 + i] > v1) { v1 = sel[gI * 4 + i]; c1 = sco[gI * 4 + i]; i1 = i; }
                int i2 = -1; float v2 = -1e30f, c2 = 0.f;
#pragma unroll
                for (int i = 0; i < 4; ++i) if (i != i1 && sel[gI * 4 + i] > v2) { v2 = sel[gI * 4 + i]; c2 = sco[gI * 4 + i]; i2 = i; }
                const float gs = v1 + v2;
                if (gs > bgs) { bgs = gs; bg = gI; ba = i1; bb = i2; sa = c1; sb = c2; }
            }
            const int a = ba < bb ? ba : bb, b = ba < bb ? bb : ba;
            const int elo = bg * 4 + a, ehi = bg * 4 + b;
            const float wl = ba < bb ? sa : sb, wh = ba < bb ? sb : sa, inv = 1.0f / (wl + wh);
            const int pairidx = (a == 0) ? (b - 1) : (a == 1 ? (b + 1) : 5);
            const int cls = bg * 6 + pairidx;
            Tok t; t.ids = (unsigned)elo | ((unsigned)ehi << 8) | ((unsigned)cls << 16); t.wlo = wl * inv; t.whi = wh * inv; t.pad = 0u;
            ((Tok*)(P.ws + WS_TOK))[m] = t;
            unsigned* ctl = (unsigned*)(P.ws + WS_CTL);
            int* le = (int*)(P.ws + WS_LISTE); int* lc = (int*)(P.ws + WS_LISTC);
            const unsigned p0 = atomicAdd(ctl + CW_CNTE + l * 16 + elo, 1u); le[(size_t)elo * MT + p0] = m;
            const unsigned p1 = atomicAdd(ctl + CW_CNTE + l * 16 + ehi, 1u); le[(size_t)ehi * MT + p1] = m;
            const unsigned p2 = atomicAdd(ctl + CW_CNTC + l * 32 + cls, 1u); lc[(size_t)cls * MT + p2] = m;
        }
    }
}
__global__ void __launch_bounds__(256) k_final(Ptrs P) {
    const int lane = threadIdx.x & 63, m = blockIdx.x * 4 + (threadIdx.x >> 6);
    float* xr = P.out + (size_t)m * D;
    f32x4 v[4]; float ss = 0.f;
#pragma unroll
    for (int j = 0; j < 4; ++j) { v[j] = *(const f32x4*)(xr + 4 * lane + 256 * j); ss += v[j].x * v[j].x + v[j].y * v[j].y + v[j].z * v[j].z + v[j].w * v[j].w; }
    const float rinv = rsqrtf(wave_sum(ss) * (1.0f / D) + EPS);
#pragma unroll
    for (int j = 0; j < 4; ++j) { const f32x4 g = *(const f32x4*)(P.final_g + 4 * lane + 256 * j); *(f32x4*)(xr + 4 * lane + 256 * j) = v[j] * rinv * g; }
}

template <class AF, class BF, class EF, bool DUAL>
__global__ void __launch_bounds__(256) naive_gemm(const unsigned* mcount, int Mmax, int K, AF af, BF bf, EF ef) {
    int M = Mmax; if (mcount) { const int c = (int)*mcount; M = c < Mmax ? c : Mmax; }
    const int m0 = blockIdx.y * 64, n0 = blockIdx.x * 64; if (m0 >= M) return;
    __shared__ float As[16][68], Bs[16][68], Bs2[DUAL ? 16 : 1][68];
    const int tx = threadIdx.x & 15, ty = threadIdx.x >> 4;
    float acc[4][4], acc2[4][4];
#pragma unroll
    for (int i = 0; i < 4; ++i)
#pragma unroll
        for (int j = 0; j < 4; ++j) { acc[i][j] = 0.f; acc2[i][j] = 0.f; }
    for (int k0 = 0; k0 < K; k0 += 16) {
#pragma unroll
        for (int i = 0; i < 4; ++i) { const int idx = threadIdx.x + 256 * i; const int r = idx >> 4, kk = idx & 15; As[kk][r] = (m0 + r < M) ? af(m0 + r, k0 + kk) : 0.f; }
#pragma unroll
        for (int i = 0; i < 4; ++i) { const int idx = threadIdx.x + 256 * i; const int kk = idx >> 6, c = idx & 63; Bs[kk][c] = bf(k0 + kk, n0 + c, 0); if (DUAL) Bs2[kk][c] = bf(k0 + kk, n0 + c, 1); }
        __syncthreads();
#pragma unroll
        for (int kk = 0; kk < 16; ++kk) {
            float a[4], b[4], b2[4];
#pragma unroll
            for (int i = 0; i < 4; ++i) { a[i] = As[kk][ty * 4 + i]; b[i] = Bs[kk][tx * 4 + i]; b2[i] = DUAL ? Bs2[kk][tx * 4 + i] : 0.f; }
#pragma unroll
            for (int i = 0; i < 4; ++i)
#pragma unroll
                for (int j = 0; j < 4; ++j) { acc[i][j] += a[i] * b[j]; if (DUAL) acc2[i][j] += a[i] * b2[j]; }
        }
        __syncthreads();
    }
#pragma unroll
    for (int i = 0; i < 4; ++i)
#pragma unroll
        for (int j = 0; j < 4; ++j) { const int row = m0 + ty * 4 + i; if (row < M) ef(row, n0 + tx * 4 + j, acc[i][j], acc2[i][j]); }
}
struct AF_dense { const bf16_t* A; long long ld; __device__ float operator()(int r, int k) const { return bf2f(A[(size_t)r * ld + k]); } };
struct AF_gather { const bf16_t* A; const int* list; __device__ float operator()(int r, int k) const { return bf2f(A[(size_t)list[r] * D + k]); } };
struct BF_plain { const float* W; long long ldn; __device__ float operator()(int k, int n, int) const { return W[(size_t)k * ldn + n]; } };
struct BF_dual { const float* W0; const float* W1; __device__ float operator()(int k, int n, int which) const { return (which ? W1 : W0)[(size_t)k * DE + n]; } };
struct EF_proj { bf16_t* O; __device__ void operator()(int r, int c, float v, float) const { O[(size_t)r * INC + c] = f2bf(v); } };
struct EF_res { const float* xsl; const float* xsc; float* xdl; float* xdc; const float* gate;
    __device__ void operator()(int r, int c, float v, float) const {
        const float gv = gate[(size_t)modrow(r) * 6144 + c];
        if (r < ML) xdl[(size_t)r * D + c] = xsl[(size_t)r * D + c] + gv * v; else xdc[(size_t)(r - ML) * D + c] = xsc[(size_t)(r - ML) * D + c] + gv * v; } };
struct EF_gateup { bf16_t* O; __device__ void operator()(int r, int c, float g, float u) const { O[(size_t)r * DE + c] = f2bf(silu_f(g) * u); } };
struct EF_down { const int* list; const Tok* tok; float* xl; float* xc; const float* gate; long long e;
    __device__ void operator()(int r, int c, float v, float) const {
        const int m = list[r]; const Tok t = tok[m]; const float w = ((int)(t.ids & 255u) == (int)e) ? t.wlo : t.whi;
        const float gv = gate[(size_t)modrow(m) * 6144 + c];
        if (m < ML) xl[(size_t)m * D + c] += gv * w * v; else xc[(size_t)(m - ML) * D + c] += gv * w * v; } };

__global__ void __launch_bounds__(256) k_rope(Ptrs P) {
    const size_t gid = (size_t)blockIdx.x * 256 + threadIdx.x; const int m = (int)(gid / 320), r = (int)(gid % 320);
    if (m >= MT) return;
    const int head = r / 32, pr = r % 32, a = pr / 16, i = pr % 16;
    bf16_t* p = (bf16_t*)(P.ws + WS_PROJ) + (size_t)m * INC + (head < 8 ? C_Q + head * 64 : C_K + (head - 8) * 64) + a * 32 + i;
    float t1 = bf2f(p[0]), t2 = bf2f(p[16]);
    if (m < ML) { const int t = m & (SEQ - 1); const int pos = a == 0 ? (t >> 6) : (t & 63); const float* tab = (const float*)(P.ws + WS_ROPE);
        const float cs = tab[pos * 16 + i], sn = tab[2048 + pos * 16 + i]; const float o1 = t1 * cs - t2 * sn, o2 = t2 * cs + t1 * sn; t1 = o1; t2 = o2; }
    if (head < 8) { t1 *= QSCALE; t2 *= QSCALE; }
    p[0] = f2bf(t1); p[16] = f2bf(t2);
}
__global__ void __launch_bounds__(256) k_gmlp_a(Ptrs P, int l, int Mrows) {
    const int lane = threadIdx.x & 63, m = blockIdx.x * 4 + (threadIdx.x >> 6); if (m >= Mrows) return;
    const bf16_t* v = (const bf16_t*)(P.ws + WS_PROJ) + (size_t)m * INC + C_V + 4 * lane;
    float g[4]; float ss = 0.f;
#pragma unroll
    for (int i = 0; i < 4; ++i) { g[i] = gelu_tanh(bf2f(v[i])); ss += g[i] * g[i]; }
    const float rinv = rsqrtf(wave_sum(ss) * (1.0f / 256.0f) + EPS);
    bf16_t* o = (bf16_t*)(P.ws + WS_VN) + (size_t)m * 256 + 4 * lane;
#pragma unroll
    for (int i = 0; i < 4; ++i) o[i] = f2bf(g[i] * rinv * P.gmlp_g[l * 256 + 4 * lane + i]);
}
__global__ void __launch_bounds__(256) k_gmlp_b(Ptrs P, int l) {
    const int m = blockIdx.x, c = threadIdx.x, p = m & 127, base = m - p, h = c >> 6;
    const float* ws = P.w_s + (((size_t)l * 4 + h) * 128 + p) * 128;
    const bf16_t* vn = (const bf16_t*)(P.ws + WS_VN) + (size_t)base * 256 + c;
    float s = P.b_s[(l * 4 + h) * 128 + p];
    for (int q = 0; q < 128; ++q) s += ws[q] * bf2f(vn[(size_t)q * 256]);
    const float u = gelu_tanh(bf2f(((const bf16_t*)(P.ws + WS_PROJ))[(size_t)m * INC + C_U + c]));
    ((bf16_t*)(P.ws + WS_MIX))[(size_t)m * D + c] = f2bf(u * s);
}
__global__ void __launch_bounds__(256) k_conv(Ptrs P, int l) {
    const int m = blockIdx.x, c = threadIdx.x;
    const int seqlen = m < ML ? SEQ : CTXL, t = m < ML ? (m & (SEQ - 1)) : ((m - ML) & (CTXL - 1));
    const bf16_t* pr = (const bf16_t*)(P.ws + WS_PROJ) + (size_t)m * INC;
    const float* w = P.conv_w + (size_t)l * 3 * 256;
    float y = bf2f(pr[C_CG + c]) * bf2f(pr[C_Z + c]) * w[256 + c];
    if (t > 0) y += bf2f(pr[C_CG + c - INC]) * bf2f(pr[C_Z + c - INC]) * w[c];
    if (t < seqlen - 1) y += bf2f(pr[C_CG + c + INC]) * bf2f(pr[C_Z + c + INC]) * w[512 + c];
    ((bf16_t*)(P.ws + WS_MIX))[(size_t)m * D + 256 + c] = f2bf(bf2f(pr[C_BG + c]) * y);
}
__global__ void __launch_bounds__(256) k_attn(Ptrs P, int l) {
    const int m = blockIdx.x * 32 + (threadIdx.x & 31), h = threadIdx.x >> 5, kvh = h >> 2;
    const bf16_t* proj = (const bf16_t*)(P.ws + WS_PROJ);
    float q[64], o[64];
    { const bf16_t* qp = proj + (size_t)m * INC + C_Q + h * 64;
#pragma unroll
      for (int d = 0; d < 64; ++d) { q[d] = bf2f(qp[d]); o[d] = 0.f; } }
    float mrun = P.sink[l * 8 + h] * LOG2E, lsum = 1.0f;
    int b, lo = 0, hi = -1;
    if (m < ML) { b = m >> 13; const int t = m & (SEQ - 1); lo = t - 128 < 0 ? 0 : t - 128; hi = t + 128 > SEQ - 1 ? SEQ - 1 : t + 128; } else b = (m - ML) >> 8;
    const int nloc = hi - lo + 1;
    for (int j = 0; j < nloc + CTXL; ++j) {
        const size_t krow = j < nloc ? (size_t)b * SEQ + lo + j : (size_t)ML + b * CTXL + (j - nloc);
        const bf16_t* kp = proj + krow * INC + C_K + kvh * 64; const bf16_t* vp = proj + krow * INC + C_VV + kvh * 64;
        float s = 0.f;
#pragma unroll
        for (int d8 = 0; d8 < 8; ++d8) { const u32x4 kk = *(const u32x4*)(kp + 8 * d8);
#pragma unroll
            for (int i = 0; i < 4; ++i) { s += q[8 * d8 + 2 * i] * __uint_as_float(kk[i] << 16); s += q[8 * d8 + 2 * i + 1] * __uint_as_float(kk[i] & 0xffff0000u); } }
        if (s > mrun) { const float f = exp2f(mrun - s); lsum *= f;
#pragma unroll
            for (int d = 0; d < 64; ++d) o[d] *= f;
            mrun = s; }
        const float p = exp2f(s - mrun); lsum += p;
#pragma unroll
        for (int d8 = 0; d8 < 8; ++d8) { const u32x4 vv = *(const u32x4*)(vp + 8 * d8);
#pragma unroll
            for (int i = 0; i < 4; ++i) { o[8 * d8 + 2 * i] += p * __uint_as_float(vv[i] << 16); o[8 * d8 + 2 * i + 1] += p * __uint_as_float(vv[i] & 0xffff0000u); } }
    }
    const float inv = 1.0f / lsum;
    bf16_t* op = (bf16_t*)(P.ws + WS_MIX) + (size_t)m * D + 512 + h * 64;
#pragma unroll
    for (int d = 0; d < 64; ++d) op[d] = f2bf(o[d] * inv);
}

extern "C" void kernel_launch(void* const* d_in, const int* in_sizes, int n_in, void* d_out, int out_size, void* d_ws, size_t ws_size, hipStream_t stream) {
    if (n_in != 21 || ws_size < WS_END) { fprintf(stderr, "kernel_launch: unexpected inputs (%d) or workspace (%zu)\n", n_in, ws_size); return; }
    Ptrs P{};
    const float** pp = (const float**)&P;
    for (int i = 0; i < 21; ++i) pp[i] = (const float*)d_in[i];
    P.out = (float*)d_out; P.ws = (unsigned char*)d_ws;
    unsigned char* ws = (unsigned char*)d_ws;
    (void)hipMemsetAsync(ws + WS_CTL, 0, 1 * MiB, stream);
    hipLaunchKernelGGL(k_mod, dim3(6144 / 256, DEPTH), dim3(256), 0, stream, P);
    hipLaunchKernelGGL(k_rope_table, dim3(8), dim3(256), 0, stream, P);
    float* xc = (float*)(ws + WS_XC);
    const float* mod = (const float*)(ws + WS_MOD);
    bf16_t* H = (bf16_t*)(ws + WS_H); bf16_t* MIX = (bf16_t*)(ws + WS_MIX); bf16_t* PROJ = (bf16_t*)(ws + WS_PROJ);
    const unsigned* ctl = (const unsigned*)(ws + WS_CTL);
    for (int l = 0; l < DEPTH; ++l) {
        const float* xsl = l == 0 ? P.x : P.out; const float* xsc = l == 0 ? P.ctx : xc;
        const int Mmix = l < DEPTH - 1 ? MT : ML;
        hipLaunchKernelGGL(k_norm<1>, dim3(MT / 4), dim3(256), 0, stream, P, l, MT, xsl, xsc);
        { AF_dense af{H, D}; BF_plain bf{P.w_in + (size_t)l * D * INC, INC}; EF_proj ef{PROJ};
          hipLaunchKernelGGL((naive_gemm<AF_dense, BF_plain, EF_proj, false>), dim3(INC / 64, MT / 64), dim3(256), 0, stream, (const unsigned*)nullptr, MT, D, af, bf, ef); }
        hipLaunchKernelGGL(k_rope, dim3((unsigned)(((size_t)MT * 320 + 255) / 256)), dim3(256), 0, stream, P);
        hipLaunchKernelGGL(k_gmlp_a, dim3(Mmix / 4), dim3(256), 0, stream, P, l, Mmix);
        hipLaunchKernelGGL(k_gmlp_b, dim3(Mmix), dim3(256), 0, stream, P, l);
        hipLaunchKernelGGL(k_conv, dim3(Mmix), dim3(256), 0, stream, P, l);
        hipLaunchKernelGGL(k_attn, dim3(Mmix / 32), dim3(256), 0, stream, P, l);
        { AF_dense af{MIX, D}; BF_plain bf{P.w_out + (size_t)l * D * D, D}; EF_res ef{xsl, xsc, P.out, xc, mod + (size_t)l * 9 * 6144 + 2048};
          hipLaunchKernelGGL((naive_gemm<AF_dense, BF_plain, EF_res, false>), dim3(D / 64, Mmix / 64), dim3(256), 0, stream, (const unsigned*)nullptr, Mmix, D, af, bf, ef); }
        hipLaunchKernelGGL(k_norm<2>, dim3(Mmix / 4), dim3(256), 0, stream, P, l, Mmix, (const float*)P.out, (const float*)xc);
        for (int e = 0; e < NE; ++e) {
            const int* list = (const int*)(ws + WS_LISTE) + (size_t)e * MT; bf16_t* act = PROJ;
            { AF_gather af{H, list}; BF_dual bf{P.w_gate + ((size_t)l * NE + e) * D * DE, P.w_up + ((size_t)l * NE + e) * D * DE}; EF_gateup ef{act};
              hipLaunchKernelGGL((naive_gemm<AF_gather, BF_dual, EF_gateup, true>), dim3(DE / 64, MT / 64), dim3(256), 0, stream, ctl + CW_CNTE + l * 16 + e, MT, D, af, bf, ef); }
            { AF_dense af{act, DE}; BF_plain bf{P.w_down + ((size_t)l * NE + e) * DE * D, D}; EF_down ef{list, (const Tok*)(ws + WS_TOK), P.out, xc, mod + (size_t)l * 9 * 6144 + 5120, e};
              hipLaunchKernelGGL((naive_gemm<AF_dense, BF_plain, EF_down, false>), dim3(D / 64, MT / 64), dim3(256), 0, stream, ctl + CW_CNTE + l * 16 + e, MT, DE, af, bf, ef); }
        }
    }
    hipLaunchKernelGGL(k_final, dim3(ML / 4), dim3(256), 0, stream, P);
}
```

```cpp
#include <hip/hip_runtime.h>
#include <stdint.h>
#include <cstdio>

constexpr int D = 1024, NB = 8, SEQ = 8192, DEPTH = 4, CTXL = 256;
constexpr int ML = NB * SEQ;
constexpr int MC = NB * CTXL;
constexpr int MT = ML + MC;
constexpr int INC = 2048;
constexpr int C_U = 0, C_V = 256, C_BG = 512, C_CG = 768, C_Z = 1024, C_Q = 1280, C_K = 1792, C_VV = 1920;
constexpr int NE = 16, DE = 512, NCLS = 24;
constexpr float EPS = 1e-6f;
constexpr float QSCALE = 0.125f * 1.4426950408889634f;
constexpr float LOG2E = 1.4426950408889634f;

typedef unsigned short bf16_t;
typedef float f32x4 __attribute__((ext_vector_type(4)));
typedef unsigned u32x4 __attribute__((ext_vector_type(4)));
typedef unsigned u32x2 __attribute__((ext_vector_type(2)));

__device__ __forceinline__ float bf2f(bf16_t v) { return __uint_as_float((unsigned)v << 16); }
__device__ __forceinline__ bf16_t f2bf(float f) { unsigned u = __float_as_uint(f); return (bf16_t)((u + 0x7fffu + ((u >> 16) & 1u)) >> 16); }
__device__ __forceinline__ unsigned pk2(float lo, float hi) { return (unsigned)f2bf(lo) | ((unsigned)f2bf(hi) << 16); }
__device__ __forceinline__ float gelu_tanh(float x) { const float y = 0.7978845608028654f * (x + 0.044715f * x * x * x); return x / (1.0f + __expf(-2.0f * y)); }
__device__ __forceinline__ float silu_f(float x) { return x / (1.0f + __expf(-x)); }
__device__ __forceinline__ float wave_sum(float v) {
#pragma unroll
    for (int o = 1; o < 64; o <<= 1) v += __shfl_xor(v, o);
    return v;
}

constexpr size_t MiB = 1u << 20;
constexpr size_t WS_CTL = 0;
constexpr size_t WS_MOD = 1 * MiB;
constexpr size_t WS_ROPE = 2 * MiB;
constexpr size_t WS_TOK = 3 * MiB;
constexpr size_t WS_XC = 5 * MiB;
constexpr size_t WS_LISTE = 13 * MiB;
constexpr size_t WS_LISTC = 18 * MiB;
constexpr size_t WS_VN = 25 * MiB;
constexpr size_t WS_WIN = 64 * MiB, WS_WOUT = 80 * MiB, WS_WGU = 88 * MiB, WS_WD = 216 * MiB;
constexpr size_t WS_H = 280 * MiB;
constexpr size_t WS_MIX = 412 * MiB;
constexpr size_t WS_PROJ = 544 * MiB;
constexpr size_t WS_END = 808 * MiB;
constexpr int CW_CNTE = 1024;
constexpr int CW_CNTC = 2048;

struct Tok { unsigned ids; float wlo, whi; unsigned pad; };

struct Ptrs {
    const float *x, *c, *ctx, *c_ctx, *w_mod, *b_mod, *norm1_g, *norm2_g, *w_in, *gmlp_g, *w_s, *b_s, *conv_w, *sink, *w_out, *router_w, *router_b, *w_gate, *w_up, *w_down, *final_g;
    float* out; unsigned char* ws;
};
__device__ __forceinline__ int modrow(int m) { return m < ML ? (m >> 13) : 8; }

__global__ void __launch_bounds__(256) k_mod(Ptrs P) {
    __shared__ float s[9][D];
    const int l = blockIdx.y, n = blockIdx.x * 256 + threadIdx.x;
    for (int i = threadIdx.x; i < 9 * D; i += 256) { const int j = i / D, k = i % D; const float v = j < 8 ? P.c[j * D + k] : P.c_ctx[k]; s[j][k] = silu_f(v); }
    __syncthreads();
    float acc[9];
#pragma unroll
    for (int j = 0; j < 9; ++j) acc[j] = 0.f;
    const float* w = P.w_mod + (size_t)l * D * 6144 + n;
    for (int k = 0; k < D; ++k) { const float wv = w[(size_t)k * 6144];
#pragma unroll
        for (int j = 0; j < 9; ++j) acc[j] += s[j][k] * wv; }
    float* mod = (float*)(P.ws + WS_MOD);
    const float b = P.b_mod[l * 6144 + n];
#pragma unroll
    for (int j = 0; j < 9; ++j) mod[((size_t)l * 9 + j) * 6144 + n] = acc[j] + b;
}
__global__ void k_rope_table(Ptrs P) {
    const int i = threadIdx.x & 15, pos = blockIdx.x * 16 + (threadIdx.x >> 4);
    float* tab = (float*)(P.ws + WS_ROPE);
    const float inv = powf(10000.0f, -(float)i / 16.0f), ang = (float)pos * inv;
    tab[pos * 16 + i] = cosf(ang); tab[2048 + pos * 16 + i] = sinf(ang);
}

template <int WHICH> __global__ void __launch_bounds__(256) k_norm(Ptrs P, int l, int Mrows, const float* xl, const float* xc) {
    const int lane = threadIdx.x & 63, m = blockIdx.x * 4 + (threadIdx.x >> 6);
    if (m >= Mrows) return;
    const float* xr = m < ML ? xl + (size_t)m * D : xc + (size_t)(m - ML) * D;
    const float* mod = (const float*)(P.ws + WS_MOD) + ((size_t)l * 9 + modrow(m)) * 6144;
    const float* sh = mod + (WHICH == 1 ? 0 : 3072); const float* sc = mod + (WHICH == 1 ? 1024 : 4096);
    const float* g = (WHICH == 1 ? P.norm1_g : P.norm2_g) + l * D;
    f32x4 v[4]; float ss = 0.f;
#pragma unroll
    for (int j = 0; j < 4; ++j) { v[j] = *(const f32x4*)(xr + 4 * lane + 256 * j); ss += v[j].x * v[j].x + v[j].y * v[j].y + v[j].z * v[j].z + v[j].w * v[j].w; }
    const float rinv = rsqrtf(wave_sum(ss) * (1.0f / D) + EPS);
    bf16_t* H = (bf16_t*)(P.ws + WS_H) + (size_t)m * D;
    float lg[16];
#pragma unroll
    for (int e = 0; e < 16; ++e) lg[e] = 0.f;
#pragma unroll
    for (int j = 0; j < 4; ++j) { const int c = 4 * lane + 256 * j;
        const f32x4 gg = *(const f32x4*)(g + c), s1 = *(const f32x4*)(sc + c), s0 = *(const f32x4*)(sh + c);
        f32x4 h; h.x = v[j].x * rinv * gg.x * (1.f + s1.x) + s0.x; h.y = v[j].y * rinv * gg.y * (1.f + s1.y) + s0.y; h.z = v[j].z * rinv * gg.z * (1.f + s1.z) + s0.z; h.w = v[j].w * rinv * gg.w * (1.f + s1.w) + s0.w;
        u32x2 o; o.x = pk2(h.x, h.y); o.y = pk2(h.z, h.w); *(u32x2*)(H + c) = o;
        if (WHICH == 2) {
#pragma unroll
            for (int i = 0; i < 4; ++i) { const float hv = i == 0 ? h.x : i == 1 ? h.y : i == 2 ? h.z : h.w; const float* rw = P.router_w + (size_t)(c + i) * 16;
#pragma unroll
                for (int e4 = 0; e4 < 4; ++e4) { const f32x4 r = *(const f32x4*)(rw + 4 * e4); lg[4 * e4] += hv * r.x; lg[4 * e4 + 1] += hv * r.y; lg[4 * e4 + 2] += hv * r.z; lg[4 * e4 + 3] += hv * r.w; } }
        }
    }
    if (WHICH == 2) {
#pragma unroll
        for (int e = 0; e < 16; ++e) lg[e] = wave_sum(lg[e]);
        if (lane == 0) {
            float sco[16], sel[16];
#pragma unroll
            for (int e = 0; e < 16; ++e) { sco[e] = 1.0f / (1.0f + __expf(-lg[e])); sel[e] = sco[e] + P.router_b[e]; }
            int bg = 0; float bgs = -1e30f; int ba = 0, bb = 1; float sa = 0.f, sb = 0.f;
#pragma unroll
            for (int gI = 0; gI < 4; ++gI) {
                int i1 = 0; float v1 = sel[gI * 4], c1 = sco[gI * 4];
#pragma unroll
                for (int i = 1; i < 4; ++i) if (sel[gI * 4 + i] > v1) { v1 = sel[gI * 4 + i]; c1 = sco[gI * 4 + i]; i1 = i; }
                int i2 = -1; float v2 = -1e30f, c2 = 0.f;
#pragma unroll
                for (int i = 0; i < 4; ++i) if (i != i1 && sel[gI * 4 + i] > v2) { v2 = sel[gI * 4 + i]; c2 = sco[gI * 4 + i]; i2 = i; }
                const float gs = v1 + v2;
                if (gs > bgs) { bgs = gs; bg = gI; ba = i1; bb = i2; sa = c1; sb = c2; }
            }
            const int a = ba < bb ? ba : bb, b = ba < bb ? bb : ba;
            const int elo = bg * 4 + a, ehi = bg * 4 + b;
            const float wl = ba < bb ? sa : sb, wh = ba < bb ? sb : sa, inv = 1.0f / (wl + wh);
            const int pairidx = (a == 0) ? (b - 1) : (a == 1 ? (b + 1) : 5);
            const int cls = bg * 6 + pairidx;
            Tok t; t.ids = (unsigned)elo | ((unsigned)ehi << 8) | ((unsigned)cls << 16); t.wlo = wl * inv; t.whi = wh * inv; t.pad = 0u;
            ((Tok*)(P.ws + WS_TOK))[m] = t;
            unsigned* ctl = (unsigned*)(P.ws + WS_CTL);
            int* le = (int*)(P.ws + WS_LISTE); int* lc = (int*)(P.ws + WS_LISTC);
            const unsigned p0 = atomicAdd(ctl + CW_CNTE + l * 16 + elo, 1u); le[(size_t)elo * MT + p0] = m;
            const unsigned p1 = atomicAdd(ctl + CW_CNTE + l * 16 + ehi, 1u); le[(size_t)ehi * MT + p1] = m;
            const unsigned p2 = atomicAdd(ctl + CW_CNTC + l * 32 + cls, 1u); lc[(size_t)cls * MT + p2] = m;
        }
    }
}
__global__ void __launch_bounds__(256) k_final(Ptrs P) {
    const int lane = threadIdx.x & 63, m = blockIdx.x * 4 + (threadIdx.x >> 6);
    float* xr = P.out + (size_t)m * D;
    f32x4 v[4]; float ss = 0.f;
#pragma unroll
    for (int j = 0; j < 4; ++j) { v[j] = *(const f32x4*)(xr + 4 * lane + 256 * j); ss += v[j].x * v[j].x + v[j].y * v[j].y + v[j].z * v[j].z + v[j].w * v[j].w; }
    const float rinv = rsqrtf(wave_sum(ss) * (1.0f / D) + EPS);
#pragma unroll
    for (int j = 0; j < 4; ++j) { const f32x4 g = *(const f32x4*)(P.final_g + 4 * lane + 256 * j); *(f32x4*)(xr + 4 * lane + 256 * j) = v[j] * rinv * g; }
}

template <class AF, class BF, class EF, bool DUAL>
__global__ void __launch_bounds__(256) naive_gemm(const unsigned* mcount, int Mmax, int K, AF af, BF bf, EF ef) {
    int M = Mmax; if (mcount) { const int c = (int)*mcount; M = c < Mmax ? c : Mmax; }
    const int m0 = blockIdx.y * 64, n0 = blockIdx.x * 64; if (m0 >= M) return;
    __shared__ float As[16][68], Bs[16][68], Bs2[DUAL ? 16 : 1][68];
    const int tx = threadIdx.x & 15, ty = threadIdx.x >> 4;
    float acc[4][4], acc2[4][4];
#pragma unroll
    for (int i = 0; i < 4; ++i)
#pragma unroll
        for (int j = 0; j < 4; ++j) { acc[i][j] = 0.f; acc2[i][j] = 0.f; }
    for (int k0 = 0; k0 < K; k0 += 16) {
#pragma unroll
        for (int i = 0; i < 4; ++i) { const int idx = threadIdx.x + 256 * i; const int r = idx >> 4, kk = idx & 15; As[kk][r] = (m0 + r < M) ? af(m0 + r, k0 + kk) : 0.f; }
#pragma unroll
        for (int i = 0; i < 4; ++i) { const int idx = threadIdx.x + 256 * i; const int kk = idx >> 6, c = idx & 63; Bs[kk][c] = bf(k0 + kk, n0 + c, 0); if (DUAL) Bs2[kk][c] = bf(k0 + kk, n0 + c, 1); }
        __syncthreads();
#pragma unroll
        for (int kk = 0; kk < 16; ++kk) {
            float a[4], b[4], b2[4];
#pragma unroll
            for (int i = 0; i < 4; ++i) { a[i] = As[kk][ty * 4 + i]; b[i] = Bs[kk][tx * 4 + i]; b2[i] = DUAL ? Bs2[kk][tx * 4 + i] : 0.f; }
#pragma unroll
            for (int i = 0; i < 4; ++i)
#pragma unroll
                for (int j = 0; j < 4; ++j) { acc[i][j] += a[i] * b[j]; if (DUAL) acc2[i][j] += a[i] * b2[j]; }
        }
        __syncthreads();
    }
#pragma unroll
    for (int i = 0; i < 4; ++i)
#pragma unroll
        for (int j = 0; j < 4; ++j) { const int row = m0 + ty * 4 + i; if (row < M) ef(row, n0 + tx * 4 + j, acc[i][j], acc2[i][j]); }
}
struct AF_dense { const bf16_t* A; long long ld; __device__ float operator()(int r, int k) const { return bf2f(A[(size_t)r * ld + k]); } };
struct AF_gather { const bf16_t* A; const int* list; __device__ float operator()(int r, int k) const { return bf2f(A[(size_t)list[r] * D + k]); } };
struct BF_plain { const float* W; long long ldn; __device__ float operator()(int k, int n, int) const { return W[(size_t)k * ldn + n]; } };
struct BF_dual { const float* W0; const float* W1; __device__ float operator()(int k, int n, int which) const { return (which ? W1 : W0)[(size_t)k * DE + n]; } };
struct EF_proj { bf16_t* O; __device__ void operator()(int r, int c, float v, float) const { O[(size_t)r * INC + c] = f2bf(v); } };
struct EF_res { const float* xsl; const float* xsc; float* xdl; float* xdc; const float* gate;
    __device__ void operator()(int r, int c, float v, float) const {
        const float gv = gate[(size_t)modrow(r) * 6144 + c];
        if (r < ML) xdl[(size_t)r * D + c] = xsl[(size_t)r * D + c] + gv * v; else xdc[(size_t)(r - ML) * D + c] = xsc[(size_t)(r - ML) * D + c] + gv * v; } };
struct EF_gateup { bf16_t* O; __device__ void operator()(int r, int c, float g, float u) const { O[(size_t)r * DE + c] = f2bf(silu_f(g) * u); } };
struct EF_down { const int* list; const Tok* tok; float* xl; float* xc; const float* gate; long long e;
    __device__ void operator()(int r, int c, float v, float) const {
        const int m = list[r]; const Tok t = tok[m]; const float w = ((int)(t.ids & 255u) == (int)e) ? t.wlo : t.whi;
        const float gv = gate[(size_t)modrow(m) * 6144 + c];
        if (m < ML) xl[(size_t)m * D + c] += gv * w * v; else xc[(size_t)(m - ML) * D + c] += gv * w * v; } };

__global__ void __launch_bounds__(256) k_rope(Ptrs P) {
    const size_t gid = (size_t)blockIdx.x * 256 + threadIdx.x; const int m = (int)(gid / 320), r = (int)(gid % 320);
    if (m >= MT) return;
    const int head = r / 32, pr = r % 32, a = pr / 16, i = pr % 16;
    bf16_t* p = (bf16_t*)(P.ws + WS_PROJ) + (size_t)m * INC + (head < 8 ? C_Q + head * 64 : C_K + (head - 8) * 64) + a * 32 + i;
    float t1 = bf2f(p[0]), t2 = bf2f(p[16]);
    if (m < ML) { const int t = m & (SEQ - 1); const int pos = a == 0 ? (t >> 6) : (t & 63); const float* tab = (const float*)(P.ws + WS_ROPE);
        const float cs = tab[pos * 16 + i], sn = tab[2048 + pos * 16 + i]; const float o1 = t1 * cs - t2 * sn, o2 = t2 * cs + t1 * sn; t1 = o1; t2 = o2; }
    if (head < 8) { t1 *= QSCALE; t2 *= QSCALE; }
    p[0] = f2bf(t1); p[16] = f2bf(t2);
}
__global__ void __launch_bounds__(256) k_gmlp_a(Ptrs P, int l, int Mrows) {
    const int lane = threadIdx.x & 63, m = blockIdx.x * 4 + (threadIdx.x >> 6); if (m >= Mrows) return;
    const bf16_t* v = (const bf16_t*)(P.ws + WS_PROJ) + (size_t)m * INC + C_V + 4 * lane;
    float g[4]; float ss = 0.f;
#pragma unroll
    for (int i = 0; i < 4; ++i) { g[i] = gelu_tanh(bf2f(v[i])); ss += g[i] * g[i]; }
    const float rinv = rsqrtf(wave_sum(ss) * (1.0f / 256.0f) + EPS);
    bf16_t* o = (bf16_t*)(P.ws + WS_VN) + (size_t)m * 256 + 4 * lane;
#pragma unroll
    for (int i = 0; i < 4; ++i) o[i] = f2bf(g[i] * rinv * P.gmlp_g[l * 256 + 4 * lane + i]);
}
__global__ void __launch_bounds__(256) k_gmlp_b(Ptrs P, int l) {
    const int m = blockIdx.x, c = threadIdx.x, p = m & 127, base = m - p, h = c >> 6;
    const float* ws = P.w_s + (((size_t)l * 4 + h) * 128 + p) * 128;
    const bf16_t* vn = (const bf16_t*)(P.ws + WS_VN) + (size_t)base * 256 + c;
    float s = P.b_s[(l * 4 + h) * 128 + p];
    for (int q = 0; q < 128; ++q) s += ws[q] * bf2f(vn[(size_t)q * 256]);
    const float u = gelu_tanh(bf2f(((const bf16_t*)(P.ws + WS_PROJ))[(size_t)m * INC + C_U + c]));
    ((bf16_t*)(P.ws + WS_MIX))[(size_t)m * D + c] = f2bf(u * s);
}
__global__ void __launch_bounds__(256) k_conv(Ptrs P, int l) {
    const int m = blockIdx.x, c = threadIdx.x;
    const int seqlen = m < ML ? SEQ : CTXL, t = m < ML ? (m & (SEQ - 1)) : ((m - ML) & (CTXL - 1));
    const bf16_t* pr = (const bf16_t*)(P.ws + WS_PROJ) + (size_t)m * INC;
    const float* w = P.conv_w + (size_t)l * 3 * 256;
    float y = bf2f(pr[C_CG + c]) * bf2f(pr[C_Z + c]) * w[256 + c];
    if (t > 0) y += bf2f(pr[C_CG + c - INC]) * bf2f(pr[C_Z + c - INC]) * w[c];
    if (t < seqlen - 1) y += bf2f(pr[C_CG + c + INC]) * bf2f(pr[C_Z + c + INC]) * w[512 + c];
    ((bf16_t*)(P.ws + WS_MIX))[(size_t)m * D + 256 + c] = f2bf(bf2f(pr[C_BG + c]) * y);
}
__global__ void __launch_bounds__(256) k_attn(Ptrs P, int l) {
    const int m = blockIdx.x * 32 + (threadIdx.x & 31), h = threadIdx.x >> 5, kvh = h >> 2;
    const bf16_t* proj = (const bf16_t*)(P.ws + WS_PROJ);
    float q[64], o[64];
    { const bf16_t* qp = proj + (size_t)m * INC + C_Q + h * 64;
#pragma unroll
      for (int d = 0; d < 64; ++d) { q[d] = bf2f(qp[d]); o[d] = 0.f; } }
    float mrun = P.sink[l * 8 + h] * LOG2E, lsum = 1.0f;
    int b, lo = 0, hi = -1;
    if (m < ML) { b = m >> 13; const int t = m & (SEQ - 1); lo = t - 128 < 0 ? 0 : t - 128; hi = t + 128 > SEQ - 1 ? SEQ - 1 : t + 128; } else b = (m - ML) >> 8;
    const int nloc = hi - lo + 1;
    for (int j = 0; j < nloc + CTXL; ++j) {
        const size_t krow = j < nloc ? (size_t)b * SEQ + lo + j : (size_t)ML + b * CTXL + (j - nloc);
        const bf16_t* kp = proj + krow * INC + C_K + kvh * 64; const bf16_t* vp = proj + krow * INC + C_VV + kvh * 64;
        float s = 0.f;
#pragma unroll
        for (int d8 = 0; d8 < 8; ++d8) { const u32x4 kk = *(const u32x4*)(kp + 8 * d8);
#pragma unroll
            for (int i = 0; i < 4; ++i) { s += q[8 * d8 + 2 * i] * __uint_as_float(kk[i] << 16); s += q[8 * d8 + 2 * i + 1] * __uint_as_float(kk[i] & 0xffff0000u); } }
        if (s > mrun) { const float f = exp2f(mrun - s); lsum *= f;
#pragma unroll
            for (int d = 0; d < 64; ++d) o[d] *= f;
            mrun = s; }
        const float p = exp2f(s - mrun); lsum += p;
#pragma unroll
        for (int d8 = 0; d8 < 8; ++d8) { const u32x4 vv = *(const u32x4*)(vp + 8 * d8);
#pragma unroll
            for (int i = 0; i < 4; ++i) { o[8 * d8 + 2 * i] += p * __uint_as_float(vv[i] << 16); o[8 * d8 + 2 * i + 1] += p * __uint_as_float(vv[i] & 0xffff0000u); } }
    }
    const float inv = 1.0f / lsum;
    bf16_t* op = (bf16_t*)(P.ws + WS_MIX) + (size_t)m * D + 512 + h * 64;
#pragma unroll
    for (int d = 0; d < 64; ++d) op[d] = f2bf(o[d] * inv);
}

#define LAS __attribute__((address_space(3)))
#define XB_TMO      128
#define XB_XCNT(j)  (256  + 64 * (j))
#define XB_XSUB(j)  (1280 + 64 * (j))
#define XB_XGEN(j)  (2304 + 64 * (j))
#define XB_TOP      3328
#define XB_TOPGEN   3392
#define XCD_BAR_WORDS 3456
#define XB_SPIN_CAP (1u << 18)

__device__ __forceinline__ unsigned xb_ld(unsigned* p)              { return __hip_atomic_load(p, __ATOMIC_RELAXED, __HIP_MEMORY_SCOPE_AGENT); }
__device__ __forceinline__ unsigned xb_add(unsigned* p, unsigned v) { return __hip_atomic_fetch_add(p, v, __ATOMIC_RELAXED, __HIP_MEMORY_SCOPE_AGENT); }
__device__ __forceinline__ unsigned xb_xcc_id() { return (unsigned)__builtin_amdgcn_s_getreg((3 << 11) | 20) & 0xFu; }
#define XB_SPIN(cond, bar) do { unsigned _sp = 0; while (cond) { __builtin_amdgcn_s_sleep(1); \
    if ((++_sp & 255u) == 0u) { if (xb_ld(&(bar)[XB_TMO])) break; if (_sp > XB_SPIN_CAP) { atomicAdd(&(bar)[XB_TMO], 1u); break; } } } } while (0)

struct XcdBarrier {
    unsigned* bar; unsigned x;
    volatile LAS unsigned* st;
};

__device__ __forceinline__ XcdBarrier xcd_barrier_post(unsigned* bar, volatile LAS unsigned* st) {
    XcdBarrier b; b.bar = bar; b.x = xb_xcc_id(); b.st = st;
    if (threadIdx.x == 0) (void)xb_add(&bar[XB_XCNT(b.x)], 1u);
    return b;
}
__device__ __forceinline__ void xcd_barrier_complete(unsigned* bar, unsigned x, unsigned& nloc, unsigned& nx) {
    const unsigned G = gridDim.x * gridDim.y * gridDim.z;
    unsigned sum, cnt, mine, sp = 0u;
    for (;;) {
        sum = 0u; cnt = 0u; mine = 0u;
#pragma unroll
        for (unsigned j = 0; j < 16; ++j) { const unsigned c = xb_ld(&bar[XB_XCNT(j)]); sum += c; cnt += (c > 0u) ? 1u : 0u; mine = (j == x) ? c : mine; }
        if (sum == G) break;
        __builtin_amdgcn_s_sleep(1);
        if ((++sp & 255u) == 0u) { if (xb_ld(&bar[XB_TMO])) break; if (sp > XB_SPIN_CAP) { atomicAdd(&bar[XB_TMO], 1u); break; } }
    }
    nloc = mine > 0u ? mine : 1u; nx = cnt > 0u ? cnt : 1u;
}

__device__ __forceinline__ void xcd_barrier(const XcdBarrier& b) {
    asm volatile("s_waitcnt vmcnt(0)" ::: "memory");
    __syncthreads();
    if (threadIdx.x == 0) {
        unsigned* bar = b.bar;
        __builtin_amdgcn_s_waitcnt(0);
        unsigned nloc = b.st[0], nx = b.st[1];
        if (nloc == 0u) { xcd_barrier_complete(bar, b.x, nloc, nx); b.st[0] = nloc; b.st[1] = nx; }
        const unsigned old = xb_add(&bar[XB_XSUB(b.x)], 1u);
        const unsigned gen = old / nloc;
        if (old + 1u == (gen + 1u) * nloc) {
            __builtin_amdgcn_fence(__ATOMIC_RELEASE, "agent");
            asm volatile("s_waitcnt vmcnt(0)" ::: "memory");
            const unsigned og = xb_add(&bar[XB_TOP], 1u);
            const unsigned tg = og / nx;
            if (og + 1u == (tg + 1u) * nx) xb_add(&bar[XB_TOPGEN], 1u);
            else XB_SPIN(xb_ld(&bar[XB_TOPGEN]) == tg, bar);
            __builtin_amdgcn_fence(__ATOMIC_ACQUIRE, "agent");
            xb_add(&bar[XB_XGEN(b.x)], 1u);
            asm volatile("s_waitcnt vmcnt(0)" ::: "memory");
        } else {
            XB_SPIN(xb_ld(&bar[XB_XGEN(b.x)]) == gen, bar);
            __builtin_amdgcn_fence(__ATOMIC_ACQUIRE, "agent");
            asm volatile("s_waitcnt vmcnt(0)" ::: "memory");
        }
    }
    __syncthreads();
}
typedef short bf16x8 __attribute__((ext_vector_type(8)));
namespace pg {
constexpr int BM = 256, BK = 64, HALF = 128, HTB = HALF * BK * 2  , STAGE_BYTES = 8 * HTB, NXCD = 8, WGM = 8;
__host__ __device__ __forceinline__ int lds_byte(int r, int c) { const int st = (r >> 4) * 2 + (c >> 5), rr = r & 15, cc = c & 31, ob = rr * 64 + cc * 2; return st * 1024 + (ob ^ (((ob >> 9) & 1) << 5)); }
__host__ __device__ __forceinline__ void stage_rc(int b, int& R, int& C) { const int st = b / 1024, sb = b % 1024, swz = sb ^ (((sb >> 9) & 1) << 5); R = (st >> 1) * 16 + swz / 64; C = (st & 1) * 32 + (swz % 64) / 2; }

struct Unit { int pm, pn, x0, x1; };

__device__ __forceinline__ void order_unit(int L, int nM, int nN, int& pm, int& pn) {
    const int nwg = nM * nN; int wgid = L;
    { const int q = nwg / NXCD, r = nwg % NXCD, xcd = wgid % NXCD, off = wgid / NXCD; wgid = (xcd < r ? xcd * (q + 1) : r * (q + 1) + (xcd - r) * q) + off; }
    const int nig = WGM * nN, gid = wgid / nig, fm = gid * WGM, gsz = (nM - fm) < WGM ? (nM - fm) : WGM;
    pm = fm + ((wgid % nig) % gsz); pn = (wgid % nig) / gsz;
}

template <class Sched, class Epi>
__device__ __forceinline__ void gemm_phase(LAS unsigned char* lds, LAS unsigned* idxtab, const Sched& S, const Epi& E) {
    constexpr int K = Sched::K, LDA = Sched::LDA, LDB = Sched::LDB, nt = K / BK, KS = Sched::KSPLIT; constexpr bool GATHER = Sched::GATHER;
    int tid = threadIdx.x; asm volatile("" : "+v"(tid));
    const int wid = __builtin_amdgcn_readfirstlane(tid >> 6), lane = tid & 63, wr = wid >> 2, wc = wid & 3, fr = lane & 15, fq = lane >> 4;
    unsigned voffA[2], voffB[2], cbyte[2];
#pragma unroll
    for (int i = 0; i < 2; ++i) { int R, C; stage_rc(tid * 16 + i * 8192, R, C); voffA[i] = (unsigned)(R * LDA + C) * 2u; voffB[i] = (unsigned)(R * LDB + C) * 2u; cbyte[i] = (unsigned)C * 2u; }
    constexpr size_t kstep = (size_t)(BK * 2);
    constexpr size_t hstepA = (size_t)HALF * LDA * 2, hstepB = (size_t)HALF * LDB * 2;
    const unsigned ldsw = (unsigned)wid * 1024u;
    const int aoff = lds_byte(wr * 64 + fr, fq * 8), boff = lds_byte(wc * 32 + fr, fq * 8);
    unsigned cv[2][2];
#define PG_SA(b, h) (((b) * 2 + (h)) * HTB)
#define PG_SB(b, h) ((4 + (b) * 2 + (h)) * HTB)
#define PG_STAGE_B(bufoff, gbase) do { _Pragma("unroll") for (int _i = 0; _i < 2; ++_i) \
        __builtin_amdgcn_global_load_lds((const unsigned*)((const char*)(gbase) + voffB[_i]), (LAS unsigned*)(lds + (bufoff) + ldsw + _i * 8192), 16, 0, 0); } while (0)
#define PG_STAGE_A(bufoff, gbase, h, V) do { _Pragma("unroll") for (int _i = 0; _i < 2; ++_i) { \
        const char* _p = GATHER ? (const char*)(gbase) + V[h][_i] : (const char*)(gbase) + ((h) ? hstepA : 0) + voffA[_i]; \
        __builtin_amdgcn_global_load_lds((const unsigned*)_p, (LAS unsigned*)(lds + (bufoff) + ldsw + _i * 8192), 16, 0, 0); } } while (0)
#define PG_LDA(dst, b, h) do { _Pragma("unroll") for (int m = 0; m < 4; ++m) _Pragma("unroll") for (int k = 0; k < 2; ++k) dst[m][k] = *(const LAS bf16x8*)(lds + PG_SA(b, h) + aoff + m * 2048 + k * 1024); } while (0)
#define PG_LDB(dst, b, h) do { _Pragma("unroll") for (int n = 0; n < 2; ++n) _Pragma("unroll") for (int k = 0; k < 2; ++k) dst[n][k] = *(const LAS bf16x8*)(lds + PG_SB(b, h) + boff + n * 2048 + k * 1024); } while (0)
#define PG_MMA(ai, bj, At, Bt) do { __builtin_amdgcn_s_setprio(1); _Pragma("unroll") for (int m = 0; m < 4; ++m) _Pragma("unroll") for (int n = 0; n < 2; ++n) _Pragma("unroll") for (int k = 0; k < 2; ++k) \
        acc[ai][bj][m][n] = __builtin_amdgcn_mfma_f32_16x16x32_bf16(Bt[n][k], At[m][k], acc[ai][bj][m][n], 0, 0, 0); __builtin_amdgcn_s_setprio(0); } while (0)
#define PG_WAIT_V(n) asm volatile("s_waitcnt vmcnt(" #n ")" ::: "memory")
#define PG_WAIT_L(n) asm volatile("s_waitcnt lgkmcnt(" #n ")" ::: "memory")
#define PG_BAR __builtin_amdgcn_s_barrier()
#define PG_SCHED __builtin_amdgcn_sched_barrier(0)
#define PG_IDX_ISSUE(u) do { const int _h = lane >> 5, _i = (lane >> 4) & 1, _r = lane & 15; const int _pos = _h * 128 + ((wid + 8 * _i) >> 1) * 16 + _r; \
        __builtin_amdgcn_global_load_lds(S.idx_src(u) + 4 * _pos, (LAS unsigned*)(idxtab + wid * 64), 4, 0, 0); } while (0)
#define PG_IDX_READ(u, V) do { const int _vr = S.valid_rows(u); _Pragma("unroll") for (int _h = 0; _h < 2; ++_h) _Pragma("unroll") for (int _i = 0; _i < 2; ++_i) { \
        const int _pos = _h * 128 + ((wid + 8 * _i) >> 1) * 16 + (lane >> 2); unsigned _tk = *(volatile LAS unsigned*)(idxtab + wid * 64 + _h * 32 + _i * 16 + (lane >> 2)); \
        _tk = _pos < _vr ? _tk : 0u; V[_h][_i] = _tk * (unsigned)(LDA * 2) + cbyte[_i]; } } while (0)
    Unit cur, nxt; int ui = 0;
    if (!S.next(0, cur)) return;
    f32x4 acc[2][2][4][2];
#pragma unroll
    for (int a = 0; a < 2; ++a)
#pragma unroll
        for (int b = 0; b < 2; ++b)
#pragma unroll
            for (int m = 0; m < 4; ++m)
#pragma unroll
                for (int n = 0; n < 2; ++n) acc[a][b][m][n] = (f32x4){0.f, 0.f, 0.f, 0.f};
    bf16x8 At[4][2], B0[2][2], B1[2][2];
    const char* cA = S.a_base(cur); const char* cB0 = S.b_base(cur, 0); const char* cB1 = S.b_base(cur, 1);
#pragma unroll
    for (int h = 0; h < 2; ++h)
#pragma unroll
        for (int i = 0; i < 2; ++i) cv[h][i] = 0u;
    if constexpr (GATHER) { PG_IDX_ISSUE(cur); PG_WAIT_V(0); PG_IDX_READ(cur, cv); }
    PG_STAGE_B(PG_SB(0, 0), cB0); PG_STAGE_B(PG_SB(0, 1), cB0 + hstepB); PG_STAGE_A(PG_SA(0, 0), cA, 0, cv); PG_STAGE_A(PG_SA(0, 1), cA, 1, cv);
    if (wr == 1) PG_BAR;
    PG_WAIT_V(2); PG_BAR;
    PG_STAGE_B(PG_SB(1, 0), cB0 + kstep); PG_STAGE_A(PG_SA(1, 0), cA + kstep, 0, cv); PG_STAGE_B(PG_SB(1, 1), cB0 + hstepB + kstep);
    PG_WAIT_V(6); PG_BAR;
    for (;;) {
        const bool has_next = S.next(ui + 1, nxt);
        const char* nA = has_next ? S.a_base(nxt) : cA; const char* nB0 = has_next ? S.b_base(nxt, 0) : cB0; const char* nB1 = has_next ? S.b_base(nxt, 1) : cB1;
        if constexpr (GATHER) { if (has_next) PG_IDX_ISSUE(nxt); }
        for (int t = 0; t < nt; t += 2) {
            const bool last = (t == nt - 2);
            const char* a1 = cA + (size_t)(t + 1) * kstep;
            const char* a2 = last ? nA : cA + (size_t)(t + 2) * kstep; const char* a3 = a2 + kstep;
            const char* b2 = last ? nB0 : ((t + 2) < KS ? cB0 : cB1) + (size_t)(t + 2) * kstep;
            const char* b3 = last ? nB0 + kstep : ((t + 3) < KS ? cB0 : cB1) + (size_t)(t + 3) * kstep;
            PG_LDB(B0, 0, 0); PG_LDB(B1, 0, 1); PG_SCHED; PG_LDA(At, 0, 0); PG_STAGE_A(PG_SA(1, 1), a1, 1, cv);
            if constexpr (GATHER) { if (last && has_next) { PG_IDX_READ(nxt, cv); } }
            PG_WAIT_V(8); PG_WAIT_L(0); PG_BAR; PG_MMA(0, 0, At, B0); PG_MMA(0, 1, At, B1); PG_BAR; PG_SCHED;
            PG_LDA(At, 0, 1); PG_STAGE_B(PG_SB(0, 0), b2); PG_STAGE_B(PG_SB(0, 1), b2 + hstepB); PG_STAGE_A(PG_SA(0, 0), a2, 0, cv);
            PG_WAIT_V(8); PG_WAIT_L(0); PG_BAR; PG_MMA(1, 0, At, B0); PG_MMA(1, 1, At, B1); PG_BAR; PG_SCHED;
            PG_LDB(B0, 1, 0); PG_LDB(B1, 1, 1); PG_SCHED; PG_LDA(At, 1, 0); PG_STAGE_A(PG_SA(0, 1), a2, 1, cv);
            PG_WAIT_V(8); PG_WAIT_L(0); PG_BAR; PG_MMA(0, 0, At, B0); PG_MMA(0, 1, At, B1); PG_BAR; PG_SCHED;
            PG_LDA(At, 1, 1); PG_STAGE_B(PG_SB(1, 0), b3); PG_STAGE_B(PG_SB(1, 1), b3 + hstepB); PG_STAGE_A(PG_SA(1, 0), a3, 0, cv);
            PG_WAIT_V(8); PG_WAIT_L(0); PG_BAR; PG_MMA(1, 0, At, B0); PG_MMA(1, 1, At, B1); PG_BAR; PG_SCHED;
        }
        if (wr == 0) PG_BAR;
        E(acc, cur, wr, wc, fr, fq);
        if (!has_next) break;
#pragma unroll
        for (int a = 0; a < 2; ++a)
#pragma unroll
            for (int b = 0; b < 2; ++b)
#pragma unroll
                for (int m = 0; m < 4; ++m)
#pragma unroll
                    for (int n = 0; n < 2; ++n) acc[a][b][m][n] = (f32x4){0.f, 0.f, 0.f, 0.f};
        cur = nxt; cA = nA; cB0 = nB0; cB1 = nB1; ++ui;
        if (wr == 1) PG_BAR;
    }
    PG_WAIT_V(0);
    PG_BAR;
#undef PG_SA
#undef PG_SB
#undef PG_STAGE_A
#undef PG_STAGE_B
#undef PG_LDA
#undef PG_LDB
#undef PG_MMA
#undef PG_WAIT_V
#undef PG_WAIT_L
#undef PG_BAR
#undef PG_SCHED
#undef PG_IDX_ISSUE
#undef PG_IDX_READ
}
}
constexpr int NWAVES = 8, NTHR = 512;
constexpr int RING_OFF = 0, RING_BYTES = 131072;
constexpr int IDX_OFF = RING_BYTES;
constexpr int TST_OFF = IDX_OFF + 2048;
constexpr int MISC_OFF = TST_OFF + 128;
constexpr int LDS_BYTES = 147456;
constexpr size_t WS_MODP = WS_VN;
constexpr size_t WS_WSB = 62 * MiB;
constexpr int CW_BAR = 8192;
constexpr int MAXT = 288;

struct ClsRec { int m; float wlo, whi; int pad; };
constexpr size_t WS_LISTR = 816 * MiB;
constexpr size_t WS_END2 = 848 * MiB;

__device__ __forceinline__ void cls_experts(int cls, int& elo, int& ehi) {
    const int g = cls / 6, p = cls % 6; const int a = p < 3 ? 0 : (p < 5 ? 1 : 2), b = p < 3 ? p + 1 : (p < 5 ? p - 1 : 3);
    elo = g * 4 + a; ehi = g * 4 + b;
}
__device__ __forceinline__ unsigned cvt_pk_bf16(float lo, float hi) { unsigned r; asm volatile("v_cvt_pk_bf16_f32 %0, %1, %2" : "=v"(r) : "v"(lo), "v"(hi)); return r; }

template <int N_> struct SchedDense {
    static constexpr int K = 1024, LDA = 1024, LDB = 1024, KSPLIT = 16; static constexpr bool GATHER = false;
    const bf16_t* A; const bf16_t* Bt; int nM, G, c;
    __device__ __forceinline__ bool next(int i, pg::Unit& u) const { const long L = (long)i * G + c; if (L >= (long)nM * (N_ / 256)) return false; pg::order_unit((int)L, nM, N_ / 256, u.pm, u.pn); u.x0 = 0; u.x1 = 0; return true; }
    __device__ __forceinline__ const char* a_base(const pg::Unit& u) const { return (const char*)A + (size_t)u.pm * 256 * LDA * 2; }
    __device__ __forceinline__ const char* b_base(const pg::Unit& u, int) const { return (const char*)Bt + (size_t)u.pn * 256 * LDB * 2; }
    __device__ __forceinline__ const unsigned* idx_src(const pg::Unit&) const { return nullptr; }
    __device__ __forceinline__ int valid_rows(const pg::Unit&) const { return 256; }
};
__device__ __forceinline__ void cls_of_tile(const LAS int* tst, int T, int& cls, int& rt) {
    int c = 0;
#pragma unroll
    for (int k = 1; k < NCLS; ++k) c += (T >= tst[k]) ? 1 : 0;
    cls = __builtin_amdgcn_readfirstlane(c); rt = __builtin_amdgcn_readfirstlane(T - tst[c]);
}
struct SchedGU {
    static constexpr int K = 1024, LDA = 1024, LDB = 1024, KSPLIT = 16; static constexpr bool GATHER = true;
    const bf16_t* H; const bf16_t* Wgu; const ClsRec* list; const LAS int* tst; const unsigned* cnt; int G, c;
    __device__ __forceinline__ bool next(int i, pg::Unit& u) const { const int TT = __builtin_amdgcn_readfirstlane(tst[NCLS]); const long L = (long)i * G + c; if (L >= (long)TT * 8) return false;
        pg::order_unit((int)L, TT, 8, u.pm, u.pn); cls_of_tile(tst, u.pm, u.x0, u.x1); return true; }
    __device__ __forceinline__ const char* a_base(const pg::Unit&) const { return (const char*)H; }
    __device__ __forceinline__ const char* b_base(const pg::Unit& u, int) const { int elo, ehi; cls_experts(u.x0, elo, ehi); const int e = u.pn < 4 ? elo : ehi;
        return (const char*)Wgu + ((size_t)e * 1024 + (size_t)(u.pn & 3) * 256) * LDB * 2; }
    __device__ __forceinline__ const unsigned* idx_src(const pg::Unit& u) const { return (const unsigned*)(list + (size_t)u.x0 * MT + (size_t)u.x1 * 256); }
    __device__ __forceinline__ int valid_rows(const pg::Unit& u) const { return (int)cnt[u.x0] - u.x1 * 256; }
};
struct SchedDown {
    static constexpr int K = 1024, LDA = 1024, LDB = 512, KSPLIT = 8; static constexpr bool GATHER = false;
    const bf16_t* ACT; const bf16_t* Wd; const LAS int* tst; int G, c;
    __device__ __forceinline__ bool next(int i, pg::Unit& u) const { const int TT = __builtin_amdgcn_readfirstlane(tst[NCLS]); const long L = (long)i * G + c; if (L >= (long)TT * 4) return false;
        pg::order_unit((int)L, TT, 4, u.pm, u.pn); cls_of_tile(tst, u.pm, u.x0, u.x1); return true; }
    __device__ __forceinline__ const char* a_base(const pg::Unit& u) const { return (const char*)ACT + (size_t)u.pm * 256 * LDA * 2; }
    __device__ __forceinline__ const char* b_base(const pg::Unit& u, int part) const { int elo, ehi; cls_experts(u.x0, elo, ehi); const int e = part ? ehi : elo;
        return (const char*)Wd + ((size_t)e * 1024 + (size_t)u.pn * 256) * LDB * 2 - (part ? (size_t)KSPLIT * 128 : 0); }
    __device__ __forceinline__ const unsigned* idx_src(const pg::Unit&) const { return nullptr; }
    __device__ __forceinline__ int valid_rows(const pg::Unit&) const { return 256; }
};

#define OPAQUE(x) asm volatile("" : "+v"(x))
#define ROWSTEP(m) ((m) == 3 ? 80 : 16)
struct EpiProj {
    bf16_t* O; const float* tab;
    __device__ __forceinline__ void operator()(const f32x4 (&acc)[2][2][4][2], const pg::Unit& u, int wr, int wc, int fr, int fq) const {
        const bool latent = u.pm < ML / 256;
        char* base = (char*)(O + (size_t)u.pm * 256 * INC + u.pn * 256);
        unsigned off = (unsigned)((wr * 64 + fr) * INC + wc * 32 + 4 * fq) * 2u;
        int t = ((u.pm * 256) & (SEQ - 1)) + wr * 64 + fr;
#pragma unroll
        for (int ai = 0; ai < 2; ++ai)
#pragma unroll
            for (int m = 0; m < 4; ++m) { char* rowp = base + off;
                const int pos = (wc & 1) ? (t & 63) : (t >> 6);
#pragma unroll
                for (int bj = 0; bj < 2; ++bj) { f32x4 v0 = acc[ai][bj][m][0], v1 = acc[ai][bj][m][1];
                    const bool rope = latent && (u.pn == 5 || u.pn == 6 || (u.pn == 7 && bj == 0));
                    if (rope) { const f32x4 cs = *(const f32x4*)(tab + pos * 16 + 4 * fq), sn = *(const f32x4*)(tab + 2048 + pos * 16 + 4 * fq);
                        const f32x4 o1 = v0 * cs - v1 * sn, o2 = v1 * cs + v0 * sn; v0 = o1; v1 = o2; }
                    u32x2 w0, w1; w0.x = cvt_pk_bf16(v0[0], v0[1]); w0.y = cvt_pk_bf16(v0[2], v0[3]); w1.x = cvt_pk_bf16(v1[0], v1[1]); w1.y = cvt_pk_bf16(v1[2], v1[3]);
                    *(u32x2*)(rowp + bj * 256) = w0; *(u32x2*)(rowp + bj * 256 + 32) = w1; }
                off += (unsigned)(ROWSTEP(m) * INC * 2); t += ROWSTEP(m); OPAQUE(off); OPAQUE(t); }
    }
};
struct EpiRes {
    const float* xsl; const float* xsc; float* xdl; float* xdc; const float* gate;
    __device__ __forceinline__ void operator()(const f32x4 (&acc)[2][2][4][2], const pg::Unit& u, int wr, int wc, int fr, int fq) const {
        const bool latent = u.pm < ML / 256; const int mb = latent ? (u.pm >> 5) : 8;
        const size_t tb = (size_t)(latent ? u.pm : u.pm - ML / 256) * 256 * D + u.pn * 256;
        const char* xs = (const char*)((latent ? xsl : xsc) + tb); char* xd = (char*)((latent ? xdl : xdc) + tb);
        unsigned off = (unsigned)((wr * 64 + fr) * D + wc * 32 + 4 * fq) * 4u;
        f32x4 gv[2][2];
#pragma unroll
        for (int bj = 0; bj < 2; ++bj)
#pragma unroll
            for (int n = 0; n < 2; ++n) gv[bj][n] = *(const f32x4*)(gate + (size_t)mb * 6144 + u.pn * 256 + wc * 32 + 4 * fq + bj * 128 + n * 16);
#pragma unroll
        for (int ai = 0; ai < 2; ++ai)
#pragma unroll
            for (int m = 0; m < 4; ++m) {
#pragma unroll
                for (int bj = 0; bj < 2; ++bj)
#pragma unroll
                    for (int n = 0; n < 2; ++n) { const f32x4 xv = *(const f32x4*)(xs + off + bj * 512 + n * 64); *(f32x4*)(xd + off + bj * 512 + n * 64) = xv + gv[bj][n] * acc[ai][bj][m][n]; }
                off += (unsigned)(ROWSTEP(m) * D * 4); OPAQUE(off); }
    }
};
struct EpiGU {
    bf16_t* ACT; const ClsRec* list; const unsigned* cnt;
    __device__ __forceinline__ void operator()(const f32x4 (&acc)[2][2][4][2], const pg::Unit& u, int wr, int wc, int fr, int fq) const {
        const int vr = (int)cnt[u.x0] - u.x1 * 256; const char* rec = (const char*)(list + (size_t)u.x0 * MT + (size_t)u.x1 * 256) + (u.pn >= 4 ? 8 : 4);
        char* base = (char*)(ACT + (size_t)u.pm * 256 * 1024 + (u.pn >> 2) * 512 + (u.pn & 3) * 128);
        int r = wr * 64 + fr; unsigned off = (unsigned)(r * 1024 + wc * 16 + 4 * fq) * 2u;
#pragma unroll
        for (int ai = 0; ai < 2; ++ai)
#pragma unroll
            for (int m = 0; m < 4; ++m) { float w = 0.f;
                if (r < vr) w = *(const float*)(rec + (size_t)r * 16);
                char* rowp = base + off;
#pragma unroll
                for (int bj = 0; bj < 2; ++bj) { const f32x4 g = acc[ai][bj][m][0], up = acc[ai][bj][m][1]; float o[4];
#pragma unroll
                    for (int i = 0; i < 4; ++i) o[i] = w * (g[i] / (1.0f + __expf(-g[i]))) * up[i];
                    u32x2 pk; pk.x = cvt_pk_bf16(o[0], o[1]); pk.y = cvt_pk_bf16(o[2], o[3]); *(u32x2*)(rowp + bj * 128) = pk; }
                off += (unsigned)(ROWSTEP(m) * 1024 * 2); r += ROWSTEP(m); OPAQUE(off); OPAQUE(r); }
    }
};
struct EpiDown {
    float* xl; float* xc; const float* gate; const ClsRec* list; const unsigned* cnt;
    __device__ __forceinline__ void operator()(const f32x4 (&acc)[2][2][4][2], const pg::Unit& u, int wr, int wc, int fr, int fq) const {
        const int vr = (int)cnt[u.x0] - u.x1 * 256; const ClsRec* rec = list + (size_t)u.x0 * MT + (size_t)u.x1 * 256;
        const int col0 = u.pn * 256 + wc * 32 + 4 * fq; int r = wr * 64 + fr;
#pragma unroll
        for (int ai = 0; ai < 2; ++ai)
#pragma unroll
            for (int m = 0; m < 4; ++m) {
                if (r < vr) { const int tk = rec[r].m; float* xr = (tk < ML ? xl + (size_t)tk * D : xc + (size_t)(tk - ML) * D) + col0; const float* gr = gate + (size_t)modrow(tk) * 6144 + col0;
#pragma unroll
                    for (int bj = 0; bj < 2; ++bj)
#pragma unroll
                        for (int n = 0; n < 2; ++n) { const f32x4 gv = *(const f32x4*)(gr + bj * 128 + n * 16); const f32x4 xv = *(const f32x4*)(xr + bj * 128 + n * 16); *(f32x4*)(xr + bj * 128 + n * 16) = xv + gv * acc[ai][bj][m][n]; } }
                r += ROWSTEP(m); OPAQUE(r); }
    }
};

__device__ __forceinline__ void p0_transpose_item(const float* W, int Kd, int N, bf16_t* WT, LAS float* scr, int item, int lane, int mode, int sc_lo, int sc_hi, float scale) {
    const int nblk = N / 32, kb = item / nblk, nb = item % nblk, k0 = 64 * kb, n0 = 32 * nb;
#pragma unroll 8
    for (int i = 0; i < 32; ++i) { const int kk = 2 * i + (lane >> 5); scr[kk * 33 + (lane & 31)] = W[(size_t)(k0 + kk) * N + n0 + (lane & 31)]; }
    asm volatile("s_waitcnt lgkmcnt(0)" ::: "memory");
    const int c = lane & 7;
#pragma unroll
    for (int j = 0; j < 4; ++j) { const int n = (lane >> 3) + 8 * j, ng = n0 + n; const LAS float* s = scr + (8 * c) * 33 + n;
        const float f = (ng >= sc_lo && ng < sc_hi) ? scale : 1.0f;
        const int row = mode == 0 ? ng : (32 * (ng >> 4) + (ng & 15) + (mode == 2 ? 16 : 0));
        u32x4 o; o.x = pk2(s[0 * 33] * f, s[1 * 33] * f); o.y = pk2(s[2 * 33] * f, s[3 * 33] * f); o.z = pk2(s[4 * 33] * f, s[5 * 33] * f); o.w = pk2(s[6 * 33] * f, s[7 * 33] * f);
        *(u32x4*)(WT + (size_t)row * Kd + k0 + 8 * c) = o; }
    asm volatile("s_waitcnt lgkmcnt(0)" ::: "memory");
}
__device__ __forceinline__ void phase_p0a(const Ptrs& P, LAS unsigned char* lds) {
    int tid = threadIdx.x; asm volatile("" : "+v"(tid)); const int lane = tid & 63, wave = __builtin_amdgcn_readfirstlane(tid >> 6);
    const int gw = blockIdx.x * NWAVES + wave, NGW = gridDim.x * NWAVES;
    LAS float* sil = (LAS float*)(lds + 73728);
    for (int i = tid; i < 9 * D; i += NTHR) { const int j = i >> 10, k = i & (D - 1); sil[i] = silu_f(j < 8 ? P.c[j * D + k] : P.c_ctx[k]); }
    __syncthreads();
    float* modp = (float*)(P.ws + WS_MODP);
    for (int u = gw; u < DEPTH * 24 * 16; u += NGW) { const int l = u / 384, r = u % 384, nc = r / 16, ks = r % 16;
        const float* w = P.w_mod + ((size_t)l * D + ks * 64) * 6144 + nc * 256 + 4 * lane;
        f32x4 a[9];
#pragma unroll
        for (int j = 0; j < 9; ++j) a[j] = (f32x4){0.f, 0.f, 0.f, 0.f};
#pragma unroll 4
        for (int k = 0; k < 64; ++k) { const f32x4 wv = *(const f32x4*)(w + (size_t)k * 6144);
#pragma unroll
            for (int j = 0; j < 9; ++j) a[j] += wv * sil[j * D + ks * 64 + k]; }
#pragma unroll
        for (int j = 0; j < 9; ++j) *(f32x4*)(modp + (((size_t)l * 16 + ks) * 9 + j) * 6144 + nc * 256 + 4 * lane) = a[j]; }
    { const int gt = blockIdx.x * NTHR + tid, NGT = gridDim.x * NTHR; float* tab = (float*)(P.ws + WS_ROPE);
      if (gt < 2048) { const int i = gt & 15, pos = gt >> 4; const float inv = powf(10000.0f, -(float)i / 16.0f), ang = (float)pos * inv; tab[gt] = cosf(ang); tab[2048 + gt] = sinf(ang); }
      bf16_t* wsb = (bf16_t*)(P.ws + WS_WSB);
      for (int i = gt; i < DEPTH * 4 * 128 * 128; i += NGT) wsb[i] = f2bf(P.w_s[i]); }
    LAS float* scr = (LAS float*)(lds + wave * 8448);
    constexpr int PER_L = 1024 + 512 + NE * 768;
    for (int it = gw; it < DEPTH * PER_L; it += NGW) { const int l = it / PER_L; int r = it % PER_L;
        if (r < 1024) { p0_transpose_item(P.w_in + (size_t)l * D * INC, D, INC, (bf16_t*)(P.ws + WS_WIN) + (size_t)l * INC * D, scr, r, lane, 0, C_Q, C_K, QSCALE); continue; } r -= 1024;
        if (r < 512) { p0_transpose_item(P.w_out + (size_t)l * D * D, D, D, (bf16_t*)(P.ws + WS_WOUT) + (size_t)l * D * D, scr, r, lane, 0, 0, 0, 1.f); continue; } r -= 512;
        const int e = r / 768, q = r % 768, which = q >> 8, idx = q & 255; const size_t le = (size_t)l * NE + e;
        if (which == 0) p0_transpose_item(P.w_gate + le * D * DE, D, DE, (bf16_t*)(P.ws + WS_WGU) + le * 1024 * 1024, scr, idx, lane, 1, 0, 0, 1.f);
        else if (which == 1) p0_transpose_item(P.w_up + le * D * DE, D, DE, (bf16_t*)(P.ws + WS_WGU) + le * 1024 * 1024, scr, idx, lane, 2, 0, 0, 1.f);
        else p0_transpose_item(P.w_down + le * DE * D, DE, D, (bf16_t*)(P.ws + WS_WD) + le * 1024 * 512, scr, idx, lane, 0, 0, 0, 1.f); }
}
__device__ __forceinline__ void phase_p0b(const Ptrs& P) {
    const int gt = blockIdx.x * NTHR + threadIdx.x, NGT = gridDim.x * NTHR;
    const float* modp = (const float*)(P.ws + WS_MODP); float* mod = (float*)(P.ws + WS_MOD);
    for (int i = gt; i < DEPTH * 9 * 6144; i += NGT) { const int l = i / (9 * 6144), r = i % (9 * 6144), j = r / 6144, n = r % 6144;
        float s = P.b_mod[l * 6144 + n];
#pragma unroll
        for (int ks = 0; ks < 16; ++ks) s += modp[(((size_t)l * 16 + ks) * 9 + j) * 6144 + n];
        mod[i] = s; }
}

template <int WHICH> __device__ __forceinline__ void phase_norm(const Ptrs& P, LAS unsigned char* lds, int l, int Mrows, const float* xl, const float* xc) {
    int tid = threadIdx.x; asm volatile("" : "+v"(tid)); const int lane = tid & 63, wave = __builtin_amdgcn_readfirstlane(tid >> 6);
    const int gw = blockIdx.x * NWAVES + wave, NGW = gridDim.x * NWAVES;
    LAS float* rwT = (LAS float*)lds;
    if (WHICH == 2) { for (int i = tid; i < D * NE; i += NTHR) rwT[(i & 15) * D + (i >> 4)] = P.router_w[i]; __syncthreads(); }
    const float* g = (WHICH == 1 ? P.norm1_g : P.norm2_g) + l * D;
    f32x4 gg[4];
#pragma unroll
    for (int j = 0; j < 4; ++j) gg[j] = *(const f32x4*)(g + 4 * lane + 256 * j);
    for (int m = gw; m < Mrows; m += NGW) {
        const float* xr = m < ML ? xl + (size_t)m * D : xc + (size_t)(m - ML) * D;
        const float* mod = (const float*)(P.ws + WS_MOD) + ((size_t)l * 9 + modrow(m)) * 6144;
        const float* sh = mod + (WHICH == 1 ? 0 : 3072); const float* sc = mod + (WHICH == 1 ? 1024 : 4096);
        f32x4 v[4]; float ss = 0.f;
#pragma unroll
        for (int j = 0; j < 4; ++j) { v[j] = *(const f32x4*)(xr + 4 * lane + 256 * j); ss += v[j].x * v[j].x + v[j].y * v[j].y + v[j].z * v[j].z + v[j].w * v[j].w; }
        const float rinv = rsqrtf(wave_sum(ss) * (1.0f / D) + EPS);
        bf16_t* H = (bf16_t*)(P.ws + WS_H) + (size_t)m * D;
        float lg[16];
#pragma unroll
        for (int e = 0; e < 16; ++e) lg[e] = 0.f;
#pragma unroll
        for (int j = 0; j < 4; ++j) { const int c = 4 * lane + 256 * j;
            const f32x4 s1 = *(const f32x4*)(sc + c), s0 = *(const f32x4*)(sh + c);
            const f32x4 h = v[j] * rinv * gg[j] * (s1 + 1.0f) + s0;
            u32x2 o; o.x = pk2(h.x, h.y); o.y = pk2(h.z, h.w); *(u32x2*)(H + c) = o;
            if (WHICH == 2) {
#pragma unroll
                for (int e4 = 0; e4 < 4; ++e4) {
#pragma unroll
                    for (int e = 4 * e4; e < 4 * e4 + 4; ++e) { const f32x4 r = *(const LAS f32x4*)(rwT + e * D + c); lg[e] += h.x * r.x + h.y * r.y + h.z * r.z + h.w * r.w; }
                    __builtin_amdgcn_sched_barrier(0); } }
        }
        if (WHICH == 2) {
#pragma unroll
            for (int e = 0; e < 16; ++e) lg[e] = wave_sum(lg[e]);
            if (lane == 0) {
                float sco[16], sel[16];
#pragma unroll
                for (int e = 0; e < 16; ++e) { sco[e] = 1.0f / (1.0f + __expf(-lg[e])); sel[e] = sco[e] + P.router_b[e]; }
                int bg = 0; float bgs = -1e30f; int ba = 0, bb = 1; float sa = 0.f, sb = 0.f;
#pragma unroll
                for (int gI = 0; gI < 4; ++gI) {
                    int i1 = 0; float v1 = sel[gI * 4], c1 = sco[gI * 4];
#pragma unroll
                    for (int i = 1; i < 4; ++i) if (sel[gI * 4 + i] > v1) { v1 = sel[gI * 4 + i]; c1 = sco[gI * 4 + i]; i1 = i; }
                    int i2 = -1; float v2 = -1e30f, c2 = 0.f;
#pragma unroll
                    for (int i = 0; i < 4; ++i) if (i != i1 && sel[gI * 4 + i] > v2) { v2 = sel[gI * 4 + i]; c2 = sco[gI * 4 + i]; i2 = i; }
                    const float gs = v1 + v2;
                    if (gs > bgs) { bgs = gs; bg = gI; ba = i1; bb = i2; sa = c1; sb = c2; }
                }
                const int a = ba < bb ? ba : bb, b = ba < bb ? bb : ba;
                const int elo = bg * 4 + a, ehi = bg * 4 + b;
                const float wl = ba < bb ? sa : sb, wh = ba < bb ? sb : sa, inv = 1.0f / (wl + wh);
                const int pairidx = (a == 0) ? (b - 1) : (a == 1 ? (b + 1) : 5);
                const int cls = bg * 6 + pairidx;
                Tok t; t.ids = (unsigned)elo | ((unsigned)ehi << 8) | ((unsigned)cls << 16); t.wlo = wl * inv; t.whi = wh * inv; t.pad = 0u;
                ((Tok*)(P.ws + WS_TOK))[m] = t;
                unsigned* ctl = (unsigned*)(P.ws + WS_CTL);
                int* le = (int*)(P.ws + WS_LISTE);
                const unsigned p0 = atomicAdd(ctl + CW_CNTE + l * 16 + elo, 1u); le[(size_t)elo * MT + p0] = m;
                const unsigned p1 = atomicAdd(ctl + CW_CNTE + l * 16 + ehi, 1u); le[(size_t)ehi * MT + p1] = m;
                const unsigned p2 = atomicAdd(ctl + CW_CNTC + l * 32 + cls, 1u);
                ClsRec rc; rc.m = m; rc.wlo = t.wlo; rc.whi = t.whi; rc.pad = 0; ((ClsRec*)(P.ws + WS_LISTR))[(size_t)cls * MT + p2] = rc;
            }
        }
    }
}
__device__ __forceinline__ void phase_final(const Ptrs& P) {
    int tid = threadIdx.x; asm volatile("" : "+v"(tid)); const int lane = tid & 63, wave = __builtin_amdgcn_readfirstlane(tid >> 6);
    const int gw = blockIdx.x * NWAVES + wave, NGW = gridDim.x * NWAVES;
    f32x4 gg[4];
#pragma unroll
    for (int j = 0; j < 4; ++j) gg[j] = *(const f32x4*)(P.final_g + 4 * lane + 256 * j);
    for (int m = gw; m < ML; m += NGW) { float* xr = P.out + (size_t)m * D;
        f32x4 v[4]; float ss = 0.f;
#pragma unroll
        for (int j = 0; j < 4; ++j) { v[j] = *(const f32x4*)(xr + 4 * lane + 256 * j); ss += v[j].x * v[j].x + v[j].y * v[j].y + v[j].z * v[j].z + v[j].w * v[j].w; }
        const float rinv = rsqrtf(wave_sum(ss) * (1.0f / D) + EPS);
#pragma unroll
        for (int j = 0; j < 4; ++j) *(f32x4*)(xr + 4 * lane + 256 * j) = v[j] * rinv * gg[j]; }
}
__device__ __forceinline__ void build_tile_table(const Ptrs& P, LAS int* tst, int l) {
    if (threadIdx.x == 0) { const unsigned* cnt = (const unsigned*)(P.ws + WS_CTL) + CW_CNTC + l * 32; int a = 0;
        for (int k = 0; k < NCLS; ++k) { tst[k] = a; a += (int)((__hip_atomic_load(cnt + k, __ATOMIC_RELAXED, __HIP_MEMORY_SCOPE_AGENT) + 255u) >> 8); }
        tst[NCLS] = a; }
    __syncthreads();
}
namespace mx {
typedef float f32x16 __attribute__((ext_vector_type(16)));
typedef short s16x4 __attribute__((ext_vector_type(4)));
constexpr int SLOTB = 8192;
constexpr int L_K = 0, L_V = 2 * SLOTB, L_WS = 4 * SLOTB, L_OST = L_WS + NWAVES * 256, L_END = L_OST + NWAVES * 4096;
constexpr int VT_PITCH = 136;
__device__ __forceinline__ int crow(int r, int hi) { return (r & 3) + 8 * (r >> 2) + 4 * hi; }
__device__ __forceinline__ unsigned cvtpk(float lo, float hi) { unsigned r; asm volatile("v_cvt_pk_bf16_f32 %0, %1, %2" : "=v"(r) : "v"(lo), "v"(hi)); return r; }
__device__ __forceinline__ float gelu_fast(float x) { const float y = x + 0.044715f * x * x * x; return x * __builtin_amdgcn_rcpf(1.0f + __builtin_amdgcn_exp2f(-2.302208198f * y)); }

__device__ __forceinline__ void qkt(f32x16& p0, f32x16& p1, const LAS unsigned char* Kslot, const bf16x8* qr, int r32, int hi) {
    const LAS unsigned char* kb = Kslot + hi * 1024 + r32 * 16;
    p0 = (f32x16){0.f, 0.f, 0.f, 0.f, 0.f, 0.f, 0.f, 0.f, 0.f, 0.f, 0.f, 0.f, 0.f, 0.f, 0.f, 0.f}; p1 = p0;
#pragma unroll
    for (int d0 = 0; d0 < 4; ++d0) {
        const bf16x8 b0 = *(const LAS bf16x8*)(kb + d0 * 2048), b1 = *(const LAS bf16x8*)(kb + d0 * 2048 + 512);
        p0 = __builtin_amdgcn_mfma_f32_32x32x16_bf16(b0, qr[d0], p0, 0, 0, 0); p1 = __builtin_amdgcn_mfma_f32_32x32x16_bf16(b1, qr[d0], p1, 0, 0, 0); }
}
__device__ __forceinline__ void pv(f32x16* o, unsigned vb, bf16x8 pa0, bf16x8 pa1, bf16x8 pa2, bf16x8 pa3) {
#pragma unroll
    for (int d0 = 0; d0 < 2; ++d0) { s16x4 lo[4], hi[4];
#pragma unroll
        for (int ks = 0; ks < 4; ++ks) {
            asm volatile("ds_read_b64_tr_b16 %0, %1 offset:%c2" : "=&v"(lo[ks]) : "v"(vb), "i"(d0 * 4096 + ks * 1024) : "memory");
            asm volatile("ds_read_b64_tr_b16 %0, %1 offset:%c2" : "=&v"(hi[ks]) : "v"(vb), "i"(d0 * 4096 + ks * 1024 + 512) : "memory"); }
        asm volatile("s_waitcnt lgkmcnt(0)" ::: "memory"); __builtin_amdgcn_sched_barrier(0);
#define MX_PK(k) (bf16x8){lo[k][0], lo[k][1], lo[k][2], lo[k][3], hi[k][0], hi[k][1], hi[k][2], hi[k][3]}
        o[d0] = __builtin_amdgcn_mfma_f32_32x32x16_bf16(pa0, MX_PK(0), o[d0], 0, 0, 0);
        o[d0] = __builtin_amdgcn_mfma_f32_32x32x16_bf16(pa1, MX_PK(1), o[d0], 0, 0, 0);
        o[d0] = __builtin_amdgcn_mfma_f32_32x32x16_bf16(pa2, MX_PK(2), o[d0], 0, 0, 0);
        o[d0] = __builtin_amdgcn_mfma_f32_32x32x16_bf16(pa3, MX_PK(3), o[d0], 0, 0, 0);
#undef MX_PK
    }
}
__device__ __forceinline__ void attn_unit(const bf16_t* PROJ, bf16_t* MIXo, const float* sink, LAS unsigned char* shm, int latent, int b, int blk, int kvh, int hp, int tid) {
    const int lane = tid & 63, r32 = lane & 31, hi = lane >> 5; const int wid = __builtin_amdgcn_readfirstlane(tid >> 6);
    const int head = kvh * 4 + hp * 2 + (wid >> 2), qw = (wid & 3) * 32;
    const int qrow0 = latent ? b * SEQ + blk * 128 : ML + b * CTXL + blk * 128;
    const int ctx0 = ML + b * CTXL;
    const int lt_lo = latent ? (blk > 0 ? 0 : 2) : 0, lt_hi = latent ? (blk < SEQ / 128 - 1 ? 6 : 4) : 0;
    const int NT = 4 + (lt_hi - lt_lo);
    LAS float* wsf = (LAS float*)(shm + L_WS) + wid * 64;
    const bf16_t* kcol = PROJ + C_K + kvh * 64 + wid * 8;
    const bf16_t* vcol = PROJ + C_VV + kvh * 64 + (wid >> 2) * 32 + (lane & 3) * 8;
#define MX_TROW(t) ((t) < 4 ? ctx0 + 64 * (t) : b * SEQ + blk * 128 - 128 + 64 * ((t) - 4 + lt_lo))
#define MX_DMA(t, slot) do { const int _r0 = MX_TROW(t); \
        __builtin_amdgcn_global_load_lds((const unsigned*)(kcol + (size_t)(_r0 + lane) * INC), (LAS unsigned*)(shm + L_K + (slot) * SLOTB + wid * 1024), 16, 0, 0); \
        __builtin_amdgcn_global_load_lds((const unsigned*)(vcol + (size_t)(_r0 + 16 * (wid & 3) + (lane >> 2)) * INC), (LAS unsigned*)(shm + L_V + (slot) * SLOTB + wid * 1024), 16, 0, 0); } while (0)
    MX_DMA(0, 0);
    bf16x8 qr[4];
    { const bf16_t* qp = PROJ + (size_t)(qrow0 + qw + r32) * INC + C_Q + head * 64 + hi * 8;
#pragma unroll
      for (int d0 = 0; d0 < 4; ++d0) qr[d0] = *(const bf16x8*)(qp + d0 * 16); }
    float mrun = sink[head] * LOG2E, lsum = hi == 0 ? 1.0f : 0.0f;
    f32x16 o[2]; o[0] = (f32x16){0.f, 0.f, 0.f, 0.f, 0.f, 0.f, 0.f, 0.f, 0.f, 0.f, 0.f, 0.f, 0.f, 0.f, 0.f, 0.f}; o[1] = o[0];
    const unsigned vb0 = (unsigned)(size_t)(shm + L_V) + ((lane >> 4) & 1) * 32 + (lane & 3) * 8 + (4 * hi + ((lane & 15) >> 2)) * 64;
    const int qc = qw + r32;
    for (int t = 0; t < NT; ++t) {
        const int slot = t & 1;
        if (t + 1 < NT) { MX_DMA(t + 1, slot ^ 1); asm volatile("s_waitcnt vmcnt(2)" ::: "memory"); } else { asm volatile("s_waitcnt vmcnt(0)" ::: "memory"); }
        asm volatile("s_barrier" ::: "memory");
        f32x16 p0, p1;
        qkt(p0, p1, shm + L_K + slot * SLOTB, qr, r32, hi);
        if (t >= 4) { const int lt = t - 4 + lt_lo; if (lt < 2 || lt >= 4) { const int kb = -128 + 64 * lt;
#pragma unroll
            for (int r = 0; r < 16; ++r) { const int k0 = kb + crow(r, hi), k1 = k0 + 32;
                if (k0 < qc - 128 || k0 > qc + 128) p0[r] = -1e30f; if (k1 < qc - 128 || k1 > qc + 128) p1[r] = -1e30f; } } }
        float rm = fmaxf(p0[0], p1[0]);
#pragma unroll
        for (int r = 1; r < 16; ++r) rm = fmaxf(rm, fmaxf(p0[r], p1[r]));
        { auto rr = __builtin_amdgcn_permlane32_swap(__float_as_uint(rm), __float_as_uint(rm), false, false); rm = fmaxf(__uint_as_float(rr[0]), __uint_as_float(rr[1])); }
        const float mnew = fmaxf(mrun, rm);
        if (__any(mnew > mrun)) { const float f = __builtin_amdgcn_exp2f(mrun - mnew); lsum *= f; if (hi == 0) wsf[r32] = f;
            asm volatile("s_waitcnt lgkmcnt(0)" ::: "memory");
#pragma unroll
            for (int r = 0; r < 16; ++r) { const float fr_ = *(volatile LAS float*)(wsf + crow(r, hi)); o[0][r] *= fr_; o[1][r] *= fr_; }
            mrun = mnew; }
        float sacc = 0.f;
#pragma unroll
        for (int r = 0; r < 16; ++r) { p0[r] = __builtin_amdgcn_exp2f(p0[r] - mrun); p1[r] = __builtin_amdgcn_exp2f(p1[r] - mrun); sacc += p0[r] + p1[r]; }
        lsum += sacc;
        u32x4 pw0, pw1, pw2, pw3;
#pragma unroll
        for (int i = 0; i < 4; ++i) { pw0[i] = cvtpk(p0[2 * i], p0[2 * i + 1]); pw1[i] = cvtpk(p0[8 + 2 * i], p0[8 + 2 * i + 1]); pw2[i] = cvtpk(p1[2 * i], p1[2 * i + 1]); pw3[i] = cvtpk(p1[8 + 2 * i], p1[8 + 2 * i + 1]); }
        pv(o, vb0 + slot * SLOTB, __builtin_bit_cast(bf16x8, pw0), __builtin_bit_cast(bf16x8, pw1), __builtin_bit_cast(bf16x8, pw2), __builtin_bit_cast(bf16x8, pw3));
        asm volatile("s_waitcnt lgkmcnt(0)" ::: "memory");
        asm volatile("s_barrier" ::: "memory");
    }
    { auto rr = __builtin_amdgcn_permlane32_swap(__float_as_uint(lsum), __float_as_uint(lsum), false, false); lsum = __uint_as_float(rr[0]) + __uint_as_float(rr[1]); }
    if (hi == 0) wsf[32 + r32] = lsum;
    asm volatile("s_waitcnt lgkmcnt(0)" ::: "memory");
    LAS bf16_t* stg = (LAS bf16_t*)(shm + L_OST) + wid * 2048;
#pragma unroll
    for (int r = 0; r < 16; ++r) { const int orow = crow(r, hi); const float rl = __builtin_amdgcn_rcpf(*(volatile LAS float*)(wsf + 32 + orow));
        stg[orow * 64 + r32] = f2bf(o[0][r] * rl); stg[orow * 64 + 32 + r32] = f2bf(o[1][r] * rl); }
    asm volatile("s_waitcnt lgkmcnt(0)" ::: "memory");
    bf16_t* op = MIXo + (size_t)(qrow0 + qw) * D + 512 + head * 64;
#pragma unroll
    for (int i = 0; i < 4; ++i) { const int row = i * 8 + (lane >> 3), ch = lane & 7; const u32x4 v = *(const LAS u32x4*)(stg + row * 64 + ch * 8); *(u32x4*)(op + (size_t)row * D + ch * 8) = v; }
    asm volatile("s_waitcnt lgkmcnt(0)" ::: "memory");
    asm volatile("s_barrier" ::: "memory");
#undef MX_DMA
#undef MX_TROW
}

__device__ __forceinline__ void gmlp_conv_unit(const Ptrs& P, const bf16_t* PROJ, bf16_t* MIXo, LAS unsigned char* shm, int l, int m0, int tid) {
    const int lane = tid & 63, r32 = lane & 31, hi = lane >> 5; const int wid = __builtin_amdgcn_readfirstlane(tid >> 6);
    LAS bf16_t* vT = (LAS bf16_t*)shm;
    { float gv[4];
#pragma unroll
      for (int i = 0; i < 4; ++i) gv[i] = P.gmlp_g[l * 256 + 4 * lane + i];
      for (int rr = 0; rr < 16; ++rr) { const int row = wid * 16 + rr;
          const u32x2 raw = *(const u32x2*)(PROJ + (size_t)(m0 + row) * INC + C_V + 4 * lane);
          float g[4]; g[0] = gelu_fast(__uint_as_float(raw.x << 16)); g[1] = gelu_fast(__uint_as_float(raw.x & 0xffff0000u)); g[2] = gelu_fast(__uint_as_float(raw.y << 16)); g[3] = gelu_fast(__uint_as_float(raw.y & 0xffff0000u));
          const float rinv = rsqrtf(wave_sum(g[0] * g[0] + g[1] * g[1] + g[2] * g[2] + g[3] * g[3]) * (1.0f / 256.0f) + EPS);
#pragma unroll
          for (int i = 0; i < 4; ++i) vT[(4 * lane + i) * VT_PITCH + row] = f2bf(g[i] * rinv * gv[i]); } }
    asm volatile("s_waitcnt lgkmcnt(0)" ::: "memory");
    asm volatile("s_barrier" ::: "memory");
    { const int h = wid >> 1, dt = wid & 1;
      bf16x8 af[8];
#pragma unroll
      for (int kk = 0; kk < 8; ++kk) af[kk] = *(const LAS bf16x8*)(vT + (h * 64 + dt * 32 + r32) * VT_PITCH + kk * 16 + hi * 8);
      const bf16_t* wsb = (const bf16_t*)(P.ws + WS_WSB) + ((size_t)(l * 4 + h) * 128) * 128;
      const float* bs = P.b_s + (l * 4 + h) * 128;
#pragma unroll
      for (int pt = 0; pt < 4; ++pt) {
          f32x16 acc = (f32x16){0.f, 0.f, 0.f, 0.f, 0.f, 0.f, 0.f, 0.f, 0.f, 0.f, 0.f, 0.f, 0.f, 0.f, 0.f, 0.f};
#pragma unroll
          for (int kk = 0; kk < 8; ++kk) { const bf16x8 bfrag = *(const bf16x8*)(wsb + (size_t)(pt * 32 + r32) * 128 + kk * 16 + hi * 8); acc = __builtin_amdgcn_mfma_f32_32x32x16_bf16(af[kk], bfrag, acc, 0, 0, 0); }
          const int p = pt * 32 + r32; const float bias = bs[p];
          const bf16_t* up = PROJ + (size_t)(m0 + p) * INC + C_U + h * 64 + dt * 32 + 4 * hi; bf16_t* op = MIXo + (size_t)(m0 + p) * D + h * 64 + dt * 32 + 4 * hi;
#pragma unroll
          for (int q4 = 0; q4 < 4; ++q4) { const u32x2 raw = *(const u32x2*)(up + 8 * q4);
              const float u0 = gelu_fast(__uint_as_float(raw.x << 16)), u1 = gelu_fast(__uint_as_float(raw.x & 0xffff0000u)), u2 = gelu_fast(__uint_as_float(raw.y << 16)), u3 = gelu_fast(__uint_as_float(raw.y & 0xffff0000u));
              u32x2 w; w.x = cvtpk(u0 * (acc[4 * q4] + bias), u1 * (acc[4 * q4 + 1] + bias)); w.y = cvtpk(u2 * (acc[4 * q4 + 2] + bias), u3 * (acc[4 * q4 + 3] + bias));
              *(u32x2*)(op + 8 * q4) = w; }
      } }
    { const int seqmask = m0 < ML ? SEQ - 1 : CTXL - 1; const int mrel = m0 < ML ? m0 : m0 - ML;
      for (int it = 0; it < 8; ++it) { const int idx = it * NTHR + tid, row = idx >> 5, c = (idx & 31) * 8;
          const int t = (mrel + row) & seqmask; const bf16_t* pr = PROJ + (size_t)(m0 + row) * INC;
          const u32x4 bg = *(const u32x4*)(pr + C_BG + c), c1 = *(const u32x4*)(pr + C_CG + c), z1 = *(const u32x4*)(pr + C_Z + c);
          u32x4 c0 = (u32x4){0u, 0u, 0u, 0u}, z0 = c0, c2 = c0, z2 = c0;
          if (t > 0) { c0 = *(const u32x4*)(pr - INC + C_CG + c); z0 = *(const u32x4*)(pr - INC + C_Z + c); }
          if (t < seqmask) { c2 = *(const u32x4*)(pr + INC + C_CG + c); z2 = *(const u32x4*)(pr + INC + C_Z + c); }
          const float* cw = P.conv_w + (size_t)l * 768 + c;
          float o[8];
#pragma unroll
          for (int i = 0; i < 8; ++i) { const int wI = i >> 1; const bool up = i & 1;
#define MX_BF(v) (up ? __uint_as_float((v)[wI] & 0xffff0000u) : __uint_as_float((v)[wI] << 16))
              const float y = MX_BF(c0) * MX_BF(z0) * cw[i] + MX_BF(c1) * MX_BF(z1) * cw[256 + i] + MX_BF(c2) * MX_BF(z2) * cw[512 + i];
              o[i] = MX_BF(bg) * y;
#undef MX_BF
          }
          u32x4 w; w.x = cvtpk(o[0], o[1]); w.y = cvtpk(o[2], o[3]); w.z = cvtpk(o[4], o[5]); w.w = cvtpk(o[6], o[7]);
          *(u32x4*)(MIXo + (size_t)(m0 + row) * D + 256 + c) = w; } }
    asm volatile("s_waitcnt lgkmcnt(0)" ::: "memory");
    asm volatile("s_barrier" ::: "memory");
}
}

__device__ __forceinline__ void phase_mixer(const Ptrs& P, LAS unsigned char* lds, int l, int Mmix) {
    int tid = threadIdx.x; asm volatile("" : "+v"(tid));
    const bf16_t* PROJ = (const bf16_t*)(P.ws + WS_PROJ); bf16_t* MIXo = (bf16_t*)(P.ws + WS_MIX);
    const int G = gridDim.x, c = blockIdx.x;
    const int nLat = (ML / 128) * 4, nCtx = Mmix > ML ? (MC / 128) * 4 : 0, nA = nLat + nCtx, nG = Mmix / 128;
    for (int u = c; u < nA; u += G) {
        if (u < nLat) { const int chunk = u >> 2, kvh = (u >> 1) & 1, hp = u & 1; mx::attn_unit(PROJ, MIXo, P.sink + l * 8, lds, 1, chunk >> 6, chunk & 63, kvh, hp, tid); }
        else { const int v = u - nLat, chunk = v >> 2, kvh = (v >> 1) & 1, hp = v & 1; mx::attn_unit(PROJ, MIXo, P.sink + l * 8, lds, 0, chunk >> 1, chunk & 1, kvh, hp, tid); }
    }
    for (int u = c; u < nG; u += G) mx::gmlp_conv_unit(P, PROJ, MIXo, lds, l, u * 128, tid);
}
constexpr int NPH = 31;
struct KArgs { Ptrs P; int lo, hi; };
__global__ void __launch_bounds__(NTHR, 2) k_fast(KArgs a) {
    extern __shared__ __attribute__((aligned(16))) unsigned char lds_raw[];
    LAS unsigned char* lds = (LAS unsigned char*)lds_raw;
    const int lo = a.lo, hi = a.hi;
#if defined(__HIP_DEVICE_COMPILE__) && defined(USE_KERNARG_RELOAD)
#define LOADP() const __attribute__((address_space(4))) unsigned long long* ap_ = (const __attribute__((address_space(4))) unsigned long long*)__builtin_amdgcn_kernarg_segment_ptr(); asm volatile("" : "+s"(ap_)); \
    Ptrs P; { unsigned long long* d_ = (unsigned long long*)&P; _Pragma("unroll") for (int i_ = 0; i_ < (int)(sizeof(Ptrs) / 8); ++i_) d_[i_] = ap_[i_]; }
#else
#define LOADP() const Ptrs P = a.P
#endif
    unsigned* ctl; { LOADP(); ctl = (unsigned*)(P.ws + WS_CTL); }
    if (threadIdx.x < 4) ((LAS unsigned*)(lds + MISC_OFF))[threadIdx.x] = 0u;
    __syncthreads();
    XcdBarrier bar; bar.bar = ctl + CW_BAR; bar.x = 0; bar.st = (volatile LAS unsigned*)(lds + MISC_OFF);
    if (hi - lo > 1) bar = xcd_barrier_post(ctl + CW_BAR, (volatile LAS unsigned*)(lds + MISC_OFF));
#ifndef PHMASK
#define PHMASK 0xffffffffu
#endif
#define IN(k, kind) (((PHMASK >> (kind)) & 1u) && lo <= (k) && (k) < hi)
#define SEAM(k) do { if (lo <= (k) && (k) + 1 < hi) xcd_barrier(bar); } while (0)
    LAS unsigned* idxtab = (LAS unsigned*)(lds + IDX_OFF);
    LAS int* tst = (LAS int*)(lds + TST_OFF);

    if (IN(0, 0)) { LOADP(); phase_p0a(P, lds); }
    SEAM(0);
    if (IN(1, 1)) { LOADP(); phase_p0b(P); }
    SEAM(1);
    for (int l = 0; l < DEPTH; ++l) {
        const int pb = 2 + 7 * l;
        const int Mmix = l < DEPTH - 1 ? MT : ML;
        if (IN(pb + 0, 2)) { LOADP(); phase_norm<1>(P, lds, l, MT, l == 0 ? P.x : P.out, l == 0 ? P.ctx : (const float*)(P.ws + WS_XC)); }
        SEAM(pb + 0);
        if (IN(pb + 1, 3)) { LOADP();
            SchedDense<INC> S{(const bf16_t*)(P.ws + WS_H), (const bf16_t*)(P.ws + WS_WIN) + (size_t)l * INC * D, MT / 256, (int)gridDim.x, (int)blockIdx.x};
            EpiProj E{(bf16_t*)(P.ws + WS_PROJ), (const float*)(P.ws + WS_ROPE)};
            pg::gemm_phase(lds + RING_OFF, idxtab, S, E);
        }
        SEAM(pb + 1);
        if (IN(pb + 2, 4)) { LOADP(); phase_mixer(P, lds, l, Mmix); }
        SEAM(pb + 2);
        if (IN(pb + 3, 5)) { LOADP(); float* xc = (float*)(P.ws + WS_XC);
            SchedDense<D> S{(const bf16_t*)(P.ws + WS_MIX), (const bf16_t*)(P.ws + WS_WOUT) + (size_t)l * D * D, Mmix / 256, (int)gridDim.x, (int)blockIdx.x};
            EpiRes E{l == 0 ? P.x : P.out, l == 0 ? P.ctx : xc, P.out, xc, (const float*)(P.ws + WS_MOD) + (size_t)l * 9 * 6144 + 2048};
            pg::gemm_phase(lds + RING_OFF, idxtab, S, E);
        }
        SEAM(pb + 3);
        if (IN(pb + 4, 6)) { LOADP(); phase_norm<2>(P, lds, l, Mmix, P.out, (const float*)(P.ws + WS_XC)); }
        SEAM(pb + 4);
        if (IN(pb + 5, 7)) { LOADP(); const ClsRec* listr = (const ClsRec*)(P.ws + WS_LISTR);
            build_tile_table(P, tst, l);
            SchedGU S{(const bf16_t*)(P.ws + WS_H), (const bf16_t*)(P.ws + WS_WGU) + (size_t)l * NE * 1024 * 1024, listr, tst, ctl + CW_CNTC + l * 32, (int)gridDim.x, (int)blockIdx.x};
            EpiGU E{(bf16_t*)(P.ws + WS_PROJ), listr, ctl + CW_CNTC + l * 32};
            pg::gemm_phase(lds + RING_OFF, idxtab, S, E);
        }
        SEAM(pb + 5);
        if (IN(pb + 6, 8)) { LOADP(); const ClsRec* listr = (const ClsRec*)(P.ws + WS_LISTR);
            build_tile_table(P, tst, l);
            SchedDown S{(const bf16_t*)(P.ws + WS_PROJ), (const bf16_t*)(P.ws + WS_WD) + (size_t)l * NE * 1024 * 512, tst, (int)gridDim.x, (int)blockIdx.x};
            EpiDown E{P.out, (float*)(P.ws + WS_XC), (const float*)(P.ws + WS_MOD) + (size_t)l * 9 * 6144 + 5120, listr, ctl + CW_CNTC + l * 32};
            pg::gemm_phase(lds + RING_OFF, idxtab, S, E);
        }
        SEAM(pb + 6);
    }
    if (IN(30, 9)) { LOADP(); phase_final(P); }
#undef IN
#undef SEAM
}
#ifndef FAST_PRO
#define FAST_PRO 1
#endif
#ifndef FAST_N1
#define FAST_N1 1
#endif
#ifndef FAST_G1
#define FAST_G1 1
#endif
#ifndef FAST_MX
#define FAST_MX 1
#endif
#ifndef FAST_G2
#define FAST_G2 1
#endif
#ifndef FAST_N2
#define FAST_N2 1
#endif
#ifndef FAST_MOE
#define FAST_MOE 1
#endif
#ifndef FAST_FN
#define FAST_FN 1
#endif
#ifndef ONE_LAUNCH
#define ONE_LAUNCH 1
#endif
static int g_grid = 256;
static void launch_fast(const Ptrs& P, int lo, int hi, hipStream_t stream) {
    KArgs a{}; a.P = P; a.lo = lo; a.hi = hi;
    hipLaunchKernelGGL(k_fast, dim3(g_grid), dim3(NTHR), LDS_BYTES, stream, a);
}
extern "C" void kernel_launch(void* const* d_in, const int* in_sizes, int n_in, void* d_out, int out_size, void* d_ws, size_t ws_size, hipStream_t stream) {
    static int ready = 0;
    if (!ready) {
        if (n_in != 21 || ws_size < WS_END2) { fprintf(stderr, "kernel_launch: unexpected inputs (%d) or workspace (%zu)\n", n_in, ws_size); ready = -1; return; }
        if (hipFuncSetAttribute((const void*)k_fast, hipFuncAttributeMaxDynamicSharedMemorySize, LDS_BYTES) != hipSuccess) { fprintf(stderr, "kernel_launch: hipFuncSetAttribute failed\n"); ready = -1; return; }
        { int dev = 0, cus = 0, per_cu = 0; (void)hipGetDevice(&dev); (void)hipDeviceGetAttribute(&cus, hipDeviceAttributeMultiprocessorCount, dev);
          if (hipOccupancyMaxActiveBlocksPerMultiprocessor(&per_cu, (const void*)k_fast, NTHR, LDS_BYTES) != hipSuccess || per_cu < 1) { fprintf(stderr, "kernel_launch: occupancy query says %d blocks per CU\n", per_cu); }
          (void)hipGetLastError(); if (cus > 0) g_grid = cus; }
        ready = 1;
    }
    if (ready < 0) return;
    Ptrs P{};
    const float** pp = (const float**)&P;
    for (int i = 0; i < 21; ++i) pp[i] = (const float*)d_in[i];
    P.out = (float*)d_out; P.ws = (unsigned char*)d_ws;
    unsigned char* ws = (unsigned char*)d_ws;
    (void)hipMemsetAsync(ws + WS_CTL, 0, 1 * MiB, stream);
#if ONE_LAUNCH
    launch_fast(P, 0, NPH, stream);
#else
    float* xc = (float*)(ws + WS_XC);
    const float* mod = (const float*)(ws + WS_MOD);
    bf16_t* H = (bf16_t*)(ws + WS_H); bf16_t* MIX = (bf16_t*)(ws + WS_MIX); bf16_t* PROJ = (bf16_t*)(ws + WS_PROJ);
    const unsigned* ctl = (const unsigned*)(ws + WS_CTL);
#if FAST_PRO
    launch_fast(P, 0, 1, stream); launch_fast(P, 1, 2, stream);
#else
    hipLaunchKernelGGL(k_mod, dim3(6144 / 256, DEPTH), dim3(256), 0, stream, P);
    hipLaunchKernelGGL(k_rope_table, dim3(8), dim3(256), 0, stream, P);
#endif
    for (int l = 0; l < DEPTH; ++l) {
        const int pb = 2 + 7 * l;
        const float* xsl = l == 0 ? P.x : P.out; const float* xsc = l == 0 ? P.ctx : xc;
        const int Mmix = l < DEPTH - 1 ? MT : ML;
#if FAST_N1
        launch_fast(P, pb + 0, pb + 1, stream);
#else
        hipLaunchKernelGGL(k_norm<1>, dim3(MT / 4), dim3(256), 0, stream, P, l, MT, xsl, xsc);
#endif
#if FAST_G1
        launch_fast(P, pb + 1, pb + 2, stream);
#else
        { AF_dense af{H, D}; BF_plain bf{P.w_in + (size_t)l * D * INC, INC}; EF_proj ef{PROJ};
          hipLaunchKernelGGL((naive_gemm<AF_dense, BF_plain, EF_proj, false>), dim3(INC / 64, MT / 64), dim3(256), 0, stream, (const unsigned*)nullptr, MT, D, af, bf, ef); }
        hipLaunchKernelGGL(k_rope, dim3((unsigned)(((size_t)MT * 320 + 255) / 256)), dim3(256), 0, stream, P);
#endif
#if FAST_MX
        launch_fast(P, pb + 2, pb + 3, stream);
#else
        hipLaunchKernelGGL(k_gmlp_a, dim3(Mmix / 4), dim3(256), 0, stream, P, l, Mmix);
        hipLaunchKernelGGL(k_gmlp_b, dim3(Mmix), dim3(256), 0, stream, P, l);
        hipLaunchKernelGGL(k_conv, dim3(Mmix), dim3(256), 0, stream, P, l);
        hipLaunchKernelGGL(k_attn, dim3(Mmix / 32), dim3(256), 0, stream, P, l);
#endif
#if FAST_G2
        launch_fast(P, pb + 3, pb + 4, stream);
#else
        { AF_dense af{MIX, D}; BF_plain bf{P.w_out + (size_t)l * D * D, D}; EF_res ef{xsl, xsc, P.out, xc, mod + (size_t)l * 9 * 6144 + 2048};
          hipLaunchKernelGGL((naive_gemm<AF_dense, BF_plain, EF_res, false>), dim3(D / 64, Mmix / 64), dim3(256), 0, stream, (const unsigned*)nullptr, Mmix, D, af, bf, ef); }
#endif
#if FAST_N2
        launch_fast(P, pb + 4, pb + 5, stream);
#else
        hipLaunchKernelGGL(k_norm<2>, dim3(Mmix / 4), dim3(256), 0, stream, P, l, Mmix, (const float*)P.out, (const float*)xc);
#endif
#if FAST_MOE
        launch_fast(P, pb + 5, pb + 6, stream); launch_fast(P, pb + 6, pb + 7, stream);
#else
        for (int e = 0; e < NE; ++e) {
            const int* list = (const int*)(ws + WS_LISTE) + (size_t)e * MT; bf16_t* act = PROJ;
            { AF_gather af{H, list}; BF_dual bf{P.w_gate + ((size_t)l * NE + e) * D * DE, P.w_up + ((size_t)l * NE + e) * D * DE}; EF_gateup ef{act};
              hipLaunchKernelGGL((naive_gemm<AF_gather, BF_dual, EF_gateup, true>), dim3(DE / 64, MT / 64), dim3(256), 0, stream, ctl + CW_CNTE + l * 16 + e, MT, D, af, bf, ef); }
            { AF_dense af{act, DE}; BF_plain bf{P.w_down + ((size_t)l * NE + e) * DE * D, D}; EF_down ef{list, (const Tok*)(ws + WS_TOK), P.out, xc, mod + (size_t)l * 9 * 6144 + 5120, e};
              hipLaunchKernelGGL((naive_gemm<AF_dense, BF_plain, EF_down, false>), dim3(D / 64, MT / 64), dim3(256), 0, stream, ctl + CW_CNTE + l * 16 + e, MT, DE, af, bf, ef); }
        }
#endif
    }
#if FAST_FN
    launch_fast(P, 30, 31, stream);
#else
    hipLaunchKernelGGL(k_final, dim3(ML / 4), dim3(256), 0, stream, P);
#endif
#endif
}
```

```cpp
#include <hip/hip_runtime.h>
#include <stdint.h>
#include <cstdio>

constexpr int D = 1024, NB = 8, SEQ = 8192, DEPTH = 4, CTXL = 256;
constexpr int ML = NB * SEQ;
constexpr int MC = NB * CTXL;
constexpr int MT = ML + MC;
constexpr int INC = 2048;
constexpr int C_U = 0, C_V = 256, C_BG = 512, C_CG = 768, C_Z = 1024, C_Q = 1280, C_K = 1792, C_VV = 1920;
constexpr int NE = 16, DE = 512, NCLS = 24;
constexpr float EPS = 1e-6f;
constexpr float QSCALE = 0.125f * 1.4426950408889634f;
constexpr float LOG2E = 1.4426950408889634f;

typedef unsigned short bf16_t;
typedef float f32x4 __attribute__((ext_vector_type(4)));
typedef unsigned u32x4 __attribute__((ext_vector_type(4)));
typedef unsigned u32x2 __attribute__((ext_vector_type(2)));

__device__ __forceinline__ float bf2f(bf16_t v) { return __uint_as_float((unsigned)v << 16); }
__device__ __forceinline__ bf16_t f2bf(float f) { unsigned u = __float_as_uint(f); return (bf16_t)((u + 0x7fffu + ((u >> 16) & 1u)) >> 16); }
__device__ __forceinline__ unsigned pk2(float lo, float hi) { return (unsigned)f2bf(lo) | ((unsigned)f2bf(hi) << 16); }
__device__ __forceinline__ float gelu_tanh(float x) { const float y = 0.7978845608028654f * (x + 0.044715f * x * x * x); return x / (1.0f + __expf(-2.0f * y)); }
__device__ __forceinline__ float silu_f(float x) { return x / (1.0f + __expf(-x)); }
__device__ __forceinline__ float wave_sum(float v) {
#pragma unroll
    for (int o = 1; o < 64; o <<= 1) v += __shfl_xor(v, o);
    return v;
}

constexpr size_t MiB = 1u << 20;
constexpr size_t WS_CTL = 0;
constexpr size_t WS_MOD = 1 * MiB;
constexpr size_t WS_ROPE = 2 * MiB;
constexpr size_t WS_TOK = 3 * MiB;
constexpr size_t WS_XC = 5 * MiB;
constexpr size_t WS_LISTE = 13 * MiB;
constexpr size_t WS_LISTC = 18 * MiB;
constexpr size_t WS_VN = 25 * MiB;
constexpr size_t WS_WIN = 64 * MiB, WS_WOUT = 80 * MiB, WS_WGU = 88 * MiB, WS_WD = 216 * MiB;
constexpr size_t WS_H = 280 * MiB;
constexpr size_t WS_MIX = 412 * MiB;
constexpr size_t WS_PROJ = 544 * MiB;
constexpr size_t WS_END = 808 * MiB;
constexpr int CW_CNTE = 1024;
constexpr int CW_CNTC = 2048;

struct Tok { unsigned ids; float wlo, whi; unsigned pad; };

struct Ptrs {
    const float *x, *c, *ctx, *c_ctx, *w_mod, *b_mod, *norm1_g, *norm2_g, *w_in, *gmlp_g, *w_s, *b_s, *conv_w, *sink, *w_out, *router_w, *router_b, *w_gate, *w_up, *w_down, *final_g;
    float* out; unsigned char* ws;
};
__device__ __forceinline__ int modrow(int m) { return m < ML ? (m >> 13) : 8; }

__global__ void __launch_bounds__(256) k_mod(Ptrs P) {
    __shared__ float s[9][D];
    const int l = blockIdx.y, n = blockIdx.x * 256 + threadIdx.x;
    for (int i = threadIdx.x; i < 9 * D; i += 256) { const int j = i / D, k = i % D; const float v = j < 8 ? P.c[j * D + k] : P.c_ctx[k]; s[j][k] = silu_f(v); }
    __syncthreads();
    float acc[9];
#pragma unroll
    for (int j = 0; j < 9; ++j) acc[j] = 0.f;
    const float* w = P.w_mod + (size_t)l * D * 6144 + n;
    for (int k = 0; k < D; ++k) { const float wv = w[(size_t)k * 6144];
#pragma unroll
        for (int j = 0; j < 9; ++j) acc[j] += s[j][k] * wv; }
    float* mod = (float*)(P.ws + WS_MOD);
    const float b = P.b_mod[l * 6144 + n];
#pragma unroll
    for (int j = 0; j < 9; ++j) mod[((size_t)l * 9 + j) * 6144 + n] = acc[j] + b;
}
__global__ void k_rope_table(Ptrs P) {
    const int i = threadIdx.x & 15, pos = blockIdx.x * 16 + (threadIdx.x >> 4);
    float* tab = (float*)(P.ws + WS_ROPE);
    const float inv = powf(10000.0f, -(float)i / 16.0f), ang = (float)pos * inv;
    tab[pos * 16 + i] = cosf(ang); tab[2048 + pos * 16 + i] = sinf(ang);
}

template <int WHICH> __global__ void __launch_bounds__(256) k_norm(Ptrs P, int l, int Mrows, const float* xl, const float* xc) {
    const int lane = threadIdx.x & 63, m = blockIdx.x * 4 + (threadIdx.x >> 6);
    if (m >= Mrows) return;
    const float* xr = m < ML ? xl + (size_t)m * D : xc + (size_t)(m - ML) * D;
    const float* mod = (const float*)(P.ws + WS_MOD) + ((size_t)l * 9 + modrow(m)) * 6144;
    const float* sh = mod + (WHICH == 1 ? 0 : 3072); const float* sc = mod + (WHICH == 1 ? 1024 : 4096);
    const float* g = (WHICH == 1 ? P.norm1_g : P.norm2_g) + l * D;
    f32x4 v[4]; float ss = 0.f;
#pragma unroll
    for (int j = 0; j < 4; ++j) { v[j] = *(const f32x4*)(xr + 4 * lane + 256 * j); ss += v[j].x * v[j].x + v[j].y * v[j].y + v[j].z * v[j].z + v[j].w * v[j].w; }
    const float rinv = rsqrtf(wave_sum(ss) * (1.0f / D) + EPS);
    bf16_t* H = (bf16_t*)(P.ws + WS_H) + (size_t)m * D;
    float lg[16];
#pragma unroll
    for (int e = 0; e < 16; ++e) lg[e] = 0.f;
#pragma unroll
    for (int j = 0; j < 4; ++j) { const int c = 4 * lane + 256 * j;
        const f32x4 gg = *(const f32x4*)(g + c), s1 = *(const f32x4*)(sc + c), s0 = *(const f32x4*)(sh + c);
        f32x4 h; h.x = v[j].x * rinv * gg.x * (1.f + s1.x) + s0.x; h.y = v[j].y * rinv * gg.y * (1.f + s1.y) + s0.y; h.z = v[j].z * rinv * gg.z * (1.f + s1.z) + s0.z; h.w = v[j].w * rinv * gg.w * (1.f + s1.w) + s0.w;
        u32x2 o; o.x = pk2(h.x, h.y); o.y = pk2(h.z, h.w); *(u32x2*)(H + c) = o;
        if (WHICH == 2) {
#pragma unroll
            for (int i = 0; i < 4; ++i) { const float hv = i == 0 ? h.x : i == 1 ? h.y : i == 2 ? h.z : h.w; const float* rw = P.router_w + (size_t)(c + i) * 16;
#pragma unroll
                for (int e4 = 0; e4 < 4; ++e4) { const f32x4 r = *(const f32x4*)(rw + 4 * e4); lg[4 * e4] += hv * r.x; lg[4 * e4 + 1] += hv * r.y; lg[4 * e4 + 2] += hv * r.z; lg[4 * e4 + 3] += hv * r.w; } }
        }
    }
    if (WHICH == 2) {
#pragma unroll
        for (int e = 0; e < 16; ++e) lg[e] = wave_sum(lg[e]);
        if (lane == 0) {
            float sco[16], sel[16];
#pragma unroll
            for (int e = 0; e < 16; ++e) { sco[e] = 1.0f / (1.0f + __expf(-lg[e])); sel[e] = sco[e] + P.router_b[e]; }
            int bg = 0; float bgs = -1e30f; int ba = 0, bb = 1; float sa = 0.f, sb = 0.f;
#pragma unroll
            for (int gI = 0; gI < 4; ++gI) {
                int i1 = 0; float v1 = sel[gI * 4], c1 = sco[gI * 4];
#pragma unroll
                for (int i = 1; i < 4; ++i) if (sel[gI * 4 + i] > v1) { v1 = sel[gI * 4 + i]; c1 = sco[gI * 4 + i]; i1 = i; }
                int i2 = -1; float v2 = -1e30f, c2 = 0.f;
#pragma unroll
                for (int i = 0; i < 4; ++i) if (i != i1 && sel[gI * 4 + i] > v2) { v2 = sel[gI * 4 + i]; c2 = sco[gI * 4 + i]; i2 = i; }
                const float gs = v1 + v2;
                if (gs > bgs) { bgs = gs; bg = gI; ba = i1; bb = i2; sa = c1; sb = c2; }
            }
            const int a = ba < bb ? ba : bb, b = ba < bb ? bb : ba;
            const int elo = bg * 4 + a, ehi = bg * 4 + b;
            const float wl = ba < bb ? sa : sb, wh = ba < bb ? sb : sa, inv = 1.0f / (wl + wh);
            const int pairidx = (a == 0) ? (b - 1) : (a == 1 ? (b + 1) : 5);
            const int cls = bg * 6 + pairidx;
            Tok t; t.ids = (unsigned)elo | ((unsigned)ehi << 8) | ((unsigned)cls << 16); t.wlo = wl * inv; t.whi = wh * inv; t.pad = 0u;
            ((Tok*)(P.ws + WS_TOK))[m] = t;
            unsigned* ctl = (unsigned*)(P.ws + WS_CTL);
            int* le = (int*)(P.ws + WS_LISTE); int* lc = (int*)(P.ws + WS_LISTC);
            const unsigned p0 = atomicAdd(ctl + CW_CNTE + l * 16 + elo, 1u); le[(size_t)elo * MT + p0] = m;
            const unsigned p1 = atomicAdd(ctl + CW_CNTE + l * 16 + ehi, 1u); le[(size_t)ehi * MT + p1] = m;
            const unsigned p2 = atomicAdd(ctl + CW_CNTC + l * 32 + cls, 1u); lc[(size_t)cls * MT + p2] = m;
        }
    }
}
__global__ void __launch_bounds__(256) k_final(Ptrs P) {
    const int lane = threadIdx.x & 63, m = blockIdx.x * 4 + (threadIdx.x >> 6);
    float* xr = P.out + (size_t)m * D;
    f32x4 v[4]; float ss = 0.f;
#pragma unroll
    for (int j = 0; j < 4; ++j) { v[j] = *(const f32x4*)(xr + 4 * lane + 256 * j); ss += v[j].x * v[j].x + v[j].y * v[j].y + v[j].z * v[j].z + v[j].w * v[j].w; }
    const float rinv = rsqrtf(wave_sum(ss) * (1.0f / D) + EPS);
#pragma unroll
    for (int j = 0; j < 4; ++j) { const f32x4 g = *(const f32x4*)(P.final_g + 4 * lane + 256 * j); *(f32x4*)(xr + 4 * lane + 256 * j) = v[j] * rinv * g; }
}

template <class AF, class BF, class EF, bool DUAL>
__global__ void __launch_bounds__(256) naive_gemm(const unsigned* mcount, int Mmax, int K, AF af, BF bf, EF ef) {
    int M = Mmax; if (mcount) { const int c = (int)*mcount; M = c < Mmax ? c : Mmax; }
    const int m0 = blockIdx.y * 64, n0 = blockIdx.x * 64; if (m0 >= M) return;
    __shared__ float As[16][68], Bs[16][68], Bs2[DUAL ? 16 : 1][68];
    const int tx = threadIdx.x & 15, ty = threadIdx.x >> 4;
    float acc[4][4], acc2[4][4];
#pragma unroll
    for (int i = 0; i < 4; ++i)
#pragma unroll
        for (int j = 0; j < 4; ++j) { acc[i][j] = 0.f; acc2[i][j] = 0.f; }
    for (int k0 = 0; k0 < K; k0 += 16) {
#pragma unroll
        for (int i = 0; i < 4; ++i) { const int idx = threadIdx.x + 256 * i; const int r = idx >> 4, kk = idx & 15; As[kk][r] = (m0 + r < M) ? af(m0 + r, k0 + kk) : 0.f; }
#pragma unroll
        for (int i = 0; i < 4; ++i) { const int idx = threadIdx.x + 256 * i; const int kk = idx >> 6, c = idx & 63; Bs[kk][c] = bf(k0 + kk, n0 + c, 0); if (DUAL) Bs2[kk][c] = bf(k0 + kk, n0 + c, 1); }
        __syncthreads();
#pragma unroll
        for (int kk = 0; kk < 16; ++kk) {
            float a[4], b[4], b2[4];
#pragma unroll
            for (int i = 0; i < 4; ++i) { a[i] = As[kk][ty * 4 + i]; b[i] = Bs[kk][tx * 4 + i]; b2[i] = DUAL ? Bs2[kk][tx * 4 + i] : 0.f; }
#pragma unroll
            for (int i = 0; i < 4; ++i)
#pragma unroll
                for (int j = 0; j < 4; ++j) { acc[i][j] += a[i] * b[j]; if (DUAL) acc2[i][j] += a[i] * b2[j]; }
        }
        __syncthreads();
    }
#pragma unroll
    for (int i = 0; i < 4; ++i)
#pragma unroll
        for (int j = 0; j < 4; ++j) { const int row = m0 + ty * 4 + i; if (row < M) ef(row, n0 + tx * 4 + j, acc[i][j], acc2[i][j]); }
}
struct AF_dense { const bf16_t* A; long long ld; __device__ float operator()(int r, int k) const { return bf2f(A[(size_t)r * ld + k]); } };
struct AF_gather { const bf16_t* A; const int* list; __device__ float operator()(int r, int k) const { return bf2f(A[(size_t)list[r] * D + k]); } };
struct BF_plain { const float* W; long long ldn; __device__ float operator()(int k, int n, int) const { return W[(size_t)k * ldn + n]; } };
struct BF_dual { const float* W0; const float* W1; __device__ float operator()(int k, int n, int which) const { return (which ? W1 : W0)[(size_t)k * DE + n]; } };
struct EF_proj { bf16_t* O; __device__ void operator()(int r, int c, float v, float) const { O[(size_t)r * INC + c] = f2bf(v); } };
struct EF_res { const float* xsl; const float* xsc; float* xdl; float* xdc; const float* gate;
    __device__ void operator()(int r, int c, float v, float) const {
        const float gv = gate[(size_t)modrow(r) * 6144 + c];
        if (r < ML) xdl[(size_t)r * D + c] = xsl[(size_t)r * D + c] + gv * v; else xdc[(size_t)(r - ML) * D + c] = xsc[(size_t)(r - ML) * D + c] + gv * v; } };
struct EF_gateup { bf16_t* O; __device__ void operator()(int r, int c, float g, float u) const { O[(size_t)r * DE + c] = f2bf(silu_f(g) * u); } };
struct EF_down { const int* list; const Tok* tok; float* xl; float* xc; const float* gate; long long e;
    __device__ void operator()(int r, int c, float v, float) const {
        const int m = list[r]; const Tok t = tok[m]; const float w = ((int)(t.ids & 255u) == (int)e) ? t.wlo : t.whi;
        const float gv = gate[(size_t)modrow(m) * 6144 + c];
        if (m < ML) xl[(size_t)m * D + c] += gv * w * v; else xc[(size_t)(m - ML) * D + c] += gv * w * v; } };

__global__ void __launch_bounds__(256) k_rope(Ptrs P) {
    const size_t gid = (size_t)blockIdx.x * 256 + threadIdx.x; const int m = (int)(gid / 320), r = (int)(gid % 320);
    if (m >= MT) return;
    const int head = r / 32, pr = r % 32, a = pr / 16, i = pr % 16;
    bf16_t* p = (bf16_t*)(P.ws + WS_PROJ) + (size_t)m * INC + (head < 8 ? C_Q + head * 64 : C_K + (head - 8) * 64) + a * 32 + i;
    float t1 = bf2f(p[0]), t2 = bf2f(p[16]);
    if (m < ML) { const int t = m & (SEQ - 1); const int pos = a == 0 ? (t >> 6) : (t & 63); const float* tab = (const float*)(P.ws + WS_ROPE);
        const float cs = tab[pos * 16 + i], sn = tab[2048 + pos * 16 + i]; const float o1 = t1 * cs - t2 * sn, o2 = t2 * cs + t1 * sn; t1 = o1; t2 = o2; }
    if (head < 8) { t1 *= QSCALE; t2 *= QSCALE; }
    p[0] = f2bf(t1); p[16] = f2bf(t2);
}
__global__ void __launch_bounds__(256) k_gmlp_a(Ptrs P, int l, int Mrows) {
    const int lane = threadIdx.x & 63, m = blockIdx.x * 4 + (threadIdx.x >> 6); if (m >= Mrows) return;
    const bf16_t* v = (const bf16_t*)(P.ws + WS_PROJ) + (size_t)m * INC + C_V + 4 * lane;
    float g[4]; float ss = 0.f;
#pragma unroll
    for (int i = 0; i < 4; ++i) { g[i] = gelu_tanh(bf2f(v[i])); ss += g[i] * g[i]; }
    const float rinv = rsqrtf(wave_sum(ss) * (1.0f / 256.0f) + EPS);
    bf16_t* o = (bf16_t*)(P.ws + WS_VN) + (size_t)m * 256 + 4 * lane;
#pragma unroll
    for (int i = 0; i < 4; ++i) o[i] = f2bf(g[i] * rinv * P.gmlp_g[l * 256 + 4 * lane + i]);
}
__global__ void __launch_bounds__(256) k_gmlp_b(Ptrs P, int l) {
    const int m = blockIdx.x, c = threadIdx.x, p = m & 127, base = m - p, h = c >> 6;
    const float* ws = P.w_s + (((size_t)l * 4 + h) * 128 + p) * 128;
    const bf16_t* vn = (const bf16_t*)(P.ws + WS_VN) + (size_t)base * 256 + c;
    float s = P.b_s[(l * 4 + h) * 128 + p];
    for (int q = 0; q < 128; ++q) s += ws[q] * bf2f(vn[(size_t)q * 256]);
    const float u = gelu_tanh(bf2f(((const bf16_t*)(P.ws + WS_PROJ))[(size_t)m * INC + C_U + c]));
    ((bf16_t*)(P.ws + WS_MIX))[(size_t)m * D + c] = f2bf(u * s);
}
__global__ void __launch_bounds__(256) k_conv(Ptrs P, int l) {
    const int m = blockIdx.x, c = threadIdx.x;
    const int seqlen = m < ML ? SEQ : CTXL, t = m < ML ? (m & (SEQ - 1)) : ((m - ML) & (CTXL - 1));
    const bf16_t* pr = (const bf16_t*)(P.ws + WS_PROJ) + (size_t)m * INC;
    const float* w = P.conv_w + (size_t)l * 3 * 256;
    float y = bf2f(pr[C_CG + c]) * bf2f(pr[C_Z + c]) * w[256 + c];
    if (t > 0) y += bf2f(pr[C_CG + c - INC]) * bf2f(pr[C_Z + c - INC]) * w[c];
    if (t < seqlen - 1) y += bf2f(pr[C_CG + c + INC]) * bf2f(pr[C_Z + c + INC]) * w[512 + c];
    ((bf16_t*)(P.ws + WS_MIX))[(size_t)m * D + 256 + c] = f2bf(bf2f(pr[C_BG + c]) * y);
}
__global__ void __launch_bounds__(256) k_attn(Ptrs P, int l) {
    const int m = blockIdx.x * 32 + (threadIdx.x & 31), h = threadIdx.x >> 5, kvh = h >> 2;
    const bf16_t* proj = (const bf16_t*)(P.ws + WS_PROJ);
    float q[64], o[64];
    { const bf16_t* qp = proj + (size_t)m * INC + C_Q + h * 64;
#pragma unroll
      for (int d = 0; d < 64; ++d) { q[d] = bf2f(qp[d]); o[d] = 0.f; } }
    float mrun = P.sink[l * 8 + h] * LOG2E, lsum = 1.0f;
    int b, lo = 0, hi = -1;
    if (m < ML) { b = m >> 13; const int t = m & (SEQ - 1); lo = t - 128 < 0 ? 0 : t - 128; hi = t + 128 > SEQ - 1 ? SEQ - 1 : t + 128; } else b = (m - ML) >> 8;
    const int nloc = hi - lo + 1;
    for (int j = 0; j < nloc + CTXL; ++j) {
        const size_t krow = j < nloc ? (size_t)b * SEQ + lo + j : (size_t)ML + b * CTXL + (j - nloc);
        const bf16_t* kp = proj + krow * INC + C_K + kvh * 64; const bf16_t* vp = proj + krow * INC + C_VV + kvh * 64;
        float s = 0.f;
#pragma unroll
        for (int d8 = 0; d8 < 8; ++d8) { const u32x4 kk = *(const u32x4*)(kp + 8 * d8);
#pragma unroll
            for (int i = 0; i < 4; ++i) { s += q[8 * d8 + 2 * i] * __uint_as_float(kk[i] << 16); s += q[8 * d8 + 2 * i + 1] * __uint_as_float(kk[i] & 0xffff0000u); } }
        if (s > mrun) { const float f = exp2f(mrun - s); lsum *= f;
#pragma unroll
            for (int d = 0; d < 64; ++d) o[d] *= f;
            mrun = s; }
        const float p = exp2f(s - mrun); lsum += p;
#pragma unroll
        for (int d8 = 0; d8 < 8; ++d8) { const u32x4 vv = *(const u32x4*)(vp + 8 * d8);
#pragma unroll
            for (int i = 0; i < 4; ++i) { o[8 * d8 + 2 * i] += p * __uint_as_float(vv[i] << 16); o[8 * d8 + 2 * i + 1] += p * __uint_as_float(vv[i] & 0xffff0000u); } }
    }
    const float inv = 1.0f / lsum;
    bf16_t* op = (bf16_t*)(P.ws + WS_MIX) + (size_t)m * D + 512 + h * 64;
#pragma unroll
    for (int d = 0; d < 64; ++d) op[d] = f2bf(o[d] * inv);
}

#define LAS __attribute__((address_space(3)))
#define XB_TMO      128
#define XB_XCNT(j)  (256  + 64 * (j))
#define XB_XSUB(j)  (1280 + 64 * (j))
#define XB_XGEN(j)  (2304 + 64 * (j))
#define XB_TOP      3328
#define XB_TOPGEN   3392
#define XCD_BAR_WORDS 3456
#define XB_SPIN_CAP (1u << 18)

__device__ __forceinline__ unsigned xb_ld(unsigned* p)              { return __hip_atomic_load(p, __ATOMIC_RELAXED, __HIP_MEMORY_SCOPE_AGENT); }
__device__ __forceinline__ unsigned xb_add(unsigned* p, unsigned v) { return __hip_atomic_fetch_add(p, v, __ATOMIC_RELAXED, __HIP_MEMORY_SCOPE_AGENT); }
__device__ __forceinline__ unsigned xb_xcc_id() { return (unsigned)__builtin_amdgcn_s_getreg((3 << 11) | 20) & 0xFu; }
#define XB_SPIN(cond, bar) do { unsigned _sp = 0; while (cond) { __builtin_amdgcn_s_sleep(1); \
    if ((++_sp & 255u) == 0u) { if (xb_ld(&(bar)[XB_TMO])) break; if (_sp > XB_SPIN_CAP) { atomicAdd(&(bar)[XB_TMO], 1u); break; } } } } while (0)

struct XcdBarrier {
    unsigned* bar; unsigned x;
    volatile LAS unsigned* st;
};

__device__ __forceinline__ XcdBarrier xcd_barrier_post(unsigned* bar, volatile LAS unsigned* st) {
    XcdBarrier b; b.bar = bar; b.x = xb_xcc_id(); b.st = st;
    if (threadIdx.x == 0) (void)xb_add(&bar[XB_XCNT(b.x)], 1u);
    return b;
}
__device__ __forceinline__ void xcd_barrier_complete(unsigned* bar, unsigned x, unsigned& nloc, unsigned& nx) {
    const unsigned G = gridDim.x * gridDim.y * gridDim.z;
    unsigned sum, cnt, mine, sp = 0u;
    for (;;) {
        sum = 0u; cnt = 0u; mine = 0u;
#pragma unroll
        for (unsigned j = 0; j < 16; ++j) { const unsigned c = xb_ld(&bar[XB_XCNT(j)]); sum += c; cnt += (c > 0u) ? 1u : 0u; mine = (j == x) ? c : mine; }
        if (sum == G) break;
        __builtin_amdgcn_s_sleep(1);
        if ((++sp & 255u) == 0u) { if (xb_ld(&bar[XB_TMO])) break; if (sp > XB_SPIN_CAP) { atomicAdd(&bar[XB_TMO], 1u); break; } }
    }
    nloc = mine > 0u ? mine : 1u; nx = cnt > 0u ? cnt : 1u;
}

__device__ __forceinline__ void xcd_barrier(const XcdBarrier& b) {
    asm volatile("s_waitcnt vmcnt(0)" ::: "memory");
    __syncthreads();
    if (threadIdx.x == 0) {
        unsigned* bar = b.bar;
        __builtin_amdgcn_s_waitcnt(0);
        unsigned nloc = b.st[0], nx = b.st[1];
        if (nloc == 0u) { xcd_barrier_complete(bar, b.x, nloc, nx); b.st[0] = nloc; b.st[1] = nx; }
        const unsigned old = xb_add(&bar[XB_XSUB(b.x)], 1u);
        const unsigned gen = old / nloc;
        if (old + 1u == (gen + 1u) * nloc) {
            __builtin_amdgcn_fence(__ATOMIC_RELEASE, "agent");
            asm volatile("s_waitcnt vmcnt(0)" ::: "memory");
            const unsigned og = xb_add(&bar[XB_TOP], 1u);
            const unsigned tg = og / nx;
            if (og + 1u == (tg + 1u) * nx) xb_add(&bar[XB_TOPGEN], 1u);
            else XB_SPIN(xb_ld(&bar[XB_TOPGEN]) == tg, bar);
            __builtin_amdgcn_fence(__ATOMIC_ACQUIRE, "agent");
            xb_add(&bar[XB_XGEN(b.x)], 1u);
            asm volatile("s_waitcnt vmcnt(0)" ::: "memory");
        } else {
            XB_SPIN(xb_ld(&bar[XB_XGEN(b.x)]) == gen, bar);
            __builtin_amdgcn_fence(__ATOMIC_ACQUIRE, "agent");
            asm volatile("s_waitcnt vmcnt(0)" ::: "memory");
        }
    }
    __syncthreads();
}
typedef short bf16x8 __attribute__((ext_vector_type(8)));
namespace pg {
constexpr int BM = 256, BK = 64, HALF = 128, HTB = HALF * BK * 2  , STAGE_BYTES = 8 * HTB, NXCD = 8, WGM = 8;
__host__ __device__ __forceinline__ int lds_byte(int r, int c) { const int st = (r >> 4) * 2 + (c >> 5), rr = r & 15, cc = c & 31, ob = rr * 64 + cc * 2; return st * 1024 + (ob ^ (((ob >> 9) & 1) << 5)); }
__host__ __device__ __forceinline__ void stage_rc(int b, int& R, int& C) { const int st = b / 1024, sb = b % 1024, swz = sb ^ (((sb >> 9) & 1) << 5); R = (st >> 1) * 16 + swz / 64; C = (st & 1) * 32 + (swz % 64) / 2; }

struct Unit { int pm, pn, x0, x1; };

__device__ __forceinline__ void order_unit(int L, int nM, int nN, int& pm, int& pn) {
    const int nwg = nM * nN; int wgid = L;
    { const int q = nwg / NXCD, r = nwg % NXCD, xcd = wgid % NXCD, off = wgid / NXCD; wgid = (xcd < r ? xcd * (q + 1) : r * (q + 1) + (xcd - r) * q) + off; }
    const int nig = WGM * nN, gid = wgid / nig, fm = gid * WGM, gsz = (nM - fm) < WGM ? (nM - fm) : WGM;
    pm = fm + ((wgid % nig) % gsz); pn = (wgid % nig) / gsz;
}

template <class Sched, class Epi>
__device__ __forceinline__ void gemm_phase(LAS unsigned char* lds, LAS unsigned* idxtab, const Sched& S, const Epi& E) {
    constexpr int K = Sched::K, LDA = Sched::LDA, LDB = Sched::LDB, nt = K / BK, KS = Sched::KSPLIT; constexpr bool GATHER = Sched::GATHER;
    int tid = threadIdx.x; asm volatile("" : "+v"(tid));
    const int wid = __builtin_amdgcn_readfirstlane(tid >> 6), lane = tid & 63, wr = wid >> 2, wc = wid & 3, fr = lane & 15, fq = lane >> 4;
    unsigned voffA[2], voffB[2], cbyte[2];
#pragma unroll
    for (int i = 0; i < 2; ++i) { int R, C; stage_rc(tid * 16 + i * 8192, R, C); voffA[i] = (unsigned)(R * LDA + C) * 2u; voffB[i] = (unsigned)(R * LDB + C) * 2u; cbyte[i] = (unsigned)C * 2u; }
    constexpr size_t kstep = (size_t)(BK * 2);
    constexpr size_t hstepA = (size_t)HALF * LDA * 2, hstepB = (size_t)HALF * LDB * 2;
    const unsigned ldsw = (unsigned)wid * 1024u;
    const int aoff = lds_byte(wr * 64 + fr, fq * 8), boff = lds_byte(wc * 32 + fr, fq * 8);
    unsigned cv[2][2];
#define PG_SA(b, h) (((b) * 2 + (h)) * HTB)
#define PG_SB(b, h) ((4 + (b) * 2 + (h)) * HTB)
#define PG_STAGE_B(bufoff, gbase) do { _Pragma("unroll") for (int _i = 0; _i < 2; ++_i) \
        __builtin_amdgcn_global_load_lds((const unsigned*)((const char*)(gbase) + voffB[_i]), (LAS unsigned*)(lds + (bufoff) + ldsw + _i * 8192), 16, 0, 0); } while (0)
#define PG_STAGE_A(bufoff, gbase, h, V) do { _Pragma("unroll") for (int _i = 0; _i < 2; ++_i) { \
        const char* _p = GATHER ? (const char*)(gbase) + V[h][_i] : (const char*)(gbase) + ((h) ? hstepA : 0) + voffA[_i]; \
        __builtin_amdgcn_global_load_lds((const unsigned*)_p, (LAS unsigned*)(lds + (bufoff) + ldsw + _i * 8192), 16, 0, 0); } } while (0)
#define PG_LDA(dst, b, h) do { _Pragma("unroll") for (int m = 0; m < 4; ++m) _Pragma("unroll") for (int k = 0; k < 2; ++k) dst[m][k] = *(const LAS bf16x8*)(lds + PG_SA(b, h) + aoff + m * 2048 + k * 1024); } while (0)
#define PG_LDB(dst, b, h) do { _Pragma("unroll") for (int n = 0; n < 2; ++n) _Pragma("unroll") for (int k = 0; k < 2; ++k) dst[n][k] = *(const LAS bf16x8*)(lds + PG_SB(b, h) + boff + n * 2048 + k * 1024); } while (0)
#define PG_MMA(ai, bj, At, Bt) do { __builtin_amdgcn_s_setprio(1); _Pragma("unroll") for (int m = 0; m < 4; ++m) _Pragma("unroll") for (int n = 0; n < 2; ++n) _Pragma("unroll") for (int k = 0; k < 2; ++k) \
        acc[ai][bj][m][n] = __builtin_amdgcn_mfma_f32_16x16x32_bf16(Bt[n][k], At[m][k], acc[ai][bj][m][n], 0, 0, 0); __builtin_amdgcn_s_setprio(0); } while (0)
#define PG_WAIT_V(n) asm volatile("s_waitcnt vmcnt(" #n ")" ::: "memory")
#define PG_WAIT_L(n) asm volatile("s_waitcnt lgkmcnt(" #n ")" ::: "memory")
#define PG_BAR __builtin_amdgcn_s_barrier()
#define PG_SCHED __builtin_amdgcn_sched_barrier(0)
#define PG_IDX_ISSUE(u) do { const int _h = lane >> 5, _i = (lane >> 4) & 1, _r = lane & 15; const int _pos = _h * 128 + ((wid + 8 * _i) >> 1) * 16 + _r; \
        __builtin_amdgcn_global_load_lds(S.idx_src(u) + 4 * _pos, (LAS unsigned*)(idxtab + wid * 64), 4, 0, 0); } while (0)
#define PG_IDX_READ(u, V) do { const int _vr = S.valid_rows(u); _Pragma("unroll") for (int _h = 0; _h < 2; ++_h) _Pragma("unroll") for (int _i = 0; _i < 2; ++_i) { \
        const int _pos = _h * 128 + ((wid + 8 * _i) >> 1) * 16 + (lane >> 2); unsigned _tk = *(volatile LAS unsigned*)(idxtab + wid * 64 + _h * 32 + _i * 16 + (lane >> 2)); \
        _tk = _pos < _vr ? _tk : 0u; V[_h][_i] = _tk * (unsigned)(LDA * 2) + cbyte[_i]; } } while (0)
    Unit cur, nxt; int ui = 0;
    if (!S.next(0, cur)) return;
    f32x4 acc[2][2][4][2];
#pragma unroll
    for (int a = 0; a < 2; ++a)
#pragma unroll
        for (int b = 0; b < 2; ++b)
#pragma unroll
            for (int m = 0; m < 4; ++m)
#pragma unroll
                for (int n = 0; n < 2; ++n) acc[a][b][m][n] = (f32x4){0.f, 0.f, 0.f, 0.f};
    bf16x8 At[4][2], B0[2][2], B1[2][2];
    const char* cA = S.a_base(cur); const char* cB0 = S.b_base(cur, 0); const char* cB1 = S.b_base(cur, 1);
#pragma unroll
    for (int h = 0; h < 2; ++h)
#pragma unroll
        for (int i = 0; i < 2; ++i) cv[h][i] = 0u;
    if constexpr (GATHER) { PG_IDX_ISSUE(cur); PG_WAIT_V(0); PG_IDX_READ(cur, cv); }
    PG_STAGE_B(PG_SB(0, 0), cB0); PG_STAGE_B(PG_SB(0, 1), cB0 + hstepB); PG_STAGE_A(PG_SA(0, 0), cA, 0, cv); PG_STAGE_A(PG_SA(0, 1), cA, 1, cv);
    if (wr == 1) PG_BAR;
    PG_WAIT_V(2); PG_BAR;
    PG_STAGE_B(PG_SB(1, 0), cB0 + kstep); PG_STAGE_A(PG_SA(1, 0), cA + kstep, 0, cv); PG_STAGE_B(PG_SB(1, 1), cB0 + hstepB + kstep);
    PG_WAIT_V(6); PG_BAR;
    for (;;) {
        const bool has_next = S.next(ui + 1, nxt);
        const char* nA = has_next ? S.a_base(nxt) : cA; const char* nB0 = has_next ? S.b_base(nxt, 0) : cB0; const char* nB1 = has_next ? S.b_base(nxt, 1) : cB1;
        if constexpr (GATHER) { if (has_next) PG_IDX_ISSUE(nxt); }
        for (int t = 0; t < nt; t += 2) {
            const bool last = (t == nt - 2);
            const char* a1 = cA + (size_t)(t + 1) * kstep;
            const char* a2 = last ? nA : cA + (size_t)(t + 2) * kstep; const char* a3 = a2 + kstep;
            const char* b2 = last ? nB0 : ((t + 2) < KS ? cB0 : cB1) + (size_t)(t + 2) * kstep;
            const char* b3 = last ? nB0 + kstep : ((t + 3) < KS ? cB0 : cB1) + (size_t)(t + 3) * kstep;
            PG_LDB(B0, 0, 0); PG_LDB(B1, 0, 1); PG_SCHED; PG_LDA(At, 0, 0); PG_STAGE_A(PG_SA(1, 1), a1, 1, cv);
            if constexpr (GATHER) { if (last && has_next) { PG_IDX_READ(nxt, cv); } }
            PG_WAIT_V(8); PG_WAIT_L(0); PG_BAR; PG_MMA(0, 0, At, B0); PG_MMA(0, 1, At, B1); PG_BAR; PG_SCHED;
            PG_LDA(At, 0, 1); PG_STAGE_B(PG_SB(0, 0), b2); PG_STAGE_B(PG_SB(0, 1), b2 + hstepB); PG_STAGE_A(PG_SA(0, 0), a2, 0, cv);
            PG_WAIT_V(8); PG_WAIT_L(0); PG_BAR; PG_MMA(1, 0, At, B0); PG_MMA(1, 1, At, B1); PG_BAR; PG_SCHED;
            PG_LDB(B0, 1, 0); PG_LDB(B1, 1, 1); PG_SCHED; PG_LDA(At, 1, 0); PG_STAGE_A(PG_SA(0, 1), a2, 1, cv);
            PG_WAIT_V(8); PG_WAIT_L(0); PG_BAR; PG_MMA(0, 0, At, B0); PG_MMA(0, 1, At, B1); PG_BAR; PG_SCHED;
            PG_LDA(At, 1, 1); PG_STAGE_B(PG_SB(1, 0), b3); PG_STAGE_B(PG_SB(1, 1), b3 + hstepB); PG_STAGE_A(PG_SA(1, 0), a3, 0, cv);
            PG_WAIT_V(8); PG_WAIT_L(0); PG_BAR; PG_MMA(1, 0, At, B0); PG_MMA(1, 1, At, B1); PG_BAR; PG_SCHED;
        }
        if (wr == 0) PG_BAR;
        E(acc, cur, wr, wc, fr, fq);
        if (!has_next) break;
#pragma unroll
        for (int a = 0; a < 2; ++a)
#pragma unroll
            for (int b = 0; b < 2; ++b)
#pragma unroll
                for (int m = 0; m < 4; ++m)
#pragma unroll
                    for (int n = 0; n < 2; ++n) acc[a][b][m][n] = (f32x4){0.f, 0.f, 0.f, 0.f};
        cur = nxt; cA = nA; cB0 = nB0; cB1 = nB1; ++ui;
        if (wr == 1) PG_BAR;
    }
    PG_WAIT_V(0);
    PG_BAR;
#undef PG_SA
#undef PG_SB
#undef PG_STAGE_A
#undef PG_STAGE_B
#undef PG_LDA
#undef PG_LDB
#undef PG_MMA
#undef PG_WAIT_V
#undef PG_WAIT_L
#undef PG_BAR
#undef PG_SCHED
#undef PG_IDX_ISSUE
#undef PG_IDX_READ
}
}
constexpr int NWAVES = 8, NTHR = 512;
constexpr int RING_OFF = 0, RING_BYTES = 131072;
constexpr int IDX_OFF = RING_BYTES;
constexpr int TST_OFF = IDX_OFF + 2048;
constexpr int MISC_OFF = TST_OFF + 128;
constexpr int LDS_BYTES = 147456;
constexpr size_t WS_MODP = WS_VN;
constexpr size_t WS_WSB = 62 * MiB;
constexpr int CW_CNTF = 16384;
constexpr int CW_BAR = 8192;
constexpr int MAXT = 288;

struct ClsRec { int m; float wlo, whi; int pad; };
constexpr size_t WS_LISTR = 816 * MiB;
constexpr size_t WS_END2 = 848 * MiB;

__device__ __forceinline__ void cls_experts(int cls, int& elo, int& ehi) {
    const int g = cls / 6, p = cls % 6; const int a = p < 3 ? 0 : (p < 5 ? 1 : 2), b = p < 3 ? p + 1 : (p < 5 ? p - 1 : 3);
    elo = g * 4 + a; ehi = g * 4 + b;
}
__device__ __forceinline__ unsigned cvt_pk_bf16(float lo, float hi) { unsigned r; asm volatile("v_cvt_pk_bf16_f32 %0, %1, %2" : "=v"(r) : "v"(lo), "v"(hi)); return r; }

template <int N_> struct SchedDense {
    static constexpr int K = 1024, LDA = 1024, LDB = 1024, KSPLIT = 16; static constexpr bool GATHER = false;
    const bf16_t* A; const bf16_t* Bt; int nM, G, c;
    __device__ __forceinline__ bool next(int i, pg::Unit& u) const { const long L = (long)i * G + c; if (L >= (long)nM * (N_ / 256)) return false; pg::order_unit((int)L, nM, N_ / 256, u.pm, u.pn); u.x0 = 0; u.x1 = 0; return true; }
    __device__ __forceinline__ const char* a_base(const pg::Unit& u) const { return (const char*)A + (size_t)u.pm * 256 * LDA * 2; }
    __device__ __forceinline__ const char* b_base(const pg::Unit& u, int) const { return (const char*)Bt + (size_t)u.pn * 256 * LDB * 2; }
    __device__ __forceinline__ const unsigned* idx_src(const pg::Unit&) const { return nullptr; }
    __device__ __forceinline__ int valid_rows(const pg::Unit&) const { return 256; }
};
__device__ __forceinline__ void cls_of_tile(const LAS int* tst, int T, int& cls, int& rt) {
    int c = 0;
#pragma unroll
    for (int k = 1; k < NCLS; ++k) c += (T >= tst[k]) ? 1 : 0;
    cls = __builtin_amdgcn_readfirstlane(c); rt = __builtin_amdgcn_readfirstlane(T - tst[c]);
}
struct SchedGU {
    static constexpr int K = 1024, LDA = 1024, LDB = 1024, KSPLIT = 16; static constexpr bool GATHER = true;
    const bf16_t* H; const bf16_t* Wgu; const ClsRec* list; const LAS int* tst; const unsigned* cnt; int G, c;
    __device__ __forceinline__ bool next(int i, pg::Unit& u) const { const int TT = __builtin_amdgcn_readfirstlane(tst[NCLS]); const long L = (long)i * G + c; if (L >= (long)TT * 8) return false;
        pg::order_unit((int)L, TT, 8, u.pm, u.pn); cls_of_tile(tst, u.pm, u.x0, u.x1); return true; }
    __device__ __forceinline__ const char* a_base(const pg::Unit&) const { return (const char*)H; }
    __device__ __forceinline__ const char* b_base(const pg::Unit& u, int) const { int elo, ehi; cls_experts(u.x0, elo, ehi); const int e = u.pn < 4 ? elo : ehi;
        return (const char*)Wgu + ((size_t)e * 1024 + (size_t)(u.pn & 3) * 256) * LDB * 2; }
    __device__ __forceinline__ const unsigned* idx_src(const pg::Unit& u) const { return (const unsigned*)(list + (size_t)u.x0 * MT + (size_t)u.x1 * 256); }
    __device__ __forceinline__ int valid_rows(const pg::Unit& u) const { return (int)cnt[u.x0 * 64] - u.x1 * 256; }
};
struct SchedDown {
    static constexpr int K = 1024, LDA = 1024, LDB = 512, KSPLIT = 8; static constexpr bool GATHER = false;
    const bf16_t* ACT; const bf16_t* Wd; const LAS int* tst; int G, c;
    __device__ __forceinline__ bool next(int i, pg::Unit& u) const { const int TT = __builtin_amdgcn_readfirstlane(tst[NCLS]); const long L = (long)i * G + c; if (L >= (long)TT * 4) return false;
        pg::order_unit((int)L, TT, 4, u.pm, u.pn); cls_of_tile(tst, u.pm, u.x0, u.x1); return true; }
    __device__ __forceinline__ const char* a_base(const pg::Unit& u) const { return (const char*)ACT + (size_t)u.pm * 256 * LDA * 2; }
    __device__ __forceinline__ const char* b_base(const pg::Unit& u, int part) const { int elo, ehi; cls_experts(u.x0, elo, ehi); const int e = part ? ehi : elo;
        return (const char*)Wd + ((size_t)e * 1024 + (size_t)u.pn * 256) * LDB * 2 - (part ? (size_t)KSPLIT * 128 : 0); }
    __device__ __forceinline__ const unsigned* idx_src(const pg::Unit&) const { return nullptr; }
    __device__ __forceinline__ int valid_rows(const pg::Unit&) const { return 256; }
};

#define OPAQUE(x) asm volatile("" : "+v"(x))
#define ROWSTEP(m) ((m) == 3 ? 80 : 16)
struct EpiProj {
    bf16_t* O; const float* tab;
    __device__ __forceinline__ void operator()(const f32x4 (&acc)[2][2][4][2], const pg::Unit& u, int wr, int wc, int fr, int fq) const {
        const bool latent = u.pm < ML / 256;
        char* base = (char*)(O + (size_t)u.pm * 256 * INC + u.pn * 256);
        unsigned off = (unsigned)((wr * 64 + fr) * INC + wc * 32 + 4 * fq) * 2u;
        int t = ((u.pm * 256) & (SEQ - 1)) + wr * 64 + fr;
#pragma unroll
        for (int ai = 0; ai < 2; ++ai)
#pragma unroll
            for (int m = 0; m < 4; ++m) { char* rowp = base + off;
                const int pos = (wc & 1) ? (t & 63) : (t >> 6);
#pragma unroll
                for (int bj = 0; bj < 2; ++bj) { f32x4 v0 = acc[ai][bj][m][0], v1 = acc[ai][bj][m][1];
                    const bool rope = latent && (u.pn == 5 || u.pn == 6 || (u.pn == 7 && bj == 0));
                    if (rope) { const f32x4 cs = *(const f32x4*)(tab + pos * 16 + 4 * fq), sn = *(const f32x4*)(tab + 2048 + pos * 16 + 4 * fq);
                        const f32x4 o1 = v0 * cs - v1 * sn, o2 = v1 * cs + v0 * sn; v0 = o1; v1 = o2; }
                    u32x2 w0, w1; w0.x = cvt_pk_bf16(v0[0], v0[1]); w0.y = cvt_pk_bf16(v0[2], v0[3]); w1.x = cvt_pk_bf16(v1[0], v1[1]); w1.y = cvt_pk_bf16(v1[2], v1[3]);
                    *(u32x2*)(rowp + bj * 256) = w0; *(u32x2*)(rowp + bj * 256 + 32) = w1; }
                off += (unsigned)(ROWSTEP(m) * INC * 2); t += ROWSTEP(m); OPAQUE(off); OPAQUE(t); }
    }
};
template <bool DRY = false> struct EpiRes {
    const float* xsl; const float* xsc; float* xdl; float* xdc; const float* gate;
    __device__ __forceinline__ void operator()(const f32x4 (&acc)[2][2][4][2], const pg::Unit& u, int wr, int wc, int fr, int fq) const {
        const bool latent = u.pm < ML / 256; const int mb = latent ? (u.pm >> 5) : 8;
        const size_t tb = (size_t)(latent ? u.pm : u.pm - ML / 256) * 256 * D + u.pn * 256;
        const char* xs = (const char*)((latent ? xsl : xsc) + tb); char* xd = (char*)((latent ? xdl : xdc) + tb);
        unsigned off = (unsigned)((wr * 64 + fr) * D + wc * 32 + 4 * fq) * 4u;
        f32x4 gv[2][2];
#pragma unroll
        for (int bj = 0; bj < 2; ++bj)
#pragma unroll
            for (int n = 0; n < 2; ++n) gv[bj][n] = *(const f32x4*)(gate + (size_t)mb * 6144 + u.pn * 256 + wc * 32 + 4 * fq + bj * 128 + n * 16);
#pragma unroll
        for (int ai = 0; ai < 2; ++ai)
#pragma unroll
            for (int m = 0; m < 4; ++m) {
#pragma unroll
                for (int bj = 0; bj < 2; ++bj)
#pragma unroll
                    for (int n = 0; n < 2; ++n) { const f32x4 xv = *(const f32x4*)(xs + off + bj * 512 + n * 64); f32x4 rv = xv + gv[bj][n] * acc[ai][bj][m][n]; if (DRY) asm volatile("" :: "v"(rv)); else *(f32x4*)(xd + off + bj * 512 + n * 64) = rv; }
                off += (unsigned)(ROWSTEP(m) * D * 4); OPAQUE(off); }
    }
};
struct EpiGU {
    bf16_t* ACT; const ClsRec* list; const unsigned* cnt;
    __device__ __forceinline__ void operator()(const f32x4 (&acc)[2][2][4][2], const pg::Unit& u, int wr, int wc, int fr, int fq) const {
        const int vr = (int)cnt[u.x0 * 64] - u.x1 * 256; const char* rec = (const char*)(list + (size_t)u.x0 * MT + (size_t)u.x1 * 256) + (u.pn >= 4 ? 8 : 4);
        char* base = (char*)(ACT + (size_t)u.pm * 256 * 1024 + (u.pn >> 2) * 512 + (u.pn & 3) * 128);
        int r = wr * 64 + fr; unsigned off = (unsigned)(r * 1024 + wc * 16 + 4 * fq) * 2u;
#pragma unroll
        for (int ai = 0; ai < 2; ++ai)
#pragma unroll
            for (int m = 0; m < 4; ++m) { float w = 0.f;
                if (r < vr) w = *(const float*)(rec + (size_t)r * 16);
                char* rowp = base + off;
#pragma unroll
                for (int bj = 0; bj < 2; ++bj) { const f32x4 g = acc[ai][bj][m][0], up = acc[ai][bj][m][1]; float o[4];
#pragma unroll
                    for (int i = 0; i < 4; ++i) o[i] = w * (g[i] / (1.0f + __expf(-g[i]))) * up[i];
                    u32x2 pk; pk.x = cvt_pk_bf16(o[0], o[1]); pk.y = cvt_pk_bf16(o[2], o[3]); *(u32x2*)(rowp + bj * 128) = pk; }
                off += (unsigned)(ROWSTEP(m) * 1024 * 2); r += ROWSTEP(m); OPAQUE(off); OPAQUE(r); }
    }
};
template <bool DRY = false> struct EpiDown {
    float* xl; float* xc; const float* gate; const ClsRec* list; const unsigned* cnt;
    __device__ __forceinline__ void operator()(const f32x4 (&acc)[2][2][4][2], const pg::Unit& u, int wr, int wc, int fr, int fq) const {
        const int vr = (int)cnt[u.x0 * 64] - u.x1 * 256; const ClsRec* rec = list + (size_t)u.x0 * MT + (size_t)u.x1 * 256;
        const int col0 = u.pn * 256 + wc * 32 + 4 * fq; int r = wr * 64 + fr;
#pragma unroll
        for (int ai = 0; ai < 2; ++ai)
#pragma unroll
            for (int m = 0; m < 4; ++m) {
                if (r < vr) { const int tk = rec[r].m; float* xr = (tk < ML ? xl + (size_t)tk * D : xc + (size_t)(tk - ML) * D) + col0; const float* gr = gate + (size_t)modrow(tk) * 6144 + col0;
#pragma unroll
                    for (int bj = 0; bj < 2; ++bj)
#pragma unroll
                        for (int n = 0; n < 2; ++n) { const f32x4 gv = *(const f32x4*)(gr + bj * 128 + n * 16); const f32x4 xv = *(const f32x4*)(xr + bj * 128 + n * 16); f32x4 rv = xv + gv * acc[ai][bj][m][n]; if (DRY) asm volatile("" :: "v"(rv)); else *(f32x4*)(xr + bj * 128 + n * 16) = rv; } }
                r += ROWSTEP(m); OPAQUE(r); }
    }
};

__device__ __forceinline__ void p0_transpose_item(const float* W, int Kd, int N, bf16_t* WT, LAS float* scr, int item, int lane, int mode, int sc_lo, int sc_hi, float scale) {
    const int nblk = N / 32, kb = item / nblk, nb = item % nblk, k0 = 64 * kb, n0 = 32 * nb;
#pragma unroll 8
    for (int i = 0; i < 32; ++i) { const int kk = 2 * i + (lane >> 5); scr[kk * 33 + (lane & 31)] = W[(size_t)(k0 + kk) * N + n0 + (lane & 31)]; }
    asm volatile("s_waitcnt lgkmcnt(0)" ::: "memory");
    const int c = lane & 7;
#pragma unroll
    for (int j = 0; j < 4; ++j) { const int n = (lane >> 3) + 8 * j, ng = n0 + n; const LAS float* s = scr + (8 * c) * 33 + n;
        const float f = (ng >= sc_lo && ng < sc_hi) ? scale : 1.0f;
        const int row = mode == 0 ? ng : (32 * (ng >> 4) + (ng & 15) + (mode == 2 ? 16 : 0));
        u32x4 o; o.x = pk2(s[0 * 33] * f, s[1 * 33] * f); o.y = pk2(s[2 * 33] * f, s[3 * 33] * f); o.z = pk2(s[4 * 33] * f, s[5 * 33] * f); o.w = pk2(s[6 * 33] * f, s[7 * 33] * f);
        *(u32x4*)(WT + (size_t)row * Kd + k0 + 8 * c) = o; }
    asm volatile("s_waitcnt lgkmcnt(0)" ::: "memory");
}
__device__ __forceinline__ void phase_p0a(const Ptrs& P, LAS unsigned char* lds) {
    int tid = threadIdx.x; asm volatile("" : "+v"(tid)); const int lane = tid & 63, wave = __builtin_amdgcn_readfirstlane(tid >> 6);
    const int gw = blockIdx.x * NWAVES + wave, NGW = gridDim.x * NWAVES;
    LAS float* sil = (LAS float*)(lds + 73728);
    for (int i = tid; i < 9 * D; i += NTHR) { const int j = i >> 10, k = i & (D - 1); sil[i] = silu_f(j < 8 ? P.c[j * D + k] : P.c_ctx[k]); }
    __syncthreads();
    float* modp = (float*)(P.ws + WS_MODP);
    for (int u = gw; u < DEPTH * 24 * 16; u += NGW) { const int l = u / 384, r = u % 384, nc = r / 16, ks = r % 16;
        const float* w = P.w_mod + ((size_t)l * D + ks * 64) * 6144 + nc * 256 + 4 * lane;
        f32x4 a[9];
#pragma unroll
        for (int j = 0; j < 9; ++j) a[j] = (f32x4){0.f, 0.f, 0.f, 0.f};
#pragma unroll 4
        for (int k = 0; k < 64; ++k) { const f32x4 wv = *(const f32x4*)(w + (size_t)k * 6144);
#pragma unroll
            for (int j = 0; j < 9; ++j) a[j] += wv * sil[j * D + ks * 64 + k]; }
#pragma unroll
        for (int j = 0; j < 9; ++j) *(f32x4*)(modp + (((size_t)l * 16 + ks) * 9 + j) * 6144 + nc * 256 + 4 * lane) = a[j]; }
    { const int gt = blockIdx.x * NTHR + tid, NGT = gridDim.x * NTHR; float* tab = (float*)(P.ws + WS_ROPE);
      if (gt < 2048) { const int i = gt & 15, pos = gt >> 4; const float inv = powf(10000.0f, -(float)i / 16.0f), ang = (float)pos * inv; tab[gt] = cosf(ang); tab[2048 + gt] = sinf(ang); }
      bf16_t* wsb = (bf16_t*)(P.ws + WS_WSB);
      for (int i = gt; i < DEPTH * 4 * 128 * 128; i += NGT) wsb[i] = f2bf(P.w_s[i]); }
    LAS float* scr = (LAS float*)(lds + wave * 8448);
    constexpr int PER_L = 1024 + 512 + NE * 768;
    for (int it = gw; it < DEPTH * PER_L; it += NGW) { const int l = it / PER_L; int r = it % PER_L;
        if (r < 1024) { p0_transpose_item(P.w_in + (size_t)l * D * INC, D, INC, (bf16_t*)(P.ws + WS_WIN) + (size_t)l * INC * D, scr, r, lane, 0, C_Q, C_K, QSCALE); continue; } r -= 1024;
        if (r < 512) { p0_transpose_item(P.w_out + (size_t)l * D * D, D, D, (bf16_t*)(P.ws + WS_WOUT) + (size_t)l * D * D, scr, r, lane, 0, 0, 0, 1.f); continue; } r -= 512;
        const int e = r / 768, q = r % 768, which = q >> 8, idx = q & 255; const size_t le = (size_t)l * NE + e;
        if (which == 0) p0_transpose_item(P.w_gate + le * D * DE, D, DE, (bf16_t*)(P.ws + WS_WGU) + le * 1024 * 1024, scr, idx, lane, 1, 0, 0, 1.f);
        else if (which == 1) p0_transpose_item(P.w_up + le * D * DE, D, DE, (bf16_t*)(P.ws + WS_WGU) + le * 1024 * 1024, scr, idx, lane, 2, 0, 0, 1.f);
        else p0_transpose_item(P.w_down + le * DE * D, DE, D, (bf16_t*)(P.ws + WS_WD) + le * 1024 * 512, scr, idx, lane, 0, 0, 0, 1.f); }
}
__device__ __forceinline__ void phase_p0b(const Ptrs& P) {
    const int gt = blockIdx.x * NTHR + threadIdx.x, NGT = gridDim.x * NTHR;
    const float* modp = (const float*)(P.ws + WS_MODP); float* mod = (float*)(P.ws + WS_MOD);
    for (int i = gt; i < DEPTH * 9 * 6144; i += NGT) { const int l = i / (9 * 6144), r = i % (9 * 6144), j = r / 6144, n = r % 6144;
        float s = P.b_mod[l * 6144 + n];
#pragma unroll
        for (int ks = 0; ks < 16; ++ks) s += modp[(((size_t)l * 16 + ks) * 9 + j) * 6144 + n];
        mod[i] = s; }
}

template <int WHICH, bool DRY = false> __device__ __forceinline__ void phase_norm(const Ptrs& P, LAS unsigned char* lds, int l, int Mrows, const float* xl, const float* xc) {
    int tid = threadIdx.x; asm volatile("" : "+v"(tid)); const int lane = tid & 63, wave = __builtin_amdgcn_readfirstlane(tid >> 6);
    const int gw = blockIdx.x * NWAVES + wave, NGW = gridDim.x * NWAVES;
    LAS float* rwT = (LAS float*)lds;
    constexpr int RPW = 40;
    LAS unsigned* recL = (LAS unsigned*)(lds + 65536);
    LAS unsigned* cntL = (LAS unsigned*)(lds + 65536 + NWAVES * RPW * 16);
    LAS unsigned* baseL = cntL + 32;
    int nrow = 0;
    if (WHICH == 2) { if (tid < 64) cntL[tid] = 0u; }
    if (WHICH == 2) { for (int i = tid; i < D * NE; i += NTHR) rwT[(i & 15) * D + (i >> 4)] = P.router_w[i]; __syncthreads(); }
    const float* g = (WHICH == 1 ? P.norm1_g : P.norm2_g) + l * D;
    f32x4 gg[4];
#pragma unroll
    for (int j = 0; j < 4; ++j) gg[j] = *(const f32x4*)(g + 4 * lane + 256 * j);
    for (int m = gw; m < Mrows; m += NGW) {
        const float* xr = m < ML ? xl + (size_t)m * D : xc + (size_t)(m - ML) * D;
        const float* mod = (const float*)(P.ws + WS_MOD) + ((size_t)l * 9 + modrow(m)) * 6144;
        const float* sh = mod + (WHICH == 1 ? 0 : 3072); const float* sc = mod + (WHICH == 1 ? 1024 : 4096);
        f32x4 v[4]; float ss = 0.f;
#pragma unroll
        for (int j = 0; j < 4; ++j) { v[j] = *(const f32x4*)(xr + 4 * lane + 256 * j); ss += v[j].x * v[j].x + v[j].y * v[j].y + v[j].z * v[j].z + v[j].w * v[j].w; }
        const float rinv = rsqrtf(wave_sum(ss) * (1.0f / D) + EPS);
        bf16_t* H = (bf16_t*)(P.ws + WS_H) + (size_t)m * D;
        float lg[16];
#pragma unroll
        for (int e = 0; e < 16; ++e) lg[e] = 0.f;
#pragma unroll
        for (int j = 0; j < 4; ++j) { const int c = 4 * lane + 256 * j;
            const f32x4 s1 = *(const f32x4*)(sc + c), s0 = *(const f32x4*)(sh + c);
            const f32x4 h = v[j] * rinv * gg[j] * (s1 + 1.0f) + s0;
            u32x2 o; o.x = pk2(h.x, h.y); o.y = pk2(h.z, h.w); *(u32x2*)(H + c) = o;
            if (WHICH == 2) {
#pragma unroll
                for (int e4 = 0; e4 < 4; ++e4) {
#pragma unroll
                    for (int e = 4 * e4; e < 4 * e4 + 4; ++e) { const f32x4 r = *(const LAS f32x4*)(rwT + e * D + c); lg[e] += h.x * r.x + h.y * r.y + h.z * r.z + h.w * r.w; }
                    __builtin_amdgcn_sched_barrier(0); } }
        }
        if (WHICH == 2) {
#pragma unroll
            for (int e = 0; e < 16; ++e) lg[e] = wave_sum(lg[e]);
            if (lane == 0 && !DRY) {
                float sco[16], sel[16];
#pragma unroll
                for (int e = 0; e < 16; ++e) { sco[e] = 1.0f / (1.0f + __expf(-lg[e])); sel[e] = sco[e] + P.router_b[e]; }
                int bg = 0; float bgs = -1e30f; int ba = 0, bb = 1; float sa = 0.f, sb = 0.f;
#pragma unroll
                for (int gI = 0; gI < 4; ++gI) {
                    int i1 = 0; float v1 = sel[gI * 4], c1 = sco[gI * 4];
#pragma unroll
                    for (int i = 1; i < 4; ++i) if (sel[gI * 4 + i] > v1) { v1 = sel[gI * 4 + i]; c1 = sco[gI * 4 + i]; i1 = i; }
                    int i2 = -1; float v2 = -1e30f, c2 = 0.f;
#pragma unroll
                    for (int i = 0; i < 4; ++i) if (i != i1 && sel[gI * 4 + i] > v2) { v2 = sel[gI * 4 + i]; c2 = sco[gI * 4 + i]; i2 = i; }
                    const float gs = v1 + v2;
                    if (gs > bgs) { bgs = gs; bg = gI; ba = i1; bb = i2; sa = c1; sb = c2; }
                }
                const int a = ba < bb ? ba : bb, b = ba < bb ? bb : ba;
                const float wl = ba < bb ? sa : sb, wh = ba < bb ? sb : sa, inv = 1.0f / (wl + wh);
                const int pairidx = (a == 0) ? (b - 1) : (a == 1 ? (b + 1) : 5);
                const int cls = bg * 6 + pairidx;
                const unsigned pl = __hip_atomic_fetch_add(cntL + cls, 1u, __ATOMIC_RELAXED, __HIP_MEMORY_SCOPE_WORKGROUP);
                LAS unsigned* rb = recL + (wave * RPW + nrow) * 4; rb[0] = (unsigned)m; rb[1] = __float_as_uint(wl * inv); rb[2] = __float_as_uint(wh * inv); rb[3] = (unsigned)cls | (pl << 8);
            }
            ++nrow;
        }
    }
    if (WHICH == 2 && !DRY) {
        asm volatile("s_waitcnt lgkmcnt(0)" ::: "memory"); __syncthreads();
        unsigned* ctl = (unsigned*)(P.ws + WS_CTL);
        if (tid < NCLS) { const unsigned n = cntL[tid]; baseL[tid] = n ? atomicAdd(ctl + CW_CNTF + (l * 32 + tid) * 64, n) : 0u; }
        __syncthreads();
        ClsRec* listr = (ClsRec*)(P.ws + WS_LISTR);
        for (int i = tid; i < NWAVES * RPW; i += NTHR) { const int w = i / RPW, r = i % RPW; const int nw = (Mrows - (blockIdx.x * NWAVES + w) + NGW - 1) / NGW;
            if (r < nw) { const LAS unsigned* rb = recL + i * 4; const unsigned cls = rb[3] & 255u, pl = rb[3] >> 8;
                ClsRec rc; rc.m = (int)rb[0]; rc.wlo = __uint_as_float(rb[1]); rc.whi = __uint_as_float(rb[2]); rc.pad = 0;
                listr[(size_t)cls * MT + baseL[cls] + pl] = rc; } }
    }
}
__device__ __forceinline__ void phase_final(const Ptrs& P) {
    int tid = threadIdx.x; asm volatile("" : "+v"(tid)); const int lane = tid & 63, wave = __builtin_amdgcn_readfirstlane(tid >> 6);
    const int gw = blockIdx.x * NWAVES + wave, NGW = gridDim.x * NWAVES;
    f32x4 gg[4];
#pragma unroll
    for (int j = 0; j < 4; ++j) gg[j] = *(const f32x4*)(P.final_g + 4 * lane + 256 * j);
    for (int m = gw; m < ML; m += NGW) { float* xr = P.out + (size_t)m * D;
        f32x4 v[4]; float ss = 0.f;
#pragma unroll
        for (int j = 0; j < 4; ++j) { v[j] = *(const f32x4*)(xr + 4 * lane + 256 * j); ss += v[j].x * v[j].x + v[j].y * v[j].y + v[j].z * v[j].z + v[j].w * v[j].w; }
        const float rinv = rsqrtf(wave_sum(ss) * (1.0f / D) + EPS);
#pragma unroll
        for (int j = 0; j < 4; ++j) *(f32x4*)(xr + 4 * lane + 256 * j) = v[j] * rinv * gg[j]; }
}
__device__ __forceinline__ void build_tile_table(const Ptrs& P, LAS int* tst, int l) {
    if (threadIdx.x == 0) { const unsigned* cnt = (const unsigned*)(P.ws + WS_CTL) + CW_CNTF + l * 32 * 64; int a = 0;
        for (int k = 0; k < NCLS; ++k) { tst[k] = a; a += (int)((__hip_atomic_load(cnt + k * 64, __ATOMIC_RELAXED, __HIP_MEMORY_SCOPE_AGENT) + 255u) >> 8); }
        tst[NCLS] = a; }
    __syncthreads();
}
namespace mx {
typedef float f32x16 __attribute__((ext_vector_type(16)));
typedef short s16x4 __attribute__((ext_vector_type(4)));
constexpr int SLOTB = 8192;
constexpr int L_K = 0, L_V = 2 * SLOTB, L_WS = 4 * SLOTB, L_OST = L_WS + NWAVES * 256, L_END = L_OST + NWAVES * 4096;
constexpr int VT_PITCH = 136;
__device__ __forceinline__ int crow(int r, int hi) { return (r & 3) + 8 * (r >> 2) + 4 * hi; }
__device__ __forceinline__ unsigned cvtpk(float lo, float hi) { unsigned r; asm volatile("v_cvt_pk_bf16_f32 %0, %1, %2" : "=v"(r) : "v"(lo), "v"(hi)); return r; }
__device__ __forceinline__ float gelu_fast(float x) { const float y = x + 0.044715f * x * x * x; return x * __builtin_amdgcn_rcpf(1.0f + __builtin_amdgcn_exp2f(-2.302208198f * y)); }

__device__ __forceinline__ void qkt(f32x16& p0, f32x16& p1, const LAS unsigned char* Kslot, const bf16x8* qr, int r32, int hi) {
    const LAS unsigned char* kb = Kslot + hi * 1024 + r32 * 16;
    p0 = (f32x16){0.f, 0.f, 0.f, 0.f, 0.f, 0.f, 0.f, 0.f, 0.f, 0.f, 0.f, 0.f, 0.f, 0.f, 0.f, 0.f}; p1 = p0;
#pragma unroll
    for (int d0 = 0; d0 < 4; ++d0) {
        const bf16x8 b0 = *(const LAS bf16x8*)(kb + d0 * 2048), b1 = *(const LAS bf16x8*)(kb + d0 * 2048 + 512);
        p0 = __builtin_amdgcn_mfma_f32_32x32x16_bf16(b0, qr[d0], p0, 0, 0, 0); p1 = __builtin_amdgcn_mfma_f32_32x32x16_bf16(b1, qr[d0], p1, 0, 0, 0); }
}
__device__ __forceinline__ void pv(f32x16* o, unsigned vb, bf16x8 pa0, bf16x8 pa1, bf16x8 pa2, bf16x8 pa3) {
#pragma unroll
    for (int d0 = 0; d0 < 2; ++d0) { s16x4 lo[4], hi[4];
#pragma unroll
        for (int ks = 0; ks < 4; ++ks) {
            asm volatile("ds_read_b64_tr_b16 %0, %1 offset:%c2" : "=&v"(lo[ks]) : "v"(vb), "i"(d0 * 4096 + ks * 1024) : "memory");
            asm volatile("ds_read_b64_tr_b16 %0, %1 offset:%c2" : "=&v"(hi[ks]) : "v"(vb), "i"(d0 * 4096 + ks * 1024 + 512) : "memory"); }
        asm volatile("s_waitcnt lgkmcnt(0)" ::: "memory"); __builtin_amdgcn_sched_barrier(0);
#define MX_PK(k) (bf16x8){lo[k][0], lo[k][1], lo[k][2], lo[k][3], hi[k][0], hi[k][1], hi[k][2], hi[k][3]}
        o[d0] = __builtin_amdgcn_mfma_f32_32x32x16_bf16(pa0, MX_PK(0), o[d0], 0, 0, 0);
        o[d0] = __builtin_amdgcn_mfma_f32_32x32x16_bf16(pa1, MX_PK(1), o[d0], 0, 0, 0);
        o[d0] = __builtin_amdgcn_mfma_f32_32x32x16_bf16(pa2, MX_PK(2), o[d0], 0, 0, 0);
        o[d0] = __builtin_amdgcn_mfma_f32_32x32x16_bf16(pa3, MX_PK(3), o[d0], 0, 0, 0);
#undef MX_PK
    }
}
__device__ __forceinline__ void attn_unit(const bf16_t* PROJ, bf16_t* MIXo, const float* sink, LAS unsigned char* shm, int latent, int b, int blk, int kvh, int hp, int tid) {
    const int lane = tid & 63, r32 = lane & 31, hi = lane >> 5; const int wid = __builtin_amdgcn_readfirstlane(tid >> 6);
    const int head = kvh * 4 + hp * 2 + (wid >> 2), qw = (wid & 3) * 32;
    const int qrow0 = latent ? b * SEQ + blk * 128 : ML + b * CTXL + blk * 128;
    const int ctx0 = ML + b * CTXL;
    const int lt_lo = latent ? (blk > 0 ? 0 : 2) : 0, lt_hi = latent ? (blk < SEQ / 128 - 1 ? 6 : 4) : 0;
    const int NT = 4 + (lt_hi - lt_lo);
    LAS float* wsf = (LAS float*)(shm + L_WS) + wid * 64;
    const bf16_t* kcol = PROJ + C_K + kvh * 64 + wid * 8;
    const bf16_t* vcol = PROJ + C_VV + kvh * 64 + (wid >> 2) * 32 + (lane & 3) * 8;
#define MX_TROW(t) ((t) < 4 ? ctx0 + 64 * (t) : b * SEQ + blk * 128 - 128 + 64 * ((t) - 4 + lt_lo))
#define MX_DMA(t, slot) do { const int _r0 = MX_TROW(t); \
        __builtin_amdgcn_global_load_lds((const unsigned*)(kcol + (size_t)(_r0 + lane) * INC), (LAS unsigned*)(shm + L_K + (slot) * SLOTB + wid * 1024), 16, 0, 0); \
        __builtin_amdgcn_global_load_lds((const unsigned*)(vcol + (size_t)(_r0 + 16 * (wid & 3) + (lane >> 2)) * INC), (LAS unsigned*)(shm + L_V + (slot) * SLOTB + wid * 1024), 16, 0, 0); } while (0)
    MX_DMA(0, 0);
    bf16x8 qr[4];
    { const bf16_t* qp = PROJ + (size_t)(qrow0 + qw + r32) * INC + C_Q + head * 64 + hi * 8;
#pragma unroll
      for (int d0 = 0; d0 < 4; ++d0) qr[d0] = *(const bf16x8*)(qp + d0 * 16); }
    float mrun = sink[head] * LOG2E, lsum = hi == 0 ? 1.0f : 0.0f;
    f32x16 o[2]; o[0] = (f32x16){0.f, 0.f, 0.f, 0.f, 0.f, 0.f, 0.f, 0.f, 0.f, 0.f, 0.f, 0.f, 0.f, 0.f, 0.f, 0.f}; o[1] = o[0];
    const unsigned vb0 = (unsigned)(size_t)(shm + L_V) + ((lane >> 4) & 1) * 32 + (lane & 3) * 8 + (4 * hi + ((lane & 15) >> 2)) * 64;
    const int qc = qw + r32;
    for (int t = 0; t < NT; ++t) {
        const int slot = t & 1;
        if (t + 1 < NT) { MX_DMA(t + 1, slot ^ 1); asm volatile("s_waitcnt vmcnt(2)" ::: "memory"); } else { asm volatile("s_waitcnt vmcnt(0)" ::: "memory"); }
        asm volatile("s_barrier" ::: "memory");
        f32x16 p0, p1;
        qkt(p0, p1, shm + L_K + slot * SLOTB, qr, r32, hi);
        if (t >= 4) { const int lt = t - 4 + lt_lo; if (lt < 2 || lt >= 4) { const int kb = -128 + 64 * lt;
#pragma unroll
            for (int r = 0; r < 16; ++r) { const int k0 = kb + crow(r, hi), k1 = k0 + 32;
                if (k0 < qc - 128 || k0 > qc + 128) p0[r] = -1e30f; if (k1 < qc - 128 || k1 > qc + 128) p1[r] = -1e30f; } } }
        float rm = fmaxf(p0[0], p1[0]);
#pragma unroll
        for (int r = 1; r < 16; ++r) rm = fmaxf(rm, fmaxf(p0[r], p1[r]));
        { auto rr = __builtin_amdgcn_permlane32_swap(__float_as_uint(rm), __float_as_uint(rm), false, false); rm = fmaxf(__uint_as_float(rr[0]), __uint_as_float(rr[1])); }
        const float mnew = fmaxf(mrun, rm);
        if (__any(mnew > mrun)) { const float f = __builtin_amdgcn_exp2f(mrun - mnew); lsum *= f; if (hi == 0) wsf[r32] = f;
            asm volatile("s_waitcnt lgkmcnt(0)" ::: "memory");
#pragma unroll
            for (int r = 0; r < 16; ++r) { const float fr_ = *(volatile LAS float*)(wsf + crow(r, hi)); o[0][r] *= fr_; o[1][r] *= fr_; }
            mrun = mnew; }
        float sacc = 0.f;
#pragma unroll
        for (int r = 0; r < 16; ++r) { p0[r] = __builtin_amdgcn_exp2f(p0[r] - mrun); p1[r] = __builtin_amdgcn_exp2f(p1[r] - mrun); sacc += p0[r] + p1[r]; }
        lsum += sacc;
        u32x4 pw0, pw1, pw2, pw3;
#pragma unroll
        for (int i = 0; i < 4; ++i) { pw0[i] = cvtpk(p0[2 * i], p0[2 * i + 1]); pw1[i] = cvtpk(p0[8 + 2 * i], p0[8 + 2 * i + 1]); pw2[i] = cvtpk(p1[2 * i], p1[2 * i + 1]); pw3[i] = cvtpk(p1[8 + 2 * i], p1[8 + 2 * i + 1]); }
        pv(o, vb0 + slot * SLOTB, __builtin_bit_cast(bf16x8, pw0), __builtin_bit_cast(bf16x8, pw1), __builtin_bit_cast(bf16x8, pw2), __builtin_bit_cast(bf16x8, pw3));
        asm volatile("s_waitcnt lgkmcnt(0)" ::: "memory");
        asm volatile("s_barrier" ::: "memory");
    }
    { auto rr = __builtin_amdgcn_permlane32_swap(__float_as_uint(lsum), __float_as_uint(lsum), false, false); lsum = __uint_as_float(rr[0]) + __uint_as_float(rr[1]); }
    if (hi == 0) wsf[32 + r32] = lsum;
    asm volatile("s_waitcnt lgkmcnt(0)" ::: "memory");
    LAS bf16_t* stg = (LAS bf16_t*)(shm + L_OST) + wid * 2048;
#pragma unroll
    for (int r = 0; r < 16; ++r) { const int orow = crow(r, hi); const float rl = __builtin_amdgcn_rcpf(*(volatile LAS float*)(wsf + 32 + orow));
        stg[orow * 64 + r32] = f2bf(o[0][r] * rl); stg[orow * 64 + 32 + r32] = f2bf(o[1][r] * rl); }
    asm volatile("s_waitcnt lgkmcnt(0)" ::: "memory");
    bf16_t* op = MIXo + (size_t)(qrow0 + qw) * D + 512 + head * 64;
#pragma unroll
    for (int i = 0; i < 4; ++i) { const int row = i * 8 + (lane >> 3), ch = lane & 7; const u32x4 v = *(const LAS u32x4*)(stg + row * 64 + ch * 8); *(u32x4*)(op + (size_t)row * D + ch * 8) = v; }
    asm volatile("s_waitcnt lgkmcnt(0)" ::: "memory");
    asm volatile("s_barrier" ::: "memory");
#undef MX_DMA
#undef MX_TROW
}

__device__ __forceinline__ void gmlp_conv_unit(const Ptrs& P, const bf16_t* PROJ, bf16_t* MIXo, LAS unsigned char* shm, int l, int m0, int tid) {
    const int lane = tid & 63, r32 = lane & 31, hi = lane >> 5; const int wid = __builtin_amdgcn_readfirstlane(tid >> 6);
    LAS bf16_t* vT = (LAS bf16_t*)shm;
    { float gv[4];
#pragma unroll
      for (int i = 0; i < 4; ++i) gv[i] = P.gmlp_g[l * 256 + 4 * lane + i];
      for (int rr = 0; rr < 16; ++rr) { const int row = wid * 16 + rr;
          const u32x2 raw = *(const u32x2*)(PROJ + (size_t)(m0 + row) * INC + C_V + 4 * lane);
          float g[4]; g[0] = gelu_fast(__uint_as_float(raw.x << 16)); g[1] = gelu_fast(__uint_as_float(raw.x & 0xffff0000u)); g[2] = gelu_fast(__uint_as_float(raw.y << 16)); g[3] = gelu_fast(__uint_as_float(raw.y & 0xffff0000u));
          const float rinv = rsqrtf(wave_sum(g[0] * g[0] + g[1] * g[1] + g[2] * g[2] + g[3] * g[3]) * (1.0f / 256.0f) + EPS);
#pragma unroll
          for (int i = 0; i < 4; ++i) vT[(4 * lane + i) * VT_PITCH + row] = f2bf(g[i] * rinv * gv[i]); } }
    asm volatile("s_waitcnt lgkmcnt(0)" ::: "memory");
    asm volatile("s_barrier" ::: "memory");
    { const int h = wid >> 1, dt = wid & 1;
      bf16x8 af[8];
#pragma unroll
      for (int kk = 0; kk < 8; ++kk) af[kk] = *(const LAS bf16x8*)(vT + (h * 64 + dt * 32 + r32) * VT_PITCH + kk * 16 + hi * 8);
      const bf16_t* wsb = (const bf16_t*)(P.ws + WS_WSB) + ((size_t)(l * 4 + h) * 128) * 128;
      const float* bs = P.b_s + (l * 4 + h) * 128;
#pragma unroll
      for (int pt = 0; pt < 4; ++pt) {
          f32x16 acc = (f32x16){0.f, 0.f, 0.f, 0.f, 0.f, 0.f, 0.f, 0.f, 0.f, 0.f, 0.f, 0.f, 0.f, 0.f, 0.f, 0.f};
#pragma unroll
          for (int kk = 0; kk < 8; ++kk) { const bf16x8 bfrag = *(const bf16x8*)(wsb + (size_t)(pt * 32 + r32) * 128 + kk * 16 + hi * 8); acc = __builtin_amdgcn_mfma_f32_32x32x16_bf16(af[kk], bfrag, acc, 0, 0, 0); }
          const int p = pt * 32 + r32; const float bias = bs[p];
          const bf16_t* up = PROJ + (size_t)(m0 + p) * INC + C_U + h * 64 + dt * 32 + 4 * hi; bf16_t* op = MIXo + (size_t)(m0 + p) * D + h * 64 + dt * 32 + 4 * hi;
#pragma unroll
          for (int q4 = 0; q4 < 4; ++q4) { const u32x2 raw = *(const u32x2*)(up + 8 * q4);
              const float u0 = gelu_fast(__uint_as_float(raw.x << 16)), u1 = gelu_fast(__uint_as_float(raw.x & 0xffff0000u)), u2 = gelu_fast(__uint_as_float(raw.y << 16)), u3 = gelu_fast(__uint_as_float(raw.y & 0xffff0000u));
              u32x2 w; w.x = cvtpk(u0 * (acc[4 * q4] + bias), u1 * (acc[4 * q4 + 1] + bias)); w.y = cvtpk(u2 * (acc[4 * q4 + 2] + bias), u3 * (acc[4 * q4 + 3] + bias));
              *(u32x2*)(op + 8 * q4) = w; }
      } }
    { const int seqmask = m0 < ML ? SEQ - 1 : CTXL - 1; const int mrel = m0 < ML ? m0 : m0 - ML;
      for (int it = 0; it < 8; ++it) { const int idx = it * NTHR + tid, row = idx >> 5, c = (idx & 31) * 8;
          const int t = (mrel + row) & seqmask; const bf16_t* pr = PROJ + (size_t)(m0 + row) * INC;
          const u32x4 bg = *(const u32x4*)(pr + C_BG + c), c1 = *(const u32x4*)(pr + C_CG + c), z1 = *(const u32x4*)(pr + C_Z + c);
          u32x4 c0 = (u32x4){0u, 0u, 0u, 0u}, z0 = c0, c2 = c0, z2 = c0;
          if (t > 0) { c0 = *(const u32x4*)(pr - INC + C_CG + c); z0 = *(const u32x4*)(pr - INC + C_Z + c); }
          if (t < seqmask) { c2 = *(const u32x4*)(pr + INC + C_CG + c); z2 = *(const u32x4*)(pr + INC + C_Z + c); }
          const float* cw = P.conv_w + (size_t)l * 768 + c;
          float o[8];
#pragma unroll
          for (int i = 0; i < 8; ++i) { const int wI = i >> 1; const bool up = i & 1;
#define MX_BF(v) (up ? __uint_as_float((v)[wI] & 0xffff0000u) : __uint_as_float((v)[wI] << 16))
              const float y = MX_BF(c0) * MX_BF(z0) * cw[i] + MX_BF(c1) * MX_BF(z1) * cw[256 + i] + MX_BF(c2) * MX_BF(z2) * cw[512 + i];
              o[i] = MX_BF(bg) * y;
#undef MX_BF
          }
          u32x4 w; w.x = cvtpk(o[0], o[1]); w.y = cvtpk(o[2], o[3]); w.z = cvtpk(o[4], o[5]); w.w = cvtpk(o[6], o[7]);
          *(u32x4*)(MIXo + (size_t)(m0 + row) * D + 256 + c) = w; } }
    asm volatile("s_waitcnt lgkmcnt(0)" ::: "memory");
    asm volatile("s_barrier" ::: "memory");
}
}

__device__ __forceinline__ void phase_mixer(const Ptrs& P, LAS unsigned char* lds, int l, int Mmix) {
    int tid = threadIdx.x; asm volatile("" : "+v"(tid));
    const bf16_t* PROJ = (const bf16_t*)(P.ws + WS_PROJ); bf16_t* MIXo = (bf16_t*)(P.ws + WS_MIX);
    const int G = gridDim.x, c = blockIdx.x;
    const int nLat = (ML / 128) * 4, nCtx = Mmix > ML ? (MC / 128) * 4 : 0, nA = nLat + nCtx, nG = Mmix / 128;
    for (int u = c; u < nA; u += G) {
        if (u < nLat) { const int chunk = u >> 2, kvh = (u >> 1) & 1, hp = u & 1; mx::attn_unit(PROJ, MIXo, P.sink + l * 8, lds, 1, chunk >> 6, chunk & 63, kvh, hp, tid); }
        else { const int v = u - nLat, chunk = v >> 2, kvh = (v >> 1) & 1, hp = v & 1; mx::attn_unit(PROJ, MIXo, P.sink + l * 8, lds, 0, chunk >> 1, chunk & 1, kvh, hp, tid); }
    }
    for (int u = c; u < nG; u += G) mx::gmlp_conv_unit(P, PROJ, MIXo, lds, l, u * 128, tid);
}
constexpr int NPH = 31;
struct KArgs { Ptrs P; int lo, hi; };
__global__ void __launch_bounds__(NTHR, 2) k_fast(KArgs a) {
    extern __shared__ __attribute__((aligned(16))) unsigned char lds_raw[];
    LAS unsigned char* lds = (LAS unsigned char*)lds_raw;
    const int lo = a.lo, hi = a.hi;
#if defined(__HIP_DEVICE_COMPILE__) && defined(USE_KERNARG_RELOAD)
#define LOADP() const __attribute__((address_space(4))) unsigned long long* ap_ = (const __attribute__((address_space(4))) unsigned long long*)__builtin_amdgcn_kernarg_segment_ptr(); asm volatile("" : "+s"(ap_)); \
    Ptrs P; { unsigned long long* d_ = (unsigned long long*)&P; _Pragma("unroll") for (int i_ = 0; i_ < (int)(sizeof(Ptrs) / 8); ++i_) d_[i_] = ap_[i_]; }
#else
#define LOADP() const Ptrs P = a.P
#endif
    unsigned* ctl; { LOADP(); ctl = (unsigned*)(P.ws + WS_CTL); }
    if (threadIdx.x < 4) ((LAS unsigned*)(lds + MISC_OFF))[threadIdx.x] = 0u;
    __syncthreads();
    XcdBarrier bar; bar.bar = ctl + CW_BAR; bar.x = 0; bar.st = (volatile LAS unsigned*)(lds + MISC_OFF);
    if (hi - lo > 1) bar = xcd_barrier_post(ctl + CW_BAR, (volatile LAS unsigned*)(lds + MISC_OFF));
#ifndef PHMASK
#define PHMASK 0xffffffffu
#endif
#ifndef REPMASK
#define REPMASK 0u
#endif
#define NREP(kind) (((REPMASK >> (kind)) & 1u) ? 2 : 1)
#define IN(k, kind) (((PHMASK >> (kind)) & 1u) && lo <= (k) && (k) < hi)
#define SEAM(k) do { if (lo <= (k) && (k) + 1 < hi) xcd_barrier(bar); } while (0)
    LAS unsigned* idxtab = (LAS unsigned*)(lds + IDX_OFF);
    LAS int* tst = (LAS int*)(lds + TST_OFF);

    if (IN(0, 0)) { LOADP(); for (int rep = 0; rep < NREP(0); ++rep) phase_p0a(P, lds); }
    SEAM(0);
    if (IN(1, 1)) { LOADP(); phase_p0b(P); }
    SEAM(1);
    for (int l = 0; l < DEPTH; ++l) {
        const int pb = 2 + 7 * l;
        const int Mmix = l < DEPTH - 1 ? MT : ML;
        if (IN(pb + 0, 2)) { LOADP(); for (int rep = 0; rep < NREP(2); ++rep) phase_norm<1>(P, lds, l, MT, l == 0 ? P.x : P.out, l == 0 ? P.ctx : (const float*)(P.ws + WS_XC)); }
        SEAM(pb + 0);
        if (IN(pb + 1, 3)) { LOADP();
            SchedDense<INC> S{(const bf16_t*)(P.ws + WS_H), (const bf16_t*)(P.ws + WS_WIN) + (size_t)l * INC * D, MT / 256, (int)gridDim.x, (int)blockIdx.x};
            EpiProj E{(bf16_t*)(P.ws + WS_PROJ), (const float*)(P.ws + WS_ROPE)};
            for (int rep = 0; rep < NREP(3); ++rep) pg::gemm_phase(lds + RING_OFF, idxtab, S, E);
        }
        SEAM(pb + 1);
        if (IN(pb + 2, 4)) { LOADP(); for (int rep = 0; rep < NREP(4); ++rep) phase_mixer(P, lds, l, Mmix); }
        SEAM(pb + 2);
        if (IN(pb + 3, 5)) { LOADP(); float* xc = (float*)(P.ws + WS_XC);
            SchedDense<D> S{(const bf16_t*)(P.ws + WS_MIX), (const bf16_t*)(P.ws + WS_WOUT) + (size_t)l * D * D, Mmix / 256, (int)gridDim.x, (int)blockIdx.x};
            EpiRes<false> E{l == 0 ? P.x : P.out, l == 0 ? P.ctx : xc, P.out, xc, (const float*)(P.ws + WS_MOD) + (size_t)l * 9 * 6144 + 2048};
            if (NREP(5) > 1) { EpiRes<true> E2{E.xsl, E.xsc, E.xdl, E.xdc, E.gate}; pg::gemm_phase(lds + RING_OFF, idxtab, S, E2); }
            pg::gemm_phase(lds + RING_OFF, idxtab, S, E);
        }
        SEAM(pb + 3);
        if (IN(pb + 4, 6)) { LOADP(); if (NREP(6) > 1) phase_norm<2, true>(P, lds, l, Mmix, P.out, (const float*)(P.ws + WS_XC)); phase_norm<2>(P, lds, l, Mmix, P.out, (const float*)(P.ws + WS_XC)); }
        SEAM(pb + 4);
        if (IN(pb + 5, 7)) { LOADP(); const ClsRec* listr = (const ClsRec*)(P.ws + WS_LISTR);
            build_tile_table(P, tst, l);
            SchedGU S{(const bf16_t*)(P.ws + WS_H), (const bf16_t*)(P.ws + WS_WGU) + (size_t)l * NE * 1024 * 1024, listr, tst, ctl + CW_CNTF + l * 32 * 64, (int)gridDim.x, (int)blockIdx.x};
            EpiGU E{(bf16_t*)(P.ws + WS_PROJ), listr, ctl + CW_CNTF + l * 32 * 64};
            for (int rep = 0; rep < NREP(7); ++rep) pg::gemm_phase(lds + RING_OFF, idxtab, S, E);
        }
        SEAM(pb + 5);
        if (IN(pb + 6, 8)) { LOADP(); const ClsRec* listr = (const ClsRec*)(P.ws + WS_LISTR);
            build_tile_table(P, tst, l);
            SchedDown S{(const bf16_t*)(P.ws + WS_PROJ), (const bf16_t*)(P.ws + WS_WD) + (size_t)l * NE * 1024 * 512, tst, (int)gridDim.x, (int)blockIdx.x};
            EpiDown<false> E{P.out, (float*)(P.ws + WS_XC), (const float*)(P.ws + WS_MOD) + (size_t)l * 9 * 6144 + 5120, listr, ctl + CW_CNTF + l * 32 * 64};
            if (NREP(8) > 1) { EpiDown<true> E2{E.xl, E.xc, E.gate, E.list, E.cnt}; pg::gemm_phase(lds + RING_OFF, idxtab, S, E2); }
            pg::gemm_phase(lds + RING_OFF, idxtab, S, E);
        }
        SEAM(pb + 6);
    }
    if (IN(30, 9)) { LOADP(); phase_final(P); }
#undef IN
#undef SEAM
}
#ifndef FAST_PRO
#define FAST_PRO 1
#endif
#ifndef FAST_N1
#define FAST_N1 1
#endif
#ifndef FAST_G1
#define FAST_G1 1
#endif
#ifndef FAST_MX
#define FAST_MX 1
#endif
#ifndef FAST_G2
#define FAST_G2 1
#endif
#ifndef FAST_N2
#define FAST_N2 1
#endif
#ifndef FAST_MOE
#define FAST_MOE 1
#endif
#ifndef FAST_FN
#define FAST_FN 1
#endif
#ifndef ONE_LAUNCH
#define ONE_LAUNCH 1
#endif
static int g_grid = 256;
static void launch_fast(const Ptrs& P, int lo, int hi, hipStream_t stream) {
    KArgs a{}; a.P = P; a.lo = lo; a.hi = hi;
    hipLaunchKernelGGL(k_fast, dim3(g_grid), dim3(NTHR), LDS_BYTES, stream, a);
}
extern "C" void kernel_launch(void* const* d_in, const int* in_sizes, int n_in, void* d_out, int out_size, void* d_ws, size_t ws_size, hipStream_t stream) {
    static int ready = 0;
    if (!ready) {
        if (n_in != 21 || ws_size < WS_END2) { fprintf(stderr, "kernel_launch: unexpected inputs (%d) or workspace (%zu)\n", n_in, ws_size); ready = -1; return; }
        if (hipFuncSetAttribute((const void*)k_fast, hipFuncAttributeMaxDynamicSharedMemorySize, LDS_BYTES) != hipSuccess) { fprintf(stderr, "kernel_launch: hipFuncSetAttribute failed\n"); ready = -1; return; }
        { int dev = 0, cus = 0, per_cu = 0; (void)hipGetDevice(&dev); (void)hipDeviceGetAttribute(&cus, hipDeviceAttributeMultiprocessorCount, dev);
          if (hipOccupancyMaxActiveBlocksPerMultiprocessor(&per_cu, (const void*)k_fast, NTHR, LDS_BYTES) != hipSuccess || per_cu < 1) { fprintf(stderr, "kernel_launch: occupancy query says %d blocks per CU\n", per_cu); }
          (void)hipGetLastError(); if (cus > 0) g_grid = cus; }
        ready = 1;
    }
    if (ready < 0) return;
    Ptrs P{};
    const float** pp = (const float**)&P;
    for (int i = 0; i < 21; ++i) pp[i] = (const float*)d_in[i];
    P.out = (float*)d_out; P.ws = (unsigned char*)d_ws;
    unsigned char* ws = (unsigned char*)d_ws;
    (void)hipMemsetAsync(ws + WS_CTL, 0, 1 * MiB, stream);
#if ONE_LAUNCH
    launch_fast(P, 0, NPH, stream);
#else
    float* xc = (float*)(ws + WS_XC);
    const float* mod = (const float*)(ws + WS_MOD);
    bf16_t* H = (bf16_t*)(ws + WS_H); bf16_t* MIX = (bf16_t*)(ws + WS_MIX); bf16_t* PROJ = (bf16_t*)(ws + WS_PROJ);
    const unsigned* ctl = (const unsigned*)(ws + WS_CTL);
#if FAST_PRO
    launch_fast(P, 0, 1, stream); launch_fast(P, 1, 2, stream);
#else
    hipLaunchKernelGGL(k_mod, dim3(6144 / 256, DEPTH), dim3(256), 0, stream, P);
    hipLaunchKernelGGL(k_rope_table, dim3(8), dim3(256), 0, stream, P);
#endif
    for (int l = 0; l < DEPTH; ++l) {
        const int pb = 2 + 7 * l;
        const float* xsl = l == 0 ? P.x : P.out; const float* xsc = l == 0 ? P.ctx : xc;
        const int Mmix = l < DEPTH - 1 ? MT : ML;
#if FAST_N1
        launch_fast(P, pb + 0, pb + 1, stream);
#else
        hipLaunchKernelGGL(k_norm<1>, dim3(MT / 4), dim3(256), 0, stream, P, l, MT, xsl, xsc);
#endif
#if FAST_G1
        launch_fast(P, pb + 1, pb + 2, stream);
#else
        { AF_dense af{H, D}; BF_plain bf{P.w_in + (size_t)l * D * INC, INC}; EF_proj ef{PROJ};
          hipLaunchKernelGGL((naive_gemm<AF_dense, BF_plain, EF_proj, false>), dim3(INC / 64, MT / 64), dim3(256), 0, stream, (const unsigned*)nullptr, MT, D, af, bf, ef); }
        hipLaunchKernelGGL(k_rope, dim3((unsigned)(((size_t)MT * 320 + 255) / 256)), dim3(256), 0, stream, P);
#endif
#if FAST_MX
        launch_fast(P, pb + 2, pb + 3, stream);
#else
        hipLaunchKernelGGL(k_gmlp_a, dim3(Mmix / 4), dim3(256), 0, stream, P, l, Mmix);
        hipLaunchKernelGGL(k_gmlp_b, dim3(Mmix), dim3(256), 0, stream, P, l);
        hipLaunchKernelGGL(k_conv, dim3(Mmix), dim3(256), 0, stream, P, l);
        hipLaunchKernelGGL(k_attn, dim3(Mmix / 32), dim3(256), 0, stream, P, l);
#endif
#if FAST_G2
        launch_fast(P, pb + 3, pb + 4, stream);
#else
        { AF_dense af{MIX, D}; BF_plain bf{P.w_out + (size_t)l * D * D, D}; EF_res ef{xsl, xsc, P.out, xc, mod + (size_t)l * 9 * 6144 + 2048};
          hipLaunchKernelGGL((naive_gemm<AF_dense, BF_plain, EF_res, false>), dim3(D / 64, Mmix / 64), dim3(256), 0, stream, (const unsigned*)nullptr, Mmix, D, af, bf, ef); }
#endif
#if FAST_N2
        launch_fast(P, pb + 4, pb + 5, stream);
#else
        hipLaunchKernelGGL(k_norm<2>, dim3(Mmix / 4), dim3(256), 0, stream, P, l, Mmix, (const float*)P.out, (const float*)xc);
#endif
#if FAST_MOE
        launch_fast(P, pb + 5, pb + 6, stream); launch_fast(P, pb + 6, pb + 7, stream);
#else
        for (int e = 0; e < NE; ++e) {
            const int* list = (const int*)(ws + WS_LISTE) + (size_t)e * MT; bf16_t* act = PROJ;
            { AF_gather af{H, list}; BF_dual bf{P.w_gate + ((size_t)l * NE + e) * D * DE, P.w_up + ((size_t)l * NE + e) * D * DE}; EF_gateup ef{act};
              hipLaunchKernelGGL((naive_gemm<AF_gather, BF_dual, EF_gateup, true>), dim3(DE / 64, MT / 64), dim3(256), 0, stream, ctl + CW_CNTE + l * 16 + e, MT, D, af, bf, ef); }
            { AF_dense af{act, DE}; BF_plain bf{P.w_down + ((size_t)l * NE + e) * DE * D, D}; EF_down ef{list, (const Tok*)(ws + WS_TOK), P.out, xc, mod + (size_t)l * 9 * 6144 + 5120, e};
              hipLaunchKernelGGL((naive_gemm<AF_dense, BF_plain, EF_down, false>), dim3(D / 64, MT / 64), dim3(256), 0, stream, ctl + CW_CNTE + l * 16 + e, MT, DE, af, bf, ef); }
        }
#endif
    }
#if FAST_FN
    launch_fast(P, 30, 31, stream);
#else
    hipLaunchKernelGGL(k_final, dim3(ML / 4), dim3(256), 0, stream, P);
#endif
#endif
}
```

```cpp
#include <hip/hip_runtime.h>
#include <stdint.h>
#include <cstdio>

constexpr int D = 1024, NB = 8, SEQ = 8192, DEPTH = 4, CTXL = 256;
constexpr int ML = NB * SEQ;
constexpr int MC = NB * CTXL;
constexpr int MT = ML + MC;
constexpr int INC = 2048;
constexpr int C_U = 0, C_V = 256, C_BG = 512, C_CG = 768, C_Z = 1024, C_Q = 1280, C_K = 1792, C_VV = 1920;
constexpr int NE = 16, DE = 512, NCLS = 24;
constexpr float EPS = 1e-6f;
constexpr float QSCALE = 0.125f * 1.4426950408889634f;
constexpr float LOG2E = 1.4426950408889634f;

typedef unsigned short bf16_t;
typedef float f32x4 __attribute__((ext_vector_type(4)));
typedef unsigned u32x4 __attribute__((ext_vector_type(4)));
typedef unsigned u32x2 __attribute__((ext_vector_type(2)));

__device__ __forceinline__ float bf2f(bf16_t v) { return __uint_as_float((unsigned)v << 16); }
__device__ __forceinline__ bf16_t f2bf(float f) { unsigned u = __float_as_uint(f); return (bf16_t)((u + 0x7fffu + ((u >> 16) & 1u)) >> 16); }
__device__ __forceinline__ unsigned pk2(float lo, float hi) { return (unsigned)f2bf(lo) | ((unsigned)f2bf(hi) << 16); }
__device__ __forceinline__ float gelu_tanh(float x) { const float y = 0.7978845608028654f * (x + 0.044715f * x * x * x); return x / (1.0f + __expf(-2.0f * y)); }
__device__ __forceinline__ float silu_f(float x) { return x / (1.0f + __expf(-x)); }
__device__ __forceinline__ float wave_sum(float v) {
#pragma unroll
    for (int o = 1; o < 64; o <<= 1) v += __shfl_xor(v, o);
    return v;
}

constexpr size_t MiB = 1u << 20;
constexpr size_t WS_CTL = 0;
constexpr size_t WS_MOD = 1 * MiB;
constexpr size_t WS_ROPE = 2 * MiB;
constexpr size_t WS_TOK = 3 * MiB;
constexpr size_t WS_XC = 5 * MiB;
constexpr size_t WS_LISTE = 13 * MiB;
constexpr size_t WS_LISTC = 18 * MiB;
constexpr size_t WS_VN = 25 * MiB;
constexpr size_t WS_WIN = 64 * MiB, WS_WOUT = 80 * MiB, WS_WGU = 88 * MiB, WS_WD = 216 * MiB;
constexpr size_t WS_H = 280 * MiB;
constexpr size_t WS_MIX = 412 * MiB;
constexpr size_t WS_PROJ = 544 * MiB;
constexpr size_t WS_END = 808 * MiB;
constexpr int CW_CNTE = 1024;
constexpr int CW_CNTC = 2048;

struct Tok { unsigned ids; float wlo, whi; unsigned pad; };

struct Ptrs {
    const float *x, *c, *ctx, *c_ctx, *w_mod, *b_mod, *norm1_g, *norm2_g, *w_in, *gmlp_g, *w_s, *b_s, *conv_w, *sink, *w_out, *router_w, *router_b, *w_gate, *w_up, *w_down, *final_g;
    float* out; unsigned char* ws;
};
__device__ __forceinline__ int modrow(int m) { return m < ML ? (m >> 13) : 8; }

#define LAS __attribute__((address_space(3)))
#define XB_TMO      128
#define XB_XCNT(j)  (256  + 64 * (j))
#define XB_XSUB(j)  (1280 + 64 * (j))
#define XB_XGEN(j)  (2304 + 64 * (j))
#define XB_TOP      3328
#define XB_TOPGEN   3392
#define XCD_BAR_WORDS 3456
#define XB_SPIN_CAP (1u << 18)

__device__ __forceinline__ unsigned xb_ld(unsigned* p)              { return __hip_atomic_load(p, __ATOMIC_RELAXED, __HIP_MEMORY_SCOPE_AGENT); }
__device__ __forceinline__ unsigned xb_add(unsigned* p, unsigned v) { return __hip_atomic_fetch_add(p, v, __ATOMIC_RELAXED, __HIP_MEMORY_SCOPE_AGENT); }
__device__ __forceinline__ unsigned xb_xcc_id() { return (unsigned)__builtin_amdgcn_s_getreg((3 << 11) | 20) & 0xFu; }
#define XB_SPIN(cond, bar) do { unsigned _sp = 0; while (cond) { __builtin_amdgcn_s_sleep(1); \
    if ((++_sp & 255u) == 0u) { if (xb_ld(&(bar)[XB_TMO])) break; if (_sp > XB_SPIN_CAP) { atomicAdd(&(bar)[XB_TMO], 1u); break; } } } } while (0)

struct XcdBarrier {
    unsigned* bar; unsigned x;
    volatile LAS unsigned* st;
};

__device__ __forceinline__ XcdBarrier xcd_barrier_post(unsigned* bar, volatile LAS unsigned* st) {
    XcdBarrier b; b.bar = bar; b.x = xb_xcc_id(); b.st = st;
    if (threadIdx.x == 0) (void)xb_add(&bar[XB_XCNT(b.x)], 1u);
    return b;
}
__device__ __forceinline__ void xcd_barrier_complete(unsigned* bar, unsigned x, unsigned& nloc, unsigned& nx) {
    const unsigned G = gridDim.x * gridDim.y * gridDim.z;
    unsigned sum, cnt, mine, sp = 0u;
    for (;;) {
        sum = 0u; cnt = 0u; mine = 0u;
#pragma unroll
        for (unsigned j = 0; j < 16; ++j) { const unsigned c = xb_ld(&bar[XB_XCNT(j)]); sum += c; cnt += (c > 0u) ? 1u : 0u; mine = (j == x) ? c : mine; }
        if (sum == G) break;
        __builtin_amdgcn_s_sleep(1);
        if ((++sp & 255u) == 0u) { if (xb_ld(&bar[XB_TMO])) break; if (sp > XB_SPIN_CAP) { atomicAdd(&bar[XB_TMO], 1u); break; } }
    }
    nloc = mine > 0u ? mine : 1u; nx = cnt > 0u ? cnt : 1u;
}

__device__ __forceinline__ void xcd_barrier(const XcdBarrier& b) {
    asm volatile("s_waitcnt vmcnt(0)" ::: "memory");
    __syncthreads();
    if (threadIdx.x == 0) {
        unsigned* bar = b.bar;
        __builtin_amdgcn_s_waitcnt(0);
        unsigned nloc = b.st[0], nx = b.st[1];
        if (nloc == 0u) { xcd_barrier_complete(bar, b.x, nloc, nx); b.st[0] = nloc; b.st[1] = nx; }
        const unsigned old = xb_add(&bar[XB_XSUB(b.x)], 1u);
        const unsigned gen = old / nloc;
        if (old + 1u == (gen + 1u) * nloc) {
            __builtin_amdgcn_fence(__ATOMIC_RELEASE, "agent");
            asm volatile("s_waitcnt vmcnt(0)" ::: "memory");
            const unsigned og = xb_add(&bar[XB_TOP], 1u);
            const unsigned tg = og / nx;
            if (og + 1u == (tg + 1u) * nx) xb_add(&bar[XB_TOPGEN], 1u);
            else XB_SPIN(xb_ld(&bar[XB_TOPGEN]) == tg, bar);
            __builtin_amdgcn_fence(__ATOMIC_ACQUIRE, "agent");
            xb_add(&bar[XB_XGEN(b.x)], 1u);
            asm volatile("s_waitcnt vmcnt(0)" ::: "memory");
        } else {
            XB_SPIN(xb_ld(&bar[XB_XGEN(b.x)]) == gen, bar);
            __builtin_amdgcn_fence(__ATOMIC_ACQUIRE, "agent");
            asm volatile("s_waitcnt vmcnt(0)" ::: "memory");
        }
    }
    __syncthreads();
}
typedef short bf16x8 __attribute__((ext_vector_type(8)));
typedef int v4i32 __attribute__((ext_vector_type(4)));
typedef int v8i32 __attribute__((ext_vector_type(8)));
namespace pg {
constexpr int BM = 256, BK = 64, HALF = 128, HTB = HALF * BK * 2  , STAGE_BYTES = 8 * HTB, NXCD = 8, WGM = 8;
__host__ __device__ __forceinline__ int lds_byte(int r, int c) { return (r >> 3) * 1024 + (r & 7) * 128 + (((c >> 3) ^ (r & 7)) << 4); }
__host__ __device__ __forceinline__ void stage_rc(int b, int& R, int& C) { const int piece = b >> 10, p = (b & 1023) >> 4; R = piece * 8 + (p >> 3); C = ((p & 7) ^ (R & 7)) << 3; }

struct Unit { int pm, pn, x0, x1; };

__device__ __forceinline__ void order_unit(int L, int nM, int nN, int& pm, int& pn) {
    const int nwg = nM * nN; int wgid = L;
    { const int q = nwg / NXCD, r = nwg % NXCD, xcd = wgid % NXCD, off = wgid / NXCD; wgid = (xcd < r ? xcd * (q + 1) : r * (q + 1) + (xcd - r) * q) + off; }
    const int nig = WGM * nN, gid = wgid / nig, fm = gid * WGM, gsz = (nM - fm) < WGM ? (nM - fm) : WGM;
    pm = fm + ((wgid % nig) % gsz); pn = (wgid % nig) / gsz;
}

template <class Sched, class Epi>
__device__ __forceinline__ void gemm_phase(LAS unsigned char* lds, LAS unsigned* idxtab, const Sched& S, const Epi& E) {
    constexpr int ESZ = Sched::ESZ;
    constexpr int K = Sched::K, LDA = Sched::LDA, LDB = Sched::LDB, nt = K * ESZ / 128, KS = Sched::KSPLIT; constexpr bool GATHER = Sched::GATHER;
    int tid = threadIdx.x; asm volatile("" : "+v"(tid));
    const int wid = __builtin_amdgcn_readfirstlane(tid >> 6), lane = tid & 63, wr = wid >> 2, wc = wid & 3;
    constexpr size_t kstep = (size_t)(BK * 2);
    constexpr size_t hstepA = (size_t)HALF * LDA * ESZ, hstepB = (size_t)HALF * LDB * ESZ;
    const unsigned ldsw = (unsigned)wid * 1024u;
    const int aoff0 = lds_byte(wr * 64 + (lane & 15), (lane >> 4) * 8), boff0 = lds_byte(wc * 32 + (lane & 15), (lane >> 4) * 8);
    unsigned pvoA[2], pvoB[2];
#pragma unroll
    for (int i = 0; i < 2; ++i) { int R_, C_; stage_rc((wid * 64 + lane) * 16 + i * 8192, R_, C_); pvoA[i] = (unsigned)(R_ * LDA * ESZ + C_ * 2); pvoB[i] = (unsigned)(R_ * LDB * ESZ + C_ * 2); }
    unsigned cv[2][2];
#define PG_SA(b, h) (((b) * 2 + (h)) * HTB)
#define PG_SB(b, h) ((4 + (b) * 2 + (h)) * HTB)
#define PG_VOFF(ld, i, dst) do { int _t = wid * 64 + lane; asm volatile("" : "+v"(_t)); int _R, _C; stage_rc(_t * 16 + (i) * 8192, _R, _C); dst = (unsigned)(_R * (ld) * ESZ + _C * 2); } while (0)
#define PG_STAGE_B(bufoff, gbase) do { _Pragma("unroll") for (int _i = 0; _i < 2; ++_i) { unsigned _vo = pvoB[_i]; if constexpr (ESZ == 1) PG_VOFF(LDB, _i, _vo); \
        __builtin_amdgcn_global_load_lds((const unsigned*)((const char*)(gbase) + _vo), (LAS unsigned*)(lds + (bufoff) + ldsw + _i * 8192), 16, 0, 0); } } while (0)
#define PG_STAGE_A(bufoff, gbase, h, V) do { _Pragma("unroll") for (int _i = 0; _i < 2; ++_i) { unsigned _vo = pvoA[_i]; if constexpr (ESZ == 1 && !GATHER) PG_VOFF(LDA, _i, _vo); \
        const char* _p = GATHER ? (const char*)(gbase) + V[h][_i] : (const char*)(gbase) + ((h) ? hstepA : 0) + _vo; \
        __builtin_amdgcn_global_load_lds((const unsigned*)_p, (LAS unsigned*)(lds + (bufoff) + ldsw + _i * 8192), 16, 0, 0); } } while (0)
#define PG_LDA(dst, b, h) do { int _a1 = aoff0 ^ 64; asm volatile("" : "+v"(_a1)); _Pragma("unroll") for (int m = 0; m < 4; ++m) _Pragma("unroll") for (int k = 0; k < 2; ++k) dst[m][k] = *(const LAS bf16x8*)(lds + PG_SA(b, h) + (k ? _a1 : aoff0) + m * 2048); } while (0)
#define PG_LDB(dst, b, h) do { int _b1 = boff0 ^ 64; asm volatile("" : "+v"(_b1)); _Pragma("unroll") for (int n = 0; n < 2; ++n) _Pragma("unroll") for (int k = 0; k < 2; ++k) dst[n][k] = *(const LAS bf16x8*)(lds + PG_SB(b, h) + (k ? _b1 : boff0) + n * 2048); } while (0)
#define PG_MMA(ai, bj, At, Bt) do { __builtin_amdgcn_s_setprio(1); _Pragma("unroll") for (int m = 0; m < 4; ++m) _Pragma("unroll") for (int n = 0; n < 2; ++n) { \
        if constexpr (ESZ == 2) { _Pragma("unroll") for (int k = 0; k < 2; ++k) acc[ai][bj][m][n] = __builtin_amdgcn_mfma_f32_16x16x32_bf16(Bt[n][k], At[m][k], acc[ai][bj][m][n], 0, 0, 0); } \
        else {   \
            const v8i32 bw = __builtin_shufflevector(__builtin_bit_cast(v4i32, Bt[n][0]), __builtin_bit_cast(v4i32, Bt[n][1]), 0, 1, 2, 3, 4, 5, 6, 7); \
            const v8i32 aw = __builtin_shufflevector(__builtin_bit_cast(v4i32, At[m][0]), __builtin_bit_cast(v4i32, At[m][1]), 0, 1, 2, 3, 4, 5, 6, 7); \
            acc[ai][bj][m][n] = __builtin_amdgcn_mfma_scale_f32_16x16x128_f8f6f4(bw, aw, acc[ai][bj][m][n], 0, 0, 0, Sched::SCALE_B, 0, Sched::SCALE_A); } } \
        __builtin_amdgcn_s_setprio(0); } while (0)
#define PG_WAIT_V(n) asm volatile("s_waitcnt vmcnt(" #n ")" ::: "memory")
#define PG_WAIT_L(n) asm volatile("s_waitcnt lgkmcnt(" #n ")" ::: "memory")
#define PG_BAR __builtin_amdgcn_s_barrier()
#define PG_SCHED __builtin_amdgcn_sched_barrier(0)
#define PG_IDX_ISSUE(u) do { int _l = lane; asm volatile("" : "+v"(_l)); const int _h = (_l >> 4) & 1, _i = (_l >> 3) & 1, _r = _l & 7; const unsigned _po = (unsigned)(_h * 128 + (wid + 8 * _i) * 8 + _r) * 16u; \
        __builtin_amdgcn_global_load_lds((const unsigned*)((const char*)S.idx_src(u) + _po), (LAS unsigned*)(idxtab + wid * 64), 4, 0, 0); } while (0)
#define PG_IDX_READ(u, V) do { const int _vr = S.valid_rows(u); _Pragma("unroll") for (int _h = 0; _h < 2; ++_h) _Pragma("unroll") for (int _i = 0; _i < 2; ++_i) { \
        const int _pos = _h * 128 + (wid + 8 * _i) * 8 + (lane >> 3); unsigned _tk = *(volatile LAS unsigned*)(idxtab + wid * 64 + _h * 16 + _i * 8 + (lane >> 3)); \
        _tk = _pos < _vr ? _tk : 0u; V[_h][_i] = _tk * (unsigned)(LDA * ESZ) + (unsigned)(((lane & 7) ^ ((lane >> 3) & 7)) << 4); } } while (0)
    Unit cur, nxt; int ui = 0;
    if (!S.next(0, cur)) return;
    f32x4 acc[2][2][4][2];
#pragma unroll
    for (int a = 0; a < 2; ++a)
#pragma unroll
        for (int b = 0; b < 2; ++b)
#pragma unroll
            for (int m = 0; m < 4; ++m)
#pragma unroll
                for (int n = 0; n < 2; ++n) acc[a][b][m][n] = (f32x4){0.f, 0.f, 0.f, 0.f};
    bf16x8 At[4][2], B0[2][2], B1[2][2];
    const char* cA = S.a_base(cur); const char* cB0 = S.b_base(cur, 0); const char* cB1 = S.b_base(cur, 1);
#pragma unroll
    for (int h = 0; h < 2; ++h)
#pragma unroll
        for (int i = 0; i < 2; ++i) cv[h][i] = 0u;
    if constexpr (GATHER) { PG_IDX_ISSUE(cur); PG_WAIT_V(0); PG_IDX_READ(cur, cv); }
    PG_STAGE_B(PG_SB(0, 0), cB0); PG_STAGE_B(PG_SB(0, 1), cB0 + hstepB); PG_STAGE_A(PG_SA(0, 0), cA, 0, cv); PG_STAGE_A(PG_SA(0, 1), cA, 1, cv);
    if (wr == 1) PG_BAR;
    PG_WAIT_V(2); PG_BAR;
    PG_STAGE_B(PG_SB(1, 0), cB0 + kstep); PG_STAGE_A(PG_SA(1, 0), cA + kstep, 0, cv); PG_STAGE_B(PG_SB(1, 1), cB0 + hstepB + kstep);
    PG_WAIT_V(6); PG_BAR;
    for (;;) {
        const bool has_next = S.next(ui + 1, nxt);
        const char* nA = has_next ? S.a_base(nxt) : cA; const char* nB0 = has_next ? S.b_base(nxt, 0) : cB0; const char* nB1 = has_next ? S.b_base(nxt, 1) : cB1;
        if constexpr (GATHER) { if (has_next) PG_IDX_ISSUE(nxt); }
#pragma nounroll
        for (int t = 0; t < nt; t += 2) {
            const bool last = (t == nt - 2);
            const char* a1 = cA + (size_t)(t + 1) * kstep;
            const char* a2 = last ? nA : cA + (size_t)(t + 2) * kstep; const char* a3 = a2 + kstep;
            const char* b2 = last ? nB0 : ((t + 2) < KS ? cB0 : cB1) + (size_t)(t + 2) * kstep;
            const char* b3 = last ? nB0 + kstep : ((t + 3) < KS ? cB0 : cB1) + (size_t)(t + 3) * kstep;
            PG_LDB(B0, 0, 0); PG_LDB(B1, 0, 1); PG_SCHED; PG_LDA(At, 0, 0); PG_STAGE_A(PG_SA(1, 1), a1, 1, cv);
            if constexpr (GATHER) { if (last && has_next) { PG_IDX_READ(nxt, cv); } }
            PG_WAIT_V(8); PG_WAIT_L(0); PG_BAR; PG_MMA(0, 0, At, B0); PG_MMA(0, 1, At, B1); PG_BAR; PG_SCHED;
            PG_LDA(At, 0, 1); PG_STAGE_B(PG_SB(0, 0), b2); PG_STAGE_B(PG_SB(0, 1), b2 + hstepB); PG_STAGE_A(PG_SA(0, 0), a2, 0, cv);
            PG_WAIT_V(8); PG_WAIT_L(0); PG_BAR; PG_MMA(1, 0, At, B0); PG_MMA(1, 1, At, B1); PG_BAR; PG_SCHED;
            PG_LDB(B0, 1, 0); PG_LDB(B1, 1, 1); PG_SCHED; PG_LDA(At, 1, 0); PG_STAGE_A(PG_SA(0, 1), a2, 1, cv);
            PG_WAIT_V(8); PG_WAIT_L(0); PG_BAR; PG_MMA(0, 0, At, B0); PG_MMA(0, 1, At, B1); PG_BAR; PG_SCHED;
            PG_LDA(At, 1, 1); PG_STAGE_B(PG_SB(1, 0), b3); PG_STAGE_B(PG_SB(1, 1), b3 + hstepB); PG_STAGE_A(PG_SA(1, 0), a3, 0, cv);
            PG_WAIT_V(8); PG_WAIT_L(0); PG_BAR; PG_MMA(1, 0, At, B0); PG_MMA(1, 1, At, B1); PG_BAR; PG_SCHED;
        }
        if (wr == 0) PG_BAR;
        { int _l = lane; asm volatile("" : "+v"(_l)); E(acc, cur, wr, wc, _l & 15, _l >> 4); }
        if (!has_next) break;
#pragma unroll
        for (int a = 0; a < 2; ++a)
#pragma unroll
            for (int b = 0; b < 2; ++b)
#pragma unroll
                for (int m = 0; m < 4; ++m)
#pragma unroll
                    for (int n = 0; n < 2; ++n) acc[a][b][m][n] = (f32x4){0.f, 0.f, 0.f, 0.f};
        cur = nxt; cA = nA; cB0 = nB0; cB1 = nB1; ++ui;
        if (wr == 1) PG_BAR;
    }
    PG_WAIT_V(0);
    PG_BAR;
#undef PG_SA
#undef PG_SB
#undef PG_STAGE_A
#undef PG_STAGE_B
#undef PG_VOFF
#undef PG_LDA
#undef PG_LDB
#undef PG_MMA
#undef PG_WAIT_V
#undef PG_WAIT_L
#undef PG_BAR
#undef PG_SCHED
#undef PG_IDX_ISSUE
#undef PG_IDX_READ
}
}
constexpr int NWAVES = 8, NTHR = 512;
constexpr int RING_OFF = 0, RING_BYTES = 131072;
constexpr int IDX_OFF = RING_BYTES;
constexpr int TST_OFF = IDX_OFF + 2048;
constexpr int MISC_OFF = TST_OFF + 128;
constexpr int LDS_BYTES = 147456;
constexpr size_t WS_MODP = WS_VN;
constexpr size_t WS_WSB = 62 * MiB;
constexpr int CW_CNTF = 16384;
constexpr int CW_XR = 12288;
constexpr int CW_MXQ = 13312;
constexpr int CW_BAR = 8192;
constexpr int MAXT = 288;

struct ClsRec { int m; float wlo, whi; int pad; };
constexpr size_t WS_LISTR = 816 * MiB;
constexpr size_t WS_XB = 848 * MiB;
constexpr size_t WS_POS = WS_TOK;
constexpr size_t WS_END2 = 980 * MiB;

__device__ __forceinline__ void cls_experts(int cls, int& elo, int& ehi) {
    const int g = cls / 6, p = cls % 6; const int a = p < 3 ? 0 : (p < 5 ? 1 : 2), b = p < 3 ? p + 1 : (p < 5 ? p - 1 : 3);
    elo = g * 4 + a; ehi = g * 4 + b;
}
constexpr int F8_SH_H = 4, F8_SH_A = 3, F8_SH_W = 5;
#define SC_E8(sh) ((127 - (sh)) * 0x01010101)
__device__ __forceinline__ unsigned pk4_fp8(float a, float b, float c, float d, float scale) {
    const float lim = 448.0f; a = fminf(fmaxf(a * scale, -lim), lim); b = fminf(fmaxf(b * scale, -lim), lim); c = fminf(fmaxf(c * scale, -lim), lim); d = fminf(fmaxf(d * scale, -lim), lim);
    int w = __builtin_amdgcn_cvt_pk_fp8_f32(a, b, 0, false); w = __builtin_amdgcn_cvt_pk_fp8_f32(c, d, w, true); return (unsigned)w; }
__device__ __forceinline__ unsigned cvt_pk_bf16(float lo, float hi) { unsigned r; asm volatile("v_cvt_pk_bf16_f32 %0, %1, %2" : "=v"(r) : "v"(lo), "v"(hi)); return r; }

template <int N_> struct SchedDense {
    static constexpr int K = 1024, LDA = 1024, LDB = 1024, KSPLIT = 16, ESZ = 2, SCALE_A = 0, SCALE_B = 0; static constexpr bool GATHER = false;
    const bf16_t* A; const bf16_t* Bt; int nM, G, c;
    __device__ __forceinline__ bool next(int i, pg::Unit& u) const { const long L = (long)i * G + c; if (L >= (long)nM * (N_ / 256)) return false; pg::order_unit((int)L, nM, N_ / 256, u.pm, u.pn); u.x0 = 0; u.x1 = 0; return true; }
    __device__ __forceinline__ const char* a_base(const pg::Unit& u) const { return (const char*)A + (size_t)u.pm * 256 * LDA * 2; }
    __device__ __forceinline__ const char* b_base(const pg::Unit& u, int) const { return (const char*)Bt + (size_t)u.pn * 256 * LDB * 2; }
    __device__ __forceinline__ const unsigned* idx_src(const pg::Unit&) const { return nullptr; }
    __device__ __forceinline__ int valid_rows(const pg::Unit&) const { return 256; }
};
__device__ __forceinline__ void cls_of_tile(const LAS int* tst, int T, int& cls, int& rt) {
    int c = 0;
#pragma unroll
    for (int k = 1; k < NCLS; ++k) c += (T >= tst[k]) ? 1 : 0;
    cls = __builtin_amdgcn_readfirstlane(c); rt = __builtin_amdgcn_readfirstlane(T - tst[c]);
}
struct SchedGU {
    static constexpr int K = 1024, LDA = 1024, LDB = 1024, KSPLIT = 8, ESZ = 1, SCALE_A = SC_E8(F8_SH_H), SCALE_B = SC_E8(F8_SH_W); static constexpr bool GATHER = true;
    const unsigned char* H; const unsigned char* Wgu; const ClsRec* list; const LAS int* tst; const unsigned* cnt; int G, c;
    __device__ __forceinline__ bool next(int i, pg::Unit& u) const { const int TT = __builtin_amdgcn_readfirstlane(tst[NCLS]); const long L = (long)i * G + c; if (L >= (long)TT * 8) return false;
        pg::order_unit((int)L, TT, 8, u.pm, u.pn); cls_of_tile(tst, u.pm, u.x0, u.x1); return true; }
    __device__ __forceinline__ const char* a_base(const pg::Unit&) const { return (const char*)H; }
    __device__ __forceinline__ const char* b_base(const pg::Unit& u, int) const { int elo, ehi; cls_experts(u.x0, elo, ehi); const int e = u.pn < 4 ? elo : ehi;
        return (const char*)Wgu + ((size_t)e * 1024 + (size_t)(u.pn & 3) * 256) * LDB; }
    __device__ __forceinline__ const unsigned* idx_src(const pg::Unit& u) const { return (const unsigned*)(list + (size_t)u.x0 * MT + (size_t)u.x1 * 256); }
    __device__ __forceinline__ int valid_rows(const pg::Unit& u) const { return (int)cnt[u.x0 * 64] - u.x1 * 256; }
};
struct SchedDown {
    static constexpr int K = 1024, LDA = 1024, LDB = 512, KSPLIT = 4, ESZ = 1, SCALE_A = SC_E8(F8_SH_A), SCALE_B = SC_E8(F8_SH_W); static constexpr bool GATHER = false;
    const unsigned char* ACT; const unsigned char* Wd; const LAS int* tst; int G, c;
    __device__ __forceinline__ bool next(int i, pg::Unit& u) const { const int TT = __builtin_amdgcn_readfirstlane(tst[NCLS]); const long L = (long)i * G + c; if (L >= (long)TT * 4) return false;
        pg::order_unit((int)L, TT, 4, u.pm, u.pn); cls_of_tile(tst, u.pm, u.x0, u.x1); return true; }
    __device__ __forceinline__ const char* a_base(const pg::Unit& u) const { return (const char*)ACT + (size_t)u.pm * 256 * LDA; }
    __device__ __forceinline__ const char* b_base(const pg::Unit& u, int part) const { int elo, ehi; cls_experts(u.x0, elo, ehi); const int e = part ? ehi : elo;
        return (const char*)Wd + ((size_t)e * 1024 + (size_t)u.pn * 256) * LDB - (part ? (size_t)KSPLIT * 128 : 0); }
    __device__ __forceinline__ const unsigned* idx_src(const pg::Unit&) const { return nullptr; }
    __device__ __forceinline__ int valid_rows(const pg::Unit&) const { return 256; }
};

#define OPAQUE(x) asm volatile("" : "+v"(x))
#define ROWSTEP(m) ((m) == 3 ? 80 : 16)
struct EpiProj {
    bf16_t* O; const float* tab;
    __device__ __forceinline__ void operator()(const f32x4 (&acc)[2][2][4][2], const pg::Unit& u, int wr, int wc, int fr, int fq) const {
        const bool latent = u.pm < ML / 256;
        char* base = (char*)(O + (size_t)u.pm * 256 * INC + u.pn * 256);
        unsigned off = (unsigned)((wr * 64 + fr) * INC + wc * 32 + 4 * fq) * 2u; OPAQUE(off);
        int t = ((u.pm * 256) & (SEQ - 1)) + wr * 64 + fr; OPAQUE(t);
#pragma unroll
        for (int ai = 0; ai < 2; ++ai)
#pragma unroll
            for (int m = 0; m < 4; ++m) { char* rowp = base + off;
                const int pos = (wc & 1) ? (t & 63) : (t >> 6);
#pragma unroll
                for (int bj = 0; bj < 2; ++bj) { f32x4 v0 = acc[ai][bj][m][0], v1 = acc[ai][bj][m][1];
                    const bool rope = latent && (u.pn == 5 || u.pn == 6 || (u.pn == 7 && bj == 0));
                    if (rope) { const f32x4 cs = *(const f32x4*)(tab + pos * 16 + 4 * fq), sn = *(const f32x4*)(tab + 2048 + pos * 16 + 4 * fq);
                        const f32x4 o1 = v0 * cs - v1 * sn, o2 = v1 * cs + v0 * sn; v0 = o1; v1 = o2; }
                    u32x2 w0, w1; w0.x = cvt_pk_bf16(v0[0], v0[1]); w0.y = cvt_pk_bf16(v0[2], v0[3]); w1.x = cvt_pk_bf16(v1[0], v1[1]); w1.y = cvt_pk_bf16(v1[2], v1[3]);
                    *(u32x2*)(rowp + bj * 256) = w0; *(u32x2*)(rowp + bj * 256 + 32) = w1; }
                off += (unsigned)(ROWSTEP(m) * INC * 2); t += ROWSTEP(m); OPAQUE(off); OPAQUE(t); }
    }
};
struct EpiPlain {
    bf16_t* O; int ldo;
    __device__ __forceinline__ void operator()(const f32x4 (&acc)[2][2][4][2], const pg::Unit& u, int wr, int wc, int fr, int fq) const {
        char* base = (char*)(O + (size_t)u.pm * 256 * ldo + u.pn * 256);
        unsigned off = (unsigned)((wr * 64 + fr) * ldo + wc * 32 + 8 * fq) * 2u; OPAQUE(off);
#pragma unroll
        for (int ai = 0; ai < 2; ++ai)
#pragma unroll
            for (int m = 0; m < 4; ++m) {
#pragma unroll
                for (int bj = 0; bj < 2; ++bj) { const f32x4 v0 = acc[ai][bj][m][0], v1 = acc[ai][bj][m][1];
                    u32x4 w; w.x = cvt_pk_bf16(v0[0], v0[1]); w.y = cvt_pk_bf16(v0[2], v0[3]); w.z = cvt_pk_bf16(v1[0], v1[1]); w.w = cvt_pk_bf16(v1[2], v1[3]);
                    *(u32x4*)(base + off + bj * 256) = w; }
                off += (unsigned)(ROWSTEP(m) * ldo * 2); OPAQUE(off); }
    }
};
struct EpiGU {
    unsigned char* ACT; const ClsRec* list; const unsigned* cnt;
    __device__ __forceinline__ void operator()(const f32x4 (&acc)[2][2][4][2], const pg::Unit& u, int wr, int wc, int fr, int fq) const {
        const int vr = (int)cnt[u.x0 * 64] - u.x1 * 256; const char* rec = (const char*)(list + (size_t)u.x0 * MT + (size_t)u.x1 * 256) + (u.pn >= 4 ? 8 : 4);
        unsigned char* base = ACT + (size_t)u.pm * 256 * 1024 + (u.pn >> 2) * 512 + (u.pn & 3) * 128;
        int r = wr * 64 + fr; OPAQUE(r); unsigned off = (unsigned)(r * 1024 + wc * 32 + 8 * fq); OPAQUE(off);
#pragma unroll
        for (int ai = 0; ai < 2; ++ai)
#pragma unroll
            for (int m = 0; m < 4; ++m) { float w = 0.f;
                if (r < vr) w = *(const float*)(rec + (size_t)r * 16);
                w *= (float)(1 << F8_SH_A);
                u32x2 pk;
#pragma unroll
                for (int bj = 0; bj < 2; ++bj) { const f32x4 g = acc[ai][bj][m][0], up = acc[ai][bj][m][1]; float o[4];
#pragma unroll
                    for (int i = 0; i < 4; ++i) o[i] = g[i] * __builtin_amdgcn_rcpf(1.0f + __builtin_amdgcn_exp2f(-LOG2E * g[i])) * up[i];
                    const unsigned v = pk4_fp8(o[0], o[1], o[2], o[3], w); if (bj == 0) pk.x = v; else pk.y = v; }
                *(u32x2*)(base + off) = pk;
                off += (unsigned)(ROWSTEP(m) * 1024); r += ROWSTEP(m); OPAQUE(off); OPAQUE(r); }
    }
};

template <bool F8 = false> __device__ __forceinline__ void p0_transpose_item(const float* W, int Kd, int N, void* WTv, LAS float* scr, int item, int lane, int mode, int sc_lo, int sc_hi, float scale) {
    bf16_t* WT = (bf16_t*)WTv;
    const int nblk = N / 32, kb = item / nblk, nb = item % nblk, k0 = 64 * kb, n0 = 32 * nb;
    f32x4 rv[8];
#pragma unroll
    for (int i = 0; i < 8; ++i) rv[i] = *(const f32x4*)(W + (size_t)(k0 + 8 * i + (lane >> 3)) * N + n0 + 4 * (lane & 7));
#pragma unroll
    for (int i = 0; i < 8; ++i) { LAS float* d = scr + (8 * i + (lane >> 3)) * 33 + 4 * (lane & 7); d[0] = rv[i].x; d[1] = rv[i].y; d[2] = rv[i].z; d[3] = rv[i].w; }
    asm volatile("s_waitcnt lgkmcnt(0)" ::: "memory");
    const int c = lane & 7;
#pragma unroll
    for (int j = 0; j < 4; ++j) { const int n = (lane >> 3) + 8 * j, ng = n0 + n; const LAS float* s = scr + (8 * c) * 33 + n;
        const float f = (ng >= sc_lo && ng < sc_hi) ? scale : 1.0f;
        const int row = mode == 0 ? ng : mode == 3 ? ((ng & ~31) + 16 * ((ng >> 2) & 1) + 4 * ((ng >> 3) & 3) + (ng & 3))
                      : (256 * (ng >> 7) + 128 * ((ng >> 2) & 1) + 32 * ((ng >> 5) & 3) + 16 * (mode == 2 ? 1 : 0) + 4 * ((ng >> 3) & 3) + (ng & 3));
        if constexpr (F8) { u32x2 o; o.x = pk4_fp8(s[0 * 33], s[1 * 33], s[2 * 33], s[3 * 33], f * (float)(1 << F8_SH_W)); o.y = pk4_fp8(s[4 * 33], s[5 * 33], s[6 * 33], s[7 * 33], f * (float)(1 << F8_SH_W));
            *(u32x2*)((unsigned char*)WTv + (size_t)row * Kd + k0 + 8 * c) = o; }
        else { u32x4 o; o.x = pk2(s[0 * 33] * f, s[1 * 33] * f); o.y = pk2(s[2 * 33] * f, s[3 * 33] * f); o.z = pk2(s[4 * 33] * f, s[5 * 33] * f); o.w = pk2(s[6 * 33] * f, s[7 * 33] * f);
            *(u32x4*)(WT + (size_t)row * Kd + k0 + 8 * c) = o; } }
    asm volatile("s_waitcnt lgkmcnt(0)" ::: "memory");
}
__device__ __forceinline__ void phase_p0a(const Ptrs& P, LAS unsigned char* lds) {
    int tid = threadIdx.x; asm volatile("" : "+v"(tid)); const int lane = tid & 63, wave = __builtin_amdgcn_readfirstlane(tid >> 6);
    const int gw = blockIdx.x * NWAVES + wave, NGW = gridDim.x * NWAVES;
    LAS float* sil = (LAS float*)(lds + 73728);
    for (int i = tid; i < 9 * D; i += NTHR) { const int j = i >> 10, k = i & (D - 1); sil[i] = silu_f(j < 8 ? P.c[j * D + k] : P.c_ctx[k]); }
    __syncthreads();
    float* modp = (float*)(P.ws + WS_MODP);
    for (int u = gw; u < DEPTH * 24 * 16; u += NGW) { const int l = u / 384, r = u % 384, nc = r / 16, ks = r % 16;
        const float* w = P.w_mod + ((size_t)l * D + ks * 64) * 6144 + nc * 256 + 4 * lane;
        f32x4 a[9];
#pragma unroll
        for (int j = 0; j < 9; ++j) a[j] = (f32x4){0.f, 0.f, 0.f, 0.f};
#pragma unroll 4
        for (int k = 0; k < 64; ++k) { const f32x4 wv = *(const f32x4*)(w + (size_t)k * 6144);
#pragma unroll
            for (int j = 0; j < 9; ++j) a[j] += wv * sil[j * D + ks * 64 + k]; }
#pragma unroll
        for (int j = 0; j < 9; ++j) *(f32x4*)(modp + (((size_t)l * 16 + ks) * 9 + j) * 6144 + nc * 256 + 4 * lane) = a[j]; }
    { const int gt = blockIdx.x * NTHR + tid, NGT = gridDim.x * NTHR; float* tab = (float*)(P.ws + WS_ROPE);
      if (gt < 2048) { const int i = gt & 15, pos = gt >> 4; const float inv = powf(10000.0f, -(float)i / 16.0f), ang = (float)pos * inv; tab[gt] = cosf(ang); tab[2048 + gt] = sinf(ang); }
      bf16_t* wsb = (bf16_t*)(P.ws + WS_WSB);
      for (int i = gt; i < DEPTH * 4 * 128 * 128; i += NGT) wsb[i] = f2bf(P.w_s[i]); }
    LAS float* scr = (LAS float*)(lds + wave * 8448);
    constexpr int PER_L = 1024 + 512 + NE * 768;
    for (int it = gw; it < DEPTH * PER_L; it += NGW) { const int l = it / PER_L; int r = it % PER_L;
        if (r < 1024) { p0_transpose_item(P.w_in + (size_t)l * D * INC, D, INC, (bf16_t*)(P.ws + WS_WIN) + (size_t)l * INC * D, scr, r, lane, 0, C_Q, C_K, QSCALE); continue; } r -= 1024;
        if (r < 512) { p0_transpose_item(P.w_out + (size_t)l * D * D, D, D, (bf16_t*)(P.ws + WS_WOUT) + (size_t)l * D * D, scr, r, lane, 3, 0, 0, 1.f); continue; } r -= 512;
        const int e = r / 768, q = r % 768, which = q >> 8, idx = q & 255; const size_t le = (size_t)l * NE + e;
        if (which == 0) p0_transpose_item<true>(P.w_gate + le * D * DE, D, DE, P.ws + WS_WGU + le * 1024 * 1024, scr, idx, lane, 1, 0, 0, 1.f);
        else if (which == 1) p0_transpose_item<true>(P.w_up + le * D * DE, D, DE, P.ws + WS_WGU + le * 1024 * 1024, scr, idx, lane, 2, 0, 0, 1.f);
        else p0_transpose_item<true>(P.w_down + le * DE * D, DE, D, P.ws + WS_WD + le * 1024 * 512, scr, idx, lane, 3, 0, 0, 1.f); }
}
__device__ __forceinline__ void phase_p0b(const Ptrs& P) {
    const int gt = blockIdx.x * NTHR + threadIdx.x, NGT = gridDim.x * NTHR;
    const float* modp = (const float*)(P.ws + WS_MODP); float* mod = (float*)(P.ws + WS_MOD);
    for (int i = gt; i < DEPTH * 9 * 6144; i += NGT) { const int l = i / (9 * 6144), r = i % (9 * 6144), j = r / 6144, n = r % 6144;
        float s = P.b_mod[l * 6144 + n];
#pragma unroll
        for (int ks = 0; ks < 16; ++ks) s += modp[(((size_t)l * 16 + ks) * 9 + j) * 6144 + n];
        mod[i] = s; }
}

__device__ __forceinline__ void bf8_to_f32(const u32x4 v, float (&o)[8]) {
#pragma unroll
    for (int i = 0; i < 4; ++i) { o[2 * i] = __uint_as_float(v[i] << 16); o[2 * i + 1] = __uint_as_float(v[i] & 0xffff0000u); }
}
template <int R> struct NormRaw { u32x4 a[R][2], b[R][2]; int m0, nv; };
template <int MODE, bool FIRST, bool DRY = false> __device__ __forceinline__ void phase_norm(const Ptrs& P, LAS unsigned char* lds, int l, int Mrows, const bf16_t* Y, const LAS int* tst) {
    constexpr int R = MODE == 2 ? 2 : 4;
    int tid = threadIdx.x; asm volatile("" : "+v"(tid)); const int lane = tid & 63, wave = __builtin_amdgcn_readfirstlane(tid >> 6);
    const int gw = blockIdx.x * NWAVES + wave, NGW = gridDim.x * NWAVES;
    const int rpw = (Mrows + NGW - 1) / NGW;
    const int mBeg = gw * rpw, mEnd = (mBeg + rpw) < Mrows ? (mBeg + rpw) : Mrows;
    LAS float* rwT = (LAS float*)lds;
    constexpr int RPW = 40;
    LAS unsigned* recL = (LAS unsigned*)(lds + 65536);
    LAS unsigned* cntL = (LAS unsigned*)(lds + 65536 + NWAVES * RPW * 16);
    LAS unsigned* baseL = cntL + 32;
    LAS float* logL = (LAS float*)(lds + 65536 + 8192);
    if (MODE == 2) { if (tid < 64) cntL[tid] = 0u; for (int i = tid; i < D * NE; i += NTHR) rwT[(i & 15) * D + (i >> 4)] = P.router_w[i]; __syncthreads(); }
    const float* g = (MODE == 1 ? P.norm1_g + l * D : MODE == 2 ? P.norm2_g + l * D : P.final_g);
    f32x4 gg[2][2];
#pragma unroll
    for (int j = 0; j < 2; ++j) { gg[j][0] = (f32x4){0.f, 0.f, 0.f, 0.f}; gg[j][1] = gg[j][0]; if (MODE == 3) { gg[j][0] = *(const f32x4*)(g + 8 * lane + 512 * j); gg[j][1] = *(const f32x4*)(g + 8 * lane + 512 * j + 4); } }
    bf16_t* XB = (bf16_t*)(P.ws + WS_XB);
    unsigned posreg = 0u;
    if (MODE != 2 && !FIRST) { if (mBeg + lane < mEnd) posreg = ((const unsigned*)(P.ws + WS_POS))[mBeg + lane]; }
    f32x4 gt[2][2], scv[2][2], shv[2][2];
#pragma unroll
    for (int j = 0; j < 2; ++j)
#pragma unroll
        for (int q = 0; q < 2; ++q) { gt[j][q] = (f32x4){0.f, 0.f, 0.f, 0.f}; scv[j][q] = gt[j][q]; shv[j][q] = gt[j][q]; }
#define NR_LOAD(G, mstart) do { (G).m0 = (mstart); { const int bnd_ = (((mstart) >> 13) + 1) << 13; const int ge_ = bnd_ < mEnd ? bnd_ : mEnd; (G).nv = (ge_ - (mstart)) < R ? (ge_ - (mstart)) : R; } \
        _Pragma("unroll") for (int r = 0; r < R; ++r) { const int m = (G).m0 + (r < (G).nv ? r : (G).nv - 1); \
            if (FIRST) { const float* xr = m < ML ? P.x + (size_t)m * D : P.ctx + (size_t)(m - ML) * D; \
                _Pragma("unroll") for (int j = 0; j < 2; ++j) { (G).a[r][j] = *(const u32x4*)(xr + 8 * lane + 512 * j); (G).b[r][j] = *(const u32x4*)(xr + 8 * lane + 512 * j + 4); } \
            } else { size_t yrow = (size_t)m; \
                if (MODE != 2) { const unsigned ps = (unsigned)__builtin_amdgcn_readlane((int)posreg, m - mBeg); yrow = (size_t)tst[ps & 255u] * 256 + (ps >> 8); } \
                const bf16_t* yr = Y + yrow * D; \
                _Pragma("unroll") for (int j = 0; j < 2; ++j) { (G).a[r][j] = *(const u32x4*)(XB + (size_t)m * D + 8 * lane + 512 * j); (G).b[r][j] = *(const u32x4*)(yr + 8 * lane + 512 * j); } } } } while (0)
    NormRaw<R> G; G.m0 = mBeg; G.nv = 0;
    if (mBeg < mEnd) NR_LOAD(G, mBeg);
    bool more = mBeg < mEnd;
    while (more) {
        const int m0 = G.m0, nv = G.nv;
        float xv[R][2][8]; float ss[R];
        { const int mb = modrow(m0);
            {
                const float* modl = (const float*)(P.ws + WS_MOD) + ((size_t)l * 9 + mb) * 6144;
                const float* gate = MODE == 2 ? modl + 2048 : (const float*)(P.ws + WS_MOD) + ((size_t)(MODE == 3 ? 3 : (l > 0 ? l - 1 : 0)) * 9 + mb) * 6144 + 5120;
                const float* sh = modl + (MODE == 1 ? 0 : 3072); const float* sc = modl + (MODE == 1 ? 1024 : 4096);
#pragma unroll
                for (int j = 0; j < 2; ++j)
#pragma unroll
                    for (int q = 0; q < 2; ++q) { const int c = 8 * lane + 512 * j + 4 * q; gt[j][q] = *(const f32x4*)(gate + c); scv[j][q] = (*(const f32x4*)(sc + c) + 1.0f) * *(const f32x4*)(g + c); shv[j][q] = *(const f32x4*)(sh + c); } } }
#pragma unroll
        for (int r = 0; r < R; ++r) { const int m = m0 + (r < nv ? r : nv - 1);
#pragma unroll
            for (int j = 0; j < 2; ++j) {
                if (FIRST) { const f32x4 a = __builtin_bit_cast(f32x4, G.a[r][j]), b = __builtin_bit_cast(f32x4, G.b[r][j]);
                    xv[r][j][0] = a.x; xv[r][j][1] = a.y; xv[r][j][2] = a.z; xv[r][j][3] = a.w; xv[r][j][4] = b.x; xv[r][j][5] = b.y; xv[r][j][6] = b.z; xv[r][j][7] = b.w;
                } else { float xf[8], yf[8]; bf8_to_f32(G.a[r][j], xf); bf8_to_f32(G.b[r][j], yf);
#pragma unroll
                    for (int i = 0; i < 8; ++i) xv[r][j][i] = xf[i] + gt[j][i >> 2][i & 3] * yf[i]; } }
            if (MODE != 3 && r < nv) {
#pragma unroll
                for (int j = 0; j < 2; ++j) { u32x4 w; w.x = cvt_pk_bf16(xv[r][j][0], xv[r][j][1]); w.y = cvt_pk_bf16(xv[r][j][2], xv[r][j][3]); w.z = cvt_pk_bf16(xv[r][j][4], xv[r][j][5]); w.w = cvt_pk_bf16(xv[r][j][6], xv[r][j][7]);
                    *(u32x4*)(XB + (size_t)m * D + 8 * lane + 512 * j) = w; } }
            float s = 0.f;
#pragma unroll
            for (int j = 0; j < 2; ++j)
#pragma unroll
                for (int i = 0; i < 8; ++i) s += xv[r][j][i] * xv[r][j][i];
            ss[r] = s;
            if (MODE != 3) {
#pragma unroll
                for (int j = 0; j < 2; ++j)
#pragma unroll
                    for (int i = 0; i < 8; ++i) xv[r][j][i] = xv[r][j][i] * scv[j][i >> 2][i & 3];
            } }
        { const int nm0 = m0 + nv; more = nm0 < mEnd; if (more) NR_LOAD(G, nm0); }
#pragma unroll
        for (int o = 1; o < 64; o <<= 1) {
#pragma unroll
            for (int r = 0; r < R; ++r) ss[r] += __shfl_xor(ss[r], o); }
#pragma unroll
        for (int r = 0; r < R; ++r) { const int m = m0 + r; const float rinv = rsqrtf(ss[r] * (1.0f / D) + EPS);
            if (MODE == 3) { if (r < nv) { float* orow = P.out + (size_t)m * D;
#pragma unroll
                for (int j = 0; j < 2; ++j) { f32x4 a, b; a.x = xv[r][j][0]; a.y = xv[r][j][1]; a.z = xv[r][j][2]; a.w = xv[r][j][3]; b.x = xv[r][j][4]; b.y = xv[r][j][5]; b.z = xv[r][j][6]; b.w = xv[r][j][7];
                    *(f32x4*)(orow + 8 * lane + 512 * j) = a * rinv * gg[j][0]; *(f32x4*)(orow + 8 * lane + 512 * j + 4) = b * rinv * gg[j][1]; } }
            } else {
#pragma unroll
                for (int j = 0; j < 2; ++j)
#pragma unroll
                    for (int i = 0; i < 8; ++i) xv[r][j][i] = xv[r][j][i] * rinv + shv[j][i >> 2][i & 3];
                if (r < nv) {
                    if (MODE == 2) { unsigned char* H8 = (unsigned char*)(P.ws + WS_H) + (size_t)m * D;
#pragma unroll
                        for (int j = 0; j < 2; ++j) { u32x2 o; o.x = pk4_fp8(xv[r][j][0], xv[r][j][1], xv[r][j][2], xv[r][j][3], (float)(1 << F8_SH_H)); o.y = pk4_fp8(xv[r][j][4], xv[r][j][5], xv[r][j][6], xv[r][j][7], (float)(1 << F8_SH_H)); *(u32x2*)(H8 + 8 * lane + 512 * j) = o; }
                    } else { bf16_t* H = (bf16_t*)(P.ws + WS_H) + (size_t)m * D;
#pragma unroll
                        for (int j = 0; j < 2; ++j) { u32x4 o; o.x = cvt_pk_bf16(xv[r][j][0], xv[r][j][1]); o.y = cvt_pk_bf16(xv[r][j][2], xv[r][j][3]); o.z = cvt_pk_bf16(xv[r][j][4], xv[r][j][5]); o.w = cvt_pk_bf16(xv[r][j][6], xv[r][j][7]); *(u32x4*)(H + 8 * lane + 512 * j) = o; } } }
            } }
        if (MODE == 2) {
#pragma unroll
            for (int r = 0; r < R; ++r) {
                float lg[16];
#pragma unroll
                for (int e = 0; e < 16; ++e) lg[e] = 0.f;
#pragma unroll
                for (int j = 0; j < 2; ++j) { const int c = 8 * lane + 512 * j;
#pragma unroll
                    for (int e4 = 0; e4 < 4; ++e4) {
#pragma unroll
                        for (int e = 4 * e4; e < 4 * e4 + 4; ++e) { const f32x4 r0 = *(const LAS f32x4*)(rwT + e * D + c), r1 = *(const LAS f32x4*)(rwT + e * D + c + 4);
                            lg[e] += xv[r][j][0] * r0.x + xv[r][j][1] * r0.y + xv[r][j][2] * r0.z + xv[r][j][3] * r0.w + xv[r][j][4] * r1.x + xv[r][j][5] * r1.y + xv[r][j][6] * r1.z + xv[r][j][7] * r1.w; }
                        __builtin_amdgcn_sched_barrier(0); } }
                float v8[8], v4[4], v2[2], v1;
                { const bool up = (lane & 32) != 0;
#pragma unroll
                  for (int i = 0; i < 8; ++i) { const float send = up ? lg[i] : lg[i + 8]; const float keep = up ? lg[i + 8] : lg[i]; v8[i] = keep + __shfl_xor(send, 32); } }
                { const bool up = (lane & 16) != 0;
#pragma unroll
                  for (int i = 0; i < 4; ++i) { const float send = up ? v8[i] : v8[i + 4]; const float keep = up ? v8[i + 4] : v8[i]; v4[i] = keep + __shfl_xor(send, 16); } }
                { const bool up = (lane & 8) != 0;
#pragma unroll
                  for (int i = 0; i < 2; ++i) { const float send = up ? v4[i] : v4[i + 2]; const float keep = up ? v4[i + 2] : v4[i]; v2[i] = keep + __shfl_xor(send, 8); } }
                { const bool up = (lane & 4) != 0; const float send = up ? v2[0] : v2[1]; const float keep = up ? v2[1] : v2[0]; v1 = keep + __shfl_xor(send, 4); }
                v1 += __shfl_xor(v1, 2); v1 += __shfl_xor(v1, 1);
                if ((lane & 3) == 0 && r < nv) logL[(wave * RPW + (m0 - mBeg) + r) * 16 + (lane >> 2)] = v1;
            }
        }
    }
#undef NR_LOAD
    if (MODE == 2 && !DRY) {
        asm volatile("s_waitcnt lgkmcnt(0)" ::: "memory");
        if (lane < mEnd - mBeg) {
            float sco[16], sel[16];
#pragma unroll
            for (int e4 = 0; e4 < 4; ++e4) { const f32x4 v = *(const LAS f32x4*)(logL + (wave * RPW + lane) * 16 + 4 * e4);
#pragma unroll
                for (int i = 0; i < 4; ++i) { const int e = 4 * e4 + i; sco[e] = 1.0f / (1.0f + __expf(-v[i])); sel[e] = sco[e] + P.router_b[e]; } }
            int bg = 0; float bgs = -1e30f; int ba = 0, bb = 1; float sa = 0.f, sb = 0.f;
#pragma unroll
            for (int gI = 0; gI < 4; ++gI) {
                int i1 = 0; float v1 = sel[gI * 4], c1 = sco[gI * 4];
#pragma unroll
                for (int i = 1; i < 4; ++i) if (sel[gI * 4 + i] > v1) { v1 = sel[gI * 4 + i]; c1 = sco[gI * 4 + i]; i1 = i; }
                int i2 = -1; float v2 = -1e30f, c2 = 0.f;
#pragma unroll
                for (int i = 0; i < 4; ++i) if (i != i1 && sel[gI * 4 + i] > v2) { v2 = sel[gI * 4 + i]; c2 = sco[gI * 4 + i]; i2 = i; }
                const float gs = v1 + v2;
                if (gs > bgs) { bgs = gs; bg = gI; ba = i1; bb = i2; sa = c1; sb = c2; }
            }
            const int a = ba < bb ? ba : bb, b = ba < bb ? bb : ba;
            const float wl = ba < bb ? sa : sb, wh = ba < bb ? sb : sa, inv = 1.0f / (wl + wh);
            const int pairidx = (a == 0) ? (b - 1) : (a == 1 ? (b + 1) : 5);
            const int cls = bg * 6 + pairidx;
            const unsigned pl = __hip_atomic_fetch_add(cntL + cls, 1u, __ATOMIC_RELAXED, __HIP_MEMORY_SCOPE_WORKGROUP);
            LAS unsigned* rb = recL + (wave * RPW + lane) * 4; rb[0] = (unsigned)(mBeg + lane); rb[1] = __float_as_uint(wl * inv); rb[2] = __float_as_uint(wh * inv); rb[3] = (unsigned)cls | (pl << 8);
        }
        asm volatile("s_waitcnt lgkmcnt(0)" ::: "memory"); __syncthreads();
        unsigned* ctl = (unsigned*)(P.ws + WS_CTL);
        if (tid < NCLS) { const unsigned n = cntL[tid]; baseL[tid] = n ? atomicAdd(ctl + CW_CNTF + (l * 32 + tid) * 64, n) : 0u; }
        __syncthreads();
        ClsRec* listr = (ClsRec*)(P.ws + WS_LISTR); unsigned* posw = (unsigned*)(P.ws + WS_POS);
        for (int i = tid; i < NWAVES * RPW; i += NTHR) { const int w = i / RPW, r = i % RPW; const int wb = (blockIdx.x * NWAVES + w) * rpw; const int nw = (wb + rpw < Mrows ? wb + rpw : Mrows) - wb;
            if (r < nw) { const LAS unsigned* rb = recL + i * 4; const unsigned cls = rb[3] & 255u, pl = rb[3] >> 8, gp = baseL[cls] + pl;
                ClsRec rc; rc.m = (int)rb[0]; rc.wlo = __uint_as_float(rb[1]); rc.whi = __uint_as_float(rb[2]); rc.pad = 0;
                listr[(size_t)cls * MT + gp] = rc; posw[rb[0]] = cls | (gp << 8); } }
    }
}
__device__ __forceinline__ void build_tile_table(const Ptrs& P, LAS int* tst, int l) {
    if (threadIdx.x < 64) {
        int lane = threadIdx.x; asm volatile("" : "+v"(lane));
        const unsigned* cnt = (const unsigned*)(P.ws + WS_CTL) + CW_CNTF + l * 32 * 64;
        const int tiles = lane < NCLS ? (int)((__hip_atomic_load(cnt + lane * 64, __ATOMIC_RELAXED, __HIP_MEMORY_SCOPE_AGENT) + 255u) >> 8) : 0;
        int incl = tiles;
#pragma unroll
        for (int o = 1; o < 32; o <<= 1) { const int t = __shfl_up(incl, o); if (lane >= o) incl += t; }
        if (lane <= NCLS) tst[lane] = incl - tiles;
    }
    __syncthreads();
}
namespace mx {
typedef float f32x16 __attribute__((ext_vector_type(16)));
typedef short s16x4 __attribute__((ext_vector_type(4)));
constexpr int SLOTB = 8192;
constexpr int L_K = 0, L_V = 2 * SLOTB, L_WS = 4 * SLOTB, L_OST = L_WS + NWAVES * 256, L_END = L_OST + NWAVES * 4096;
constexpr int VT_PITCH = 136;
__device__ __forceinline__ int crow(int r, int hi) { return (r & 3) + 8 * (r >> 2) + 4 * hi; }
__device__ __forceinline__ unsigned cvtpk(float lo, float hi) { unsigned r; asm volatile("v_cvt_pk_bf16_f32 %0, %1, %2" : "=v"(r) : "v"(lo), "v"(hi)); return r; }
__device__ __forceinline__ float gelu_fast(float x) { const float y = x + 0.044715f * x * x * x; return x * __builtin_amdgcn_rcpf(1.0f + __builtin_amdgcn_exp2f(-2.302208198f * y)); }

__device__ __forceinline__ void qkt(f32x16& p0, f32x16& p1, const LAS unsigned char* Kslot, const bf16x8* qr, const f32x16& negm, int r32, int hi) {
    const LAS unsigned char* kb = Kslot + hi * 1024 + r32 * 16;
#pragma unroll
    for (int d0 = 0; d0 < 4; ++d0) {
        const bf16x8 b0 = *(const LAS bf16x8*)(kb + d0 * 2048), b1 = *(const LAS bf16x8*)(kb + d0 * 2048 + 512);
        if (d0 == 0) { p0 = __builtin_amdgcn_mfma_f32_32x32x16_bf16(b0, qr[0], negm, 0, 0, 0); p1 = __builtin_amdgcn_mfma_f32_32x32x16_bf16(b1, qr[0], negm, 0, 0, 0); }
        else { p0 = __builtin_amdgcn_mfma_f32_32x32x16_bf16(b0, qr[d0], p0, 0, 0, 0); p1 = __builtin_amdgcn_mfma_f32_32x32x16_bf16(b1, qr[d0], p1, 0, 0, 0); } }
}
__device__ __forceinline__ void pv(f32x16* o, unsigned vb, bf16x8 pa0, bf16x8 pa1, bf16x8 pa2, bf16x8 pa3) {
#pragma unroll
    for (int d0 = 0; d0 < 2; ++d0) { s16x4 lo[4], hi[4];
#pragma unroll
        for (int ks = 0; ks < 4; ++ks) {
            asm volatile("ds_read_b64_tr_b16 %0, %1 offset:%c2" : "=&v"(lo[ks]) : "v"(vb), "i"(d0 * 4096 + ks * 1024) : "memory");
            asm volatile("ds_read_b64_tr_b16 %0, %1 offset:%c2" : "=&v"(hi[ks]) : "v"(vb), "i"(d0 * 4096 + ks * 1024 + 512) : "memory"); }
        asm volatile("s_waitcnt lgkmcnt(0)" ::: "memory"); __builtin_amdgcn_sched_barrier(0);
#define MX_PK(k) (bf16x8){lo[k][0], lo[k][1], lo[k][2], lo[k][3], hi[k][0], hi[k][1], hi[k][2], hi[k][3]}
        o[d0] = __builtin_amdgcn_mfma_f32_32x32x16_bf16(pa0, MX_PK(0), o[d0], 0, 0, 0);
        o[d0] = __builtin_amdgcn_mfma_f32_32x32x16_bf16(pa1, MX_PK(1), o[d0], 0, 0, 0);
        o[d0] = __builtin_amdgcn_mfma_f32_32x32x16_bf16(pa2, MX_PK(2), o[d0], 0, 0, 0);
        o[d0] = __builtin_amdgcn_mfma_f32_32x32x16_bf16(pa3, MX_PK(3), o[d0], 0, 0, 0);
#undef MX_PK
    }
}
struct ConvRaw { u32x4 bg, c0, c1, c2, z0, z1, z2; };
__device__ __forceinline__ void conv_load(ConvRaw& R, const bf16_t* PROJ, int m0, int tid, int q) {
    const int seqmask = m0 < ML ? SEQ - 1 : CTXL - 1; const int mrel = m0 < ML ? m0 : m0 - ML;
    const int idx = q * NTHR + tid, row = idx >> 5, c = (idx & 31) * 8;
    const int t = (mrel + row) & seqmask; const bf16_t* pr = PROJ + (size_t)(m0 + row) * INC;
    R.bg = *(const u32x4*)(pr + C_BG + c); R.c1 = *(const u32x4*)(pr + C_CG + c); R.z1 = *(const u32x4*)(pr + C_Z + c);
    R.c0 = (u32x4){0u, 0u, 0u, 0u}; R.z0 = R.c0; R.c2 = R.c0; R.z2 = R.c0;
    if (t > 0) { R.c0 = *(const u32x4*)(pr - INC + C_CG + c); R.z0 = *(const u32x4*)(pr - INC + C_Z + c); }
    if (t < seqmask) { R.c2 = *(const u32x4*)(pr + INC + C_CG + c); R.z2 = *(const u32x4*)(pr + INC + C_Z + c); }
}
__device__ __forceinline__ void conv_finish(const ConvRaw& R, const float* cwl, bf16_t* MIXo, int m0, int tid, int q) {
    const int idx = q * NTHR + tid, row = idx >> 5, c = (idx & 31) * 8;
    const float* cw = cwl + c;
    float o[8];
#pragma unroll
    for (int i = 0; i < 8; ++i) { const int wI = i >> 1; const bool up = i & 1;
#define MX_BF(v) (up ? __uint_as_float((v)[wI] & 0xffff0000u) : __uint_as_float((v)[wI] << 16))
        const float y = MX_BF(R.c0) * MX_BF(R.z0) * cw[i] + MX_BF(R.c1) * MX_BF(R.z1) * cw[256 + i] + MX_BF(R.c2) * MX_BF(R.z2) * cw[512 + i];
        o[i] = MX_BF(R.bg) * y;
#undef MX_BF
    }
    u32x4 w; w.x = cvtpk(o[0], o[1]); w.y = cvtpk(o[2], o[3]); w.z = cvtpk(o[4], o[5]); w.w = cvtpk(o[6], o[7]);
    *(u32x4*)(MIXo + (size_t)(m0 + row) * D + 256 + c) = w;
}
constexpr int NSLOT = 4;
constexpr int ATT_THR = 8;
typedef float f32x2 __attribute__((ext_vector_type(2)));
#define MX3(a, b, c) __builtin_fmaxf(__builtin_fmaxf((a), (b)), (c))
constexpr int A_K = 0, A_V = NSLOT * SLOTB, A_WS = 2 * NSLOT * SLOTB, A_OST = A_WS + NWAVES * 512, A_END = A_OST + NWAVES * 4096;
template <int NH> __device__ __forceinline__ void attn_unit(const bf16_t* PROJ, bf16_t* MIXo, const float* sink, const float* cwl, LAS unsigned char* shm, int latent, int b, int blk, int kvh, int hp, int tid) {
    const int lane = tid & 63, r32 = lane & 31, hi = lane >> 5; const int wid = __builtin_amdgcn_readfirstlane(tid >> 6);
    const int head0 = NH == 2 ? kvh * 4 + (wid >> 2) * 2 : kvh * 4 + hp * 2 + (wid >> 2), qw = (wid & 3) * 32;
    const int qrow0 = latent ? b * SEQ + blk * 128 : ML + b * CTXL + blk * 128;
    const int ctx0 = ML + b * CTXL;
    const int lt_lo = latent ? (blk > 0 ? 0 : 2) : 0, lt_hi = latent ? (blk < SEQ / 128 - 1 ? 6 : 4) : 0;
    const int NT = 4 + (lt_hi - lt_lo);
    LAS float* wsf = (LAS float*)(shm + A_WS) + wid * 128;
    const bf16_t* kcol = PROJ + C_K + kvh * 64 + wid * 8;
    const bf16_t* vcol = PROJ + C_VV + kvh * 64 + (wid >> 2) * 32 + (lane & 3) * 8;
#define MX_TROW(t) ((t) < 4 ? ctx0 + 64 * (t) : b * SEQ + blk * 128 - 128 + 64 * ((t) - 4 + lt_lo))
#define MX_DMA(t) do { const int _r0 = MX_TROW(t); const int _sl = (t) & (NSLOT - 1); \
        __builtin_amdgcn_global_load_lds((const unsigned*)(kcol + (size_t)(_r0 + lane) * INC), (LAS unsigned*)(shm + A_K + _sl * SLOTB + wid * 1024), 16, 0, 0); \
        __builtin_amdgcn_global_load_lds((const unsigned*)(vcol + (size_t)(_r0 + 16 * (wid & 3) + (lane >> 2)) * INC), (LAS unsigned*)(shm + A_V + _sl * SLOTB + wid * 1024), 16, 0, 0); } while (0)
    static_assert(NH == 1, "the conv slice deal assumes four attention units per chunk");
    const int cm0 = qrow0 + (kvh * 2 + hp) * 32;
    ConvRaw CR; conv_load(CR, PROJ, cm0, tid, 0);
    bf16x8 qr[NH][4];
    { const bf16_t* qp = PROJ + (size_t)(qrow0 + qw + r32) * INC + C_Q + head0 * 64 + hi * 8;
#pragma unroll
      for (int hh = 0; hh < NH; ++hh)
#pragma unroll
          for (int d0 = 0; d0 < 4; ++d0) qr[hh][d0] = *(const bf16x8*)(qp + hh * 64 + d0 * 16); }
    MX_DMA(0); MX_DMA(1); MX_DMA(2);
    float mrun[NH], lsum[NH]; f32x16 o[NH][2], negm[NH];
#pragma unroll
    for (int hh = 0; hh < NH; ++hh) { mrun[hh] = sink[head0 + hh] * LOG2E; lsum[hh] = hi == 0 ? 1.0f : 0.0f;
#pragma unroll
        for (int r = 0; r < 16; ++r) negm[hh][r] = -mrun[hh];
        o[hh][0] = (f32x16){0.f, 0.f, 0.f, 0.f, 0.f, 0.f, 0.f, 0.f, 0.f, 0.f, 0.f, 0.f, 0.f, 0.f, 0.f, 0.f}; o[hh][1] = o[hh][0]; }
    const unsigned vb0 = (unsigned)(size_t)(shm + A_V) + ((lane >> 4) & 1) * 32 + (lane & 3) * 8 + (4 * hi + ((lane & 15) >> 2)) * 64;
    const int qc = qw + r32;
    for (int t = 0; t < NT; ++t) {
        const int slot = t & (NSLOT - 1);
        if (t + 2 < NT) asm volatile("s_waitcnt vmcnt(4)" ::: "memory"); else if (t + 1 < NT) asm volatile("s_waitcnt vmcnt(2)" ::: "memory"); else asm volatile("s_waitcnt vmcnt(0)" ::: "memory");
        asm volatile("s_waitcnt lgkmcnt(0)\n\ts_barrier" ::: "memory");
        if (t + 3 < NT) MX_DMA(t + 3);
        if (t == 3) { conv_finish(CR, cwl, MIXo, cm0, tid, 0); conv_load(CR, PROJ, cm0, tid, 1); }
        bool masked = false; int kb = 0;
        if (t >= 4) { const int lt = t - 4 + lt_lo; masked = (lt < 2 || lt >= 4); kb = -128 + 64 * lt; }
        const bool dead = masked && ((kb == -128 && qw >= 64) || (kb == 192 && qw < 64));
        if (!dead) {
#pragma unroll
        for (int hh = 0; hh < NH; ++hh) {
            f32x16 p0, p1;
            qkt(p0, p1, shm + A_K + slot * SLOTB, qr[hh], negm[hh], r32, hi);
            if (masked) {
#pragma unroll
                for (int r = 0; r < 16; ++r) { const int k0 = kb + crow(r, hi), k1 = k0 + 32;
                    if (k0 < qc - 128 || k0 > qc + 128) p0[r] = -1e30f; if (k1 < qc - 128 || k1 > qc + 128) p1[r] = -1e30f; } }
            float ma = MX3(p0[0], p0[1], p1[0]), mb = MX3(p0[2], p0[3], p1[1]); ma = MX3(ma, p1[2], p1[3]);
#pragma unroll
            for (int r = 4; r < 16; r += 4) { ma = MX3(ma, p0[r], p0[r + 1]); mb = MX3(mb, p0[r + 2], p0[r + 3]); ma = MX3(ma, p1[r], p1[r + 1]); mb = MX3(mb, p1[r + 2], p1[r + 3]); }
            float rm = __builtin_fmaxf(ma, mb);
            { auto rr = __builtin_amdgcn_permlane32_swap(__float_as_uint(rm), __float_as_uint(rm), false, false); rm = __builtin_fmaxf(__uint_as_float(rr[0]), __uint_as_float(rr[1])); }
            if (__any(rm > (float)ATT_THR)) { const float dl = __builtin_fmaxf(rm, 0.f); mrun[hh] += dl;
#pragma unroll
                for (int r = 0; r < 16; ++r) { p0[r] -= dl; p1[r] -= dl; negm[hh][r] = -mrun[hh]; }
                const float f = __builtin_amdgcn_exp2f(-dl); lsum[hh] *= f; if (hi == 0) wsf[hh * 64 + r32] = f;
                asm volatile("s_waitcnt lgkmcnt(0)" ::: "memory");
#pragma unroll
                for (int r = 0; r < 16; ++r) { const float fr_ = *(volatile LAS float*)(wsf + hh * 64 + crow(r, hi)); o[hh][0][r] *= fr_; o[hh][1][r] *= fr_; } }
#pragma unroll
            for (int r = 0; r < 16; ++r) { p0[r] = __builtin_amdgcn_exp2f(p0[r]); p1[r] = __builtin_amdgcn_exp2f(p1[r]); }
            { f32x2 s2 = (f32x2){p0[0], p0[1]} + (f32x2){p1[0], p1[1]};
#pragma unroll
              for (int r = 2; r < 16; r += 2) { s2 += (f32x2){p0[r], p0[r + 1]}; s2 += (f32x2){p1[r], p1[r + 1]}; }
              lsum[hh] += s2.x + s2.y; }
            u32x4 pw0, pw1, pw2, pw3;
#pragma unroll
            for (int i = 0; i < 4; ++i) { pw0[i] = cvtpk(p0[2 * i], p0[2 * i + 1]); pw1[i] = cvtpk(p0[8 + 2 * i], p0[8 + 2 * i + 1]); pw2[i] = cvtpk(p1[2 * i], p1[2 * i + 1]); pw3[i] = cvtpk(p1[8 + 2 * i], p1[8 + 2 * i + 1]); }
            pv(o[hh], vb0 + slot * SLOTB, __builtin_bit_cast(bf16x8, pw0), __builtin_bit_cast(bf16x8, pw1), __builtin_bit_cast(bf16x8, pw2), __builtin_bit_cast(bf16x8, pw3));
            __builtin_amdgcn_sched_barrier(0);
        }
        }
    }
    LAS bf16_t* stg = (LAS bf16_t*)(shm + A_OST) + wid * 2048;
#pragma unroll
    for (int hh = 0; hh < NH; ++hh) {
        float ls = lsum[hh];
        { auto rr = __builtin_amdgcn_permlane32_swap(__float_as_uint(ls), __float_as_uint(ls), false, false); ls = __uint_as_float(rr[0]) + __uint_as_float(rr[1]); }
        if (hi == 0) wsf[hh * 64 + 32 + r32] = ls;
        asm volatile("s_waitcnt lgkmcnt(0)" ::: "memory");
#pragma unroll
        for (int r = 0; r < 16; ++r) { const int orow = crow(r, hi); const float rl = __builtin_amdgcn_rcpf(*(volatile LAS float*)(wsf + hh * 64 + 32 + orow));
            stg[orow * 64 + r32] = f2bf(o[hh][0][r] * rl); stg[orow * 64 + 32 + r32] = f2bf(o[hh][1][r] * rl); }
        asm volatile("s_waitcnt lgkmcnt(0)" ::: "memory");
        bf16_t* op = MIXo + (size_t)(qrow0 + qw) * D + 512 + (head0 + hh) * 64;
#pragma unroll
        for (int i = 0; i < 4; ++i) { const int row = i * 8 + (lane >> 3), ch = lane & 7; const u32x4 v = *(const LAS u32x4*)(stg + row * 64 + ch * 8); *(u32x4*)(op + (size_t)row * D + ch * 8) = v; }
        asm volatile("s_waitcnt lgkmcnt(0)" ::: "memory");
    }
    conv_finish(CR, cwl, MIXo, cm0, tid, 1);
    asm volatile("s_barrier" ::: "memory");
#undef MX_DMA
#undef MX_TROW
}

__device__ __forceinline__ void gmlp_conv_unit(const Ptrs& P, const bf16_t* PROJ, bf16_t* MIXo, LAS unsigned char* shm, int l, int m0, int tid) {
    const int lane = tid & 63, r32 = lane & 31, hi = lane >> 5; const int wid = __builtin_amdgcn_readfirstlane(tid >> 6);
    LAS bf16_t* vT = (LAS bf16_t*)shm;
    { u32x2 raw[16];
#pragma unroll
      for (int rr = 0; rr < 16; ++rr) raw[rr] = *(const u32x2*)(PROJ + (size_t)(m0 + wid * 16 + rr) * INC + C_V + 4 * lane);
      float gv[4];
#pragma unroll
      for (int i = 0; i < 4; ++i) gv[i] = P.gmlp_g[l * 256 + 4 * lane + i];
#pragma unroll
      for (int r4 = 0; r4 < 4; ++r4) { float g[4][4], ss[4];
#pragma unroll
          for (int q = 0; q < 4; ++q) { const u32x2 w = raw[r4 * 4 + q];
              g[q][0] = gelu_fast(__uint_as_float(w.x << 16)); g[q][1] = gelu_fast(__uint_as_float(w.x & 0xffff0000u)); g[q][2] = gelu_fast(__uint_as_float(w.y << 16)); g[q][3] = gelu_fast(__uint_as_float(w.y & 0xffff0000u));
              ss[q] = g[q][0] * g[q][0] + g[q][1] * g[q][1] + g[q][2] * g[q][2] + g[q][3] * g[q][3]; }
#pragma unroll
          for (int o = 1; o < 64; o <<= 1) {
#pragma unroll
              for (int q = 0; q < 4; ++q) ss[q] += __shfl_xor(ss[q], o); }
          float rinv[4];
#pragma unroll
          for (int q = 0; q < 4; ++q) rinv[q] = rsqrtf(ss[q] * (1.0f / 256.0f) + EPS);
#pragma unroll
          for (int i = 0; i < 4; ++i) { u32x2 w; w.x = cvtpk(g[0][i] * rinv[0] * gv[i], g[1][i] * rinv[1] * gv[i]); w.y = cvtpk(g[2][i] * rinv[2] * gv[i], g[3][i] * rinv[3] * gv[i]);
              *(LAS u32x2*)(vT + (4 * lane + i) * VT_PITCH + wid * 16 + r4 * 4) = w; } } }
    asm volatile("s_waitcnt lgkmcnt(0)\n\ts_barrier" ::: "memory");
    { const int h = wid >> 1, dt = wid & 1;
      const bf16_t* wsb = (const bf16_t*)(P.ws + WS_WSB) + ((size_t)(l * 4 + h) * 128) * 128 + (size_t)r32 * 128 + hi * 8;
      bf16x8 bfr[2][8];
#pragma unroll
      for (int kk = 0; kk < 8; ++kk) bfr[0][kk] = *(const bf16x8*)(wsb + kk * 16);
      u32x2 uraw[4][4];
#pragma unroll
      for (int pt = 0; pt < 4; ++pt)
#pragma unroll
          for (int q4 = 0; q4 < 4; ++q4) uraw[pt][q4] = *(const u32x2*)(PROJ + (size_t)(m0 + pt * 32 + r32) * INC + C_U + h * 64 + dt * 32 + 4 * hi + 8 * q4);
      bf16x8 af[8];
#pragma unroll
      for (int kk = 0; kk < 8; ++kk) af[kk] = *(const LAS bf16x8*)(vT + (h * 64 + dt * 32 + r32) * VT_PITCH + kk * 16 + hi * 8);
      const float* bs = P.b_s + (l * 4 + h) * 128;
#pragma unroll
      for (int pt = 0; pt < 4; ++pt) {
          if (pt < 3) {
#pragma unroll
              for (int kk = 0; kk < 8; ++kk) bfr[(pt + 1) & 1][kk] = *(const bf16x8*)(wsb + (size_t)(pt + 1) * 32 * 128 + kk * 16); }
          f32x16 acc = (f32x16){0.f, 0.f, 0.f, 0.f, 0.f, 0.f, 0.f, 0.f, 0.f, 0.f, 0.f, 0.f, 0.f, 0.f, 0.f, 0.f};
#pragma unroll
          for (int kk = 0; kk < 8; ++kk) acc = __builtin_amdgcn_mfma_f32_32x32x16_bf16(af[kk], bfr[pt & 1][kk], acc, 0, 0, 0);
          const int p = pt * 32 + r32; const float bias = bs[p];
          bf16_t* op = MIXo + (size_t)(m0 + p) * D + h * 64 + dt * 32 + 4 * hi;
#pragma unroll
          for (int q4 = 0; q4 < 4; ++q4) { const u32x2 raw = uraw[pt][q4];
              const float u0 = gelu_fast(__uint_as_float(raw.x << 16)), u1 = gelu_fast(__uint_as_float(raw.x & 0xffff0000u)), u2 = gelu_fast(__uint_as_float(raw.y << 16)), u3 = gelu_fast(__uint_as_float(raw.y & 0xffff0000u));
              u32x2 w; w.x = cvtpk(u0 * (acc[4 * q4] + bias), u1 * (acc[4 * q4 + 1] + bias)); w.y = cvtpk(u2 * (acc[4 * q4 + 2] + bias), u3 * (acc[4 * q4 + 3] + bias));
              *(u32x2*)(op + 8 * q4) = w; }
      } }
    asm volatile("s_waitcnt lgkmcnt(0)\n\ts_barrier" ::: "memory");
}
}

constexpr int ATT_NH = 1;
__device__ __forceinline__ void phase_mixer(const Ptrs& P, LAS unsigned char* lds, int l, int Mmix) {
    int tid = threadIdx.x; asm volatile("" : "+v"(tid));
    const bf16_t* PROJ = (const bf16_t*)(P.ws + WS_PROJ); bf16_t* MIXo = (bf16_t*)(P.ws + WS_MIX);
    const int G = gridDim.x, c = blockIdx.x;
    constexpr int UPC = ATT_NH == 2 ? 2 : 4;
    const int nLat = (ML / 128) * UPC, nCtx = Mmix > ML ? (MC / 128) * UPC : 0, nG = Mmix / 128;
    for (int u = c; u < nLat; u += G) { const int chunk = u / UPC, kvh = (u / (UPC / 2)) & 1, hp = u & 1; mx::attn_unit<ATT_NH>(PROJ, MIXo, P.sink + l * 8, P.conv_w + (size_t)l * 768, lds, 1, chunk >> 6, chunk & 63, kvh, hp, tid); }
    for (int u = c; u < nG + nCtx; u += G) {
        if (u < nG) mx::gmlp_conv_unit(P, PROJ, MIXo, lds, l, u * 128, tid);
        else { const int v = u - nG, chunk = v / UPC, kvh = (v / (UPC / 2)) & 1, hp = v & 1; mx::attn_unit<ATT_NH>(PROJ, MIXo, P.sink + l * 8, P.conv_w + (size_t)l * 768, lds, 0, chunk >> 1, chunk & 1, kvh, hp, tid); } }
}
constexpr int NPH = 31;
struct KArgs { Ptrs P; int lo, hi; };
__global__ void __launch_bounds__(NTHR, 2) k_fast(KArgs a) {
    extern __shared__ __attribute__((aligned(16))) unsigned char lds_raw[];
    LAS unsigned char* lds = (LAS unsigned char*)lds_raw;
    const int lo = a.lo, hi = a.hi;
#if defined(__HIP_DEVICE_COMPILE__) && defined(USE_KERNARG_RELOAD)
#define LOADP() const __attribute__((address_space(4))) unsigned long long* ap_ = (const __attribute__((address_space(4))) unsigned long long*)__builtin_amdgcn_kernarg_segment_ptr(); asm volatile("" : "+s"(ap_)); \
    Ptrs P; { unsigned long long* d_ = (unsigned long long*)&P; _Pragma("unroll") for (int i_ = 0; i_ < (int)(sizeof(Ptrs) / 8); ++i_) d_[i_] = ap_[i_]; }
#else
#define LOADP() const Ptrs P = a.P
#endif
    unsigned* ctl; { LOADP(); ctl = (unsigned*)(P.ws + WS_CTL); }
    if (threadIdx.x < 4) ((LAS unsigned*)(lds + MISC_OFF))[threadIdx.x] = 0u;
    __syncthreads();
    XcdBarrier bar; bar.bar = ctl + CW_BAR; bar.x = 0; bar.st = (volatile LAS unsigned*)(lds + MISC_OFF);
    if (hi - lo > 1) bar = xcd_barrier_post(ctl + CW_BAR, (volatile LAS unsigned*)(lds + MISC_OFF));
    volatile LAS int* vcw = (volatile LAS int*)(lds + MISC_OFF + 32);
    if (threadIdx.x == 0) { vcw[3] = 0; vcw[0] = (int)blockIdx.x; vcw[1] = (int)xb_xcc_id(); vcw[2] = (hi - lo > 1) ? (int)xb_add(ctl + CW_XR + 64 * xb_xcc_id(), 1u) : 0; }
    __syncthreads();
#define IN(k, kind) (lo <= (k) && (k) < hi)
#define SEAM(k) do { if (lo <= (k) && (k) + 1 < hi) xcd_barrier(bar); } while (0)
    LAS unsigned* idxtab = (LAS unsigned*)(lds + IDX_OFF);
    LAS int* tst = (LAS int*)(lds + TST_OFF);

    if (IN(0, 0)) { LOADP(); phase_p0a(P, lds); }
    SEAM(0);
    if (lo == 0 && hi > 1) {
        if (threadIdx.x == 0) { const int myx = vcw[1], rank = vcw[2]; int npop = 0, xi = 0; bool even = true;
            for (int j = 0; j < 16; ++j) { const unsigned cj = xb_ld(ctl + CW_XR + 64 * j); if (cj) { ++npop; if (j < myx) ++xi; if (cj * 8u != gridDim.x) even = false; } }
            if (even && npop == 8 && rank < (int)(gridDim.x / 8)) { vcw[0] = rank * 8 + xi; vcw[3] = (int)(gridDim.x / 8); }
            }
        __syncthreads(); }
    const int vc = vcw[0];
    if (IN(1, 1)) { LOADP(); phase_p0b(P); }
    SEAM(1);
    for (int l = 0; l < DEPTH; ++l) {
        const int pb = 2 + 7 * l;
        const int Mmix = l < DEPTH - 1 ? MT : ML;
        if (IN(pb + 0, 2)) { LOADP(); if (l > 0) build_tile_table(P, tst, l - 1);
            if (l == 0) phase_norm<1, true>(P, lds, l, MT, (const bf16_t*)P.out, tst); else phase_norm<1, false>(P, lds, l, MT, (const bf16_t*)P.out, tst); }
        SEAM(pb + 0);
        if (IN(pb + 1, 3)) { LOADP();
            SchedDense<INC> S{(const bf16_t*)(P.ws + WS_H), (const bf16_t*)(P.ws + WS_WIN) + (size_t)l * INC * D, MT / 256, (int)gridDim.x, vc};
            EpiProj E{(bf16_t*)(P.ws + WS_PROJ), (const float*)(P.ws + WS_ROPE)};
            pg::gemm_phase(lds + RING_OFF, idxtab, S, E);
        }
        SEAM(pb + 1);
        if (IN(pb + 2, 4)) { LOADP(); phase_mixer(P, lds, l, Mmix); }
        SEAM(pb + 2);
        if (IN(pb + 3, 5)) { LOADP();
            SchedDense<D> S{(const bf16_t*)(P.ws + WS_MIX), (const bf16_t*)(P.ws + WS_WOUT) + (size_t)l * D * D, Mmix / 256, (int)gridDim.x, vc};
            EpiPlain E{(bf16_t*)(P.ws + WS_PROJ), D};
            pg::gemm_phase(lds + RING_OFF, idxtab, S, E);
        }
        SEAM(pb + 3);
        if (IN(pb + 4, 6)) { LOADP(); phase_norm<2, false>(P, lds, l, Mmix, (const bf16_t*)(P.ws + WS_PROJ), tst); }
        SEAM(pb + 4);
        if (IN(pb + 5, 7)) { LOADP(); const ClsRec* listr = (const ClsRec*)(P.ws + WS_LISTR);
            build_tile_table(P, tst, l);
            SchedGU S{(const unsigned char*)(P.ws + WS_H), (const unsigned char*)(P.ws + WS_WGU) + (size_t)l * NE * 1024 * 1024, listr, tst, ctl + CW_CNTF + l * 32 * 64, (int)gridDim.x, vc};
            EpiGU E{(unsigned char*)(P.ws + WS_PROJ), listr, ctl + CW_CNTF + l * 32 * 64};
            pg::gemm_phase(lds + RING_OFF, idxtab, S, E);
        }
        SEAM(pb + 5);
        if (IN(pb + 6, 8)) { LOADP();
            build_tile_table(P, tst, l);
            SchedDown S{(const unsigned char*)(P.ws + WS_PROJ), (const unsigned char*)(P.ws + WS_WD) + (size_t)l * NE * 1024 * 512, tst, (int)gridDim.x, vc};
            EpiPlain E{l < DEPTH - 1 ? (bf16_t*)P.out : (bf16_t*)(P.ws + WS_H), D};
            pg::gemm_phase(lds + RING_OFF, idxtab, S, E);
        }
        SEAM(pb + 6);
    }
    if (IN(30, 9)) { LOADP(); build_tile_table(P, tst, DEPTH - 1); phase_norm<3, false>(P, lds, DEPTH - 1, ML, (const bf16_t*)(P.ws + WS_H), tst); }
#undef IN
#undef SEAM
}
static int g_grid = 256;
static void launch_fast(const Ptrs& P, int lo, int hi, hipStream_t stream) {
    KArgs a{}; a.P = P; a.lo = lo; a.hi = hi;
    hipLaunchKernelGGL(k_fast, dim3(g_grid), dim3(NTHR), LDS_BYTES, stream, a);
}
extern "C" void kernel_launch(void* const* d_in, const int* in_sizes, int n_in, void* d_out, int out_size, void* d_ws, size_t ws_size, hipStream_t stream) {
    static int ready = 0;
    if (!ready) {
        if (n_in != 21 || ws_size < WS_END2) { fprintf(stderr, "kernel_launch: unexpected inputs (%d) or workspace (%zu)\n", n_in, ws_size); ready = -1; return; }
        if (hipFuncSetAttribute((const void*)k_fast, hipFuncAttributeMaxDynamicSharedMemorySize, LDS_BYTES) != hipSuccess) { fprintf(stderr, "kernel_launch: hipFuncSetAttribute failed\n"); ready = -1; return; }
        { int dev = 0, cus = 0, per_cu = 0; (void)hipGetDevice(&dev); (void)hipDeviceGetAttribute(&cus, hipDeviceAttributeMultiprocessorCount, dev);
          if (hipOccupancyMaxActiveBlocksPerMultiprocessor(&per_cu, (const void*)k_fast, NTHR, LDS_BYTES) != hipSuccess || per_cu < 1) { fprintf(stderr, "kernel_launch: occupancy query says %d blocks per CU\n", per_cu); }
          (void)hipGetLastError(); if (cus > 0) g_grid = cus; }
        ready = 1;
    }
    if (ready < 0) return;
    Ptrs P{};
    const float** pp = (const float**)&P;
    for (int i = 0; i < 21; ++i) pp[i] = (const float*)d_in[i];
    P.out = (float*)d_out; P.ws = (unsigned char*)d_ws;
    unsigned char* ws = (unsigned char*)d_ws;
    (void)hipMemsetAsync(ws + WS_CTL, 0, 1 * MiB, stream);
    launch_fast(P, 0, NPH, stream);
}
```

```cpp
#include <hip/hip_runtime.h>
#include <stdint.h>
#include <cstdio>

constexpr int D = 1024, NB = 8, SEQ = 8192, DEPTH = 4, CTXL = 256;
constexpr int ML = NB * SEQ;
constexpr int MC = NB * CTXL;
constexpr int MT = ML + MC;
constexpr int INC = 2048;
constexpr int C_U = 0, C_V = 256, C_BG = 512, C_CG = 768, C_Z = 1024, C_Q = 1280, C_K = 1792, C_VV = 1920;
constexpr int NE = 16, DE = 512, NCLS = 24;
constexpr float EPS = 1e-6f;
constexpr float QSCALE = 0.125f * 1.4426950408889634f;
constexpr float LOG2E = 1.4426950408889634f;

typedef unsigned short bf16_t;
typedef float f32x4 __attribute__((ext_vector_type(4)));
typedef unsigned u32x4 __attribute__((ext_vector_type(4)));
typedef unsigned u32x2 __attribute__((ext_vector_type(2)));

__device__ __forceinline__ float bf2f(bf16_t v) { return __uint_as_float((unsigned)v << 16); }
__device__ __forceinline__ bf16_t f2bf(float f) { unsigned u = __float_as_uint(f); return (bf16_t)((u + 0x7fffu + ((u >> 16) & 1u)) >> 16); }
__device__ __forceinline__ unsigned pk2(float lo, float hi) { return (unsigned)f2bf(lo) | ((unsigned)f2bf(hi) << 16); }
__device__ __forceinline__ float gelu_tanh(float x) { const float y = 0.7978845608028654f * (x + 0.044715f * x * x * x); return x / (1.0f + __expf(-2.0f * y)); }
__device__ __forceinline__ float silu_f(float x) { return x / (1.0f + __expf(-x)); }
__device__ __forceinline__ float wave_sum(float v) {
#pragma unroll
    for (int o = 1; o < 64; o <<= 1) v += __shfl_xor(v, o);
    return v;
}

constexpr size_t MiB = 1u << 20;
constexpr size_t WS_CTL = 0;
constexpr size_t WS_MOD = 1 * MiB;
constexpr size_t WS_ROPE = 2 * MiB;
constexpr size_t WS_TOK = 3 * MiB;
constexpr size_t WS_XC = 5 * MiB;
constexpr size_t WS_LISTE = 13 * MiB;
constexpr size_t WS_LISTC = 18 * MiB;
constexpr size_t WS_VN = 25 * MiB;
constexpr size_t WS_WIN = 64 * MiB, WS_WOUT = 80 * MiB, WS_WGU = 88 * MiB, WS_WD = 216 * MiB;
constexpr size_t WS_H = 280 * MiB;
constexpr size_t WS_MIX = 412 * MiB;
constexpr size_t WS_PROJ = 544 * MiB;
constexpr size_t WS_END = 808 * MiB;
constexpr int CW_CNTE = 1024;
constexpr int CW_CNTC = 2048;

struct Tok { unsigned ids; float wlo, whi; unsigned pad; };

struct Ptrs {
    const float *x, *c, *ctx, *c_ctx, *w_mod, *b_mod, *norm1_g, *norm2_g, *w_in, *gmlp_g, *w_s, *b_s, *conv_w, *sink, *w_out, *router_w, *router_b, *w_gate, *w_up, *w_down, *final_g;
    float* out; unsigned char* ws;
};
__device__ __forceinline__ int modrow(int m) { return m < ML ? (m >> 13) : 8; }

#define LAS __attribute__((address_space(3)))
#define XB_TMO      128
#define XB_XCNT(j)  (256  + 64 * (j))
#define XB_XSUB(j)  (1280 + 64 * (j))
#define XB_XGEN(j)  (2304 + 64 * (j))
#define XB_TOP      3328
#define XB_TOPGEN   3392
#define XCD_BAR_WORDS 3456
#define XB_SPIN_CAP (1u << 18)

__device__ __forceinline__ unsigned xb_ld(unsigned* p)              { return __hip_atomic_load(p, __ATOMIC_RELAXED, __HIP_MEMORY_SCOPE_AGENT); }
__device__ __forceinline__ unsigned xb_add(unsigned* p, unsigned v) { return __hip_atomic_fetch_add(p, v, __ATOMIC_RELAXED, __HIP_MEMORY_SCOPE_AGENT); }
__device__ __forceinline__ unsigned xb_xcc_id() { return (unsigned)__builtin_amdgcn_s_getreg((3 << 11) | 20) & 0xFu; }
#define XB_SPIN(cond, bar) do { unsigned _sp = 0; while (cond) { __builtin_amdgcn_s_sleep(1); \
    if ((++_sp & 255u) == 0u) { if (xb_ld(&(bar)[XB_TMO])) break; if (_sp > XB_SPIN_CAP) { atomicAdd(&(bar)[XB_TMO], 1u); break; } } } } while (0)

struct XcdBarrier {
    unsigned* bar; unsigned x;
    volatile LAS unsigned* st;
};

__device__ __forceinline__ XcdBarrier xcd_barrier_post(unsigned* bar, volatile LAS unsigned* st) {
    XcdBarrier b; b.bar = bar; b.x = xb_xcc_id(); b.st = st;
    if (threadIdx.x == 0) (void)xb_add(&bar[XB_XCNT(b.x)], 1u);
    return b;
}
__device__ __forceinline__ void xcd_barrier_complete(unsigned* bar, unsigned x, unsigned& nloc, unsigned& nx) {
    const unsigned G = gridDim.x * gridDim.y * gridDim.z;
    unsigned sum, cnt, mine, sp = 0u;
    for (;;) {
        sum = 0u; cnt = 0u; mine = 0u;
#pragma unroll
        for (unsigned j = 0; j < 16; ++j) { const unsigned c = xb_ld(&bar[XB_XCNT(j)]); sum += c; cnt += (c > 0u) ? 1u : 0u; mine = (j == x) ? c : mine; }
        if (sum == G) break;
        __builtin_amdgcn_s_sleep(1);
        if ((++sp & 255u) == 0u) { if (xb_ld(&bar[XB_TMO])) break; if (sp > XB_SPIN_CAP) { atomicAdd(&bar[XB_TMO], 1u); break; } }
    }
    nloc = mine > 0u ? mine : 1u; nx = cnt > 0u ? cnt : 1u;
}

__device__ __forceinline__ void xcd_barrier(const XcdBarrier& b) {
    asm volatile("s_waitcnt vmcnt(0)" ::: "memory");
    __syncthreads();
    if (threadIdx.x == 0) {
        unsigned* bar = b.bar;
        __builtin_amdgcn_s_waitcnt(0);
        unsigned nloc = b.st[0], nx = b.st[1];
        if (nloc == 0u) { xcd_barrier_complete(bar, b.x, nloc, nx); b.st[0] = nloc; b.st[1] = nx; }
        const unsigned old = xb_add(&bar[XB_XSUB(b.x)], 1u);
        const unsigned gen = old / nloc;
        if (old + 1u == (gen + 1u) * nloc) {
            __builtin_amdgcn_fence(__ATOMIC_RELEASE, "agent");
            asm volatile("s_waitcnt vmcnt(0)" ::: "memory");
            const unsigned og = xb_add(&bar[XB_TOP], 1u);
            const unsigned tg = og / nx;
            if (og + 1u == (tg + 1u) * nx) xb_add(&bar[XB_TOPGEN], 1u);
            else XB_SPIN(xb_ld(&bar[XB_TOPGEN]) == tg, bar);
            __builtin_amdgcn_fence(__ATOMIC_ACQUIRE, "agent");
            xb_add(&bar[XB_XGEN(b.x)], 1u);
            asm volatile("s_waitcnt vmcnt(0)" ::: "memory");
        } else {
            XB_SPIN(xb_ld(&bar[XB_XGEN(b.x)]) == gen, bar);
            __builtin_amdgcn_fence(__ATOMIC_ACQUIRE, "agent");
            asm volatile("s_waitcnt vmcnt(0)" ::: "memory");
        }
    }
    __syncthreads();
}
typedef short bf16x8 __attribute__((ext_vector_type(8)));
typedef int v4i32 __attribute__((ext_vector_type(4)));
typedef int v8i32 __attribute__((ext_vector_type(8)));
namespace pg {
constexpr int BM = 256, BK = 64, HALF = 128, HTB = HALF * BK * 2  , STAGE_BYTES = 8 * HTB, NXCD = 8, WGM = 8;
__host__ __device__ __forceinline__ int lds_byte(int r, int c) { return (r >> 3) * 1024 + (r & 7) * 128 + (((c >> 3) ^ (r & 7)) << 4); }
__host__ __device__ __forceinline__ void stage_rc(int b, int& R, int& C) { const int piece = b >> 10, p = (b & 1023) >> 4; R = piece * 8 + (p >> 3); C = ((p & 7) ^ (R & 7)) << 3; }

struct Unit { int pm, pn, x0, x1; };

__device__ __forceinline__ void order_unit(int L, int nM, int nN, int& pm, int& pn) {
    const int nwg = nM * nN; int wgid = L;
    { const int q = nwg / NXCD, r = nwg % NXCD, xcd = wgid % NXCD, off = wgid / NXCD; wgid = (xcd < r ? xcd * (q + 1) : r * (q + 1) + (xcd - r) * q) + off; }
    const int nig = WGM * nN, gid = wgid / nig, fm = gid * WGM, gsz = (nM - fm) < WGM ? (nM - fm) : WGM;
    pm = fm + ((wgid % nig) % gsz); pn = (wgid % nig) / gsz;
}

template <class Sched, class Epi>
__device__ __forceinline__ void gemm_phase(LAS unsigned char* lds, LAS unsigned* idxtab, const Sched& S, const Epi& E) {
    constexpr int ESZ = Sched::ESZ;
    constexpr int K = Sched::K, LDA = Sched::LDA, LDB = Sched::LDB, nt = K * ESZ / 128, KS = Sched::KSPLIT; constexpr bool GATHER = Sched::GATHER;
    int tid = threadIdx.x; asm volatile("" : "+v"(tid));
    const int wid = __builtin_amdgcn_readfirstlane(tid >> 6), lane = tid & 63, wr = wid >> 2, wc = wid & 3;
    constexpr size_t kstep = (size_t)(BK * 2);
    constexpr size_t hstepA = (size_t)HALF * LDA * ESZ, hstepB = (size_t)HALF * LDB * ESZ;
    const unsigned ldsw = (unsigned)wid * 1024u;
    const int aoff0 = lds_byte(wr * 64 + (lane & 15), (lane >> 4) * 8), boff0 = lds_byte(wc * 32 + (lane & 15), (lane >> 4) * 8);
    unsigned pvoA[2], pvoB[2];
#pragma unroll
    for (int i = 0; i < 2; ++i) { int R_, C_; stage_rc((wid * 64 + lane) * 16 + i * 8192, R_, C_); pvoA[i] = (unsigned)(R_ * LDA * ESZ + C_ * 2); pvoB[i] = (unsigned)(R_ * LDB * ESZ + C_ * 2); }
    unsigned cv[2][2];
#define PG_SA(b, h) (((b) * 2 + (h)) * HTB)
#define PG_SB(b, h) ((4 + (b) * 2 + (h)) * HTB)
#define PG_VOFF(ld, i, dst) do { int _t = wid * 64 + lane; asm volatile("" : "+v"(_t)); int _R, _C; stage_rc(_t * 16 + (i) * 8192, _R, _C); dst = (unsigned)(_R * (ld) * ESZ + _C * 2); } while (0)
#define PG_STAGE_B(bufoff, gbase) do { _Pragma("unroll") for (int _i = 0; _i < 2; ++_i) { unsigned _vo = pvoB[_i]; if constexpr (ESZ == 1) PG_VOFF(LDB, _i, _vo); \
        __builtin_amdgcn_global_load_lds((const unsigned*)((const char*)(gbase) + _vo), (LAS unsigned*)(lds + (bufoff) + ldsw + _i * 8192), 16, 0, 0); } } while (0)
#define PG_STAGE_A(bufoff, gbase, h, V) do { _Pragma("unroll") for (int _i = 0; _i < 2; ++_i) { unsigned _vo = pvoA[_i]; if constexpr (ESZ == 1 && !GATHER) PG_VOFF(LDA, _i, _vo); \
        const char* _p = GATHER ? (const char*)(gbase) + V[h][_i] : (const char*)(gbase) + ((h) ? hstepA : 0) + _vo; \
        __builtin_amdgcn_global_load_lds((const unsigned*)_p, (LAS unsigned*)(lds + (bufoff) + ldsw + _i * 8192), 16, 0, 0); } } while (0)
#define PG_LDA(dst, b, h) do { int _a1 = aoff0 ^ 64; asm volatile("" : "+v"(_a1)); _Pragma("unroll") for (int m = 0; m < 4; ++m) _Pragma("unroll") for (int k = 0; k < 2; ++k) dst[m][k] = *(const LAS bf16x8*)(lds + PG_SA(b, h) + (k ? _a1 : aoff0) + m * 2048); } while (0)
#define PG_LDB(dst, b, h) do { int _b1 = boff0 ^ 64; asm volatile("" : "+v"(_b1)); _Pragma("unroll") for (int n = 0; n < 2; ++n) _Pragma("unroll") for (int k = 0; k < 2; ++k) dst[n][k] = *(const LAS bf16x8*)(lds + PG_SB(b, h) + (k ? _b1 : boff0) + n * 2048); } while (0)
#define PG_MMA(ai, bj, At, Bt) do { __builtin_amdgcn_s_setprio(1); _Pragma("unroll") for (int m = 0; m < 4; ++m) _Pragma("unroll") for (int n = 0; n < 2; ++n) { \
        if constexpr (ESZ == 2) { _Pragma("unroll") for (int k = 0; k < 2; ++k) acc[ai][bj][m][n] = __builtin_amdgcn_mfma_f32_16x16x32_bf16(Bt[n][k], At[m][k], acc[ai][bj][m][n], 0, 0, 0); } \
        else {   \
            const v8i32 bw = __builtin_shufflevector(__builtin_bit_cast(v4i32, Bt[n][0]), __builtin_bit_cast(v4i32, Bt[n][1]), 0, 1, 2, 3, 4, 5, 6, 7); \
            const v8i32 aw = __builtin_shufflevector(__builtin_bit_cast(v4i32, At[m][0]), __builtin_bit_cast(v4i32, At[m][1]), 0, 1, 2, 3, 4, 5, 6, 7); \
            acc[ai][bj][m][n] = __builtin_amdgcn_mfma_scale_f32_16x16x128_f8f6f4(bw, aw, acc[ai][bj][m][n], 0, 0, 0, Sched::SCALE_B, 0, Sched::SCALE_A); } } \
        __builtin_amdgcn_s_setprio(0); } while (0)
#define PG_WAIT_V(n) asm volatile("s_waitcnt vmcnt(" #n ")" ::: "memory")
#define PG_WAIT_L(n) asm volatile("s_waitcnt lgkmcnt(" #n ")" ::: "memory")
#define PG_BAR __builtin_amdgcn_s_barrier()
#define PG_SCHED __builtin_amdgcn_sched_barrier(0)
#define PG_IDX_ISSUE(u) do { int _l = lane; asm volatile("" : "+v"(_l)); const int _h = (_l >> 4) & 1, _i = (_l >> 3) & 1, _r = _l & 7; const unsigned _po = (unsigned)(_h * 128 + (wid + 8 * _i) * 8 + _r) * 16u; \
        __builtin_amdgcn_global_load_lds((const unsigned*)((const char*)S.idx_src(u) + _po), (LAS unsigned*)(idxtab + wid * 64), 4, 0, 0); } while (0)
#define PG_IDX_READ(u, V) do { const int _vr = S.valid_rows(u); _Pragma("unroll") for (int _h = 0; _h < 2; ++_h) _Pragma("unroll") for (int _i = 0; _i < 2; ++_i) { \
        const int _pos = _h * 128 + (wid + 8 * _i) * 8 + (lane >> 3); unsigned _tk = *(volatile LAS unsigned*)(idxtab + wid * 64 + _h * 16 + _i * 8 + (lane >> 3)); \
        _tk = _pos < _vr ? _tk : 0u; V[_h][_i] = _tk * (unsigned)(LDA * ESZ) + (unsigned)(((lane & 7) ^ ((lane >> 3) & 7)) << 4); } } while (0)
    Unit cur, nxt; int ui = 0;
    if (!S.next(0, cur)) return;
    f32x4 acc[2][2][4][2];
#pragma unroll
    for (int a = 0; a < 2; ++a)
#pragma unroll
        for (int b = 0; b < 2; ++b)
#pragma unroll
            for (int m = 0; m < 4; ++m)
#pragma unroll
                for (int n = 0; n < 2; ++n) acc[a][b][m][n] = (f32x4){0.f, 0.f, 0.f, 0.f};
    bf16x8 At[4][2], B0[2][2], B1[2][2];
    const char* cA = S.a_base(cur); const char* cB0 = S.b_base(cur, 0); const char* cB1 = S.b_base(cur, 1);
#pragma unroll
    for (int h = 0; h < 2; ++h)
#pragma unroll
        for (int i = 0; i < 2; ++i) cv[h][i] = 0u;
    if constexpr (GATHER) { PG_IDX_ISSUE(cur); PG_WAIT_V(0); PG_IDX_READ(cur, cv); }
    PG_STAGE_B(PG_SB(0, 0), cB0); PG_STAGE_B(PG_SB(0, 1), cB0 + hstepB); PG_STAGE_A(PG_SA(0, 0), cA, 0, cv); PG_STAGE_A(PG_SA(0, 1), cA, 1, cv);
    if (wr == 1) PG_BAR;
    PG_WAIT_V(2); PG_BAR;
    PG_STAGE_B(PG_SB(1, 0), cB0 + kstep); PG_STAGE_A(PG_SA(1, 0), cA + kstep, 0, cv); PG_STAGE_B(PG_SB(1, 1), cB0 + hstepB + kstep);
    PG_WAIT_V(6); PG_BAR;
    for (;;) {
        const bool has_next = S.next(ui + 1, nxt);
        const char* nA = has_next ? S.a_base(nxt) : cA; const char* nB0 = has_next ? S.b_base(nxt, 0) : cB0; const char* nB1 = has_next ? S.b_base(nxt, 1) : cB1;
        if constexpr (GATHER) { if (has_next) PG_IDX_ISSUE(nxt); }
#pragma nounroll
        for (int t = 0; t < nt; t += 2) {
            const bool last = (t == nt - 2);
            const char* a1 = cA + (size_t)(t + 1) * kstep;
            const char* a2 = last ? nA : cA + (size_t)(t + 2) * kstep; const char* a3 = a2 + kstep;
            const char* b2 = last ? nB0 : ((t + 2) < KS ? cB0 : cB1) + (size_t)(t + 2) * kstep;
            const char* b3 = last ? nB0 + kstep : ((t + 3) < KS ? cB0 : cB1) + (size_t)(t + 3) * kstep;
            PG_LDB(B0, 0, 0); PG_LDB(B1, 0, 1); PG_SCHED; PG_LDA(At, 0, 0); PG_STAGE_A(PG_SA(1, 1), a1, 1, cv);
            if constexpr (GATHER) { if (last && has_next) { PG_IDX_READ(nxt, cv); } }
            PG_WAIT_V(8); PG_WAIT_L(0); PG_BAR; PG_MMA(0, 0, At, B0); PG_MMA(0, 1, At, B1); PG_BAR; PG_SCHED;
            PG_LDA(At, 0, 1); PG_STAGE_B(PG_SB(0, 0), b2); PG_STAGE_B(PG_SB(0, 1), b2 + hstepB); PG_STAGE_A(PG_SA(0, 0), a2, 0, cv);
            PG_WAIT_V(8); PG_WAIT_L(0); PG_BAR; PG_MMA(1, 0, At, B0); PG_MMA(1, 1, At, B1); PG_BAR; PG_SCHED;
            PG_LDB(B0, 1, 0); PG_LDB(B1, 1, 1); PG_SCHED; PG_LDA(At, 1, 0); PG_STAGE_A(PG_SA(0, 1), a2, 1, cv);
            PG_WAIT_V(8); PG_WAIT_L(0); PG_BAR; PG_MMA(0, 0, At, B0); PG_MMA(0, 1, At, B1); PG_BAR; PG_SCHED;
            PG_LDA(At, 1, 1); PG_STAGE_B(PG_SB(1, 0), b3); PG_STAGE_B(PG_SB(1, 1), b3 + hstepB); PG_STAGE_A(PG_SA(1, 0), a3, 0, cv);
            PG_WAIT_V(8); PG_WAIT_L(0); PG_BAR; PG_MMA(1, 0, At, B0); PG_MMA(1, 1, At, B1); PG_BAR; PG_SCHED;
        }
        if (wr == 0) PG_BAR;
        { int _l = lane; asm volatile("" : "+v"(_l)); E(acc, cur, wr, wc, _l & 15, _l >> 4); }
        if (!has_next) break;
#pragma unroll
        for (int a = 0; a < 2; ++a)
#pragma unroll
            for (int b = 0; b < 2; ++b)
#pragma unroll
                for (int m = 0; m < 4; ++m)
#pragma unroll
                    for (int n = 0; n < 2; ++n) acc[a][b][m][n] = (f32x4){0.f, 0.f, 0.f, 0.f};
        cur = nxt; cA = nA; cB0 = nB0; cB1 = nB1; ++ui;
        if (wr == 1) PG_BAR;
    }
    PG_WAIT_V(0);
    PG_BAR;
#undef PG_SA
#undef PG_SB
#undef PG_STAGE_A
#undef PG_STAGE_B
#undef PG_VOFF
#undef PG_LDA
#undef PG_LDB
#undef PG_MMA
#undef PG_WAIT_V
#undef PG_WAIT_L
#undef PG_BAR
#undef PG_SCHED
#undef PG_IDX_ISSUE
#undef PG_IDX_READ
}
}
constexpr int NWAVES = 8, NTHR = 512;
constexpr int RING_OFF = 0, RING_BYTES = 131072;
constexpr int IDX_OFF = RING_BYTES;
constexpr int TST_OFF = IDX_OFF + 2048;
constexpr int MISC_OFF = TST_OFF + 128;
constexpr int LDS_BYTES = 147456;
constexpr size_t WS_MODP = WS_VN;
constexpr size_t WS_WSB = 62 * MiB;
constexpr int CW_CNTF = 16384;
constexpr int CW_XR = 12288;
constexpr int CW_MXQ = 13312;
constexpr int CW_BAR = 8192;
constexpr int MAXT = 288;

struct ClsRec { int m; float wlo, whi; int pad; };
constexpr size_t WS_LISTR = 816 * MiB;
constexpr size_t WS_XB = 848 * MiB;
constexpr size_t WS_POS = WS_TOK;
constexpr size_t WS_END2 = 980 * MiB;

__device__ __forceinline__ void cls_experts(int cls, int& elo, int& ehi) {
    const int g = cls / 6, p = cls % 6; const int a = p < 3 ? 0 : (p < 5 ? 1 : 2), b = p < 3 ? p + 1 : (p < 5 ? p - 1 : 3);
    elo = g * 4 + a; ehi = g * 4 + b;
}
constexpr int F8_SH_H = 4, F8_SH_A = 3, F8_SH_W = 5;
#define SC_E8(sh) ((127 - (sh)) * 0x01010101)
__device__ __forceinline__ unsigned pk4_fp8(float a, float b, float c, float d, float scale) {
    const float lim = 448.0f; a = fminf(fmaxf(a * scale, -lim), lim); b = fminf(fmaxf(b * scale, -lim), lim); c = fminf(fmaxf(c * scale, -lim), lim); d = fminf(fmaxf(d * scale, -lim), lim);
    int w = __builtin_amdgcn_cvt_pk_fp8_f32(a, b, 0, false); w = __builtin_amdgcn_cvt_pk_fp8_f32(c, d, w, true); return (unsigned)w; }
__device__ __forceinline__ unsigned cvt_pk_bf16(float lo, float hi) { unsigned r; asm volatile("v_cvt_pk_bf16_f32 %0, %1, %2" : "=v"(r) : "v"(lo), "v"(hi)); return r; }

template <int N_> struct SchedDense {
    static constexpr int K = 1024, LDA = 1024, LDB = 1024, KSPLIT = 16, ESZ = 2, SCALE_A = 0, SCALE_B = 0; static constexpr bool GATHER = false;
    const bf16_t* A; const bf16_t* Bt; int nM, G, c;
    __device__ __forceinline__ bool next(int i, pg::Unit& u) const { const long L = (long)i * G + c; if (L >= (long)nM * (N_ / 256)) return false; pg::order_unit((int)L, nM, N_ / 256, u.pm, u.pn); u.x0 = 0; u.x1 = 0; return true; }
    __device__ __forceinline__ const char* a_base(const pg::Unit& u) const { return (const char*)A + (size_t)u.pm * 256 * LDA * 2; }
    __device__ __forceinline__ const char* b_base(const pg::Unit& u, int) const { return (const char*)Bt + (size_t)u.pn * 256 * LDB * 2; }
    __device__ __forceinline__ const unsigned* idx_src(const pg::Unit&) const { return nullptr; }
    __device__ __forceinline__ int valid_rows(const pg::Unit&) const { return 256; }
};
__device__ __forceinline__ void cls_of_tile(const LAS int* tst, int T, int& cls, int& rt) {
    int c = 0;
#pragma unroll
    for (int k = 1; k < NCLS; ++k) c += (T >= tst[k]) ? 1 : 0;
    cls = __builtin_amdgcn_readfirstlane(c); rt = __builtin_amdgcn_readfirstlane(T - tst[c]);
}
struct SchedGU {
    static constexpr int K = 1024, LDA = 1024, LDB = 1024, KSPLIT = 8, ESZ = 1, SCALE_A = SC_E8(F8_SH_H), SCALE_B = SC_E8(F8_SH_W); static constexpr bool GATHER = true;
    const unsigned char* H; const unsigned char* Wgu; const ClsRec* list; const LAS int* tst; const unsigned* cnt; int G, c;
    __device__ __forceinline__ bool next(int i, pg::Unit& u) const { const int TT = __builtin_amdgcn_readfirstlane(tst[NCLS]); const long L = (long)i * G + c; if (L >= (long)TT * 8) return false;
        pg::order_unit((int)L, TT, 8, u.pm, u.pn); cls_of_tile(tst, u.pm, u.x0, u.x1); return true; }
    __device__ __forceinline__ const char* a_base(const pg::Unit&) const { return (const char*)H; }
    __device__ __forceinline__ const char* b_base(const pg::Unit& u, int) const { int elo, ehi; cls_experts(u.x0, elo, ehi); const int e = u.pn < 4 ? elo : ehi;
        return (const char*)Wgu + ((size_t)e * 1024 + (size_t)(u.pn & 3) * 256) * LDB; }
    __device__ __forceinline__ const unsigned* idx_src(const pg::Unit& u) const { return (const unsigned*)(list + (size_t)u.x0 * MT + (size_t)u.x1 * 256); }
    __device__ __forceinline__ int valid_rows(const pg::Unit& u) const { return (int)cnt[u.x0 * 64] - u.x1 * 256; }
};
struct SchedDown {
    static constexpr int K = 1024, LDA = 1024, LDB = 512, KSPLIT = 4, ESZ = 1, SCALE_A = SC_E8(F8_SH_A), SCALE_B = SC_E8(F8_SH_W); static constexpr bool GATHER = false;
    const unsigned char* ACT; const unsigned char* Wd; const LAS int* tst; int G, c;
    __device__ __forceinline__ bool next(int i, pg::Unit& u) const { const int TT = __builtin_amdgcn_readfirstlane(tst[NCLS]); const long L = (long)i * G + c; if (L >= (long)TT * 4) return false;
        pg::order_unit((int)L, TT, 4, u.pm, u.pn); cls_of_tile(tst, u.pm, u.x0, u.x1); return true; }
    __device__ __forceinline__ const char* a_base(const pg::Unit& u) const { return (const char*)ACT + (size_t)u.pm * 256 * LDA; }
    __device__ __forceinline__ const char* b_base(const pg::Unit& u, int part) const { int elo, ehi; cls_experts(u.x0, elo, ehi); const int e = part ? ehi : elo;
        return (const char*)Wd + ((size_t)e * 1024 + (size_t)u.pn * 256) * LDB - (part ? (size_t)KSPLIT * 128 : 0); }
    __device__ __forceinline__ const unsigned* idx_src(const pg::Unit&) const { return nullptr; }
    __device__ __forceinline__ int valid_rows(const pg::Unit&) const { return 256; }
};

#define OPAQUE(x) asm volatile("" : "+v"(x))
#define ROWSTEP(m) ((m) == 3 ? 80 : 16)
struct EpiProj {
    bf16_t* O; const float* tab;
    __device__ __forceinline__ void operator()(const f32x4 (&acc)[2][2][4][2], const pg::Unit& u, int wr, int wc, int fr, int fq) const {
        const bool latent = u.pm < ML / 256;
        char* base = (char*)(O + (size_t)u.pm * 256 * INC + u.pn * 256);
        unsigned off = (unsigned)((wr * 64 + fr) * INC + wc * 32 + 4 * fq) * 2u; OPAQUE(off);
        int t = ((u.pm * 256) & (SEQ - 1)) + wr * 64 + fr; OPAQUE(t);
#pragma unroll
        for (int ai = 0; ai < 2; ++ai)
#pragma unroll
            for (int m = 0; m < 4; ++m) { char* rowp = base + off;
                const int pos = (wc & 1) ? (t & 63) : (t >> 6);
#pragma unroll
                for (int bj = 0; bj < 2; ++bj) { f32x4 v0 = acc[ai][bj][m][0], v1 = acc[ai][bj][m][1];
                    const bool rope = latent && (u.pn == 5 || u.pn == 6 || (u.pn == 7 && bj == 0));
                    if (rope) { const f32x4 cs = *(const f32x4*)(tab + pos * 16 + 4 * fq), sn = *(const f32x4*)(tab + 2048 + pos * 16 + 4 * fq);
                        const f32x4 o1 = v0 * cs - v1 * sn, o2 = v1 * cs + v0 * sn; v0 = o1; v1 = o2; }
                    u32x2 w0, w1; w0.x = cvt_pk_bf16(v0[0], v0[1]); w0.y = cvt_pk_bf16(v0[2], v0[3]); w1.x = cvt_pk_bf16(v1[0], v1[1]); w1.y = cvt_pk_bf16(v1[2], v1[3]);
                    *(u32x2*)(rowp + bj * 256) = w0; *(u32x2*)(rowp + bj * 256 + 32) = w1; }
                off += (unsigned)(ROWSTEP(m) * INC * 2); t += ROWSTEP(m); OPAQUE(off); OPAQUE(t); }
    }
};
struct EpiPlain {
    bf16_t* O; int ldo;
    __device__ __forceinline__ void operator()(const f32x4 (&acc)[2][2][4][2], const pg::Unit& u, int wr, int wc, int fr, int fq) const {
        char* base = (char*)(O + (size_t)u.pm * 256 * ldo + u.pn * 256);
        unsigned off = (unsigned)((wr * 64 + fr) * ldo + wc * 32 + 8 * fq) * 2u; OPAQUE(off);
#pragma unroll
        for (int ai = 0; ai < 2; ++ai)
#pragma unroll
            for (int m = 0; m < 4; ++m) {
#pragma unroll
                for (int bj = 0; bj < 2; ++bj) { const f32x4 v0 = acc[ai][bj][m][0], v1 = acc[ai][bj][m][1];
                    u32x4 w; w.x = cvt_pk_bf16(v0[0], v0[1]); w.y = cvt_pk_bf16(v0[2], v0[3]); w.z = cvt_pk_bf16(v1[0], v1[1]); w.w = cvt_pk_bf16(v1[2], v1[3]);
                    *(u32x4*)(base + off + bj * 256) = w; }
                off += (unsigned)(ROWSTEP(m) * ldo * 2); OPAQUE(off); }
    }
};
struct EpiGU {
    unsigned char* ACT; const ClsRec* list; const unsigned* cnt;
    __device__ __forceinline__ void operator()(const f32x4 (&acc)[2][2][4][2], const pg::Unit& u, int wr, int wc, int fr, int fq) const {
        const int vr = (int)cnt[u.x0 * 64] - u.x1 * 256; const char* rec = (const char*)(list + (size_t)u.x0 * MT + (size_t)u.x1 * 256) + (u.pn >= 4 ? 8 : 4);
        unsigned char* base = ACT + (size_t)u.pm * 256 * 1024 + (u.pn >> 2) * 512 + (u.pn & 3) * 128;
        int r = wr * 64 + fr; OPAQUE(r); unsigned off = (unsigned)(r * 1024 + wc * 32 + 8 * fq); OPAQUE(off);
#pragma unroll
        for (int ai = 0; ai < 2; ++ai)
#pragma unroll
            for (int m = 0; m < 4; ++m) { float w = 0.f;
                if (r < vr) w = *(const float*)(rec + (size_t)r * 16);
                w *= (float)(1 << F8_SH_A);
                u32x2 pk;
#pragma unroll
                for (int bj = 0; bj < 2; ++bj) { const f32x4 g = acc[ai][bj][m][0], up = acc[ai][bj][m][1]; float o[4];
#pragma unroll
                    for (int i = 0; i < 4; ++i) o[i] = g[i] * __builtin_amdgcn_rcpf(1.0f + __builtin_amdgcn_exp2f(-LOG2E * g[i])) * up[i];
                    const unsigned v = pk4_fp8(o[0], o[1], o[2], o[3], w); if (bj == 0) pk.x = v; else pk.y = v; }
                *(u32x2*)(base + off) = pk;
                off += (unsigned)(ROWSTEP(m) * 1024); r += ROWSTEP(m); OPAQUE(off); OPAQUE(r); }
    }
};

template <bool F8 = false> __device__ __forceinline__ void p0_transpose_item(const float* W, int Kd, int N, void* WTv, LAS float* scr, int item, int lane, int mode, int sc_lo, int sc_hi, float scale) {
    bf16_t* WT = (bf16_t*)WTv;
    const int nblk = N / 32, kb = item / nblk, nb = item % nblk, k0 = 64 * kb, n0 = 32 * nb;
    f32x4 rv[8];
#pragma unroll
    for (int i = 0; i < 8; ++i) rv[i] = *(const f32x4*)(W + (size_t)(k0 + 8 * i + (lane >> 3)) * N + n0 + 4 * (lane & 7));
#pragma unroll
    for (int i = 0; i < 8; ++i) { LAS float* d = scr + (8 * i + (lane >> 3)) * 33 + 4 * (lane & 7); d[0] = rv[i].x; d[1] = rv[i].y; d[2] = rv[i].z; d[3] = rv[i].w; }
    asm volatile("s_waitcnt lgkmcnt(0)" ::: "memory");
    const int c = lane & 7;
#pragma unroll
    for (int j = 0; j < 4; ++j) { const int n = (lane >> 3) + 8 * j, ng = n0 + n; const LAS float* s = scr + (8 * c) * 33 + n;
        const float f = (ng >= sc_lo && ng < sc_hi) ? scale : 1.0f;
        const int row = mode == 0 ? ng : mode == 3 ? ((ng & ~31) + 16 * ((ng >> 2) & 1) + 4 * ((ng >> 3) & 3) + (ng & 3))
                      : (256 * (ng >> 7) + 128 * ((ng >> 2) & 1) + 32 * ((ng >> 5) & 3) + 16 * (mode == 2 ? 1 : 0) + 4 * ((ng >> 3) & 3) + (ng & 3));
        if constexpr (F8) { u32x2 o; o.x = pk4_fp8(s[0 * 33], s[1 * 33], s[2 * 33], s[3 * 33], f * (float)(1 << F8_SH_W)); o.y = pk4_fp8(s[4 * 33], s[5 * 33], s[6 * 33], s[7 * 33], f * (float)(1 << F8_SH_W));
            *(u32x2*)((unsigned char*)WTv + (size_t)row * Kd + k0 + 8 * c) = o; }
        else { u32x4 o; o.x = pk2(s[0 * 33] * f, s[1 * 33] * f); o.y = pk2(s[2 * 33] * f, s[3 * 33] * f); o.z = pk2(s[4 * 33] * f, s[5 * 33] * f); o.w = pk2(s[6 * 33] * f, s[7 * 33] * f);
            *(u32x4*)(WT + (size_t)row * Kd + k0 + 8 * c) = o; } }
    asm volatile("s_waitcnt lgkmcnt(0)" ::: "memory");
}
__device__ __forceinline__ void phase_p0a(const Ptrs& P, LAS unsigned char* lds) {
    int tid = threadIdx.x; asm volatile("" : "+v"(tid)); const int lane = tid & 63, wave = __builtin_amdgcn_readfirstlane(tid >> 6);
    const int gw = blockIdx.x * NWAVES + wave, NGW = gridDim.x * NWAVES;
    LAS float* sil = (LAS float*)(lds + 73728);
    for (int i = tid; i < 9 * D; i += NTHR) { const int j = i >> 10, k = i & (D - 1); sil[i] = silu_f(j < 8 ? P.c[j * D + k] : P.c_ctx[k]); }
    __syncthreads();
    float* modp = (float*)(P.ws + WS_MODP);
    for (int u = gw; u < DEPTH * 24 * 16; u += NGW) { const int l = u / 384, r = u % 384, nc = r / 16, ks = r % 16;
        const float* w = P.w_mod + ((size_t)l * D + ks * 64) * 6144 + nc * 256 + 4 * lane;
        f32x4 a[9];
#pragma unroll
        for (int j = 0; j < 9; ++j) a[j] = (f32x4){0.f, 0.f, 0.f, 0.f};
#pragma unroll 4
        for (int k = 0; k < 64; ++k) { const f32x4 wv = *(const f32x4*)(w + (size_t)k * 6144);
#pragma unroll
            for (int j = 0; j < 9; ++j) a[j] += wv * sil[j * D + ks * 64 + k]; }
#pragma unroll
        for (int j = 0; j < 9; ++j) *(f32x4*)(modp + (((size_t)l * 16 + ks) * 9 + j) * 6144 + nc * 256 + 4 * lane) = a[j]; }
    { const int gt = blockIdx.x * NTHR + tid, NGT = gridDim.x * NTHR; float* tab = (float*)(P.ws + WS_ROPE);
      if (gt < 2048) { const int i = gt & 15, pos = gt >> 4; const float inv = powf(10000.0f, -(float)i / 16.0f), ang = (float)pos * inv; tab[gt] = cosf(ang); tab[2048 + gt] = sinf(ang); }
      bf16_t* wsb = (bf16_t*)(P.ws + WS_WSB);
      for (int i = gt; i < DEPTH * 4 * 128 * 128; i += NGT) wsb[i] = f2bf(P.w_s[i]); }
    LAS float* scr = (LAS float*)(lds + wave * 8448);
    constexpr int PER_L = 1024 + 512 + NE * 768;
    for (int it = gw; it < DEPTH * PER_L; it += NGW) { const int l = it / PER_L; int r = it % PER_L;
        if (r < 1024) { p0_transpose_item(P.w_in + (size_t)l * D * INC, D, INC, (bf16_t*)(P.ws + WS_WIN) + (size_t)l * INC * D, scr, r, lane, 0, C_Q, C_K, QSCALE); continue; } r -= 1024;
        if (r < 512) { p0_transpose_item(P.w_out + (size_t)l * D * D, D, D, (bf16_t*)(P.ws + WS_WOUT) + (size_t)l * D * D, scr, r, lane, 3, 0, 0, 1.f); continue; } r -= 512;
        const int e = r / 768, q = r % 768, which = q >> 8, idx = q & 255; const size_t le = (size_t)l * NE + e;
        if (which == 0) p0_transpose_item<true>(P.w_gate + le * D * DE, D, DE, P.ws + WS_WGU + le * 1024 * 1024, scr, idx, lane, 1, 0, 0, 1.f);
        else if (which == 1) p0_transpose_item<true>(P.w_up + le * D * DE, D, DE, P.ws + WS_WGU + le * 1024 * 1024, scr, idx, lane, 2, 0, 0, 1.f);
        else p0_transpose_item<true>(P.w_down + le * DE * D, DE, D, P.ws + WS_WD + le * 1024 * 512, scr, idx, lane, 3, 0, 0, 1.f); }
}
__device__ __forceinline__ void phase_p0b(const Ptrs& P) {
    const int gt = blockIdx.x * NTHR + threadIdx.x, NGT = gridDim.x * NTHR;
    const float* modp = (const float*)(P.ws + WS_MODP); float* mod = (float*)(P.ws + WS_MOD);
    for (int i = gt; i < DEPTH * 9 * 6144; i += NGT) { const int l = i / (9 * 6144), r = i % (9 * 6144), j = r / 6144, n = r % 6144;
        float s = P.b_mod[l * 6144 + n];
#pragma unroll
        for (int ks = 0; ks < 16; ++ks) s += modp[(((size_t)l * 16 + ks) * 9 + j) * 6144 + n];
        mod[i] = s; }
}

__device__ __forceinline__ void bf8_to_f32(const u32x4 v, float (&o)[8]) {
#pragma unroll
    for (int i = 0; i < 4; ++i) { o[2 * i] = __uint_as_float(v[i] << 16); o[2 * i + 1] = __uint_as_float(v[i] & 0xffff0000u); }
}
template <int R> struct NormRaw { u32x4 a[R][2], b[R][2]; int m0, nv; };
template <int MODE, bool FIRST, bool DRY = false> __device__ __forceinline__ void phase_norm(const Ptrs& P, LAS unsigned char* lds, int l, int Mrows, const bf16_t* Y, const LAS int* tst) {
    constexpr int R = MODE == 2 ? 2 : 4;
    int tid = threadIdx.x; asm volatile("" : "+v"(tid)); const int lane = tid & 63, wave = __builtin_amdgcn_readfirstlane(tid >> 6);
    const int gw = blockIdx.x * NWAVES + wave, NGW = gridDim.x * NWAVES;
    const int rpw = (Mrows + NGW - 1) / NGW;
    const int mBeg = gw * rpw, mEnd = (mBeg + rpw) < Mrows ? (mBeg + rpw) : Mrows;
    LAS float* rwT = (LAS float*)lds;
    constexpr int RPW = 72;
    LAS unsigned* recL = (LAS unsigned*)(lds + 65536);
    LAS unsigned* cntL = (LAS unsigned*)(lds + 65536 + NWAVES * RPW * 16);
    LAS unsigned* baseL = cntL + 32;
    LAS float* logL = (LAS float*)(lds + 65536 + 12288);
    if (MODE == 2) { if (tid < 64) cntL[tid] = 0u; for (int i = tid; i < D * NE; i += NTHR) rwT[(i & 15) * D + (i >> 4)] = P.router_w[i]; __syncthreads(); }
    const float* g = (MODE == 1 ? P.norm1_g + l * D : MODE == 2 ? P.norm2_g + l * D : P.final_g);
    f32x4 gg[2][2];
#pragma unroll
    for (int j = 0; j < 2; ++j) { gg[j][0] = (f32x4){0.f, 0.f, 0.f, 0.f}; gg[j][1] = gg[j][0]; if (MODE == 3) { gg[j][0] = *(const f32x4*)(g + 8 * lane + 512 * j); gg[j][1] = *(const f32x4*)(g + 8 * lane + 512 * j + 4); } }
    bf16_t* XB = (bf16_t*)(P.ws + WS_XB);
    unsigned posreg = 0u;
    if (MODE != 2 && !FIRST) { if (mBeg + lane < mEnd) posreg = ((const unsigned*)(P.ws + WS_POS))[mBeg + lane]; }
    f32x4 gt[2][2], scv[2][2], shv[2][2];
#pragma unroll
    for (int j = 0; j < 2; ++j)
#pragma unroll
        for (int q = 0; q < 2; ++q) { gt[j][q] = (f32x4){0.f, 0.f, 0.f, 0.f}; scv[j][q] = gt[j][q]; shv[j][q] = gt[j][q]; }
#define NR_LOAD(G, mstart) do { (G).m0 = (mstart); { const int bnd_ = (((mstart) >> 13) + 1) << 13; const int ge_ = bnd_ < mEnd ? bnd_ : mEnd; (G).nv = (ge_ - (mstart)) < R ? (ge_ - (mstart)) : R; } \
        _Pragma("unroll") for (int r = 0; r < R; ++r) { const int m = (G).m0 + (r < (G).nv ? r : (G).nv - 1); \
            if (FIRST) { const float* xr = m < ML ? P.x + (size_t)m * D : P.ctx + (size_t)(m - ML) * D; \
                _Pragma("unroll") for (int j = 0; j < 2; ++j) { (G).a[r][j] = *(const u32x4*)(xr + 8 * lane + 512 * j); (G).b[r][j] = *(const u32x4*)(xr + 8 * lane + 512 * j + 4); } \
            } else { size_t yrow = (size_t)m; \
                if (MODE != 2) { const unsigned ps = (unsigned)__builtin_amdgcn_readlane((int)posreg, m - mBeg); yrow = (size_t)tst[ps & 255u] * 256 + (ps >> 8); } \
                const bf16_t* yr = Y + yrow * D; \
                _Pragma("unroll") for (int j = 0; j < 2; ++j) { (G).a[r][j] = *(const u32x4*)(XB + (size_t)m * D + 8 * lane + 512 * j); (G).b[r][j] = *(const u32x4*)(yr + 8 * lane + 512 * j); } } } } while (0)
    NormRaw<R> G; G.m0 = mBeg; G.nv = 0;
    if (mBeg < mEnd) NR_LOAD(G, mBeg);
    bool more = mBeg < mEnd;
    while (more) {
        const int m0 = G.m0, nv = G.nv;
        float xv[R][2][8]; float ss[R];
        { const int mb = modrow(m0);
            {
                const float* modl = (const float*)(P.ws + WS_MOD) + ((size_t)l * 9 + mb) * 6144;
                const float* gate = MODE == 2 ? modl + 2048 : (const float*)(P.ws + WS_MOD) + ((size_t)(MODE == 3 ? 3 : (l > 0 ? l - 1 : 0)) * 9 + mb) * 6144 + 5120;
                const float* sh = modl + (MODE == 1 ? 0 : 3072); const float* sc = modl + (MODE == 1 ? 1024 : 4096);
#pragma unroll
                for (int j = 0; j < 2; ++j)
#pragma unroll
                    for (int q = 0; q < 2; ++q) { const int c = 8 * lane + 512 * j + 4 * q; gt[j][q] = *(const f32x4*)(gate + c); scv[j][q] = (*(const f32x4*)(sc + c) + 1.0f) * *(const f32x4*)(g + c); shv[j][q] = *(const f32x4*)(sh + c); } } }
#pragma unroll
        for (int r = 0; r < R; ++r) { const int m = m0 + (r < nv ? r : nv - 1);
#pragma unroll
            for (int j = 0; j < 2; ++j) {
                if (FIRST) { const f32x4 a = __builtin_bit_cast(f32x4, G.a[r][j]), b = __builtin_bit_cast(f32x4, G.b[r][j]);
                    xv[r][j][0] = a.x; xv[r][j][1] = a.y; xv[r][j][2] = a.z; xv[r][j][3] = a.w; xv[r][j][4] = b.x; xv[r][j][5] = b.y; xv[r][j][6] = b.z; xv[r][j][7] = b.w;
                } else { float xf[8], yf[8]; bf8_to_f32(G.a[r][j], xf); bf8_to_f32(G.b[r][j], yf);
#pragma unroll
                    for (int i = 0; i < 8; ++i) xv[r][j][i] = xf[i] + gt[j][i >> 2][i & 3] * yf[i]; } }
            if (MODE != 3 && r < nv) {
#pragma unroll
                for (int j = 0; j < 2; ++j) { u32x4 w; w.x = cvt_pk_bf16(xv[r][j][0], xv[r][j][1]); w.y = cvt_pk_bf16(xv[r][j][2], xv[r][j][3]); w.z = cvt_pk_bf16(xv[r][j][4], xv[r][j][5]); w.w = cvt_pk_bf16(xv[r][j][6], xv[r][j][7]);
                    *(u32x4*)(XB + (size_t)m * D + 8 * lane + 512 * j) = w; } }
            float s = 0.f;
#pragma unroll
            for (int j = 0; j < 2; ++j)
#pragma unroll
                for (int i = 0; i < 8; ++i) s += xv[r][j][i] * xv[r][j][i];
            ss[r] = s;
            if (MODE != 3) {
#pragma unroll
                for (int j = 0; j < 2; ++j)
#pragma unroll
                    for (int i = 0; i < 8; ++i) xv[r][j][i] = xv[r][j][i] * scv[j][i >> 2][i & 3];
            } }
        { const int nm0 = m0 + nv; more = nm0 < mEnd; if (more) NR_LOAD(G, nm0); }
#pragma unroll
        for (int o = 1; o < 64; o <<= 1) {
#pragma unroll
            for (int r = 0; r < R; ++r) ss[r] += __shfl_xor(ss[r], o); }
#pragma unroll
        for (int r = 0; r < R; ++r) { const int m = m0 + r; const float rinv = rsqrtf(ss[r] * (1.0f / D) + EPS);
            if (MODE == 3) { if (r < nv) { float* orow = P.out + (size_t)m * D;
#pragma unroll
                for (int j = 0; j < 2; ++j) { f32x4 a, b; a.x = xv[r][j][0]; a.y = xv[r][j][1]; a.z = xv[r][j][2]; a.w = xv[r][j][3]; b.x = xv[r][j][4]; b.y = xv[r][j][5]; b.z = xv[r][j][6]; b.w = xv[r][j][7];
                    *(f32x4*)(orow + 8 * lane + 512 * j) = a * rinv * gg[j][0]; *(f32x4*)(orow + 8 * lane + 512 * j + 4) = b * rinv * gg[j][1]; } }
            } else {
#pragma unroll
                for (int j = 0; j < 2; ++j)
#pragma unroll
                    for (int i = 0; i < 8; ++i) xv[r][j][i] = xv[r][j][i] * rinv + shv[j][i >> 2][i & 3];
                if (r < nv) {
                    if (MODE == 2) { unsigned char* H8 = (unsigned char*)(P.ws + WS_H) + (size_t)m * D;
#pragma unroll
                        for (int j = 0; j < 2; ++j) { u32x2 o; o.x = pk4_fp8(xv[r][j][0], xv[r][j][1], xv[r][j][2], xv[r][j][3], (float)(1 << F8_SH_H)); o.y = pk4_fp8(xv[r][j][4], xv[r][j][5], xv[r][j][6], xv[r][j][7], (float)(1 << F8_SH_H)); *(u32x2*)(H8 + 8 * lane + 512 * j) = o; }
                    } else { bf16_t* H = (bf16_t*)(P.ws + WS_H) + (size_t)m * D;
#pragma unroll
                        for (int j = 0; j < 2; ++j) { u32x4 o; o.x = cvt_pk_bf16(xv[r][j][0], xv[r][j][1]); o.y = cvt_pk_bf16(xv[r][j][2], xv[r][j][3]); o.z = cvt_pk_bf16(xv[r][j][4], xv[r][j][5]); o.w = cvt_pk_bf16(xv[r][j][6], xv[r][j][7]); *(u32x4*)(H + 8 * lane + 512 * j) = o; } } }
            } }
        if (MODE == 2) {
#pragma unroll
            for (int r = 0; r < R; ++r) {
                float lg[16];
#pragma unroll
                for (int e = 0; e < 16; ++e) lg[e] = 0.f;
#pragma unroll
                for (int j = 0; j < 2; ++j) { const int c = 8 * lane + 512 * j;
#pragma unroll
                    for (int e4 = 0; e4 < 4; ++e4) {
#pragma unroll
                        for (int e = 4 * e4; e < 4 * e4 + 4; ++e) { const f32x4 r0 = *(const LAS f32x4*)(rwT + e * D + c), r1 = *(const LAS f32x4*)(rwT + e * D + c + 4);
                            lg[e] += xv[r][j][0] * r0.x + xv[r][j][1] * r0.y + xv[r][j][2] * r0.z + xv[r][j][3] * r0.w + xv[r][j][4] * r1.x + xv[r][j][5] * r1.y + xv[r][j][6] * r1.z + xv[r][j][7] * r1.w; }
                        __builtin_amdgcn_sched_barrier(0); } }
                float v8[8], v4[4], v2[2], v1;
                { const bool up = (lane & 32) != 0;
#pragma unroll
                  for (int i = 0; i < 8; ++i) { const float send = up ? lg[i] : lg[i + 8]; const float keep = up ? lg[i + 8] : lg[i]; v8[i] = keep + __shfl_xor(send, 32); } }
                { const bool up = (lane & 16) != 0;
#pragma unroll
                  for (int i = 0; i < 4; ++i) { const float send = up ? v8[i] : v8[i + 4]; const float keep = up ? v8[i + 4] : v8[i]; v4[i] = keep + __shfl_xor(send, 16); } }
                { const bool up = (lane & 8) != 0;
#pragma unroll
                  for (int i = 0; i < 2; ++i) { const float send = up ? v4[i] : v4[i + 2]; const float keep = up ? v4[i + 2] : v4[i]; v2[i] = keep + __shfl_xor(send, 8); } }
                { const bool up = (lane & 4) != 0; const float send = up ? v2[0] : v2[1]; const float keep = up ? v2[1] : v2[0]; v1 = keep + __shfl_xor(send, 4); }
                v1 += __shfl_xor(v1, 2); v1 += __shfl_xor(v1, 1);
                if ((lane & 3) == 0 && r < nv) logL[(wave * RPW + (m0 - mBeg) + r) * 16 + (lane >> 2)] = v1;
            }
        }
    }
#undef NR_LOAD
    if (MODE == 2 && !DRY) {
        asm volatile("s_waitcnt lgkmcnt(0)" ::: "memory");
        if (lane < mEnd - mBeg) {
            float sco[16], sel[16];
#pragma unroll
            for (int e4 = 0; e4 < 4; ++e4) { const f32x4 v = *(const LAS f32x4*)(logL + (wave * RPW + lane) * 16 + 4 * e4);
#pragma unroll
                for (int i = 0; i < 4; ++i) { const int e = 4 * e4 + i; sco[e] = 1.0f / (1.0f + __expf(-v[i])); sel[e] = sco[e] + P.router_b[e]; } }
            int bg = 0; float bgs = -1e30f; int ba = 0, bb = 1; float sa = 0.f, sb = 0.f;
#pragma unroll
            for (int gI = 0; gI < 4; ++gI) {
                int i1 = 0; float v1 = sel[gI * 4], c1 = sco[gI * 4];
#pragma unroll
                for (int i = 1; i < 4; ++i) if (sel[gI * 4 + i] > v1) { v1 = sel[gI * 4 + i]; c1 = sco[gI * 4 + i]; i1 = i; }
                int i2 = -1; float v2 = -1e30f, c2 = 0.f;
#pragma unroll
                for (int i = 0; i < 4; ++i) if (i != i1 && sel[gI * 4 + i] > v2) { v2 = sel[gI * 4 + i]; c2 = sco[gI * 4 + i]; i2 = i; }
                const float gs = v1 + v2;
                if (gs > bgs) { bgs = gs; bg = gI; ba = i1; bb = i2; sa = c1; sb = c2; }
            }
            const int a = ba < bb ? ba : bb, b = ba < bb ? bb : ba;
            const float wl = ba < bb ? sa : sb, wh = ba < bb ? sb : sa, inv = 1.0f / (wl + wh);
            const int pairidx = (a == 0) ? (b - 1) : (a == 1 ? (b + 1) : 5);
            const int cls = bg * 6 + pairidx;
            const unsigned pl = __hip_atomic_fetch_add(cntL + cls, 1u, __ATOMIC_RELAXED, __HIP_MEMORY_SCOPE_WORKGROUP);
            LAS unsigned* rb = recL + (wave * RPW + lane) * 4; rb[0] = (unsigned)(mBeg + lane); rb[1] = __float_as_uint(wl * inv); rb[2] = __float_as_uint(wh * inv); rb[3] = (unsigned)cls | (pl << 8);
        }
        asm volatile("s_waitcnt lgkmcnt(0)" ::: "memory"); __syncthreads();
        unsigned* ctl = (unsigned*)(P.ws + WS_CTL);
        if (tid < NCLS) { const unsigned n = cntL[tid]; baseL[tid] = n ? atomicAdd(ctl + CW_CNTF + (l * 32 + tid) * 64, n) : 0u; }
        __syncthreads();
        ClsRec* listr = (ClsRec*)(P.ws + WS_LISTR); unsigned* posw = (unsigned*)(P.ws + WS_POS);
        for (int i = tid; i < NWAVES * RPW; i += NTHR) { const int w = i / RPW, r = i % RPW; const int wb = (blockIdx.x * NWAVES + w) * rpw; const int nw = (wb + rpw < Mrows ? wb + rpw : Mrows) - wb;
            if (r < nw) { const LAS unsigned* rb = recL + i * 4; const unsigned cls = rb[3] & 255u, pl = rb[3] >> 8, gp = baseL[cls] + pl;
                ClsRec rc; rc.m = (int)rb[0]; rc.wlo = __uint_as_float(rb[1]); rc.whi = __uint_as_float(rb[2]); rc.pad = 0;
                listr[(size_t)cls * MT + gp] = rc; posw[rb[0]] = cls | (gp << 8); } }
    }
}
__device__ __forceinline__ void build_tile_table(const Ptrs& P, LAS int* tst, int l) {
    if (threadIdx.x < 64) {
        int lane = threadIdx.x; asm volatile("" : "+v"(lane));
        const unsigned* cnt = (const unsigned*)(P.ws + WS_CTL) + CW_CNTF + l * 32 * 64;
        const int tiles = lane < NCLS ? (int)((__hip_atomic_load(cnt + lane * 64, __ATOMIC_RELAXED, __HIP_MEMORY_SCOPE_AGENT) + 255u) >> 8) : 0;
        int incl = tiles;
#pragma unroll
        for (int o = 1; o < 32; o <<= 1) { const int t = __shfl_up(incl, o); if (lane >= o) incl += t; }
        if (lane <= NCLS) tst[lane] = incl - tiles;
    }
    __syncthreads();
}
namespace mx {
typedef float f32x16 __attribute__((ext_vector_type(16)));
typedef short s16x4 __attribute__((ext_vector_type(4)));
constexpr int SLOTB = 8192;
constexpr int L_K = 0, L_V = 2 * SLOTB, L_WS = 4 * SLOTB, L_OST = L_WS + NWAVES * 256, L_END = L_OST + NWAVES * 4096;
constexpr int VT_PITCH = 136;
__device__ __forceinline__ int crow(int r, int hi) { return (r & 3) + 8 * (r >> 2) + 4 * hi; }
__device__ __forceinline__ unsigned cvtpk(float lo, float hi) { unsigned r; asm volatile("v_cvt_pk_bf16_f32 %0, %1, %2" : "=v"(r) : "v"(lo), "v"(hi)); return r; }
__device__ __forceinline__ float gelu_fast(float x) { const float y = x + 0.044715f * x * x * x; return x * __builtin_amdgcn_rcpf(1.0f + __builtin_amdgcn_exp2f(-2.302208198f * y)); }

__device__ __forceinline__ void qkt(f32x16& p0, f32x16& p1, const LAS unsigned char* Kslot, const bf16x8* qr, const f32x16& negm, int r32, int hi) {
    const LAS unsigned char* kb = Kslot + hi * 1024 + r32 * 16;
#pragma unroll
    for (int d0 = 0; d0 < 4; ++d0) {
        const bf16x8 b0 = *(const LAS bf16x8*)(kb + d0 * 2048), b1 = *(const LAS bf16x8*)(kb + d0 * 2048 + 512);
        if (d0 == 0) { p0 = __builtin_amdgcn_mfma_f32_32x32x16_bf16(b0, qr[0], negm, 0, 0, 0); p1 = __builtin_amdgcn_mfma_f32_32x32x16_bf16(b1, qr[0], negm, 0, 0, 0); }
        else { p0 = __builtin_amdgcn_mfma_f32_32x32x16_bf16(b0, qr[d0], p0, 0, 0, 0); p1 = __builtin_amdgcn_mfma_f32_32x32x16_bf16(b1, qr[d0], p1, 0, 0, 0); } }
}
__device__ __forceinline__ void pv(f32x16* o, unsigned vb, bf16x8 pa0, bf16x8 pa1, bf16x8 pa2, bf16x8 pa3) {
#pragma unroll
    for (int d0 = 0; d0 < 2; ++d0) { s16x4 lo[4], hi[4];
#pragma unroll
        for (int ks = 0; ks < 4; ++ks) {
            asm volatile("ds_read_b64_tr_b16 %0, %1 offset:%c2" : "=&v"(lo[ks]) : "v"(vb), "i"(d0 * 4096 + ks * 1024) : "memory");
            asm volatile("ds_read_b64_tr_b16 %0, %1 offset:%c2" : "=&v"(hi[ks]) : "v"(vb), "i"(d0 * 4096 + ks * 1024 + 512) : "memory"); }
        asm volatile("s_waitcnt lgkmcnt(0)" ::: "memory"); __builtin_amdgcn_sched_barrier(0);
#define MX_PK(k) (bf16x8){lo[k][0], lo[k][1], lo[k][2], lo[k][3], hi[k][0], hi[k][1], hi[k][2], hi[k][3]}
        o[d0] = __builtin_amdgcn_mfma_f32_32x32x16_bf16(pa0, MX_PK(0), o[d0], 0, 0, 0);
        o[d0] = __builtin_amdgcn_mfma_f32_32x32x16_bf16(pa1, MX_PK(1), o[d0], 0, 0, 0);
        o[d0] = __builtin_amdgcn_mfma_f32_32x32x16_bf16(pa2, MX_PK(2), o[d0], 0, 0, 0);
        o[d0] = __builtin_amdgcn_mfma_f32_32x32x16_bf16(pa3, MX_PK(3), o[d0], 0, 0, 0);
#undef MX_PK
    }
}
struct ConvRaw { u32x4 bg, c0, c1, c2, z0, z1, z2; };
__device__ __forceinline__ void conv_load(ConvRaw& R, const bf16_t* PROJ, int m0, int tid, int q) {
    const int seqmask = m0 < ML ? SEQ - 1 : CTXL - 1; const int mrel = m0 < ML ? m0 : m0 - ML;
    const int idx = q * NTHR + tid, row = idx >> 5, c = (idx & 31) * 8;
    const int t = (mrel + row) & seqmask; const bf16_t* pr = PROJ + (size_t)(m0 + row) * INC;
    R.bg = *(const u32x4*)(pr + C_BG + c); R.c1 = *(const u32x4*)(pr + C_CG + c); R.z1 = *(const u32x4*)(pr + C_Z + c);
    R.c0 = (u32x4){0u, 0u, 0u, 0u}; R.z0 = R.c0; R.c2 = R.c0; R.z2 = R.c0;
    if (t > 0) { R.c0 = *(const u32x4*)(pr - INC + C_CG + c); R.z0 = *(const u32x4*)(pr - INC + C_Z + c); }
    if (t < seqmask) { R.c2 = *(const u32x4*)(pr + INC + C_CG + c); R.z2 = *(const u32x4*)(pr + INC + C_Z + c); }
}
__device__ __forceinline__ void conv_finish(const ConvRaw& R, const float* cwl, bf16_t* MIXo, int m0, int tid, int q) {
    const int idx = q * NTHR + tid, row = idx >> 5, c = (idx & 31) * 8;
    const float* cw = cwl + c;
    float o[8];
#pragma unroll
    for (int i = 0; i < 8; ++i) { const int wI = i >> 1; const bool up = i & 1;
#define MX_BF(v) (up ? __uint_as_float((v)[wI] & 0xffff0000u) : __uint_as_float((v)[wI] << 16))
        const float y = MX_BF(R.c0) * MX_BF(R.z0) * cw[i] + MX_BF(R.c1) * MX_BF(R.z1) * cw[256 + i] + MX_BF(R.c2) * MX_BF(R.z2) * cw[512 + i];
        o[i] = MX_BF(R.bg) * y;
#undef MX_BF
    }
    u32x4 w; w.x = cvtpk(o[0], o[1]); w.y = cvtpk(o[2], o[3]); w.z = cvtpk(o[4], o[5]); w.w = cvtpk(o[6], o[7]);
    *(u32x4*)(MIXo + (size_t)(m0 + row) * D + 256 + c) = w;
}
constexpr int NSLOT = 4;
constexpr int ATT_THR = 8;
typedef float f32x2 __attribute__((ext_vector_type(2)));
#define MX3(a, b, c) __builtin_fmaxf(__builtin_fmaxf((a), (b)), (c))
constexpr int A_K = 0, A_V = NSLOT * SLOTB, A_WS = 2 * NSLOT * SLOTB, A_OST = A_WS + NWAVES * 512, A_END = A_OST + NWAVES * 4096;
template <int NH> __device__ __forceinline__ void attn_unit(const bf16_t* PROJ, bf16_t* MIXo, const float* sink, const float* cwl, LAS unsigned char* shm, int latent, int b, int blk, int kvh, int hp, int tid) {
    const int lane = tid & 63, r32 = lane & 31, hi = lane >> 5; const int wid = __builtin_amdgcn_readfirstlane(tid >> 6);
    const int head0 = NH == 2 ? kvh * 4 + (wid >> 2) * 2 : kvh * 4 + hp * 2 + (wid >> 2), qw = (wid & 3) * 32;
    const int qrow0 = latent ? b * SEQ + blk * 128 : ML + b * CTXL + blk * 128;
    const int ctx0 = ML + b * CTXL;
    const int lt_lo = latent ? (blk > 0 ? 0 : 2) : 0, lt_hi = latent ? (blk < SEQ / 128 - 1 ? 6 : 4) : 0;
    const int NT = 4 + (lt_hi - lt_lo);
    LAS float* wsf = (LAS float*)(shm + A_WS) + wid * 128;
    const bf16_t* kcol = PROJ + C_K + kvh * 64 + wid * 8;
    const bf16_t* vcol = PROJ + C_VV + kvh * 64 + (wid >> 2) * 32 + (lane & 3) * 8;
#define MX_TROW(t) ((t) < 4 ? ctx0 + 64 * (t) : b * SEQ + blk * 128 - 128 + 64 * ((t) - 4 + lt_lo))
#define MX_DMA(t) do { const int _r0 = MX_TROW(t); const int _sl = (t) & (NSLOT - 1); \
        __builtin_amdgcn_global_load_lds((const unsigned*)(kcol + (size_t)(_r0 + lane) * INC), (LAS unsigned*)(shm + A_K + _sl * SLOTB + wid * 1024), 16, 0, 0); \
        __builtin_amdgcn_global_load_lds((const unsigned*)(vcol + (size_t)(_r0 + 16 * (wid & 3) + (lane >> 2)) * INC), (LAS unsigned*)(shm + A_V + _sl * SLOTB + wid * 1024), 16, 0, 0); } while (0)
    static_assert(NH == 1, "the conv slice deal assumes four attention units per chunk");
    const int cm0 = qrow0 + (kvh * 2 + hp) * 32;
    ConvRaw CR; conv_load(CR, PROJ, cm0, tid, 0);
    bf16x8 qr[NH][4];
    { const bf16_t* qp = PROJ + (size_t)(qrow0 + qw + r32) * INC + C_Q + head0 * 64 + hi * 8;
#pragma unroll
      for (int hh = 0; hh < NH; ++hh)
#pragma unroll
          for (int d0 = 0; d0 < 4; ++d0) qr[hh][d0] = *(const bf16x8*)(qp + hh * 64 + d0 * 16); }
    MX_DMA(0); MX_DMA(1); MX_DMA(2);
    float mrun[NH], lsum[NH]; f32x16 o[NH][2], negm[NH];
#pragma unroll
    for (int hh = 0; hh < NH; ++hh) { mrun[hh] = sink[head0 + hh] * LOG2E; lsum[hh] = hi == 0 ? 1.0f : 0.0f;
#pragma unroll
        for (int r = 0; r < 16; ++r) negm[hh][r] = -mrun[hh];
        o[hh][0] = (f32x16){0.f, 0.f, 0.f, 0.f, 0.f, 0.f, 0.f, 0.f, 0.f, 0.f, 0.f, 0.f, 0.f, 0.f, 0.f, 0.f}; o[hh][1] = o[hh][0]; }
    const unsigned vb0 = (unsigned)(size_t)(shm + A_V) + ((lane >> 4) & 1) * 32 + (lane & 3) * 8 + (4 * hi + ((lane & 15) >> 2)) * 64;
    const int qc = qw + r32;
    for (int t = 0; t < NT; ++t) {
        const int slot = t & (NSLOT - 1);
        if (t + 2 < NT) asm volatile("s_waitcnt vmcnt(4)" ::: "memory"); else if (t + 1 < NT) asm volatile("s_waitcnt vmcnt(2)" ::: "memory"); else asm volatile("s_waitcnt vmcnt(0)" ::: "memory");
        asm volatile("s_waitcnt lgkmcnt(0)\n\ts_barrier" ::: "memory");
        if (t + 3 < NT) MX_DMA(t + 3);
        if (t == 3) { conv_finish(CR, cwl, MIXo, cm0, tid, 0); conv_load(CR, PROJ, cm0, tid, 1); }
        bool masked = false; int kb = 0;
        if (t >= 4) { const int lt = t - 4 + lt_lo; masked = (lt < 2 || lt >= 4); kb = -128 + 64 * lt; }
        const bool dead = masked && ((kb == -128 && qw >= 64) || (kb == 192 && qw < 64));
        if (!dead) {
#pragma unroll
        for (int hh = 0; hh < NH; ++hh) {
            f32x16 p0, p1;
            qkt(p0, p1, shm + A_K + slot * SLOTB, qr[hh], negm[hh], r32, hi);
            if (masked) {
#pragma unroll
                for (int r = 0; r < 16; ++r) { const int k0 = kb + crow(r, hi), k1 = k0 + 32;
                    if (k0 < qc - 128 || k0 > qc + 128) p0[r] = -1e30f; if (k1 < qc - 128 || k1 > qc + 128) p1[r] = -1e30f; } }
            float ma = MX3(p0[0], p0[1], p1[0]), mb = MX3(p0[2], p0[3], p1[1]); ma = MX3(ma, p1[2], p1[3]);
#pragma unroll
            for (int r = 4; r < 16; r += 4) { ma = MX3(ma, p0[r], p0[r + 1]); mb = MX3(mb, p0[r + 2], p0[r + 3]); ma = MX3(ma, p1[r], p1[r + 1]); mb = MX3(mb, p1[r + 2], p1[r + 3]); }
            float rm = __builtin_fmaxf(ma, mb);
            { auto rr = __builtin_amdgcn_permlane32_swap(__float_as_uint(rm), __float_as_uint(rm), false, false); rm = __builtin_fmaxf(__uint_as_float(rr[0]), __uint_as_float(rr[1])); }
            if (__any(rm > (float)ATT_THR)) { const float dl = __builtin_fmaxf(rm, 0.f); mrun[hh] += dl;
#pragma unroll
                for (int r = 0; r < 16; ++r) { p0[r] -= dl; p1[r] -= dl; negm[hh][r] = -mrun[hh]; }
                const float f = __builtin_amdgcn_exp2f(-dl); lsum[hh] *= f; if (hi == 0) wsf[hh * 64 + r32] = f;
                asm volatile("s_waitcnt lgkmcnt(0)" ::: "memory");
#pragma unroll
                for (int r = 0; r < 16; ++r) { const float fr_ = *(volatile LAS float*)(wsf + hh * 64 + crow(r, hi)); o[hh][0][r] *= fr_; o[hh][1][r] *= fr_; } }
#pragma unroll
            for (int r = 0; r < 16; ++r) { p0[r] = __builtin_amdgcn_exp2f(p0[r]); p1[r] = __builtin_amdgcn_exp2f(p1[r]); }
            { f32x2 s2 = (f32x2){p0[0], p0[1]} + (f32x2){p1[0], p1[1]};
#pragma unroll
              for (int r = 2; r < 16; r += 2) { s2 += (f32x2){p0[r], p0[r + 1]}; s2 += (f32x2){p1[r], p1[r + 1]}; }
              lsum[hh] += s2.x + s2.y; }
            u32x4 pw0, pw1, pw2, pw3;
#pragma unroll
            for (int i = 0; i < 4; ++i) { pw0[i] = cvtpk(p0[2 * i], p0[2 * i + 1]); pw1[i] = cvtpk(p0[8 + 2 * i], p0[8 + 2 * i + 1]); pw2[i] = cvtpk(p1[2 * i], p1[2 * i + 1]); pw3[i] = cvtpk(p1[8 + 2 * i], p1[8 + 2 * i + 1]); }
            pv(o[hh], vb0 + slot * SLOTB, __builtin_bit_cast(bf16x8, pw0), __builtin_bit_cast(bf16x8, pw1), __builtin_bit_cast(bf16x8, pw2), __builtin_bit_cast(bf16x8, pw3));
            __builtin_amdgcn_sched_barrier(0);
        }
        }
    }
    LAS bf16_t* stg = (LAS bf16_t*)(shm + A_OST) + wid * 2048;
#pragma unroll
    for (int hh = 0; hh < NH; ++hh) {
        float ls = lsum[hh];
        { auto rr = __builtin_amdgcn_permlane32_swap(__float_as_uint(ls), __float_as_uint(ls), false, false); ls = __uint_as_float(rr[0]) + __uint_as_float(rr[1]); }
        if (hi == 0) wsf[hh * 64 + 32 + r32] = ls;
        asm volatile("s_waitcnt lgkmcnt(0)" ::: "memory");
#pragma unroll
        for (int r = 0; r < 16; ++r) { const int orow = crow(r, hi); const float rl = __builtin_amdgcn_rcpf(*(volatile LAS float*)(wsf + hh * 64 + 32 + orow));
            stg[orow * 64 + r32] = f2bf(o[hh][0][r] * rl); stg[orow * 64 + 32 + r32] = f2bf(o[hh][1][r] * rl); }
        asm volatile("s_waitcnt lgkmcnt(0)" ::: "memory");
        bf16_t* op = MIXo + (size_t)(qrow0 + qw) * D + 512 + (head0 + hh) * 64;
#pragma unroll
        for (int i = 0; i < 4; ++i) { const int row = i * 8 + (lane >> 3), ch = lane & 7; const u32x4 v = *(const LAS u32x4*)(stg + row * 64 + ch * 8); *(u32x4*)(op + (size_t)row * D + ch * 8) = v; }
        asm volatile("s_waitcnt lgkmcnt(0)" ::: "memory");
    }
    conv_finish(CR, cwl, MIXo, cm0, tid, 1);
    asm volatile("s_barrier" ::: "memory");
#undef MX_DMA
#undef MX_TROW
}

__device__ __forceinline__ void gmlp_conv_unit(const Ptrs& P, const bf16_t* PROJ, bf16_t* MIXo, LAS unsigned char* shm, int l, int m0, int tid) {
    const int lane = tid & 63, r32 = lane & 31, hi = lane >> 5; const int wid = __builtin_amdgcn_readfirstlane(tid >> 6);
    LAS bf16_t* vT = (LAS bf16_t*)shm;
    { u32x2 raw[16];
#pragma unroll
      for (int rr = 0; rr < 16; ++rr) raw[rr] = *(const u32x2*)(PROJ + (size_t)(m0 + wid * 16 + rr) * INC + C_V + 4 * lane);
      float gv[4];
#pragma unroll
      for (int i = 0; i < 4; ++i) gv[i] = P.gmlp_g[l * 256 + 4 * lane + i];
#pragma unroll
      for (int r4 = 0; r4 < 4; ++r4) { float g[4][4], ss[4];
#pragma unroll
          for (int q = 0; q < 4; ++q) { const u32x2 w = raw[r4 * 4 + q];
              g[q][0] = gelu_fast(__uint_as_float(w.x << 16)); g[q][1] = gelu_fast(__uint_as_float(w.x & 0xffff0000u)); g[q][2] = gelu_fast(__uint_as_float(w.y << 16)); g[q][3] = gelu_fast(__uint_as_float(w.y & 0xffff0000u));
              ss[q] = g[q][0] * g[q][0] + g[q][1] * g[q][1] + g[q][2] * g[q][2] + g[q][3] * g[q][3]; }
#pragma unroll
          for (int o = 1; o < 64; o <<= 1) {
#pragma unroll
              for (int q = 0; q < 4; ++q) ss[q] += __shfl_xor(ss[q], o); }
          float rinv[4];
#pragma unroll
          for (int q = 0; q < 4; ++q) rinv[q] = rsqrtf(ss[q] * (1.0f / 256.0f) + EPS);
#pragma unroll
          for (int i = 0; i < 4; ++i) { u32x2 w; w.x = cvtpk(g[0][i] * rinv[0] * gv[i], g[1][i] * rinv[1] * gv[i]); w.y = cvtpk(g[2][i] * rinv[2] * gv[i], g[3][i] * rinv[3] * gv[i]);
              *(LAS u32x2*)(vT + (4 * lane + i) * VT_PITCH + wid * 16 + r4 * 4) = w; } } }
    asm volatile("s_waitcnt lgkmcnt(0)\n\ts_barrier" ::: "memory");
    { const int h = wid >> 1, dt = wid & 1;
      const bf16_t* wsb = (const bf16_t*)(P.ws + WS_WSB) + ((size_t)(l * 4 + h) * 128) * 128 + (size_t)r32 * 128 + hi * 8;
      bf16x8 bfr[2][8];
#pragma unroll
      for (int kk = 0; kk < 8; ++kk) bfr[0][kk] = *(const bf16x8*)(wsb + kk * 16);
      u32x2 uraw[4][4];
#pragma unroll
      for (int pt = 0; pt < 4; ++pt)
#pragma unroll
          for (int q4 = 0; q4 < 4; ++q4) uraw[pt][q4] = *(const u32x2*)(PROJ + (size_t)(m0 + pt * 32 + r32) * INC + C_U + h * 64 + dt * 32 + 4 * hi + 8 * q4);
      bf16x8 af[8];
#pragma unroll
      for (int kk = 0; kk < 8; ++kk) af[kk] = *(const LAS bf16x8*)(vT + (h * 64 + dt * 32 + r32) * VT_PITCH + kk * 16 + hi * 8);
      const float* bs = P.b_s + (l * 4 + h) * 128;
#pragma unroll
      for (int pt = 0; pt < 4; ++pt) {
          if (pt < 3) {
#pragma unroll
              for (int kk = 0; kk < 8; ++kk) bfr[(pt + 1) & 1][kk] = *(const bf16x8*)(wsb + (size_t)(pt + 1) * 32 * 128 + kk * 16); }
          f32x16 acc = (f32x16){0.f, 0.f, 0.f, 0.f, 0.f, 0.f, 0.f, 0.f, 0.f, 0.f, 0.f, 0.f, 0.f, 0.f, 0.f, 0.f};
#pragma unroll
          for (int kk = 0; kk < 8; ++kk) acc = __builtin_amdgcn_mfma_f32_32x32x16_bf16(af[kk], bfr[pt & 1][kk], acc, 0, 0, 0);
          const int p = pt * 32 + r32; const float bias = bs[p];
          bf16_t* op = MIXo + (size_t)(m0 + p) * D + h * 64 + dt * 32 + 4 * hi;
#pragma unroll
          for (int q4 = 0; q4 < 4; ++q4) { const u32x2 raw = uraw[pt][q4];
              const float u0 = gelu_fast(__uint_as_float(raw.x << 16)), u1 = gelu_fast(__uint_as_float(raw.x & 0xffff0000u)), u2 = gelu_fast(__uint_as_float(raw.y << 16)), u3 = gelu_fast(__uint_as_float(raw.y & 0xffff0000u));
              u32x2 w; w.x = cvtpk(u0 * (acc[4 * q4] + bias), u1 * (acc[4 * q4 + 1] + bias)); w.y = cvtpk(u2 * (acc[4 * q4 + 2] + bias), u3 * (acc[4 * q4 + 3] + bias));
              *(u32x2*)(op + 8 * q4) = w; }
      } }
    asm volatile("s_waitcnt lgkmcnt(0)\n\ts_barrier" ::: "memory");
}
}

constexpr int ATT_NH = 1;
__device__ __forceinline__ void phase_mixer(const Ptrs& P, LAS unsigned char* lds, int l, int Mmix) {
    int tid = threadIdx.x; asm volatile("" : "+v"(tid));
    const bf16_t* PROJ = (const bf16_t*)(P.ws + WS_PROJ); bf16_t* MIXo = (bf16_t*)(P.ws + WS_MIX);
    const int G = gridDim.x, c = blockIdx.x;
    constexpr int UPC = ATT_NH == 2 ? 2 : 4;
    const int nLat = (ML / 128) * UPC, nCtx = Mmix > ML ? (MC / 128) * UPC : 0, nG = Mmix / 128;
    const bool gfirst = (c & 1) != 0;
    for (int pass = 0; pass < 2; ++pass) {
        if ((pass == 0) != gfirst) { for (int u = c; u < nLat; u += G) { const int chunk = u / UPC, kvh = (u / (UPC / 2)) & 1, hp = u & 1; mx::attn_unit<ATT_NH>(PROJ, MIXo, P.sink + l * 8, P.conv_w + (size_t)l * 768, lds, 1, chunk >> 6, chunk & 63, kvh, hp, tid); } }
        else { for (int u = c; u < nG + nCtx; u += G) {
            if (u < nG) mx::gmlp_conv_unit(P, PROJ, MIXo, lds, l, u * 128, tid);
            else { const int v = u - nG, chunk = v / UPC, kvh = (v / (UPC / 2)) & 1, hp = v & 1; mx::attn_unit<ATT_NH>(PROJ, MIXo, P.sink + l * 8, P.conv_w + (size_t)l * 768, lds, 0, chunk >> 1, chunk & 1, kvh, hp, tid); } } }
    }
}
constexpr int NPH = 31;
struct KArgs { Ptrs P; int lo, hi; };
__global__ void __launch_bounds__(NTHR, 2) k_fast(KArgs a) {
    extern __shared__ __attribute__((aligned(16))) unsigned char lds_raw[];
    LAS unsigned char* lds = (LAS unsigned char*)lds_raw;
    const int lo = a.lo, hi = a.hi;
#if defined(__HIP_DEVICE_COMPILE__) && defined(USE_KERNARG_RELOAD)
#define LOADP() const __attribute__((address_space(4))) unsigned long long* ap_ = (const __attribute__((address_space(4))) unsigned long long*)__builtin_amdgcn_kernarg_segment_ptr(); asm volatile("" : "+s"(ap_)); \
    Ptrs P; { unsigned long long* d_ = (unsigned long long*)&P; _Pragma("unroll") for (int i_ = 0; i_ < (int)(sizeof(Ptrs) / 8); ++i_) d_[i_] = ap_[i_]; }
#else
#define LOADP() const Ptrs P = a.P
#endif
    unsigned* ctl; { LOADP(); ctl = (unsigned*)(P.ws + WS_CTL); }
    if (threadIdx.x < 4) ((LAS unsigned*)(lds + MISC_OFF))[threadIdx.x] = 0u;
    __syncthreads();
    XcdBarrier bar; bar.bar = ctl + CW_BAR; bar.x = 0; bar.st = (volatile LAS unsigned*)(lds + MISC_OFF);
    if (hi - lo > 1) bar = xcd_barrier_post(ctl + CW_BAR, (volatile LAS unsigned*)(lds + MISC_OFF));
    volatile LAS int* vcw = (volatile LAS int*)(lds + MISC_OFF + 32);
    if (threadIdx.x == 0) { vcw[3] = 0; vcw[0] = (int)blockIdx.x; vcw[1] = (int)xb_xcc_id(); vcw[2] = (hi - lo > 1) ? (int)xb_add(ctl + CW_XR + 64 * xb_xcc_id(), 1u) : 0; }
    __syncthreads();
#define IN(k, kind) (lo <= (k) && (k) < hi)
#define SEAM(k) do { if (lo <= (k) && (k) + 1 < hi) xcd_barrier(bar); } while (0)
    LAS unsigned* idxtab = (LAS unsigned*)(lds + IDX_OFF);
    LAS int* tst = (LAS int*)(lds + TST_OFF);

    if (IN(0, 0)) { LOADP(); phase_p0a(P, lds); }
    SEAM(0);
    if (lo == 0 && hi > 1) {
        if (threadIdx.x == 0) { const int myx = vcw[1], rank = vcw[2]; int npop = 0, xi = 0; bool even = true;
            for (int j = 0; j < 16; ++j) { const unsigned cj = xb_ld(ctl + CW_XR + 64 * j); if (cj) { ++npop; if (j < myx) ++xi; if (cj * 8u != gridDim.x) even = false; } }
            if (even && npop == 8 && rank < (int)(gridDim.x / 8)) { vcw[0] = rank * 8 + xi; vcw[3] = (int)(gridDim.x / 8); }
            }
        __syncthreads(); }
    const int vc = vcw[0];
    if (IN(1, 1)) { LOADP(); phase_p0b(P); }
    SEAM(1);
    for (int l = 0; l < DEPTH; ++l) {
        const int pb = 2 + 7 * l;
        const int Mmix = l < DEPTH - 1 ? MT : ML;
        if (IN(pb + 0, 2)) { LOADP(); if (l > 0) build_tile_table(P, tst, l - 1);
            if (l == 0) phase_norm<1, true>(P, lds, l, MT, (const bf16_t*)P.out, tst); else phase_norm<1, false>(P, lds, l, MT, (const bf16_t*)P.out, tst); }
        SEAM(pb + 0);
        if (IN(pb + 1, 3)) { LOADP();
            SchedDense<INC> S{(const bf16_t*)(P.ws + WS_H), (const bf16_t*)(P.ws + WS_WIN) + (size_t)l * INC * D, MT / 256, (int)gridDim.x, vc};
            EpiProj E{(bf16_t*)(P.ws + WS_PROJ), (const float*)(P.ws + WS_ROPE)};
            pg::gemm_phase(lds + RING_OFF, idxtab, S, E);
        }
        SEAM(pb + 1);
        if (IN(pb + 2, 4)) { LOADP(); phase_mixer(P, lds, l, Mmix); }
        SEAM(pb + 2);
        if (IN(pb + 3, 5)) { LOADP();
            SchedDense<D> S{(const bf16_t*)(P.ws + WS_MIX), (const bf16_t*)(P.ws + WS_WOUT) + (size_t)l * D * D, Mmix / 256, (int)gridDim.x, vc};
            EpiPlain E{(bf16_t*)(P.ws + WS_PROJ), D};
            pg::gemm_phase(lds + RING_OFF, idxtab, S, E);
        }
        SEAM(pb + 3);
        if (IN(pb + 4, 6)) { LOADP(); phase_norm<2, false>(P, lds, l, Mmix, (const bf16_t*)(P.ws + WS_PROJ), tst); }
        SEAM(pb + 4);
        if (IN(pb + 5, 7)) { LOADP(); const ClsRec* listr = (const ClsRec*)(P.ws + WS_LISTR);
            build_tile_table(P, tst, l);
            SchedGU S{(const unsigned char*)(P.ws + WS_H), (const unsigned char*)(P.ws + WS_WGU) + (size_t)l * NE * 1024 * 1024, listr, tst, ctl + CW_CNTF + l * 32 * 64, (int)gridDim.x, vc};
            EpiGU E{(unsigned char*)(P.ws + WS_PROJ), listr, ctl + CW_CNTF + l * 32 * 64};
            pg::gemm_phase(lds + RING_OFF, idxtab, S, E);
        }
        SEAM(pb + 5);
        if (IN(pb + 6, 8)) { LOADP();
            build_tile_table(P, tst, l);
            SchedDown S{(const unsigned char*)(P.ws + WS_PROJ), (const unsigned char*)(P.ws + WS_WD) + (size_t)l * NE * 1024 * 512, tst, (int)gridDim.x, vc};
            EpiPlain E{l < DEPTH - 1 ? (bf16_t*)P.out : (bf16_t*)(P.ws + WS_H), D};
            pg::gemm_phase(lds + RING_OFF, idxtab, S, E);
        }
        SEAM(pb + 6);
    }
    if (IN(30, 9)) { LOADP(); build_tile_table(P, tst, DEPTH - 1); phase_norm<3, false>(P, lds, DEPTH - 1, ML, (const bf16_t*)(P.ws + WS_H), tst); }
#undef IN
#undef SEAM
}
static int g_grid = 256;
static void launch_fast(const Ptrs& P, int lo, int hi, hipStream_t stream) {
    KArgs a{}; a.P = P; a.lo = lo; a.hi = hi;
    hipLaunchKernelGGL(k_fast, dim3(g_grid), dim3(NTHR), LDS_BYTES, stream, a);
}
extern "C" void kernel_launch(void* const* d_in, const int* in_sizes, int n_in, void* d_out, int out_size, void* d_ws, size_t ws_size, hipStream_t stream) {
    static int ready = 0;
    if (!ready) {
        if (n_in != 21 || ws_size < WS_END2) { fprintf(stderr, "kernel_launch: unexpected inputs (%d) or workspace (%zu)\n", n_in, ws_size); ready = -1; return; }
        if (hipFuncSetAttribute((const void*)k_fast, hipFuncAttributeMaxDynamicSharedMemorySize, LDS_BYTES) != hipSuccess) { fprintf(stderr, "kernel_launch: hipFuncSetAttribute failed\n"); ready = -1; return; }
        { int dev = 0, cus = 0, per_cu = 0; (void)hipGetDevice(&dev); (void)hipDeviceGetAttribute(&cus, hipDeviceAttributeMultiprocessorCount, dev);
          if (hipOccupancyMaxActiveBlocksPerMultiprocessor(&per_cu, (const void*)k_fast, NTHR, LDS_BYTES) != hipSuccess || per_cu < 1) { fprintf(stderr, "kernel_launch: occupancy query says %d blocks per CU\n", per_cu); }
          (void)hipGetLastError(); if (cus > 0) g_grid = cus;
          if (g_grid * NWAVES * 64 < MT) { fprintf(stderr, "kernel_launch: %d workgroups are too few for the routing tables\n", g_grid); ready = -1; return; } }
        ready = 1;
    }
    if (ready < 0) return;
    Ptrs P{};
    const float** pp = (const float**)&P;
    for (int i = 0; i < 21; ++i) pp[i] = (const float*)d_in[i];
    P.out = (float*)d_out; P.ws = (unsigned char*)d_ws;
    unsigned char* ws = (unsigned char*)d_ws;
    (void)hipMemsetAsync(ws + WS_CTL, 0, 1 * MiB, stream);
    launch_fast(P, 0, NPH, stream);
}
```

```cpp
#include <hip/hip_runtime.h>
#include <stdint.h>
#include <cstdio>

constexpr int D = 1024, NB = 8, SEQ = 8192, DEPTH = 4, CTXL = 256;
constexpr int ML = NB * SEQ;
constexpr int MC = NB * CTXL;
constexpr int MT = ML + MC;
constexpr int INC = 2048;
constexpr int C_U = 0, C_V = 256, C_BG = 512, C_CG = 768, C_Z = 1024, C_Q = 1280, C_K = 1792, C_VV = 1920;
constexpr int NE = 16, DE = 512, NCLS = 24;
constexpr float EPS = 1e-6f;
constexpr float QSCALE = 0.125f * 1.4426950408889634f;
constexpr float LOG2E = 1.4426950408889634f;

typedef unsigned short bf16_t;
typedef float f32x4 __attribute__((ext_vector_type(4)));
typedef unsigned u32x4 __attribute__((ext_vector_type(4)));
typedef unsigned u32x2 __attribute__((ext_vector_type(2)));

__device__ __forceinline__ float bf2f(bf16_t v) { return __uint_as_float((unsigned)v << 16); }
__device__ __forceinline__ bf16_t f2bf(float f) { unsigned u = __float_as_uint(f); return (bf16_t)((u + 0x7fffu + ((u >> 16) & 1u)) >> 16); }
__device__ __forceinline__ unsigned pk2(float lo, float hi) { return (unsigned)f2bf(lo) | ((unsigned)f2bf(hi) << 16); }
__device__ __forceinline__ float gelu_tanh(float x) { const float y = 0.7978845608028654f * (x + 0.044715f * x * x * x); return x / (1.0f + __expf(-2.0f * y)); }
__device__ __forceinline__ float silu_f(float x) { return x / (1.0f + __expf(-x)); }
__device__ __forceinline__ float wave_sum(float v) {
#pragma unroll
    for (int o = 1; o < 64; o <<= 1) v += __shfl_xor(v, o);
    return v;
}

constexpr size_t MiB = 1u << 20;
constexpr size_t WS_CTL = 0;
constexpr size_t WS_MOD = 1 * MiB;
constexpr size_t WS_ROPE = 2 * MiB;
constexpr size_t WS_TOK = 3 * MiB;
constexpr size_t WS_XC = 5 * MiB;
constexpr size_t WS_LISTE = 13 * MiB;
constexpr size_t WS_LISTC = 18 * MiB;
constexpr size_t WS_VN = 25 * MiB;
constexpr size_t WS_WIN = 64 * MiB, WS_WOUT = 80 * MiB, WS_WGU = 88 * MiB, WS_WD = 216 * MiB;
constexpr size_t WS_H = 280 * MiB;
constexpr size_t WS_MIX = 412 * MiB;
constexpr size_t WS_PROJ = 544 * MiB;
constexpr size_t WS_END = 808 * MiB;
constexpr int CW_CNTE = 1024;
constexpr int CW_CNTC = 2048;

struct Tok { unsigned ids; float wlo, whi; unsigned pad; };

struct Ptrs {
    const float *x, *c, *ctx, *c_ctx, *w_mod, *b_mod, *norm1_g, *norm2_g, *w_in, *gmlp_g, *w_s, *b_s, *conv_w, *sink, *w_out, *router_w, *router_b, *w_gate, *w_up, *w_down, *final_g;
    float* out; unsigned char* ws;
};
__device__ __forceinline__ int modrow(int m) { return m < ML ? (m >> 13) : 8; }

#define LAS __attribute__((address_space(3)))
#define XB_TMO      128
#define XB_XCNT(j)  (256  + 64 * (j))
#define XB_XSUB(j)  (1280 + 64 * (j))
#define XB_XGEN(j)  (2304 + 64 * (j))
#define XB_TOP      3328
#define XB_TOPGEN   3392
#define XCD_BAR_WORDS 3456
#define XB_SPIN_CAP (1u << 18)

__device__ __forceinline__ unsigned xb_ld(unsigned* p)              { return __hip_atomic_load(p, __ATOMIC_RELAXED, __HIP_MEMORY_SCOPE_AGENT); }
__device__ __forceinline__ unsigned xb_add(unsigned* p, unsigned v) { return __hip_atomic_fetch_add(p, v, __ATOMIC_RELAXED, __HIP_MEMORY_SCOPE_AGENT); }
__device__ __forceinline__ unsigned xb_xcc_id() { return (unsigned)__builtin_amdgcn_s_getreg((3 << 11) | 20) & 0xFu; }
#define XB_SPIN(cond, bar) do { unsigned _sp = 0; while (cond) { __builtin_amdgcn_s_sleep(1); \
    if ((++_sp & 255u) == 0u) { if (xb_ld(&(bar)[XB_TMO])) break; if (_sp > XB_SPIN_CAP) { atomicAdd(&(bar)[XB_TMO], 1u); break; } } } } while (0)

struct XcdBarrier {
    unsigned* bar; unsigned x;
    volatile LAS unsigned* st;
};

__device__ __forceinline__ XcdBarrier xcd_barrier_post(unsigned* bar, volatile LAS unsigned* st) {
    XcdBarrier b; b.bar = bar; b.x = xb_xcc_id(); b.st = st;
    if (threadIdx.x == 0) (void)xb_add(&bar[XB_XCNT(b.x)], 1u);
    return b;
}
__device__ __forceinline__ void xcd_barrier_complete(unsigned* bar, unsigned x, unsigned& nloc, unsigned& nx) {
    const unsigned G = gridDim.x * gridDim.y * gridDim.z;
    unsigned sum, cnt, mine, sp = 0u;
    for (;;) {
        sum = 0u; cnt = 0u; mine = 0u;
#pragma unroll
        for (unsigned j = 0; j < 16; ++j) { const unsigned c = xb_ld(&bar[XB_XCNT(j)]); sum += c; cnt += (c > 0u) ? 1u : 0u; mine = (j == x) ? c : mine; }
        if (sum == G) break;
        __builtin_amdgcn_s_sleep(1);
        if ((++sp & 255u) == 0u) { if (xb_ld(&bar[XB_TMO])) break; if (sp > XB_SPIN_CAP) { atomicAdd(&bar[XB_TMO], 1u); break; } }
    }
    nloc = mine > 0u ? mine : 1u; nx = cnt > 0u ? cnt : 1u;
}

__device__ __forceinline__ void xcd_barrier(const XcdBarrier& b) {
    asm volatile("s_waitcnt vmcnt(0)" ::: "memory");
    __syncthreads();
    if (threadIdx.x == 0) {
        unsigned* bar = b.bar;
        __builtin_amdgcn_s_waitcnt(0);
        unsigned nloc = b.st[0], nx = b.st[1];
        if (nloc == 0u) { xcd_barrier_complete(bar, b.x, nloc, nx); b.st[0] = nloc; b.st[1] = nx; }
        const unsigned old = xb_add(&bar[XB_XSUB(b.x)], 1u);
        const unsigned gen = old / nloc;
        if (old + 1u == (gen + 1u) * nloc) {
            __builtin_amdgcn_fence(__ATOMIC_RELEASE, "agent");
            asm volatile("s_waitcnt vmcnt(0)" ::: "memory");
            const unsigned og = xb_add(&bar[XB_TOP], 1u);
            const unsigned tg = og / nx;
            if (og + 1u == (tg + 1u) * nx) xb_add(&bar[XB_TOPGEN], 1u);
            else XB_SPIN(xb_ld(&bar[XB_TOPGEN]) == tg, bar);
            __builtin_amdgcn_fence(__ATOMIC_ACQUIRE, "agent");
            xb_add(&bar[XB_XGEN(b.x)], 1u);
            asm volatile("s_waitcnt vmcnt(0)" ::: "memory");
        } else {
            XB_SPIN(xb_ld(&bar[XB_XGEN(b.x)]) == gen, bar);
            __builtin_amdgcn_fence(__ATOMIC_ACQUIRE, "agent");
            asm volatile("s_waitcnt vmcnt(0)" ::: "memory");
        }
    }
    __syncthreads();
}
typedef short bf16x8 __attribute__((ext_vector_type(8)));
typedef int v4i32 __attribute__((ext_vector_type(4)));
typedef int v8i32 __attribute__((ext_vector_type(8)));
namespace pg {
constexpr int BM = 256, BK = 64, HALF = 128, HTB = HALF * BK * 2  , STAGE_BYTES = 8 * HTB, NXCD = 8, WGM = 8;
__host__ __device__ __forceinline__ int lds_byte(int r, int c) { return (r >> 3) * 1024 + (r & 7) * 128 + (((c >> 3) ^ (r & 7)) << 4); }
__host__ __device__ __forceinline__ void stage_rc(int b, int& R, int& C) { const int piece = b >> 10, p = (b & 1023) >> 4; R = piece * 8 + (p >> 3); C = ((p & 7) ^ (R & 7)) << 3; }

struct Unit { int pm, pn, x0, x1; };

__device__ __forceinline__ void order_unit(int L, int nM, int nN, int& pm, int& pn) {
    const int nwg = nM * nN; int wgid = L;
    { const int q = nwg / NXCD, r = nwg % NXCD, xcd = wgid % NXCD, off = wgid / NXCD; wgid = (xcd < r ? xcd * (q + 1) : r * (q + 1) + (xcd - r) * q) + off; }
    const int nig = WGM * nN, gid = wgid / nig, fm = gid * WGM, gsz = (nM - fm) < WGM ? (nM - fm) : WGM;
    pm = fm + ((wgid % nig) % gsz); pn = (wgid % nig) / gsz;
}

template <class Sched, class Epi>
__device__ __forceinline__ void gemm_phase(LAS unsigned char* lds, LAS unsigned* idxtab, const Sched& S, const Epi& E) {
    constexpr int ESZ = Sched::ESZ;
    constexpr int K = Sched::K, LDA = Sched::LDA, LDB = Sched::LDB, nt = K * ESZ / 128, KS = Sched::KSPLIT; constexpr bool GATHER = Sched::GATHER;
    int tid = threadIdx.x; asm volatile("" : "+v"(tid));
    const int wid = __builtin_amdgcn_readfirstlane(tid >> 6), lane = tid & 63, wr = wid >> 2, wc = wid & 3;
    constexpr size_t kstep = (size_t)(BK * 2);
    constexpr size_t hstepA = (size_t)HALF * LDA * ESZ, hstepB = (size_t)HALF * LDB * ESZ;
    const unsigned ldsw = (unsigned)wid * 1024u;
    const int aoff0 = lds_byte(wr * 64 + (lane & 15), (lane >> 4) * 8), boff0 = lds_byte(wc * 32 + (lane & 15), (lane >> 4) * 8);
    unsigned pvoA[2], pvoB[2];
#pragma unroll
    for (int i = 0; i < 2; ++i) { int R_, C_; stage_rc((wid * 64 + lane) * 16 + i * 8192, R_, C_); pvoA[i] = (unsigned)(R_ * LDA * ESZ + C_ * 2); pvoB[i] = (unsigned)(R_ * LDB * ESZ + C_ * 2); }
    unsigned cv[2][2];
#define PG_SA(b, h) (((b) * 2 + (h)) * HTB)
#define PG_SB(b, h) ((4 + (b) * 2 + (h)) * HTB)
#define PG_VOFF(ld, i, dst) do { int _t = wid * 64 + lane; asm volatile("" : "+v"(_t)); int _R, _C; stage_rc(_t * 16 + (i) * 8192, _R, _C); dst = (unsigned)(_R * (ld) * ESZ + _C * 2); } while (0)
#define PG_STAGE_B(bufoff, gbase) do { _Pragma("unroll") for (int _i = 0; _i < 2; ++_i) { unsigned _vo = pvoB[_i]; if constexpr (ESZ == 1) PG_VOFF(LDB, _i, _vo); \
        __builtin_amdgcn_global_load_lds((const unsigned*)((const char*)(gbase) + _vo), (LAS unsigned*)(lds + (bufoff) + ldsw + _i * 8192), 16, 0, 0); } } while (0)
#define PG_STAGE_A(bufoff, gbase, h, V) do { _Pragma("unroll") for (int _i = 0; _i < 2; ++_i) { unsigned _vo = pvoA[_i]; \
        const char* _p = GATHER ? (const char*)(gbase) + V[h][_i] : (const char*)(gbase) + ((h) ? hstepA : 0) + _vo; \
        __builtin_amdgcn_global_load_lds((const unsigned*)_p, (LAS unsigned*)(lds + (bufoff) + ldsw + _i * 8192), 16, 0, 0); } } while (0)
#define PG_LDA(dst, b, h) do { int _a1 = aoff0 ^ 64; asm volatile("" : "+v"(_a1)); _Pragma("unroll") for (int m = 0; m < 4; ++m) _Pragma("unroll") for (int k = 0; k < 2; ++k) dst[m][k] = *(const LAS bf16x8*)(lds + PG_SA(b, h) + (k ? _a1 : aoff0) + m * 2048); } while (0)
#define PG_LDB(dst, b, h) do { int _b1 = boff0 ^ 64; asm volatile("" : "+v"(_b1)); _Pragma("unroll") for (int n = 0; n < 2; ++n) _Pragma("unroll") for (int k = 0; k < 2; ++k) dst[n][k] = *(const LAS bf16x8*)(lds + PG_SB(b, h) + (k ? _b1 : boff0) + n * 2048); } while (0)
#define PG_MMA(ai, bj, At, Bt) do { __builtin_amdgcn_s_setprio(1); _Pragma("unroll") for (int m = 0; m < 4; ++m) _Pragma("unroll") for (int n = 0; n < 2; ++n) { \
        if constexpr (ESZ == 2) { _Pragma("unroll") for (int k = 0; k < 2; ++k) acc[ai][bj][m][n] = __builtin_amdgcn_mfma_f32_16x16x32_bf16(Bt[n][k], At[m][k], acc[ai][bj][m][n], 0, 0, 0); } \
        else {   \
            const v8i32 bw = __builtin_shufflevector(__builtin_bit_cast(v4i32, Bt[n][0]), __builtin_bit_cast(v4i32, Bt[n][1]), 0, 1, 2, 3, 4, 5, 6, 7); \
            const v8i32 aw = __builtin_shufflevector(__builtin_bit_cast(v4i32, At[m][0]), __builtin_bit_cast(v4i32, At[m][1]), 0, 1, 2, 3, 4, 5, 6, 7); \
            acc[ai][bj][m][n] = __builtin_amdgcn_mfma_scale_f32_16x16x128_f8f6f4(bw, aw, acc[ai][bj][m][n], 0, 0, 0, Sched::SCALE_B, 0, Sched::SCALE_A); } } \
        __builtin_amdgcn_s_setprio(0); } while (0)
#define PG_WAIT_V(n) asm volatile("s_waitcnt vmcnt(" #n ")" ::: "memory")
#define PG_WAIT_L(n) asm volatile("s_waitcnt lgkmcnt(" #n ")" ::: "memory")
#define PG_BAR __builtin_amdgcn_s_barrier()
#define PG_SCHED __builtin_amdgcn_sched_barrier(0)
#define PG_IDX_ISSUE(u) do { int _l = lane; asm volatile("" : "+v"(_l)); const int _h = (_l >> 4) & 1, _i = (_l >> 3) & 1, _r = _l & 7; const unsigned _po = (unsigned)(_h * 128 + (wid + 8 * _i) * 8 + _r) * 16u; \
        __builtin_amdgcn_global_load_lds((const unsigned*)((const char*)S.idx_src(u) + _po), (LAS unsigned*)(idxtab + wid * 64), 4, 0, 0); } while (0)
#define PG_IDX_READ(u, V) do { const int _vr = S.valid_rows(u); _Pragma("unroll") for (int _h = 0; _h < 2; ++_h) _Pragma("unroll") for (int _i = 0; _i < 2; ++_i) { \
        const int _pos = _h * 128 + (wid + 8 * _i) * 8 + (lane >> 3); unsigned _tk = *(volatile LAS unsigned*)(idxtab + wid * 64 + _h * 16 + _i * 8 + (lane >> 3)); \
        _tk = _pos < _vr ? _tk : 0u; V[_h][_i] = _tk * (unsigned)(LDA * ESZ) + (unsigned)(((lane & 7) ^ ((lane >> 3) & 7)) << 4); } } while (0)
    Unit cur, nxt; int ui = 0;
    if (!S.next(0, cur)) return;
    f32x4 acc[2][2][4][2];
#pragma unroll
    for (int a = 0; a < 2; ++a)
#pragma unroll
        for (int b = 0; b < 2; ++b)
#pragma unroll
            for (int m = 0; m < 4; ++m)
#pragma unroll
                for (int n = 0; n < 2; ++n) acc[a][b][m][n] = (f32x4){0.f, 0.f, 0.f, 0.f};
    bf16x8 At[4][2], B0[2][2], B1[2][2];
    const char* cA = S.a_base(cur); const char* cB0 = S.b_base(cur, 0); const char* cB1 = S.b_base(cur, 1);
#pragma unroll
    for (int h = 0; h < 2; ++h)
#pragma unroll
        for (int i = 0; i < 2; ++i) cv[h][i] = 0u;
    if constexpr (GATHER) { PG_IDX_ISSUE(cur); PG_WAIT_V(0); PG_IDX_READ(cur, cv); }
    PG_STAGE_B(PG_SB(0, 0), cB0); PG_STAGE_B(PG_SB(0, 1), cB0 + hstepB); PG_STAGE_A(PG_SA(0, 0), cA, 0, cv); PG_STAGE_A(PG_SA(0, 1), cA, 1, cv);
    if (wr == 1) PG_BAR;
    PG_WAIT_V(2); PG_BAR;
    PG_STAGE_B(PG_SB(1, 0), cB0 + kstep); PG_STAGE_A(PG_SA(1, 0), cA + kstep, 0, cv); PG_STAGE_B(PG_SB(1, 1), cB0 + hstepB + kstep);
    PG_WAIT_V(6); PG_BAR;
    for (;;) {
        const bool has_next = S.next(ui + 1, nxt);
        const char* nA = has_next ? S.a_base(nxt) : cA; const char* nB0 = has_next ? S.b_base(nxt, 0) : cB0; const char* nB1 = has_next ? S.b_base(nxt, 1) : cB1;
        if constexpr (GATHER) { if (has_next) PG_IDX_ISSUE(nxt); }
#pragma nounroll
        for (int t = 0; t < nt; t += 2) {
            const bool last = (t == nt - 2);
            const char* a1 = cA + (size_t)(t + 1) * kstep;
            const char* a2 = last ? nA : cA + (size_t)(t + 2) * kstep; const char* a3 = a2 + kstep;
            const char* b2 = last ? nB0 : ((t + 2) < KS ? cB0 : cB1) + (size_t)(t + 2) * kstep;
            const char* b3 = last ? nB0 + kstep : ((t + 3) < KS ? cB0 : cB1) + (size_t)(t + 3) * kstep;
            PG_LDB(B0, 0, 0); PG_LDB(B1, 0, 1); PG_SCHED; PG_LDA(At, 0, 0); PG_STAGE_A(PG_SA(1, 1), a1, 1, cv);
            if constexpr (GATHER) { if (last && has_next) { PG_IDX_READ(nxt, cv); } }
            PG_WAIT_V(8); PG_WAIT_L(0); PG_BAR; PG_MMA(0, 0, At, B0); PG_MMA(0, 1, At, B1); PG_BAR; PG_SCHED;
            PG_LDA(At, 0, 1); PG_STAGE_B(PG_SB(0, 0), b2); PG_STAGE_B(PG_SB(0, 1), b2 + hstepB); PG_STAGE_A(PG_SA(0, 0), a2, 0, cv);
            PG_WAIT_V(8); PG_WAIT_L(0); PG_BAR; PG_MMA(1, 0, At, B0); PG_MMA(1, 1, At, B1); PG_BAR; PG_SCHED;
            PG_LDB(B0, 1, 0); PG_LDB(B1, 1, 1); PG_SCHED; PG_LDA(At, 1, 0); PG_STAGE_A(PG_SA(0, 1), a2, 1, cv);
            PG_WAIT_V(8); PG_WAIT_L(0); PG_BAR; PG_MMA(0, 0, At, B0); PG_MMA(0, 1, At, B1); PG_BAR; PG_SCHED;
            PG_LDA(At, 1, 1); PG_STAGE_B(PG_SB(1, 0), b3); PG_STAGE_B(PG_SB(1, 1), b3 + hstepB); PG_STAGE_A(PG_SA(1, 0), a3, 0, cv);
            PG_WAIT_V(8); PG_WAIT_L(0); PG_BAR; PG_MMA(1, 0, At, B0); PG_MMA(1, 1, At, B1); PG_BAR; PG_SCHED;
        }
        if (wr == 0) PG_BAR;
        { int _l = lane; asm volatile("" : "+v"(_l)); E(acc, cur, wr, wc, _l & 15, _l >> 4); }
        if (!has_next) break;
#pragma unroll
        for (int a = 0; a < 2; ++a)
#pragma unroll
            for (int b = 0; b < 2; ++b)
#pragma unroll
                for (int m = 0; m < 4; ++m)
#pragma unroll
                    for (int n = 0; n < 2; ++n) acc[a][b][m][n] = (f32x4){0.f, 0.f, 0.f, 0.f};
        cur = nxt; cA = nA; cB0 = nB0; cB1 = nB1; ++ui;
        if (wr == 1) PG_BAR;
    }
    PG_WAIT_V(0);
    PG_BAR;
#undef PG_SA
#undef PG_SB
#undef PG_STAGE_A
#undef PG_STAGE_B
#undef PG_VOFF
#undef PG_LDA
#undef PG_LDB
#undef PG_MMA
#undef PG_WAIT_V
#undef PG_WAIT_L
#undef PG_BAR
#undef PG_SCHED
#undef PG_IDX_ISSUE
#undef PG_IDX_READ
}
}
constexpr int NWAVES = 8, NTHR = 512;
constexpr int RING_OFF = 0, RING_BYTES = 131072;
constexpr int IDX_OFF = RING_BYTES;
constexpr int TST_OFF = IDX_OFF + 2048;
constexpr int MISC_OFF = TST_OFF + 128;
constexpr int LDS_BYTES = 147456;
constexpr size_t WS_MODP = WS_VN;
constexpr size_t WS_WSB = 62 * MiB;
constexpr int CW_CNTF = 16384;
constexpr int CW_XR = 12288;
constexpr int CW_MXQ = 13312;
constexpr int CW_BAR = 8192;
constexpr int MAXT = 288;

struct ClsRec { int m; float wlo, whi; int pad; };
constexpr size_t WS_LISTR = 816 * MiB;
constexpr size_t WS_XB = 848 * MiB;
constexpr size_t WS_POS = WS_TOK;
constexpr size_t WS_END2 = 980 * MiB;

__device__ __forceinline__ void cls_experts(int cls, int& elo, int& ehi) {
    const int g = cls / 6, p = cls % 6; const int a = p < 3 ? 0 : (p < 5 ? 1 : 2), b = p < 3 ? p + 1 : (p < 5 ? p - 1 : 3);
    elo = g * 4 + a; ehi = g * 4 + b;
}
constexpr int F8_SH_H = 4, F8_SH_A = 3, F8_SH_W = 5;
#define SC_E8(sh) ((127 - (sh)) * 0x01010101)
__device__ __forceinline__ unsigned pk4_fp8(float a, float b, float c, float d, float scale) {
    const float lim = 448.0f; a = fminf(fmaxf(a * scale, -lim), lim); b = fminf(fmaxf(b * scale, -lim), lim); c = fminf(fmaxf(c * scale, -lim), lim); d = fminf(fmaxf(d * scale, -lim), lim);
    int w = __builtin_amdgcn_cvt_pk_fp8_f32(a, b, 0, false); w = __builtin_amdgcn_cvt_pk_fp8_f32(c, d, w, true); return (unsigned)w; }
__device__ __forceinline__ unsigned cvt_pk_bf16(float lo, float hi) { unsigned r; asm volatile("v_cvt_pk_bf16_f32 %0, %1, %2" : "=v"(r) : "v"(lo), "v"(hi)); return r; }

template <int N_> struct SchedDense {
    static constexpr int K = 1024, LDA = 1024, LDB = 1024, KSPLIT = 16, ESZ = 2, SCALE_A = 0, SCALE_B = 0; static constexpr bool GATHER = false;
    const bf16_t* A; const bf16_t* Bt; int nM, G, c;
    __device__ __forceinline__ bool next(int i, pg::Unit& u) const { const long L = (long)i * G + c; if (L >= (long)nM * (N_ / 256)) return false; pg::order_unit((int)L, nM, N_ / 256, u.pm, u.pn); u.x0 = 0; u.x1 = 0; return true; }
    __device__ __forceinline__ const char* a_base(const pg::Unit& u) const { return (const char*)A + (size_t)u.pm * 256 * LDA * 2; }
    __device__ __forceinline__ const char* b_base(const pg::Unit& u, int) const { return (const char*)Bt + (size_t)u.pn * 256 * LDB * 2; }
    __device__ __forceinline__ const unsigned* idx_src(const pg::Unit&) const { return nullptr; }
    __device__ __forceinline__ int valid_rows(const pg::Unit&) const { return 256; }
};
__device__ __forceinline__ void cls_of_tile(const LAS int* tst, int T, int& cls, int& rt) {
    int c = 0;
#pragma unroll
    for (int k = 1; k < NCLS; ++k) c += (T >= tst[k]) ? 1 : 0;
    cls = __builtin_amdgcn_readfirstlane(c); rt = __builtin_amdgcn_readfirstlane(T - tst[c]);
}
struct SchedGU {
    static constexpr int K = 1024, LDA = 1024, LDB = 1024, KSPLIT = 8, ESZ = 1, SCALE_A = SC_E8(F8_SH_H), SCALE_B = SC_E8(F8_SH_W); static constexpr bool GATHER = true;
    const unsigned char* H; const unsigned char* Wgu; const ClsRec* list; const LAS int* tst; const unsigned* cnt; int G, c;
    __device__ __forceinline__ bool next(int i, pg::Unit& u) const { const int TT = __builtin_amdgcn_readfirstlane(tst[NCLS]); const long L = (long)i * G + c; if (L >= (long)TT * 8) return false;
        pg::order_unit((int)L, TT, 8, u.pm, u.pn); cls_of_tile(tst, u.pm, u.x0, u.x1); return true; }
    __device__ __forceinline__ const char* a_base(const pg::Unit&) const { return (const char*)H; }
    __device__ __forceinline__ const char* b_base(const pg::Unit& u, int) const { int elo, ehi; cls_experts(u.x0, elo, ehi); const int e = u.pn < 4 ? elo : ehi;
        return (const char*)Wgu + ((size_t)e * 1024 + (size_t)(u.pn & 3) * 256) * LDB; }
    __device__ __forceinline__ const unsigned* idx_src(const pg::Unit& u) const { return (const unsigned*)(list + (size_t)u.x0 * MT + (size_t)u.x1 * 256); }
    __device__ __forceinline__ int valid_rows(const pg::Unit& u) const { return (int)cnt[u.x0 * 64] - u.x1 * 256; }
};
struct SchedDown {
    static constexpr int K = 1024, LDA = 1024, LDB = 512, KSPLIT = 4, ESZ = 1, SCALE_A = SC_E8(F8_SH_A), SCALE_B = SC_E8(F8_SH_W); static constexpr bool GATHER = false;
    const unsigned char* ACT; const unsigned char* Wd; const LAS int* tst; int G, c;
    __device__ __forceinline__ bool next(int i, pg::Unit& u) const { const int TT = __builtin_amdgcn_readfirstlane(tst[NCLS]); const long L = (long)i * G + c; if (L >= (long)TT * 4) return false;
        pg::order_unit((int)L, TT, 4, u.pm, u.pn); cls_of_tile(tst, u.pm, u.x0, u.x1); return true; }
    __device__ __forceinline__ const char* a_base(const pg::Unit& u) const { return (const char*)ACT + (size_t)u.pm * 256 * LDA; }
    __device__ __forceinline__ const char* b_base(const pg::Unit& u, int part) const { int elo, ehi; cls_experts(u.x0, elo, ehi); const int e = part ? ehi : elo;
        return (const char*)Wd + ((size_t)e * 1024 + (size_t)u.pn * 256) * LDB - (part ? (size_t)KSPLIT * 128 : 0); }
    __device__ __forceinline__ const unsigned* idx_src(const pg::Unit&) const { return nullptr; }
    __device__ __forceinline__ int valid_rows(const pg::Unit&) const { return 256; }
};

#define OPAQUE(x) asm volatile("" : "+v"(x))
#define ROWSTEP(m) ((m) == 3 ? 80 : 16)
struct EpiProj {
    bf16_t* O; const float* tab;
    __device__ __forceinline__ void operator()(const f32x4 (&acc)[2][2][4][2], const pg::Unit& u, int wr, int wc, int fr, int fq) const {
        const bool latent = u.pm < ML / 256;
        char* base = (char*)(O + (size_t)u.pm * 256 * INC + u.pn * 256);
        unsigned off = (unsigned)((wr * 64 + fr) * INC + wc * 32 + 8 * fq) * 2u; OPAQUE(off);
        int t = ((u.pm * 256) & (SEQ - 1)) + wr * 64 + fr; OPAQUE(t);
        const bool second = (fq >> 1) != 0;
#pragma unroll
        for (int ai = 0; ai < 2; ++ai)
#pragma unroll
            for (int m = 0; m < 4; ++m) { char* rowp = base + off;
                const int pos = (wc & 1) ? (t & 63) : (t >> 6);
#pragma unroll
                for (int bj = 0; bj < 2; ++bj) { f32x4 v0 = acc[ai][bj][m][0], v1 = acc[ai][bj][m][1];
                    const bool rope = latent && (u.pn == 5 || u.pn == 6 || (u.pn == 7 && bj == 0));
                    if (rope) { const float* tp = tab + pos * 16 + 8 * (fq & 1);
                        const f32x4 cs0 = *(const f32x4*)tp, cs1 = *(const f32x4*)(tp + 4), sn0 = *(const f32x4*)(tp + 2048), sn1 = *(const f32x4*)(tp + 2052);
                        f32x4 p0, p1;
#pragma unroll
                        for (int i = 0; i < 4; ++i) { p0[i] = __shfl_xor(v0[i], 32); p1[i] = __shfl_xor(v1[i], 32); }
                        if (second) { v0 = v0 * cs0 + p0 * sn0; v1 = v1 * cs1 + p1 * sn1; } else { v0 = v0 * cs0 - p0 * sn0; v1 = v1 * cs1 - p1 * sn1; } }
                    u32x4 w; w.x = cvt_pk_bf16(v0[0], v0[1]); w.y = cvt_pk_bf16(v0[2], v0[3]); w.z = cvt_pk_bf16(v1[0], v1[1]); w.w = cvt_pk_bf16(v1[2], v1[3]);
                    *(u32x4*)(rowp + bj * 256) = w; }
                off += (unsigned)(ROWSTEP(m) * INC * 2); t += ROWSTEP(m); OPAQUE(off); OPAQUE(t); }
    }
};
struct EpiPlain {
    bf16_t* O; int ldo;
    __device__ __forceinline__ void operator()(const f32x4 (&acc)[2][2][4][2], const pg::Unit& u, int wr, int wc, int fr, int fq) const {
        char* base = (char*)(O + (size_t)u.pm * 256 * ldo + u.pn * 256);
        unsigned off = (unsigned)((wr * 64 + fr) * ldo + wc * 32 + 8 * fq) * 2u; OPAQUE(off);
#pragma unroll
        for (int ai = 0; ai < 2; ++ai)
#pragma unroll
            for (int m = 0; m < 4; ++m) {
#pragma unroll
                for (int bj = 0; bj < 2; ++bj) { const f32x4 v0 = acc[ai][bj][m][0], v1 = acc[ai][bj][m][1];
                    u32x4 w; w.x = cvt_pk_bf16(v0[0], v0[1]); w.y = cvt_pk_bf16(v0[2], v0[3]); w.z = cvt_pk_bf16(v1[0], v1[1]); w.w = cvt_pk_bf16(v1[2], v1[3]);
                    *(u32x4*)(base + off + bj * 256) = w; }
                off += (unsigned)(ROWSTEP(m) * ldo * 2); OPAQUE(off); }
    }
};
struct EpiGU {
    unsigned char* ACT; const ClsRec* list; const unsigned* cnt;
    __device__ __forceinline__ void operator()(const f32x4 (&acc)[2][2][4][2], const pg::Unit& u, int wr, int wc, int fr, int fq) const {
        const int vr = (int)cnt[u.x0 * 64] - u.x1 * 256; const char* rec = (const char*)(list + (size_t)u.x0 * MT + (size_t)u.x1 * 256) + (u.pn >= 4 ? 8 : 4);
        unsigned char* base = ACT + (size_t)u.pm * 256 * 1024 + (u.pn >> 2) * 512 + (u.pn & 3) * 128;
        int r = wr * 64 + fr; OPAQUE(r); unsigned off = (unsigned)(r * 1024 + wc * 32 + 8 * fq); OPAQUE(off);
#pragma unroll
        for (int ai = 0; ai < 2; ++ai)
#pragma unroll
            for (int m = 0; m < 4; ++m) { float w = 0.f;
                if (r < vr) w = *(const float*)(rec + (size_t)r * 16);
                w *= (float)(1 << F8_SH_A);
                u32x2 pk;
#pragma unroll
                for (int bj = 0; bj < 2; ++bj) { const f32x4 g = acc[ai][bj][m][0], up = acc[ai][bj][m][1]; float o[4];
#pragma unroll
                    for (int i = 0; i < 4; ++i) o[i] = g[i] * __builtin_amdgcn_rcpf(1.0f + __builtin_amdgcn_exp2f(-LOG2E * g[i])) * up[i];
                    const unsigned v = pk4_fp8(o[0], o[1], o[2], o[3], w); if (bj == 0) pk.x = v; else pk.y = v; }
                *(u32x2*)(base + off) = pk;
                off += (unsigned)(ROWSTEP(m) * 1024); r += ROWSTEP(m); OPAQUE(off); OPAQUE(r); }
    }
};

template <bool F8 = false> __device__ __forceinline__ void p0_transpose_item(const float* W, int Kd, int N, void* WTv, LAS float* scr, int item, int lane, int mode, int sc_lo, int sc_hi, float scale) {
    bf16_t* WT = (bf16_t*)WTv;
    const int nblk = N / 32, kb = item / nblk, nb = item % nblk, k0 = 64 * kb, n0 = 32 * nb;
    f32x4 rv[8];
#pragma unroll
    for (int i = 0; i < 8; ++i) rv[i] = *(const f32x4*)(W + (size_t)(k0 + 8 * i + (lane >> 3)) * N + n0 + 4 * (lane & 7));
#pragma unroll
    for (int i = 0; i < 8; ++i) { LAS float* d = scr + (8 * i + (lane >> 3)) * 33 + 4 * (lane & 7); d[0] = rv[i].x; d[1] = rv[i].y; d[2] = rv[i].z; d[3] = rv[i].w; }
    asm volatile("s_waitcnt lgkmcnt(0)" ::: "memory");
    const int c = lane & 7;
#pragma unroll
    for (int j = 0; j < 4; ++j) { const int n = (lane >> 3) + 8 * j, ng = n0 + n; const LAS float* s = scr + (8 * c) * 33 + n;
        const float f = (ng >= sc_lo && ng < sc_hi) ? scale : 1.0f;
        const int row = mode == 0 ? ng : mode == 3 ? ((ng & ~31) + 16 * ((ng >> 2) & 1) + 4 * ((ng >> 3) & 3) + (ng & 3))
                      : (256 * (ng >> 7) + 128 * ((ng >> 2) & 1) + 32 * ((ng >> 5) & 3) + 16 * (mode == 2 ? 1 : 0) + 4 * ((ng >> 3) & 3) + (ng & 3));
        if constexpr (F8) { u32x2 o; o.x = pk4_fp8(s[0 * 33], s[1 * 33], s[2 * 33], s[3 * 33], f * (float)(1 << F8_SH_W)); o.y = pk4_fp8(s[4 * 33], s[5 * 33], s[6 * 33], s[7 * 33], f * (float)(1 << F8_SH_W));
            *(u32x2*)((unsigned char*)WTv + (size_t)row * Kd + k0 + 8 * c) = o; }
        else { u32x4 o; o.x = pk2(s[0 * 33] * f, s[1 * 33] * f); o.y = pk2(s[2 * 33] * f, s[3 * 33] * f); o.z = pk2(s[4 * 33] * f, s[5 * 33] * f); o.w = pk2(s[6 * 33] * f, s[7 * 33] * f);
            *(u32x4*)(WT + (size_t)row * Kd + k0 + 8 * c) = o; } }
    asm volatile("s_waitcnt lgkmcnt(0)" ::: "memory");
}
__device__ __forceinline__ void phase_p0a(const Ptrs& P, LAS unsigned char* lds) {
    int tid = threadIdx.x; asm volatile("" : "+v"(tid)); const int lane = tid & 63, wave = __builtin_amdgcn_readfirstlane(tid >> 6);
    const int gw = blockIdx.x * NWAVES + wave, NGW = gridDim.x * NWAVES;
    LAS float* sil = (LAS float*)(lds + 73728);
    for (int i = tid; i < 9 * D; i += NTHR) { const int j = i >> 10, k = i & (D - 1); sil[i] = silu_f(j < 8 ? P.c[j * D + k] : P.c_ctx[k]); }
    __syncthreads();
    float* modp = (float*)(P.ws + WS_MODP);
    for (int u = gw; u < DEPTH * 24 * 16; u += NGW) { const int l = u / 384, r = u % 384, nc = r / 16, ks = r % 16;
        const float* w = P.w_mod + ((size_t)l * D + ks * 64) * 6144 + nc * 256 + 4 * lane;
        f32x4 a[9];
#pragma unroll
        for (int j = 0; j < 9; ++j) a[j] = (f32x4){0.f, 0.f, 0.f, 0.f};
#pragma unroll 4
        for (int k = 0; k < 64; ++k) { const f32x4 wv = *(const f32x4*)(w + (size_t)k * 6144);
#pragma unroll
            for (int j = 0; j < 9; ++j) a[j] += wv * sil[j * D + ks * 64 + k]; }
#pragma unroll
        for (int j = 0; j < 9; ++j) *(f32x4*)(modp + (((size_t)l * 16 + ks) * 9 + j) * 6144 + nc * 256 + 4 * lane) = a[j]; }
    { const int gt = blockIdx.x * NTHR + tid, NGT = gridDim.x * NTHR; float* tab = (float*)(P.ws + WS_ROPE);
      if (gt < 2048) { const int i = gt & 15, pos = gt >> 4; const float inv = powf(10000.0f, -(float)i / 16.0f), ang = (float)pos * inv; tab[gt] = cosf(ang); tab[2048 + gt] = sinf(ang); }
      bf16_t* wsb = (bf16_t*)(P.ws + WS_WSB);
      for (int i = gt; i < DEPTH * 4 * 128 * 128; i += NGT) wsb[i] = f2bf(P.w_s[i]); }
    LAS float* scr = (LAS float*)(lds + wave * 8448);
    constexpr int PER_L = 1024 + 512 + NE * 768;
    for (int it = gw; it < DEPTH * PER_L; it += NGW) { const int l = it / PER_L; int r = it % PER_L;
        if (r < 1024) { p0_transpose_item(P.w_in + (size_t)l * D * INC, D, INC, (bf16_t*)(P.ws + WS_WIN) + (size_t)l * INC * D, scr, r, lane, 3, C_Q, C_K, QSCALE); continue; } r -= 1024;
        if (r < 512) { p0_transpose_item(P.w_out + (size_t)l * D * D, D, D, (bf16_t*)(P.ws + WS_WOUT) + (size_t)l * D * D, scr, r, lane, 3, 0, 0, 1.f); continue; } r -= 512;
        const int e = r / 768, q = r % 768, which = q >> 8, idx = q & 255; const size_t le = (size_t)l * NE + e;
        if (which == 0) p0_transpose_item<true>(P.w_gate + le * D * DE, D, DE, P.ws + WS_WGU + le * 1024 * 1024, scr, idx, lane, 1, 0, 0, 1.f);
        else if (which == 1) p0_transpose_item<true>(P.w_up + le * D * DE, D, DE, P.ws + WS_WGU + le * 1024 * 1024, scr, idx, lane, 2, 0, 0, 1.f);
        else p0_transpose_item<true>(P.w_down + le * DE * D, DE, D, P.ws + WS_WD + le * 1024 * 512, scr, idx, lane, 3, 0, 0, 1.f); }
}
__device__ __forceinline__ void phase_p0b(const Ptrs& P) {
    const int gt = blockIdx.x * NTHR + threadIdx.x, NGT = gridDim.x * NTHR;
    const float* modp = (const float*)(P.ws + WS_MODP); float* mod = (float*)(P.ws + WS_MOD);
    for (int i = gt; i < DEPTH * 9 * 6144; i += NGT) { const int l = i / (9 * 6144), r = i % (9 * 6144), j = r / 6144, n = r % 6144;
        float s = P.b_mod[l * 6144 + n];
#pragma unroll
        for (int ks = 0; ks < 16; ++ks) s += modp[(((size_t)l * 16 + ks) * 9 + j) * 6144 + n];
        mod[i] = s; }
}

__device__ __forceinline__ void bf8_to_f32(const u32x4 v, float (&o)[8]) {
#pragma unroll
    for (int i = 0; i < 4; ++i) { o[2 * i] = __uint_as_float(v[i] << 16); o[2 * i + 1] = __uint_as_float(v[i] & 0xffff0000u); }
}
template <int R> struct NormRaw { u32x4 a[R][2], b[R][2]; int m0, nv; };
template <int MODE, bool FIRST, bool DRY = false> __device__ __forceinline__ void phase_norm(const Ptrs& P, LAS unsigned char* lds, int l, int Mrows, const bf16_t* Y, const LAS int* tst) {
    constexpr int R = MODE == 2 ? 2 : 4;
    int tid = threadIdx.x; asm volatile("" : "+v"(tid)); const int lane = tid & 63, wave = __builtin_amdgcn_readfirstlane(tid >> 6);
    const int gw = blockIdx.x * NWAVES + wave, NGW = gridDim.x * NWAVES;
    const int rpw = (Mrows + NGW - 1) / NGW;
    const int mBeg = gw * rpw, mEnd = (mBeg + rpw) < Mrows ? (mBeg + rpw) : Mrows;
    LAS float* rwT = (LAS float*)lds;
    constexpr int RPW = 72;
    LAS unsigned* recL = (LAS unsigned*)(lds + 65536);
    LAS unsigned* cntL = (LAS unsigned*)(lds + 65536 + NWAVES * RPW * 16);
    LAS unsigned* baseL = cntL + 32;
    LAS float* logL = (LAS float*)(lds + 65536 + 12288);
    if (MODE == 2) { if (tid < 64) cntL[tid] = 0u; for (int i = tid; i < D * NE; i += NTHR) rwT[(i & 15) * D + (i >> 4)] = P.router_w[i]; __syncthreads(); }
    const float* g = (MODE == 1 ? P.norm1_g + l * D : MODE == 2 ? P.norm2_g + l * D : P.final_g);
    f32x4 gg[2][2];
#pragma unroll
    for (int j = 0; j < 2; ++j) { gg[j][0] = (f32x4){0.f, 0.f, 0.f, 0.f}; gg[j][1] = gg[j][0]; if (MODE == 3) { gg[j][0] = *(const f32x4*)(g + 8 * lane + 512 * j); gg[j][1] = *(const f32x4*)(g + 8 * lane + 512 * j + 4); } }
    bf16_t* XB = (bf16_t*)(P.ws + WS_XB);
    unsigned posreg = 0u;
    if (MODE != 2 && !FIRST) { if (mBeg + lane < mEnd) posreg = ((const unsigned*)(P.ws + WS_POS))[mBeg + lane]; }
    f32x4 gt[2][2], scv[2][2], shv[2][2];
#pragma unroll
    for (int j = 0; j < 2; ++j)
#pragma unroll
        for (int q = 0; q < 2; ++q) { gt[j][q] = (f32x4){0.f, 0.f, 0.f, 0.f}; scv[j][q] = gt[j][q]; shv[j][q] = gt[j][q]; }
#define NR_LOAD(G, mstart) do { (G).m0 = (mstart); { const int bnd_ = (((mstart) >> 13) + 1) << 13; const int ge_ = bnd_ < mEnd ? bnd_ : mEnd; (G).nv = (ge_ - (mstart)) < R ? (ge_ - (mstart)) : R; } \
        _Pragma("unroll") for (int r = 0; r < R; ++r) { const int m = (G).m0 + (r < (G).nv ? r : (G).nv - 1); \
            if (FIRST) { const float* xr = m < ML ? P.x + (size_t)m * D : P.ctx + (size_t)(m - ML) * D; \
                _Pragma("unroll") for (int j = 0; j < 2; ++j) { (G).a[r][j] = *(const u32x4*)(xr + 8 * lane + 512 * j); (G).b[r][j] = *(const u32x4*)(xr + 8 * lane + 512 * j + 4); } \
            } else { size_t yrow = (size_t)m; \
                if (MODE != 2) { const unsigned ps = (unsigned)__builtin_amdgcn_readlane((int)posreg, m - mBeg); yrow = (size_t)tst[ps & 255u] * 256 + (ps >> 8); } \
                const bf16_t* yr = Y + yrow * D; \
                _Pragma("unroll") for (int j = 0; j < 2; ++j) { (G).a[r][j] = *(const u32x4*)(XB + (size_t)m * D + 8 * lane + 512 * j); (G).b[r][j] = *(const u32x4*)(yr + 8 * lane + 512 * j); } } } } while (0)
    NormRaw<R> G; G.m0 = mBeg; G.nv = 0;
    if (mBeg < mEnd) NR_LOAD(G, mBeg);
    bool more = mBeg < mEnd;
    while (more) {
        const int m0 = G.m0, nv = G.nv;
        float xv[R][2][8]; float ss[R];
        { const int mb = modrow(m0);
            {
                const float* modl = (const float*)(P.ws + WS_MOD) + ((size_t)l * 9 + mb) * 6144;
                const float* gate = MODE == 2 ? modl + 2048 : (const float*)(P.ws + WS_MOD) + ((size_t)(MODE == 3 ? 3 : (l > 0 ? l - 1 : 0)) * 9 + mb) * 6144 + 5120;
                const float* sh = modl + (MODE == 1 ? 0 : 3072); const float* sc = modl + (MODE == 1 ? 1024 : 4096);
#pragma unroll
                for (int j = 0; j < 2; ++j)
#pragma unroll
                    for (int q = 0; q < 2; ++q) { const int c = 8 * lane + 512 * j + 4 * q; gt[j][q] = *(const f32x4*)(gate + c); scv[j][q] = (*(const f32x4*)(sc + c) + 1.0f) * *(const f32x4*)(g + c); shv[j][q] = *(const f32x4*)(sh + c); } } }
#pragma unroll
        for (int r = 0; r < R; ++r) { const int m = m0 + (r < nv ? r : nv - 1);
#pragma unroll
            for (int j = 0; j < 2; ++j) {
                if (FIRST) { const f32x4 a = __builtin_bit_cast(f32x4, G.a[r][j]), b = __builtin_bit_cast(f32x4, G.b[r][j]);
                    xv[r][j][0] = a.x; xv[r][j][1] = a.y; xv[r][j][2] = a.z; xv[r][j][3] = a.w; xv[r][j][4] = b.x; xv[r][j][5] = b.y; xv[r][j][6] = b.z; xv[r][j][7] = b.w;
                } else { float xf[8], yf[8]; bf8_to_f32(G.a[r][j], xf); bf8_to_f32(G.b[r][j], yf);
#pragma unroll
                    for (int i = 0; i < 8; ++i) xv[r][j][i] = xf[i] + gt[j][i >> 2][i & 3] * yf[i]; } }
            if (MODE != 3 && r < nv) {
#pragma unroll
                for (int j = 0; j < 2; ++j) { u32x4 w; w.x = cvt_pk_bf16(xv[r][j][0], xv[r][j][1]); w.y = cvt_pk_bf16(xv[r][j][2], xv[r][j][3]); w.z = cvt_pk_bf16(xv[r][j][4], xv[r][j][5]); w.w = cvt_pk_bf16(xv[r][j][6], xv[r][j][7]);
                    *(u32x4*)(XB + (size_t)m * D + 8 * lane + 512 * j) = w; } }
            float s = 0.f;
#pragma unroll
            for (int j = 0; j < 2; ++j)
#pragma unroll
                for (int i = 0; i < 8; ++i) s += xv[r][j][i] * xv[r][j][i];
            ss[r] = s;
            if (MODE != 3) {
#pragma unroll
                for (int j = 0; j < 2; ++j)
#pragma unroll
                    for (int i = 0; i < 8; ++i) xv[r][j][i] = xv[r][j][i] * scv[j][i >> 2][i & 3];
            } }
        { const int nm0 = m0 + nv; more = nm0 < mEnd; if (more) NR_LOAD(G, nm0); }
#pragma unroll
        for (int o = 1; o < 64; o <<= 1) {
#pragma unroll
            for (int r = 0; r < R; ++r) ss[r] += __shfl_xor(ss[r], o); }
#pragma unroll
        for (int r = 0; r < R; ++r) { const int m = m0 + r; const float rinv = rsqrtf(ss[r] * (1.0f / D) + EPS);
            if (MODE == 3) { if (r < nv) { float* orow = P.out + (size_t)m * D;
#pragma unroll
                for (int j = 0; j < 2; ++j) { f32x4 a, b; a.x = xv[r][j][0]; a.y = xv[r][j][1]; a.z = xv[r][j][2]; a.w = xv[r][j][3]; b.x = xv[r][j][4]; b.y = xv[r][j][5]; b.z = xv[r][j][6]; b.w = xv[r][j][7];
                    *(f32x4*)(orow + 8 * lane + 512 * j) = a * rinv * gg[j][0]; *(f32x4*)(orow + 8 * lane + 512 * j + 4) = b * rinv * gg[j][1]; } }
            } else {
#pragma unroll
                for (int j = 0; j < 2; ++j)
#pragma unroll
                    for (int i = 0; i < 8; ++i) xv[r][j][i] = xv[r][j][i] * rinv + shv[j][i >> 2][i & 3];
                if (r < nv) {
                    if (MODE == 2) { unsigned char* H8 = (unsigned char*)(P.ws + WS_H) + (size_t)m * D;
#pragma unroll
                        for (int j = 0; j < 2; ++j) { u32x2 o; o.x = pk4_fp8(xv[r][j][0], xv[r][j][1], xv[r][j][2], xv[r][j][3], (float)(1 << F8_SH_H)); o.y = pk4_fp8(xv[r][j][4], xv[r][j][5], xv[r][j][6], xv[r][j][7], (float)(1 << F8_SH_H)); *(u32x2*)(H8 + 8 * lane + 512 * j) = o; }
                    } else { bf16_t* H = (bf16_t*)(P.ws + WS_H) + (size_t)m * D;
#pragma unroll
                        for (int j = 0; j < 2; ++j) { u32x4 o; o.x = cvt_pk_bf16(xv[r][j][0], xv[r][j][1]); o.y = cvt_pk_bf16(xv[r][j][2], xv[r][j][3]); o.z = cvt_pk_bf16(xv[r][j][4], xv[r][j][5]); o.w = cvt_pk_bf16(xv[r][j][6], xv[r][j][7]); *(u32x4*)(H + 8 * lane + 512 * j) = o; } } }
            } }
        if (MODE == 2) {
#pragma unroll
            for (int r = 0; r < R; ++r) {
                float lg[16];
#pragma unroll
                for (int e = 0; e < 16; ++e) lg[e] = 0.f;
#pragma unroll
                for (int j = 0; j < 2; ++j) { const int c = 8 * lane + 512 * j;
#pragma unroll
                    for (int e4 = 0; e4 < 4; ++e4) {
#pragma unroll
                        for (int e = 4 * e4; e < 4 * e4 + 4; ++e) { const f32x4 r0 = *(const LAS f32x4*)(rwT + e * D + c), r1 = *(const LAS f32x4*)(rwT + e * D + c + 4);
                            lg[e] += xv[r][j][0] * r0.x + xv[r][j][1] * r0.y + xv[r][j][2] * r0.z + xv[r][j][3] * r0.w + xv[r][j][4] * r1.x + xv[r][j][5] * r1.y + xv[r][j][6] * r1.z + xv[r][j][7] * r1.w; }
                        __builtin_amdgcn_sched_barrier(0); } }
                float v8[8], v4[4], v2[2], v1;
                { const bool up = (lane & 32) != 0;
#pragma unroll
                  for (int i = 0; i < 8; ++i) { const float send = up ? lg[i] : lg[i + 8]; const float keep = up ? lg[i + 8] : lg[i]; v8[i] = keep + __shfl_xor(send, 32); } }
                { const bool up = (lane & 16) != 0;
#pragma unroll
                  for (int i = 0; i < 4; ++i) { const float send = up ? v8[i] : v8[i + 4]; const float keep = up ? v8[i + 4] : v8[i]; v4[i] = keep + __shfl_xor(send, 16); } }
                { const bool up = (lane & 8) != 0;
#pragma unroll
                  for (int i = 0; i < 2; ++i) { const float send = up ? v4[i] : v4[i + 2]; const float keep = up ? v4[i + 2] : v4[i]; v2[i] = keep + __shfl_xor(send, 8); } }
                { const bool up = (lane & 4) != 0; const float send = up ? v2[0] : v2[1]; const float keep = up ? v2[1] : v2[0]; v1 = keep + __shfl_xor(send, 4); }
                v1 += __shfl_xor(v1, 2); v1 += __shfl_xor(v1, 1);
                if ((lane & 3) == 0 && r < nv) logL[(wave * RPW + (m0 - mBeg) + r) * 16 + (lane >> 2)] = v1;
            }
        }
    }
#undef NR_LOAD
    if (MODE == 2 && !DRY) {
        asm volatile("s_waitcnt lgkmcnt(0)" ::: "memory");
        if (lane < mEnd - mBeg) {
            float sco[16], sel[16];
#pragma unroll
            for (int e4 = 0; e4 < 4; ++e4) { const f32x4 v = *(const LAS f32x4*)(logL + (wave * RPW + lane) * 16 + 4 * e4);
#pragma unroll
                for (int i = 0; i < 4; ++i) { const int e = 4 * e4 + i; sco[e] = 1.0f / (1.0f + __expf(-v[i])); sel[e] = sco[e] + P.router_b[e]; } }
            int bg = 0; float bgs = -1e30f; int ba = 0, bb = 1; float sa = 0.f, sb = 0.f;
#pragma unroll
            for (int gI = 0; gI < 4; ++gI) {
                int i1 = 0; float v1 = sel[gI * 4], c1 = sco[gI * 4];
#pragma unroll
                for (int i = 1; i < 4; ++i) if (sel[gI * 4 + i] > v1) { v1 = sel[gI * 4 + i]; c1 = sco[gI * 4 + i]; i1 = i; }
                int i2 = -1; float v2 = -1e30f, c2 = 0.f;
#pragma unroll
                for (int i = 0; i < 4; ++i) if (i != i1 && sel[gI * 4 + i] > v2) { v2 = sel[gI * 4 + i]; c2 = sco[gI * 4 + i]; i2 = i; }
                const float gs = v1 + v2;
                if (gs > bgs) { bgs = gs; bg = gI; ba = i1; bb = i2; sa = c1; sb = c2; }
            }
            const int a = ba < bb ? ba : bb, b = ba < bb ? bb : ba;
            const float wl = ba < bb ? sa : sb, wh = ba < bb ? sb : sa, inv = 1.0f / (wl + wh);
            const int pairidx = (a == 0) ? (b - 1) : (a == 1 ? (b + 1) : 5);
            const int cls = bg * 6 + pairidx;
            const unsigned pl = __hip_atomic_fetch_add(cntL + cls, 1u, __ATOMIC_RELAXED, __HIP_MEMORY_SCOPE_WORKGROUP);
            LAS unsigned* rb = recL + (wave * RPW + lane) * 4; rb[0] = (unsigned)(mBeg + lane); rb[1] = __float_as_uint(wl * inv); rb[2] = __float_as_uint(wh * inv); rb[3] = (unsigned)cls | (pl << 8);
        }
        asm volatile("s_waitcnt lgkmcnt(0)" ::: "memory"); __syncthreads();
        unsigned* ctl = (unsigned*)(P.ws + WS_CTL);
        if (tid < NCLS) { const unsigned n = cntL[tid]; baseL[tid] = n ? atomicAdd(ctl + CW_CNTF + (l * 32 + tid) * 64, n) : 0u; }
        __syncthreads();
        ClsRec* listr = (ClsRec*)(P.ws + WS_LISTR); unsigned* posw = (unsigned*)(P.ws + WS_POS);
        for (int i = tid; i < NWAVES * RPW; i += NTHR) { const int w = i / RPW, r = i % RPW; const int wb = (blockIdx.x * NWAVES + w) * rpw; const int nw = (wb + rpw < Mrows ? wb + rpw : Mrows) - wb;
            if (r < nw) { const LAS unsigned* rb = recL + i * 4; const unsigned cls = rb[3] & 255u, pl = rb[3] >> 8, gp = baseL[cls] + pl;
                ClsRec rc; rc.m = (int)rb[0]; rc.wlo = __uint_as_float(rb[1]); rc.whi = __uint_as_float(rb[2]); rc.pad = 0;
                listr[(size_t)cls * MT + gp] = rc; posw[rb[0]] = cls | (gp << 8); } }
    }
}
__device__ __forceinline__ void build_tile_table(const Ptrs& P, LAS int* tst, int l) {
    if (threadIdx.x < 64) {
        int lane = threadIdx.x; asm volatile("" : "+v"(lane));
        const unsigned* cnt = (const unsigned*)(P.ws + WS_CTL) + CW_CNTF + l * 32 * 64;
        const int tiles = lane < NCLS ? (int)((__hip_atomic_load(cnt + lane * 64, __ATOMIC_RELAXED, __HIP_MEMORY_SCOPE_AGENT) + 255u) >> 8) : 0;
        int incl = tiles;
#pragma unroll
        for (int o = 1; o < 32; o <<= 1) { const int t = __shfl_up(incl, o); if (lane >= o) incl += t; }
        if (lane <= NCLS) tst[lane] = incl - tiles;
    }
    __syncthreads();
}
namespace mx {
typedef float f32x16 __attribute__((ext_vector_type(16)));
typedef short s16x4 __attribute__((ext_vector_type(4)));
constexpr int SLOTB = 8192;
constexpr int L_K = 0, L_V = 2 * SLOTB, L_WS = 4 * SLOTB, L_OST = L_WS + NWAVES * 256, L_END = L_OST + NWAVES * 4096;
constexpr int VT_PITCH = 136;
__device__ __forceinline__ int crow(int r, int hi) { return (r & 3) + 8 * (r >> 2) + 4 * hi; }
__device__ __forceinline__ unsigned cvtpk(float lo, float hi) { unsigned r; asm volatile("v_cvt_pk_bf16_f32 %0, %1, %2" : "=v"(r) : "v"(lo), "v"(hi)); return r; }
__device__ __forceinline__ float gelu_fast(float x) { const float y = x + 0.044715f * x * x * x; return x * __builtin_amdgcn_rcpf(1.0f + __builtin_amdgcn_exp2f(-2.302208198f * y)); }

__device__ __forceinline__ void qkt(f32x16& p0, f32x16& p1, const LAS unsigned char* Kslot, const bf16x8* qr, const f32x16& negm, int r32, int hi) {
    const LAS unsigned char* kb = Kslot + hi * 1024 + r32 * 16;
#pragma unroll
    for (int d0 = 0; d0 < 4; ++d0) {
        const bf16x8 b0 = *(const LAS bf16x8*)(kb + d0 * 2048), b1 = *(const LAS bf16x8*)(kb + d0 * 2048 + 512);
        if (d0 == 0) { p0 = __builtin_amdgcn_mfma_f32_32x32x16_bf16(b0, qr[0], negm, 0, 0, 0); p1 = __builtin_amdgcn_mfma_f32_32x32x16_bf16(b1, qr[0], negm, 0, 0, 0); }
        else { p0 = __builtin_amdgcn_mfma_f32_32x32x16_bf16(b0, qr[d0], p0, 0, 0, 0); p1 = __builtin_amdgcn_mfma_f32_32x32x16_bf16(b1, qr[d0], p1, 0, 0, 0); } }
}
__device__ __forceinline__ void pv(f32x16* o, unsigned vb, bf16x8 pa0, bf16x8 pa1, bf16x8 pa2, bf16x8 pa3) {
#pragma unroll
    for (int d0 = 0; d0 < 2; ++d0) { s16x4 lo[4], hi[4];
#pragma unroll
        for (int ks = 0; ks < 4; ++ks) {
            asm volatile("ds_read_b64_tr_b16 %0, %1 offset:%c2" : "=&v"(lo[ks]) : "v"(vb), "i"(d0 * 4096 + ks * 1024) : "memory");
            asm volatile("ds_read_b64_tr_b16 %0, %1 offset:%c2" : "=&v"(hi[ks]) : "v"(vb), "i"(d0 * 4096 + ks * 1024 + 512) : "memory"); }
        asm volatile("s_waitcnt lgkmcnt(0)" ::: "memory"); __builtin_amdgcn_sched_barrier(0);
#define MX_PK(k) (bf16x8){lo[k][0], lo[k][1], lo[k][2], lo[k][3], hi[k][0], hi[k][1], hi[k][2], hi[k][3]}
        o[d0] = __builtin_amdgcn_mfma_f32_32x32x16_bf16(pa0, MX_PK(0), o[d0], 0, 0, 0);
        o[d0] = __builtin_amdgcn_mfma_f32_32x32x16_bf16(pa1, MX_PK(1), o[d0], 0, 0, 0);
        o[d0] = __builtin_amdgcn_mfma_f32_32x32x16_bf16(pa2, MX_PK(2), o[d0], 0, 0, 0);
        o[d0] = __builtin_amdgcn_mfma_f32_32x32x16_bf16(pa3, MX_PK(3), o[d0], 0, 0, 0);
#undef MX_PK
    }
}
struct ConvRaw { u32x4 bg, c0, c1, c2, z0, z1, z2; };
__device__ __forceinline__ void conv_load(ConvRaw& R, const bf16_t* PROJ, int m0, int tid, int q) {
    const int seqmask = m0 < ML ? SEQ - 1 : CTXL - 1; const int mrel = m0 < ML ? m0 : m0 - ML;
    const int idx = q * NTHR + tid, row = idx >> 5, c = (idx & 31) * 8;
    const int t = (mrel + row) & seqmask; const bf16_t* pr = PROJ + (size_t)(m0 + row) * INC;
    R.bg = *(const u32x4*)(pr + C_BG + c); R.c1 = *(const u32x4*)(pr + C_CG + c); R.z1 = *(const u32x4*)(pr + C_Z + c);
    R.c0 = (u32x4){0u, 0u, 0u, 0u}; R.z0 = R.c0; R.c2 = R.c0; R.z2 = R.c0;
    if (t > 0) { R.c0 = *(const u32x4*)(pr - INC + C_CG + c); R.z0 = *(const u32x4*)(pr - INC + C_Z + c); }
    if (t < seqmask) { R.c2 = *(const u32x4*)(pr + INC + C_CG + c); R.z2 = *(const u32x4*)(pr + INC + C_Z + c); }
}
__device__ __forceinline__ void conv_finish(const ConvRaw& R, const float* cwl, bf16_t* MIXo, int m0, int tid, int q) {
    const int idx = q * NTHR + tid, row = idx >> 5, c = (idx & 31) * 8;
    const float* cw = cwl + c;
    float o[8];
#pragma unroll
    for (int i = 0; i < 8; ++i) { const int wI = i >> 1; const bool up = i & 1;
#define MX_BF(v) (up ? __uint_as_float((v)[wI] & 0xffff0000u) : __uint_as_float((v)[wI] << 16))
        const float y = MX_BF(R.c0) * MX_BF(R.z0) * cw[i] + MX_BF(R.c1) * MX_BF(R.z1) * cw[256 + i] + MX_BF(R.c2) * MX_BF(R.z2) * cw[512 + i];
        o[i] = MX_BF(R.bg) * y;
#undef MX_BF
    }
    u32x4 w; w.x = cvtpk(o[0], o[1]); w.y = cvtpk(o[2], o[3]); w.z = cvtpk(o[4], o[5]); w.w = cvtpk(o[6], o[7]);
    *(u32x4*)(MIXo + (size_t)(m0 + row) * D + 256 + c) = w;
}
constexpr int NSLOT = 4;
constexpr int ATT_THR = 8;
typedef float f32x2 __attribute__((ext_vector_type(2)));
#define MX3(a, b, c) __builtin_fmaxf(__builtin_fmaxf((a), (b)), (c))
constexpr int A_K = 0, A_V = NSLOT * SLOTB, A_WS = 2 * NSLOT * SLOTB, A_OST = A_WS + NWAVES * 512, A_END = A_OST + NWAVES * 4096;
template <int NH> __device__ __forceinline__ void attn_unit(const bf16_t* PROJ, bf16_t* MIXo, const float* sink, const float* cwl, LAS unsigned char* shm, int latent, int b, int blk, int kvh, int hp, int tid) {
    const int lane = tid & 63, r32 = lane & 31, hi = lane >> 5; const int wid = __builtin_amdgcn_readfirstlane(tid >> 6);
    const int head0 = NH == 2 ? kvh * 4 + (wid >> 2) * 2 : kvh * 4 + hp * 2 + (wid >> 2), qw = (wid & 3) * 32;
    const int qrow0 = latent ? b * SEQ + blk * 128 : ML + b * CTXL + blk * 128;
    const int ctx0 = ML + b * CTXL;
    const int lt_lo = latent ? (blk > 0 ? 0 : 2) : 0, lt_hi = latent ? (blk < SEQ / 128 - 1 ? 6 : 4) : 0;
    const int NT = 4 + (lt_hi - lt_lo);
    LAS float* wsf = (LAS float*)(shm + A_WS) + wid * 128;
    const bf16_t* kcol = PROJ + C_K + kvh * 64 + wid * 8;
    const bf16_t* vcol = PROJ + C_VV + kvh * 64 + (wid >> 2) * 32 + (lane & 3) * 8;
#define MX_TROW(t) ((t) < 4 ? ctx0 + 64 * (t) : b * SEQ + blk * 128 - 128 + 64 * ((t) - 4 + lt_lo))
#define MX_DMA(t) do { const int _r0 = MX_TROW(t); const int _sl = (t) & (NSLOT - 1); \
        __builtin_amdgcn_global_load_lds((const unsigned*)(kcol + (size_t)(_r0 + lane) * INC), (LAS unsigned*)(shm + A_K + _sl * SLOTB + wid * 1024), 16, 0, 0); \
        __builtin_amdgcn_global_load_lds((const unsigned*)(vcol + (size_t)(_r0 + 16 * (wid & 3) + (lane >> 2)) * INC), (LAS unsigned*)(shm + A_V + _sl * SLOTB + wid * 1024), 16, 0, 0); } while (0)
    static_assert(NH == 1, "the conv slice deal assumes four attention units per chunk");
    const int cm0 = qrow0 + (kvh * 2 + hp) * 32;
    ConvRaw CR; conv_load(CR, PROJ, cm0, tid, 0);
    bf16x8 qr[NH][4];
    { const bf16_t* qp = PROJ + (size_t)(qrow0 + qw + r32) * INC + C_Q + head0 * 64 + hi * 8;
#pragma unroll
      for (int hh = 0; hh < NH; ++hh)
#pragma unroll
          for (int d0 = 0; d0 < 4; ++d0) qr[hh][d0] = *(const bf16x8*)(qp + hh * 64 + d0 * 16); }
    MX_DMA(0); MX_DMA(1); MX_DMA(2);
    float mrun[NH], lsum[NH]; f32x16 o[NH][2], negm[NH];
#pragma unroll
    for (int hh = 0; hh < NH; ++hh) { mrun[hh] = sink[head0 + hh] * LOG2E; lsum[hh] = hi == 0 ? 1.0f : 0.0f;
#pragma unroll
        for (int r = 0; r < 16; ++r) negm[hh][r] = -mrun[hh];
        o[hh][0] = (f32x16){0.f, 0.f, 0.f, 0.f, 0.f, 0.f, 0.f, 0.f, 0.f, 0.f, 0.f, 0.f, 0.f, 0.f, 0.f, 0.f}; o[hh][1] = o[hh][0]; }
    const unsigned vb0 = (unsigned)(size_t)(shm + A_V) + ((lane >> 4) & 1) * 32 + (lane & 3) * 8 + (4 * hi + ((lane & 15) >> 2)) * 64;
    const int qc = qw + r32;
    for (int t = 0; t < NT; ++t) {
        const int slot = t & (NSLOT - 1);
        if (t + 2 < NT) asm volatile("s_waitcnt vmcnt(4)" ::: "memory"); else if (t + 1 < NT) asm volatile("s_waitcnt vmcnt(2)" ::: "memory"); else asm volatile("s_waitcnt vmcnt(0)" ::: "memory");
        asm volatile("s_waitcnt lgkmcnt(0)\n\ts_barrier" ::: "memory");
        if (t + 3 < NT) MX_DMA(t + 3);
        if (t == 3) { conv_finish(CR, cwl, MIXo, cm0, tid, 0); conv_load(CR, PROJ, cm0, tid, 1); }
        bool masked = false; int kb = 0;
        if (t >= 4) { const int lt = t - 4 + lt_lo; masked = (lt < 2 || lt >= 4); kb = -128 + 64 * lt; }
        const bool dead = masked && ((kb == -128 && qw >= 64) || (kb == 192 && qw < 64));
        if (!dead) {
#pragma unroll
        for (int hh = 0; hh < NH; ++hh) {
            f32x16 p0, p1;
            qkt(p0, p1, shm + A_K + slot * SLOTB, qr[hh], negm[hh], r32, hi);
            if (masked) {
#pragma unroll
                for (int r = 0; r < 16; ++r) { const int k0 = kb + crow(r, hi), k1 = k0 + 32;
                    if (k0 < qc - 128 || k0 > qc + 128) p0[r] = -1e30f; if (k1 < qc - 128 || k1 > qc + 128) p1[r] = -1e30f; } }
            float ma = MX3(p0[0], p0[1], p1[0]), mb = MX3(p0[2], p0[3], p1[1]); ma = MX3(ma, p1[2], p1[3]);
#pragma unroll
            for (int r = 4; r < 16; r += 4) { ma = MX3(ma, p0[r], p0[r + 1]); mb = MX3(mb, p0[r + 2], p0[r + 3]); ma = MX3(ma, p1[r], p1[r + 1]); mb = MX3(mb, p1[r + 2], p1[r + 3]); }
            float rm = __builtin_fmaxf(ma, mb);
            { auto rr = __builtin_amdgcn_permlane32_swap(__float_as_uint(rm), __float_as_uint(rm), false, false); rm = __builtin_fmaxf(__uint_as_float(rr[0]), __uint_as_float(rr[1])); }
            if (__any(rm > (float)ATT_THR)) { const float dl = __builtin_fmaxf(rm, 0.f); mrun[hh] += dl;
#pragma unroll
                for (int r = 0; r < 16; ++r) { p0[r] -= dl; p1[r] -= dl; negm[hh][r] = -mrun[hh]; }
                const float f = __builtin_amdgcn_exp2f(-dl); lsum[hh] *= f; if (hi == 0) wsf[hh * 64 + r32] = f;
                asm volatile("s_waitcnt lgkmcnt(0)" ::: "memory");
#pragma unroll
                for (int r = 0; r < 16; ++r) { const float fr_ = *(volatile LAS float*)(wsf + hh * 64 + crow(r, hi)); o[hh][0][r] *= fr_; o[hh][1][r] *= fr_; } }
#pragma unroll
            for (int r = 0; r < 16; ++r) { p0[r] = __builtin_amdgcn_exp2f(p0[r]); p1[r] = __builtin_amdgcn_exp2f(p1[r]); }
            { f32x2 s2 = (f32x2){p0[0], p0[1]} + (f32x2){p1[0], p1[1]};
#pragma unroll
              for (int r = 2; r < 16; r += 2) { s2 += (f32x2){p0[r], p0[r + 1]}; s2 += (f32x2){p1[r], p1[r + 1]}; }
              lsum[hh] += s2.x + s2.y; }
            u32x4 pw0, pw1, pw2, pw3;
#pragma unroll
            for (int i = 0; i < 4; ++i) { pw0[i] = cvtpk(p0[2 * i], p0[2 * i + 1]); pw1[i] = cvtpk(p0[8 + 2 * i], p0[8 + 2 * i + 1]); pw2[i] = cvtpk(p1[2 * i], p1[2 * i + 1]); pw3[i] = cvtpk(p1[8 + 2 * i], p1[8 + 2 * i + 1]); }
            pv(o[hh], vb0 + slot * SLOTB, __builtin_bit_cast(bf16x8, pw0), __builtin_bit_cast(bf16x8, pw1), __builtin_bit_cast(bf16x8, pw2), __builtin_bit_cast(bf16x8, pw3));
            __builtin_amdgcn_sched_barrier(0);
        }
        }
    }
    LAS bf16_t* stg = (LAS bf16_t*)(shm + A_OST) + wid * 2048;
#pragma unroll
    for (int hh = 0; hh < NH; ++hh) {
        float ls = lsum[hh];
        { auto rr = __builtin_amdgcn_permlane32_swap(__float_as_uint(ls), __float_as_uint(ls), false, false); ls = __uint_as_float(rr[0]) + __uint_as_float(rr[1]); }
        if (hi == 0) wsf[hh * 64 + 32 + r32] = ls;
        asm volatile("s_waitcnt lgkmcnt(0)" ::: "memory");
#pragma unroll
        for (int r = 0; r < 16; ++r) { const int orow = crow(r, hi); const float rl = __builtin_amdgcn_rcpf(*(volatile LAS float*)(wsf + hh * 64 + 32 + orow));
            stg[orow * 64 + r32] = f2bf(o[hh][0][r] * rl); stg[orow * 64 + 32 + r32] = f2bf(o[hh][1][r] * rl); }
        asm volatile("s_waitcnt lgkmcnt(0)" ::: "memory");
        bf16_t* op = MIXo + (size_t)(qrow0 + qw) * D + 512 + (head0 + hh) * 64;
#pragma unroll
        for (int i = 0; i < 4; ++i) { const int row = i * 8 + (lane >> 3), ch = lane & 7; const u32x4 v = *(const LAS u32x4*)(stg + row * 64 + ch * 8); *(u32x4*)(op + (size_t)row * D + ch * 8) = v; }
        asm volatile("s_waitcnt lgkmcnt(0)" ::: "memory");
    }
    conv_finish(CR, cwl, MIXo, cm0, tid, 1);
    asm volatile("s_barrier" ::: "memory");
#undef MX_DMA
#undef MX_TROW
}

__device__ __forceinline__ void gmlp_conv_unit(const Ptrs& P, const bf16_t* PROJ, bf16_t* MIXo, LAS unsigned char* shm, int l, int m0, int tid) {
    const int lane = tid & 63, r32 = lane & 31, hi = lane >> 5; const int wid = __builtin_amdgcn_readfirstlane(tid >> 6);
    LAS bf16_t* vT = (LAS bf16_t*)shm;
    { u32x2 raw[16];
#pragma unroll
      for (int rr = 0; rr < 16; ++rr) raw[rr] = *(const u32x2*)(PROJ + (size_t)(m0 + wid * 16 + rr) * INC + C_V + 4 * lane);
      float gv[4];
#pragma unroll
      for (int i = 0; i < 4; ++i) gv[i] = P.gmlp_g[l * 256 + 4 * lane + i];
#pragma unroll
      for (int r4 = 0; r4 < 4; ++r4) { float g[4][4], ss[4];
#pragma unroll
          for (int q = 0; q < 4; ++q) { const u32x2 w = raw[r4 * 4 + q];
              g[q][0] = gelu_fast(__uint_as_float(w.x << 16)); g[q][1] = gelu_fast(__uint_as_float(w.x & 0xffff0000u)); g[q][2] = gelu_fast(__uint_as_float(w.y << 16)); g[q][3] = gelu_fast(__uint_as_float(w.y & 0xffff0000u));
              ss[q] = g[q][0] * g[q][0] + g[q][1] * g[q][1] + g[q][2] * g[q][2] + g[q][3] * g[q][3]; }
#pragma unroll
          for (int o = 1; o < 64; o <<= 1) {
#pragma unroll
              for (int q = 0; q < 4; ++q) ss[q] += __shfl_xor(ss[q], o); }
          float rinv[4];
#pragma unroll
          for (int q = 0; q < 4; ++q) rinv[q] = rsqrtf(ss[q] * (1.0f / 256.0f) + EPS);
#pragma unroll
          for (int i = 0; i < 4; ++i) { u32x2 w; w.x = cvtpk(g[0][i] * rinv[0] * gv[i], g[1][i] * rinv[1] * gv[i]); w.y = cvtpk(g[2][i] * rinv[2] * gv[i], g[3][i] * rinv[3] * gv[i]);
              *(LAS u32x2*)(vT + (4 * lane + i) * VT_PITCH + wid * 16 + r4 * 4) = w; } } }
    asm volatile("s_waitcnt lgkmcnt(0)\n\ts_barrier" ::: "memory");
    { const int h = wid >> 1, dt = wid & 1;
      const bf16_t* wsb = (const bf16_t*)(P.ws + WS_WSB) + ((size_t)(l * 4 + h) * 128) * 128 + (size_t)r32 * 128 + hi * 8;
      bf16x8 bfr[2][8];
#pragma unroll
      for (int kk = 0; kk < 8; ++kk) bfr[0][kk] = *(const bf16x8*)(wsb + kk * 16);
      u32x2 uraw[4][4];
#pragma unroll
      for (int pt = 0; pt < 4; ++pt)
#pragma unroll
          for (int q4 = 0; q4 < 4; ++q4) uraw[pt][q4] = *(const u32x2*)(PROJ + (size_t)(m0 + pt * 32 + r32) * INC + C_U + h * 64 + dt * 32 + 4 * hi + 8 * q4);
      bf16x8 af[8];
#pragma unroll
      for (int kk = 0; kk < 8; ++kk) af[kk] = *(const LAS bf16x8*)(vT + (h * 64 + dt * 32 + r32) * VT_PITCH + kk * 16 + hi * 8);
      const float* bs = P.b_s + (l * 4 + h) * 128;
#pragma unroll
      for (int pt = 0; pt < 4; ++pt) {
          if (pt < 3) {
#pragma unroll
              for (int kk = 0; kk < 8; ++kk) bfr[(pt + 1) & 1][kk] = *(const bf16x8*)(wsb + (size_t)(pt + 1) * 32 * 128 + kk * 16); }
          f32x16 acc = (f32x16){0.f, 0.f, 0.f, 0.f, 0.f, 0.f, 0.f, 0.f, 0.f, 0.f, 0.f, 0.f, 0.f, 0.f, 0.f, 0.f};
#pragma unroll
          for (int kk = 0; kk < 8; ++kk) acc = __builtin_amdgcn_mfma_f32_32x32x16_bf16(af[kk], bfr[pt & 1][kk], acc, 0, 0, 0);
          const int p = pt * 32 + r32; const float bias = bs[p];
          bf16_t* op = MIXo + (size_t)(m0 + p) * D + h * 64 + dt * 32 + 4 * hi;
#pragma unroll
          for (int q4 = 0; q4 < 4; ++q4) { const u32x2 raw = uraw[pt][q4];
              const float u0 = gelu_fast(__uint_as_float(raw.x << 16)), u1 = gelu_fast(__uint_as_float(raw.x & 0xffff0000u)), u2 = gelu_fast(__uint_as_float(raw.y << 16)), u3 = gelu_fast(__uint_as_float(raw.y & 0xffff0000u));
              u32x2 w; w.x = cvtpk(u0 * (acc[4 * q4] + bias), u1 * (acc[4 * q4 + 1] + bias)); w.y = cvtpk(u2 * (acc[4 * q4 + 2] + bias), u3 * (acc[4 * q4 + 3] + bias));
              *(u32x2*)(op + 8 * q4) = w; }
      } }
    asm volatile("s_waitcnt lgkmcnt(0)\n\ts_barrier" ::: "memory");
}
}

constexpr int ATT_NH = 1;
__device__ __forceinline__ void phase_mixer(const Ptrs& P, LAS unsigned char* lds, int l, int Mmix) {
    int tid = threadIdx.x; asm volatile("" : "+v"(tid));
    const bf16_t* PROJ = (const bf16_t*)(P.ws + WS_PROJ); bf16_t* MIXo = (bf16_t*)(P.ws + WS_MIX);
    const int G = gridDim.x, c = blockIdx.x;
    constexpr int UPC = ATT_NH == 2 ? 2 : 4;
    const int nLat = (ML / 128) * UPC, nCtx = Mmix > ML ? (MC / 128) * UPC : 0, nG = Mmix / 128;
    const bool gfirst = (c & 1) != 0;
    for (int pass = 0; pass < 2; ++pass) {
        if ((pass == 0) != gfirst) { for (int u = c; u < nLat; u += G) { const int chunk = u / UPC, kvh = (u / (UPC / 2)) & 1, hp = u & 1; mx::attn_unit<ATT_NH>(PROJ, MIXo, P.sink + l * 8, P.conv_w + (size_t)l * 768, lds, 1, chunk >> 6, chunk & 63, kvh, hp, tid); } }
        else { for (int u = c; u < nG + nCtx; u += G) {
            if (u < nG) mx::gmlp_conv_unit(P, PROJ, MIXo, lds, l, u * 128, tid);
            else { const int v = u - nG, chunk = v / UPC, kvh = (v / (UPC / 2)) & 1, hp = v & 1; mx::attn_unit<ATT_NH>(PROJ, MIXo, P.sink + l * 8, P.conv_w + (size_t)l * 768, lds, 0, chunk >> 1, chunk & 1, kvh, hp, tid); } } }
    }
}
constexpr int NPH = 31;
struct KArgs { Ptrs P; int lo, hi; };
__global__ void __launch_bounds__(NTHR, 2) k_fast(KArgs a) {
    extern __shared__ __attribute__((aligned(16))) unsigned char lds_raw[];
    LAS unsigned char* lds = (LAS unsigned char*)lds_raw;
    const int lo = a.lo, hi = a.hi;
#if defined(__HIP_DEVICE_COMPILE__) && defined(USE_KERNARG_RELOAD)
#define LOADP() const __attribute__((address_space(4))) unsigned long long* ap_ = (const __attribute__((address_space(4))) unsigned long long*)__builtin_amdgcn_kernarg_segment_ptr(); asm volatile("" : "+s"(ap_)); \
    Ptrs P; { unsigned long long* d_ = (unsigned long long*)&P; _Pragma("unroll") for (int i_ = 0; i_ < (int)(sizeof(Ptrs) / 8); ++i_) d_[i_] = ap_[i_]; }
#else
#define LOADP() const Ptrs P = a.P
#endif
    unsigned* ctl; { LOADP(); ctl = (unsigned*)(P.ws + WS_CTL); }
    if (threadIdx.x < 4) ((LAS unsigned*)(lds + MISC_OFF))[threadIdx.x] = 0u;
    __syncthreads();
    XcdBarrier bar; bar.bar = ctl + CW_BAR; bar.x = 0; bar.st = (volatile LAS unsigned*)(lds + MISC_OFF);
    if (hi - lo > 1) bar = xcd_barrier_post(ctl + CW_BAR, (volatile LAS unsigned*)(lds + MISC_OFF));
    volatile LAS int* vcw = (volatile LAS int*)(lds + MISC_OFF + 32);
    if (threadIdx.x == 0) { vcw[3] = 0; vcw[0] = (int)blockIdx.x; vcw[1] = (int)xb_xcc_id(); vcw[2] = (hi - lo > 1) ? (int)xb_add(ctl + CW_XR + 64 * xb_xcc_id(), 1u) : 0; }
    __syncthreads();
#define IN(k, kind) (lo <= (k) && (k) < hi)
#define SEAM(k) do { if (lo <= (k) && (k) + 1 < hi) xcd_barrier(bar); } while (0)
    LAS unsigned* idxtab = (LAS unsigned*)(lds + IDX_OFF);
    LAS int* tst = (LAS int*)(lds + TST_OFF);

    if (IN(0, 0)) { LOADP(); phase_p0a(P, lds); }
    SEAM(0);
    if (lo == 0 && hi > 1) {
        if (threadIdx.x == 0) { const int myx = vcw[1], rank = vcw[2]; int npop = 0, xi = 0; bool even = true;
            for (int j = 0; j < 16; ++j) { const unsigned cj = xb_ld(ctl + CW_XR + 64 * j); if (cj) { ++npop; if (j < myx) ++xi; if (cj * 8u != gridDim.x) even = false; } }
            if (even && npop == 8 && rank < (int)(gridDim.x / 8)) { vcw[0] = rank * 8 + xi; vcw[3] = (int)(gridDim.x / 8); }
            }
        __syncthreads(); }
    const int vc = vcw[0];
    if (IN(1, 1)) { LOADP(); phase_p0b(P); }
    SEAM(1);
    for (int l = 0; l < DEPTH; ++l) {
        const int pb = 2 + 7 * l;
        const int Mmix = l < DEPTH - 1 ? MT : ML;
        if (IN(pb + 0, 2)) { LOADP(); if (l > 0) build_tile_table(P, tst, l - 1);
            if (l == 0) phase_norm<1, true>(P, lds, l, MT, (const bf16_t*)P.out, tst); else phase_norm<1, false>(P, lds, l, MT, (const bf16_t*)P.out, tst); }
        SEAM(pb + 0);
        if (IN(pb + 1, 3)) { LOADP();
            SchedDense<INC> S{(const bf16_t*)(P.ws + WS_H), (const bf16_t*)(P.ws + WS_WIN) + (size_t)l * INC * D, MT / 256, (int)gridDim.x, vc};
            EpiProj E{(bf16_t*)(P.ws + WS_PROJ), (const float*)(P.ws + WS_ROPE)};
            pg::gemm_phase(lds + RING_OFF, idxtab, S, E);
        }
        SEAM(pb + 1);
        if (IN(pb + 2, 4)) { LOADP(); phase_mixer(P, lds, l, Mmix); }
        SEAM(pb + 2);
        if (IN(pb + 3, 5)) { LOADP();
            SchedDense<D> S{(const bf16_t*)(P.ws + WS_MIX), (const bf16_t*)(P.ws + WS_WOUT) + (size_t)l * D * D, Mmix / 256, (int)gridDim.x, vc};
            EpiPlain E{(bf16_t*)(P.ws + WS_PROJ), D};
            pg::gemm_phase(lds + RING_OFF, idxtab, S, E);
        }
        SEAM(pb + 3);
        if (IN(pb + 4, 6)) { LOADP(); phase_norm<2, false>(P, lds, l, Mmix, (const bf16_t*)(P.ws + WS_PROJ), tst); }
        SEAM(pb + 4);
        if (IN(pb + 5, 7)) { LOADP(); const ClsRec* listr = (const ClsRec*)(P.ws + WS_LISTR);
            build_tile_table(P, tst, l);
            SchedGU S{(const unsigned char*)(P.ws + WS_H), (const unsigned char*)(P.ws + WS_WGU) + (size_t)l * NE * 1024 * 1024, listr, tst, ctl + CW_CNTF + l * 32 * 64, (int)gridDim.x, vc};
            EpiGU E{(unsigned char*)(P.ws + WS_PROJ), listr, ctl + CW_CNTF + l * 32 * 64};
            pg::gemm_phase(lds + RING_OFF, idxtab, S, E);
        }
        SEAM(pb + 5);
        if (IN(pb + 6, 8)) { LOADP();
            build_tile_table(P, tst, l);
            SchedDown S{(const unsigned char*)(P.ws + WS_PROJ), (const unsigned char*)(P.ws + WS_WD) + (size_t)l * NE * 1024 * 512, tst, (int)gridDim.x, vc};
            EpiPlain E{l < DEPTH - 1 ? (bf16_t*)P.out : (bf16_t*)(P.ws + WS_H), D};
            pg::gemm_phase(lds + RING_OFF, idxtab, S, E);
        }
        SEAM(pb + 6);
    }
    if (IN(30, 9)) { LOADP(); build_tile_table(P, tst, DEPTH - 1); phase_norm<3, false>(P, lds, DEPTH - 1, ML, (const bf16_t*)(P.ws + WS_H), tst); }
#undef IN
#undef SEAM
}
static int g_grid = 256;
static void launch_fast(const Ptrs& P, int lo, int hi, hipStream_t stream) {
    KArgs a{}; a.P = P; a.lo = lo; a.hi = hi;
    hipLaunchKernelGGL(k_fast, dim3(g_grid), dim3(NTHR), LDS_BYTES, stream, a);
}
extern "C" void kernel_launch(void* const* d_in, const int* in_sizes, int n_in, void* d_out, int out_size, void* d_ws, size_t ws_size, hipStream_t stream) {
    static int ready = 0;
    if (!ready) {
        if (n_in != 21 || ws_size < WS_END2) { fprintf(stderr, "kernel_launch: unexpected inputs (%d) or workspace (%zu)\n", n_in, ws_size); ready = -1; return; }
        if (hipFuncSetAttribute((const void*)k_fast, hipFuncAttributeMaxDynamicSharedMemorySize, LDS_BYTES) != hipSuccess) { fprintf(stderr, "kernel_launch: hipFuncSetAttribute failed\n"); ready = -1; return; }
        { int dev = 0, cus = 0, per_cu = 0; (void)hipGetDevice(&dev); (void)hipDeviceGetAttribute(&cus, hipDeviceAttributeMultiprocessorCount, dev);
          if (hipOccupancyMaxActiveBlocksPerMultiprocessor(&per_cu, (const void*)k_fast, NTHR, LDS_BYTES) != hipSuccess || per_cu < 1) { fprintf(stderr, "kernel_launch: occupancy query says %d blocks per CU\n", per_cu); }
          (void)hipGetLastError(); if (cus > 0) g_grid = cus;
          if (g_grid * NWAVES * 64 < MT) { fprintf(stderr, "kernel_launch: %d workgroups are too few for the routing tables\n", g_grid); ready = -1; return; } }
        ready = 1;
    }
    if (ready < 0) return;
    Ptrs P{};
    const float** pp = (const float**)&P;
    for (int i = 0; i < 21; ++i) pp[i] = (const float*)d_in[i];
    P.out = (float*)d_out; P.ws = (unsigned char*)d_ws;
    unsigned char* ws = (unsigned char*)d_ws;
    (void)hipMemsetAsync(ws + WS_CTL, 0, 1 * MiB, stream);
    launch_fast(P, 0, NPH, stream);
}
```

```cpp
#include <hip/hip_runtime.h>
#include <stdint.h>
#include <cstdio>

constexpr int D = 1024, NB = 8, SEQ = 8192, DEPTH = 4, CTXL = 256;
constexpr int ML = NB * SEQ;
constexpr int MC = NB * CTXL;
constexpr int MT = ML + MC;
constexpr int INC = 2048;
constexpr int C_U = 0, C_V = 256, C_BG = 512, C_CG = 768, C_Z = 1024, C_Q = 1280, C_K = 1792, C_VV = 1920;
constexpr int NE = 16, DE = 512, NCLS = 24;
constexpr float EPS = 1e-6f;
constexpr float QSCALE = 0.125f * 1.4426950408889634f;
constexpr float LOG2E = 1.4426950408889634f;

typedef unsigned short bf16_t;
typedef float f32x4 __attribute__((ext_vector_type(4)));
typedef unsigned u32x4 __attribute__((ext_vector_type(4)));
typedef unsigned u32x2 __attribute__((ext_vector_type(2)));

__device__ __forceinline__ float bf2f(bf16_t v) { return __uint_as_float((unsigned)v << 16); }
__device__ __forceinline__ bf16_t f2bf(float f) { unsigned u = __float_as_uint(f); return (bf16_t)((u + 0x7fffu + ((u >> 16) & 1u)) >> 16); }
__device__ __forceinline__ unsigned pk2(float lo, float hi) { return (unsigned)f2bf(lo) | ((unsigned)f2bf(hi) << 16); }
__device__ __forceinline__ float gelu_tanh(float x) { const float y = 0.7978845608028654f * (x + 0.044715f * x * x * x); return x / (1.0f + __expf(-2.0f * y)); }
__device__ __forceinline__ float silu_f(float x) { return x / (1.0f + __expf(-x)); }
__device__ __forceinline__ float wave_sum(float v) {
#pragma unroll
    for (int o = 1; o < 64; o <<= 1) v += __shfl_xor(v, o);
    return v;
}

constexpr size_t MiB = 1u << 20;
constexpr size_t WS_CTL = 0;
constexpr size_t WS_MOD = 1 * MiB;
constexpr size_t WS_ROPE = 2 * MiB;
constexpr size_t WS_TOK = 3 * MiB;
constexpr size_t WS_XC = 5 * MiB;
constexpr size_t WS_LISTE = 13 * MiB;
constexpr size_t WS_LISTC = 18 * MiB;
constexpr size_t WS_VN = 25 * MiB;
constexpr size_t WS_WIN = 64 * MiB, WS_WOUT = 80 * MiB, WS_WGU = 88 * MiB, WS_WD = 216 * MiB;
constexpr size_t WS_H = 280 * MiB;
constexpr size_t WS_MIX = 412 * MiB;
constexpr size_t WS_PROJ = 544 * MiB;
constexpr size_t WS_END = 808 * MiB;
constexpr int CW_CNTE = 1024;
constexpr int CW_CNTC = 2048;

struct Tok { unsigned ids; float wlo, whi; unsigned pad; };

struct Ptrs {
    const float *x, *c, *ctx, *c_ctx, *w_mod, *b_mod, *norm1_g, *norm2_g, *w_in, *gmlp_g, *w_s, *b_s, *conv_w, *sink, *w_out, *router_w, *router_b, *w_gate, *w_up, *w_down, *final_g;
    float* out; unsigned char* ws;
};
__device__ __forceinline__ int modrow(int m) { return m < ML ? (m >> 13) : 8; }

#define LAS __attribute__((address_space(3)))
#define XB_TMO      128
#define XB_XCNT(j)  (256  + 64 * (j))
#define XB_XSUB(j)  (1280 + 64 * (j))
#define XB_XGEN(j)  (2304 + 64 * (j))
#define XB_TOP      3328
#define XB_TOPGEN   3392
#define XCD_BAR_WORDS 3456
#define XB_SPIN_CAP (1u << 18)

__device__ __forceinline__ unsigned xb_ld(unsigned* p)              { return __hip_atomic_load(p, __ATOMIC_RELAXED, __HIP_MEMORY_SCOPE_AGENT); }
__device__ __forceinline__ unsigned xb_add(unsigned* p, unsigned v) { return __hip_atomic_fetch_add(p, v, __ATOMIC_RELAXED, __HIP_MEMORY_SCOPE_AGENT); }
__device__ __forceinline__ unsigned xb_xcc_id() { return (unsigned)__builtin_amdgcn_s_getreg((3 << 11) | 20) & 0xFu; }
#define XB_SPIN(cond, bar) do { unsigned _sp = 0; while (cond) { __builtin_amdgcn_s_sleep(1); \
    if ((++_sp & 255u) == 0u) { if (xb_ld(&(bar)[XB_TMO])) break; if (_sp > XB_SPIN_CAP) { atomicAdd(&(bar)[XB_TMO], 1u); break; } } } } while (0)

struct XcdBarrier {
    unsigned* bar; unsigned x;
    volatile LAS unsigned* st;
};

__device__ __forceinline__ XcdBarrier xcd_barrier_post(unsigned* bar, volatile LAS unsigned* st) {
    XcdBarrier b; b.bar = bar; b.x = xb_xcc_id(); b.st = st;
    if (threadIdx.x == 0) (void)xb_add(&bar[XB_XCNT(b.x)], 1u);
    return b;
}
__device__ __forceinline__ void xcd_barrier_complete(unsigned* bar, unsigned x, unsigned& nloc, unsigned& nx) {
    const unsigned G = gridDim.x * gridDim.y * gridDim.z;
    unsigned sum, cnt, mine, sp = 0u;
    for (;;) {
        sum = 0u; cnt = 0u; mine = 0u;
#pragma unroll
        for (unsigned j = 0; j < 16; ++j) { const unsigned c = xb_ld(&bar[XB_XCNT(j)]); sum += c; cnt += (c > 0u) ? 1u : 0u; mine = (j == x) ? c : mine; }
        if (sum == G) break;
        __builtin_amdgcn_s_sleep(1);
        if ((++sp & 255u) == 0u) { if (xb_ld(&bar[XB_TMO])) break; if (sp > XB_SPIN_CAP) { atomicAdd(&bar[XB_TMO], 1u); break; } }
    }
    nloc = mine > 0u ? mine : 1u; nx = cnt > 0u ? cnt : 1u;
}

__device__ __forceinline__ void xcd_barrier(const XcdBarrier& b) {
    asm volatile("s_waitcnt vmcnt(0)" ::: "memory");
    __syncthreads();
    if (threadIdx.x == 0) {
        unsigned* bar = b.bar;
        __builtin_amdgcn_s_waitcnt(0);
        unsigned nloc = b.st[0], nx = b.st[1];
        if (nloc == 0u) { xcd_barrier_complete(bar, b.x, nloc, nx); b.st[0] = nloc; b.st[1] = nx; }
        const unsigned old = xb_add(&bar[XB_XSUB(b.x)], 1u);
        const unsigned gen = old / nloc;
        if (old + 1u == (gen + 1u) * nloc) {
            __builtin_amdgcn_fence(__ATOMIC_RELEASE, "agent");
            asm volatile("s_waitcnt vmcnt(0)" ::: "memory");
            const unsigned og = xb_add(&bar[XB_TOP], 1u);
            const unsigned tg = og / nx;
            if (og + 1u == (tg + 1u) * nx) xb_add(&bar[XB_TOPGEN], 1u);
            else XB_SPIN(xb_ld(&bar[XB_TOPGEN]) == tg, bar);
            __builtin_amdgcn_fence(__ATOMIC_ACQUIRE, "agent");
            xb_add(&bar[XB_XGEN(b.x)], 1u);
            asm volatile("s_waitcnt vmcnt(0)" ::: "memory");
        } else {
            XB_SPIN(xb_ld(&bar[XB_XGEN(b.x)]) == gen, bar);
            __builtin_amdgcn_fence(__ATOMIC_ACQUIRE, "agent");
            asm volatile("s_waitcnt vmcnt(0)" ::: "memory");
        }
    }
    __syncthreads();
}
typedef short bf16x8 __attribute__((ext_vector_type(8)));
typedef int v4i32 __attribute__((ext_vector_type(4)));
typedef int v8i32 __attribute__((ext_vector_type(8)));
namespace pg {
constexpr int BM = 256, BK = 64, HALF = 128, HTB = HALF * BK * 2  , STAGE_BYTES = 8 * HTB, NXCD = 8, WGM = 8;
__host__ __device__ __forceinline__ int lds_byte(int r, int c) { return (r >> 3) * 1024 + (r & 7) * 128 + (((c >> 3) ^ (r & 7)) << 4); }
__host__ __device__ __forceinline__ void stage_rc(int b, int& R, int& C) { const int piece = b >> 10, p = (b & 1023) >> 4; R = piece * 8 + (p >> 3); C = ((p & 7) ^ (R & 7)) << 3; }

struct Unit { int pm, pn, x0, x1; };

__device__ __forceinline__ void order_unit(int L, int nM, int nN, int& pm, int& pn) {
    const int nwg = nM * nN; int wgid = L;
    { const int q = nwg / NXCD, r = nwg % NXCD, xcd = wgid % NXCD, off = wgid / NXCD; wgid = (xcd < r ? xcd * (q + 1) : r * (q + 1) + (xcd - r) * q) + off; }
    const int nig = WGM * nN, gid = wgid / nig, fm = gid * WGM, gsz = (nM - fm) < WGM ? (nM - fm) : WGM;
    pm = fm + ((wgid % nig) % gsz); pn = (wgid % nig) / gsz;
}

template <class Sched, class Epi>
__device__ __forceinline__ void gemm_phase(LAS unsigned char* lds, LAS unsigned* idxtab, const Sched& S, const Epi& E) {
    constexpr int ESZ = Sched::ESZ;
    constexpr int K = Sched::K, LDA = Sched::LDA, LDB = Sched::LDB, nt = K * ESZ / 128, KS = Sched::KSPLIT; constexpr bool GATHER = Sched::GATHER;
    int tid = threadIdx.x; asm volatile("" : "+v"(tid));
    const int wid = __builtin_amdgcn_readfirstlane(tid >> 6), lane = tid & 63, wr = wid >> 2, wc = wid & 3;
    constexpr size_t kstep = (size_t)(BK * 2);
    constexpr size_t hstepA = (size_t)HALF * LDA * ESZ, hstepB = (size_t)HALF * LDB * ESZ;
    const unsigned ldsw = (unsigned)wid * 1024u;
    const int aoff0 = lds_byte(wr * 64 + (lane & 15), (lane >> 4) * 8), boff0 = lds_byte(wc * 32 + (lane & 15), (lane >> 4) * 8);
    unsigned pvoA[2], pvoB[2];
#pragma unroll
    for (int i = 0; i < 2; ++i) { int R_, C_; stage_rc((wid * 64 + lane) * 16 + i * 8192, R_, C_); pvoA[i] = (unsigned)(R_ * LDA * ESZ + C_ * 2); pvoB[i] = (unsigned)(R_ * LDB * ESZ + C_ * 2); }
    unsigned cv[2][2];
#define PG_SA(b, h) (((b) * 2 + (h)) * HTB)
#define PG_SB(b, h) ((4 + (b) * 2 + (h)) * HTB)
#define PG_VOFF(ld, i, dst) do { int _t = wid * 64 + lane; asm volatile("" : "+v"(_t)); int _R, _C; stage_rc(_t * 16 + (i) * 8192, _R, _C); dst = (unsigned)(_R * (ld) * ESZ + _C * 2); } while (0)
#define PG_STAGE_B(bufoff, gbase) do { _Pragma("unroll") for (int _i = 0; _i < 2; ++_i) { unsigned _vo = pvoB[_i]; if constexpr (ESZ == 1) PG_VOFF(LDB, _i, _vo); \
        __builtin_amdgcn_global_load_lds((const unsigned*)((const char*)(gbase) + _vo), (LAS unsigned*)(lds + (bufoff) + ldsw + _i * 8192), 16, 0, 0); } } while (0)
#define PG_STAGE_A(bufoff, gbase, h, V) do { _Pragma("unroll") for (int _i = 0; _i < 2; ++_i) { unsigned _vo = pvoA[_i]; \
        const char* _p = GATHER ? (const char*)(gbase) + V[h][_i] : (const char*)(gbase) + ((h) ? hstepA : 0) + _vo; \
        __builtin_amdgcn_global_load_lds((const unsigned*)_p, (LAS unsigned*)(lds + (bufoff) + ldsw + _i * 8192), 16, 0, 0); } } while (0)
#define PG_LDA(dst, b, h) do { int _a1 = aoff0 ^ 64; asm volatile("" : "+v"(_a1)); _Pragma("unroll") for (int m = 0; m < 4; ++m) _Pragma("unroll") for (int k = 0; k < 2; ++k) dst[m][k] = *(const LAS bf16x8*)(lds + PG_SA(b, h) + (k ? _a1 : aoff0) + m * 2048); } while (0)
#define PG_LDB(dst, b, h) do { int _b1 = boff0 ^ 64; asm volatile("" : "+v"(_b1)); _Pragma("unroll") for (int n = 0; n < 2; ++n) _Pragma("unroll") for (int k = 0; k < 2; ++k) dst[n][k] = *(const LAS bf16x8*)(lds + PG_SB(b, h) + (k ? _b1 : boff0) + n * 2048); } while (0)
#define PG_MMA(ai, bj, At, Bt) do { __builtin_amdgcn_s_setprio(1); _Pragma("unroll") for (int m = 0; m < 4; ++m) _Pragma("unroll") for (int n = 0; n < 2; ++n) { \
        if constexpr (ESZ == 2) { _Pragma("unroll") for (int k = 0; k < 2; ++k) acc[ai][bj][m][n] = __builtin_amdgcn_mfma_f32_16x16x32_bf16(Bt[n][k], At[m][k], acc[ai][bj][m][n], 0, 0, 0); } \
        else {   \
            const v8i32 bw = __builtin_shufflevector(__builtin_bit_cast(v4i32, Bt[n][0]), __builtin_bit_cast(v4i32, Bt[n][1]), 0, 1, 2, 3, 4, 5, 6, 7); \
            const v8i32 aw = __builtin_shufflevector(__builtin_bit_cast(v4i32, At[m][0]), __builtin_bit_cast(v4i32, At[m][1]), 0, 1, 2, 3, 4, 5, 6, 7); \
            acc[ai][bj][m][n] = __builtin_amdgcn_mfma_scale_f32_16x16x128_f8f6f4(bw, aw, acc[ai][bj][m][n], 0, 0, 0, Sched::SCALE_B, 0, Sched::SCALE_A); } } \
        __builtin_amdgcn_s_setprio(0); } while (0)
#define PG_WAIT_V(n) asm volatile("s_waitcnt vmcnt(" #n ")" ::: "memory")
#define PG_WAIT_L(n) asm volatile("s_waitcnt lgkmcnt(" #n ")" ::: "memory")
#define PG_BAR __builtin_amdgcn_s_barrier()
#define PG_SCHED __builtin_amdgcn_sched_barrier(0)
#define PG_IDX_ISSUE(u) do { int _l = lane; asm volatile("" : "+v"(_l)); const int _h = (_l >> 4) & 1, _i = (_l >> 3) & 1, _r = _l & 7; const unsigned _po = (unsigned)(_h * 128 + (wid + 8 * _i) * 8 + _r) * 16u; \
        __builtin_amdgcn_global_load_lds((const unsigned*)((const char*)S.idx_src(u) + _po), (LAS unsigned*)(idxtab + wid * 64), 4, 0, 0); } while (0)
#define PG_IDX_READ(u, V) do { const int _vr = S.valid_rows(u); _Pragma("unroll") for (int _h = 0; _h < 2; ++_h) _Pragma("unroll") for (int _i = 0; _i < 2; ++_i) { \
        const int _pos = _h * 128 + (wid + 8 * _i) * 8 + (lane >> 3); unsigned _tk = *(volatile LAS unsigned*)(idxtab + wid * 64 + _h * 16 + _i * 8 + (lane >> 3)); \
        _tk = _pos < _vr ? _tk : 0u; V[_h][_i] = _tk * (unsigned)(LDA * ESZ) + (unsigned)(((lane & 7) ^ ((lane >> 3) & 7)) << 4); } } while (0)
    Unit cur, nxt; int ui = 0;
    if (!S.next(0, cur)) return;
    f32x4 acc[2][2][4][2];
#pragma unroll
    for (int a = 0; a < 2; ++a)
#pragma unroll
        for (int b = 0; b < 2; ++b)
#pragma unroll
            for (int m = 0; m < 4; ++m)
#pragma unroll
                for (int n = 0; n < 2; ++n) acc[a][b][m][n] = (f32x4){0.f, 0.f, 0.f, 0.f};
    bf16x8 At[4][2], B0[2][2], B1[2][2];
    const char* cA = S.a_base(cur); const char* cB0 = S.b_base(cur, 0); const char* cB1 = S.b_base(cur, 1);
#pragma unroll
    for (int h = 0; h < 2; ++h)
#pragma unroll
        for (int i = 0; i < 2; ++i) cv[h][i] = 0u;
    if constexpr (GATHER) { PG_IDX_ISSUE(cur); PG_WAIT_V(0); PG_IDX_READ(cur, cv); }
    PG_STAGE_B(PG_SB(0, 0), cB0); PG_STAGE_B(PG_SB(0, 1), cB0 + hstepB); PG_STAGE_A(PG_SA(0, 0), cA, 0, cv); PG_STAGE_A(PG_SA(0, 1), cA, 1, cv);
    if (wr == 1) PG_BAR;
    PG_WAIT_V(2); PG_BAR;
    PG_STAGE_B(PG_SB(1, 0), cB0 + kstep); PG_STAGE_A(PG_SA(1, 0), cA + kstep, 0, cv); PG_STAGE_B(PG_SB(1, 1), cB0 + hstepB + kstep);
    PG_WAIT_V(6); PG_BAR;
    for (;;) {
        const bool has_next = S.next(ui + 1, nxt);
        const char* nA = has_next ? S.a_base(nxt) : cA; const char* nB0 = has_next ? S.b_base(nxt, 0) : cB0; const char* nB1 = has_next ? S.b_base(nxt, 1) : cB1;
        if constexpr (GATHER) { if (has_next) PG_IDX_ISSUE(nxt); }
#pragma nounroll
        for (int t = 0; t < nt; t += 2) {
            const bool last = (t == nt - 2);
            const char* a1 = cA + (size_t)(t + 1) * kstep;
            const char* a2 = last ? nA : cA + (size_t)(t + 2) * kstep; const char* a3 = a2 + kstep;
            const char* b2 = last ? nB0 : ((t + 2) < KS ? cB0 : cB1) + (size_t)(t + 2) * kstep;
            const char* b3 = last ? nB0 + kstep : ((t + 3) < KS ? cB0 : cB1) + (size_t)(t + 3) * kstep;
            PG_LDB(B0, 0, 0); PG_LDB(B1, 0, 1); PG_SCHED; PG_LDA(At, 0, 0); PG_STAGE_A(PG_SA(1, 1), a1, 1, cv);
            if constexpr (GATHER) { if (last && has_next) { PG_IDX_READ(nxt, cv); } }
            PG_WAIT_V(8); PG_WAIT_L(0); PG_BAR; PG_MMA(0, 0, At, B0); PG_MMA(0, 1, At, B1); PG_BAR; PG_SCHED;
            PG_LDA(At, 0, 1); PG_STAGE_B(PG_SB(0, 0), b2); PG_STAGE_B(PG_SB(0, 1), b2 + hstepB); PG_STAGE_A(PG_SA(0, 0), a2, 0, cv);
            PG_WAIT_V(8); PG_WAIT_L(0); PG_BAR; PG_MMA(1, 0, At, B0); PG_MMA(1, 1, At, B1); PG_BAR; PG_SCHED;
            PG_LDB(B0, 1, 0); PG_LDB(B1, 1, 1); PG_SCHED; PG_LDA(At, 1, 0); PG_STAGE_A(PG_SA(0, 1), a2, 1, cv);
            PG_WAIT_V(8); PG_WAIT_L(0); PG_BAR; PG_MMA(0, 0, At, B0); PG_MMA(0, 1, At, B1); PG_BAR; PG_SCHED;
            PG_LDA(At, 1, 1); PG_STAGE_B(PG_SB(1, 0), b3); PG_STAGE_B(PG_SB(1, 1), b3 + hstepB); PG_STAGE_A(PG_SA(1, 0), a3, 0, cv);
            PG_WAIT_V(8); PG_WAIT_L(0); PG_BAR; PG_MMA(1, 0, At, B0); PG_MMA(1, 1, At, B1); PG_BAR; PG_SCHED;
        }
        if (wr == 0) PG_BAR;
        { int _l = lane; asm volatile("" : "+v"(_l)); E(acc, cur, wr, wc, _l & 15, _l >> 4); }
        if (!has_next) break;
#pragma unroll
        for (int a = 0; a < 2; ++a)
#pragma unroll
            for (int b = 0; b < 2; ++b)
#pragma unroll
                for (int m = 0; m < 4; ++m)
#pragma unroll
                    for (int n = 0; n < 2; ++n) acc[a][b][m][n] = (f32x4){0.f, 0.f, 0.f, 0.f};
        cur = nxt; cA = nA; cB0 = nB0; cB1 = nB1; ++ui;
        if (wr == 1) PG_BAR;
    }
    PG_WAIT_V(0);
    PG_BAR;
#undef PG_SA
#undef PG_SB
#undef PG_STAGE_A
#undef PG_STAGE_B
#undef PG_VOFF
#undef PG_LDA
#undef PG_LDB
#undef PG_MMA
#undef PG_WAIT_V
#undef PG_WAIT_L
#undef PG_BAR
#undef PG_SCHED
#undef PG_IDX_ISSUE
#undef PG_IDX_READ
}
}
constexpr int NWAVES = 8, NTHR = 512;
constexpr int RING_OFF = 0, RING_BYTES = 131072;
constexpr int IDX_OFF = RING_BYTES;
constexpr int TST_OFF = IDX_OFF + 2048;
constexpr int MISC_OFF = TST_OFF + 128;
constexpr int LDS_BYTES = 147456;
constexpr size_t WS_MODP = WS_VN;
constexpr size_t WS_WSB = 62 * MiB;
constexpr int CW_CNTF = 16384;
constexpr int CW_XR = 12288;
constexpr int CW_MXQ = 13312;
constexpr int CW_BAR = 8192;
constexpr int MAXT = 288;

struct ClsRec { int m; float wlo, whi; int pad; };
constexpr size_t WS_LISTR = 816 * MiB;
constexpr size_t WS_XB = 848 * MiB;
constexpr size_t WS_POS = WS_TOK;
constexpr size_t WS_END2 = 980 * MiB;

__device__ __forceinline__ void cls_experts(int cls, int& elo, int& ehi) {
    const int g = cls / 6, p = cls % 6; const int a = p < 3 ? 0 : (p < 5 ? 1 : 2), b = p < 3 ? p + 1 : (p < 5 ? p - 1 : 3);
    elo = g * 4 + a; ehi = g * 4 + b;
}
constexpr int F8_SH_H = 4, F8_SH_A = 3, F8_SH_W = 5, F8_SH_M = 2;
#define SC_E8(sh) ((127 - (sh)) * 0x01010101)
__device__ __forceinline__ unsigned pk4_fp8(float a, float b, float c, float d, float scale) {
    const float lim = 448.0f; a = fminf(fmaxf(a * scale, -lim), lim); b = fminf(fmaxf(b * scale, -lim), lim); c = fminf(fmaxf(c * scale, -lim), lim); d = fminf(fmaxf(d * scale, -lim), lim);
    int w = __builtin_amdgcn_cvt_pk_fp8_f32(a, b, 0, false); w = __builtin_amdgcn_cvt_pk_fp8_f32(c, d, w, true); return (unsigned)w; }
__device__ __forceinline__ unsigned cvt_pk_bf16(float lo, float hi) { unsigned r; asm volatile("v_cvt_pk_bf16_f32 %0, %1, %2" : "=v"(r) : "v"(lo), "v"(hi)); return r; }

template <int N_, int ESZ_> struct SchedDense {
    static constexpr int K = 1024, LDA = 1024, LDB = 1024, KSPLIT = K * ESZ_ / 128, ESZ = ESZ_, SCALE_A = ESZ_ == 1 ? SC_E8(F8_SH_M) : 0, SCALE_B = ESZ_ == 1 ? SC_E8(F8_SH_W) : 0; static constexpr bool GATHER = false;
    const void* A; const void* Bt; int nM, G, c;
    __device__ __forceinline__ bool next(int i, pg::Unit& u) const { const long L = (long)i * G + c; if (L >= (long)nM * (N_ / 256)) return false; pg::order_unit((int)L, nM, N_ / 256, u.pm, u.pn); u.x0 = 0; u.x1 = 0; return true; }
    __device__ __forceinline__ const char* a_base(const pg::Unit& u) const { return (const char*)A + (size_t)u.pm * 256 * LDA * ESZ; }
    __device__ __forceinline__ const char* b_base(const pg::Unit& u, int) const { return (const char*)Bt + (size_t)u.pn * 256 * LDB * ESZ; }
    __device__ __forceinline__ const unsigned* idx_src(const pg::Unit&) const { return nullptr; }
    __device__ __forceinline__ int valid_rows(const pg::Unit&) const { return 256; }
};
__device__ __forceinline__ void cls_of_tile(const LAS int* tst, int T, int& cls, int& rt) {
    int c = 0;
#pragma unroll
    for (int k = 1; k < NCLS; ++k) c += (T >= tst[k]) ? 1 : 0;
    cls = __builtin_amdgcn_readfirstlane(c); rt = __builtin_amdgcn_readfirstlane(T - tst[c]);
}
struct SchedGU {
    static constexpr int K = 1024, LDA = 1024, LDB = 1024, KSPLIT = 8, ESZ = 1, SCALE_A = SC_E8(F8_SH_H), SCALE_B = SC_E8(F8_SH_W); static constexpr bool GATHER = true;
    const unsigned char* H; const unsigned char* Wgu; const ClsRec* list; const LAS int* tst; const unsigned* cnt; int G, c;
    __device__ __forceinline__ bool next(int i, pg::Unit& u) const { const int TT = __builtin_amdgcn_readfirstlane(tst[NCLS]); const long L = (long)i * G + c; if (L >= (long)TT * 8) return false;
        pg::order_unit((int)L, TT, 8, u.pm, u.pn); cls_of_tile(tst, u.pm, u.x0, u.x1); return true; }
    __device__ __forceinline__ const char* a_base(const pg::Unit&) const { return (const char*)H; }
    __device__ __forceinline__ const char* b_base(const pg::Unit& u, int) const { int elo, ehi; cls_experts(u.x0, elo, ehi); const int e = u.pn < 4 ? elo : ehi;
        return (const char*)Wgu + ((size_t)e * 1024 + (size_t)(u.pn & 3) * 256) * LDB; }
    __device__ __forceinline__ const unsigned* idx_src(const pg::Unit& u) const { return (const unsigned*)(list + (size_t)u.x0 * MT + (size_t)u.x1 * 256); }
    __device__ __forceinline__ int valid_rows(const pg::Unit& u) const { return (int)cnt[u.x0 * 64] - u.x1 * 256; }
};
struct SchedDown {
    static constexpr int K = 1024, LDA = 1024, LDB = 512, KSPLIT = 4, ESZ = 1, SCALE_A = SC_E8(F8_SH_A), SCALE_B = SC_E8(F8_SH_W); static constexpr bool GATHER = false;
    const unsigned char* ACT; const unsigned char* Wd; const LAS int* tst; int G, c;
    __device__ __forceinline__ bool next(int i, pg::Unit& u) const { const int TT = __builtin_amdgcn_readfirstlane(tst[NCLS]); const long L = (long)i * G + c; if (L >= (long)TT * 4) return false;
        pg::order_unit((int)L, TT, 4, u.pm, u.pn); cls_of_tile(tst, u.pm, u.x0, u.x1); return true; }
    __device__ __forceinline__ const char* a_base(const pg::Unit& u) const { return (const char*)ACT + (size_t)u.pm * 256 * LDA; }
    __device__ __forceinline__ const char* b_base(const pg::Unit& u, int part) const { int elo, ehi; cls_experts(u.x0, elo, ehi); const int e = part ? ehi : elo;
        return (const char*)Wd + ((size_t)e * 1024 + (size_t)u.pn * 256) * LDB - (part ? (size_t)KSPLIT * 128 : 0); }
    __device__ __forceinline__ const unsigned* idx_src(const pg::Unit&) const { return nullptr; }
    __device__ __forceinline__ int valid_rows(const pg::Unit&) const { return 256; }
};

#define OPAQUE(x) asm volatile("" : "+v"(x))
#define ROWSTEP(m) ((m) == 3 ? 80 : 16)
struct EpiProj {
    bf16_t* O; const float* tab;
    __device__ __forceinline__ void operator()(const f32x4 (&acc)[2][2][4][2], const pg::Unit& u, int wr, int wc, int fr, int fq) const {
        const bool latent = u.pm < ML / 256;
        char* base = (char*)(O + (size_t)u.pm * 256 * INC + u.pn * 256);
        unsigned off = (unsigned)((wr * 64 + fr) * INC + wc * 32 + 8 * fq) * 2u; OPAQUE(off);
        int t = ((u.pm * 256) & (SEQ - 1)) + wr * 64 + fr; OPAQUE(t);
        const bool second = (fq >> 1) != 0;
#pragma unroll
        for (int ai = 0; ai < 2; ++ai)
#pragma unroll
            for (int m = 0; m < 4; ++m) { char* rowp = base + off;
                const int pos = (wc & 1) ? (t & 63) : (t >> 6);
#pragma unroll
                for (int bj = 0; bj < 2; ++bj) { f32x4 v0 = acc[ai][bj][m][0], v1 = acc[ai][bj][m][1];
                    const bool rope = latent && (u.pn == 5 || u.pn == 6 || (u.pn == 7 && bj == 0));
                    if (rope) { const float* tp = tab + pos * 16 + 8 * (fq & 1);
                        const f32x4 cs0 = *(const f32x4*)tp, cs1 = *(const f32x4*)(tp + 4), sn0 = *(const f32x4*)(tp + 2048), sn1 = *(const f32x4*)(tp + 2052);
                        f32x4 p0, p1;
#pragma unroll
                        for (int i = 0; i < 4; ++i) { p0[i] = __shfl_xor(v0[i], 32); p1[i] = __shfl_xor(v1[i], 32); }
                        if (second) { v0 = v0 * cs0 + p0 * sn0; v1 = v1 * cs1 + p1 * sn1; } else { v0 = v0 * cs0 - p0 * sn0; v1 = v1 * cs1 - p1 * sn1; } }
                    u32x4 w; w.x = cvt_pk_bf16(v0[0], v0[1]); w.y = cvt_pk_bf16(v0[2], v0[3]); w.z = cvt_pk_bf16(v1[0], v1[1]); w.w = cvt_pk_bf16(v1[2], v1[3]);
                    *(u32x4*)(rowp + bj * 256) = w; }
                off += (unsigned)(ROWSTEP(m) * INC * 2); t += ROWSTEP(m); OPAQUE(off); OPAQUE(t); }
    }
};
struct EpiPlain {
    bf16_t* O; int ldo;
    __device__ __forceinline__ void operator()(const f32x4 (&acc)[2][2][4][2], const pg::Unit& u, int wr, int wc, int fr, int fq) const {
        char* base = (char*)(O + (size_t)u.pm * 256 * ldo + u.pn * 256);
        unsigned off = (unsigned)((wr * 64 + fr) * ldo + wc * 32 + 8 * fq) * 2u; OPAQUE(off);
#pragma unroll
        for (int ai = 0; ai < 2; ++ai)
#pragma unroll
            for (int m = 0; m < 4; ++m) {
#pragma unroll
                for (int bj = 0; bj < 2; ++bj) { const f32x4 v0 = acc[ai][bj][m][0], v1 = acc[ai][bj][m][1];
                    u32x4 w; w.x = cvt_pk_bf16(v0[0], v0[1]); w.y = cvt_pk_bf16(v0[2], v0[3]); w.z = cvt_pk_bf16(v1[0], v1[1]); w.w = cvt_pk_bf16(v1[2], v1[3]);
                    *(u32x4*)(base + off + bj * 256) = w; }
                off += (unsigned)(ROWSTEP(m) * ldo * 2); OPAQUE(off); }
    }
};
struct EpiGU {
    unsigned char* ACT; const ClsRec* list; const unsigned* cnt;
    __device__ __forceinline__ void operator()(const f32x4 (&acc)[2][2][4][2], const pg::Unit& u, int wr, int wc, int fr, int fq) const {
        const int vr = (int)cnt[u.x0 * 64] - u.x1 * 256; const char* rec = (const char*)(list + (size_t)u.x0 * MT + (size_t)u.x1 * 256) + (u.pn >= 4 ? 8 : 4);
        unsigned char* base = ACT + (size_t)u.pm * 256 * 1024 + (u.pn >> 2) * 512 + (u.pn & 3) * 128;
        int r = wr * 64 + fr; OPAQUE(r); unsigned off = (unsigned)(r * 1024 + wc * 32 + 8 * fq); OPAQUE(off);
#pragma unroll
        for (int ai = 0; ai < 2; ++ai)
#pragma unroll
            for (int m = 0; m < 4; ++m) { float w = 0.f;
                if (r < vr) w = *(const float*)(rec + (size_t)r * 16);
                w *= (float)(1 << F8_SH_A);
                u32x2 pk;
#pragma unroll
                for (int bj = 0; bj < 2; ++bj) { const f32x4 g = acc[ai][bj][m][0], up = acc[ai][bj][m][1]; float o[4];
#pragma unroll
                    for (int i = 0; i < 4; ++i) o[i] = g[i] * __builtin_amdgcn_rcpf(1.0f + __builtin_amdgcn_exp2f(-LOG2E * g[i])) * up[i];
                    const unsigned v = pk4_fp8(o[0], o[1], o[2], o[3], w); if (bj == 0) pk.x = v; else pk.y = v; }
                *(u32x2*)(base + off) = pk;
                off += (unsigned)(ROWSTEP(m) * 1024); r += ROWSTEP(m); OPAQUE(off); OPAQUE(r); }
    }
};

template <bool F8 = false> __device__ __forceinline__ void p0_transpose_item(const float* W, int Kd, int N, void* WTv, LAS float* scr, int item, int lane, int mode, int sc_lo, int sc_hi, float scale) {
    bf16_t* WT = (bf16_t*)WTv;
    const int nblk = N / 32, kb = item / nblk, nb = item % nblk, k0 = 64 * kb, n0 = 32 * nb;
    f32x4 rv[8];
#pragma unroll
    for (int i = 0; i < 8; ++i) rv[i] = *(const f32x4*)(W + (size_t)(k0 + 8 * i + (lane >> 3)) * N + n0 + 4 * (lane & 7));
#pragma unroll
    for (int i = 0; i < 8; ++i) { LAS float* d = scr + (8 * i + (lane >> 3)) * 33 + 4 * (lane & 7); d[0] = rv[i].x; d[1] = rv[i].y; d[2] = rv[i].z; d[3] = rv[i].w; }
    asm volatile("s_waitcnt lgkmcnt(0)" ::: "memory");
    const int c = lane & 7;
#pragma unroll
    for (int j = 0; j < 4; ++j) { const int n = (lane >> 3) + 8 * j, ng = n0 + n; const LAS float* s = scr + (8 * c) * 33 + n;
        const float f = (ng >= sc_lo && ng < sc_hi) ? scale : 1.0f;
        const int row = mode == 0 ? ng : mode == 3 ? ((ng & ~31) + 16 * ((ng >> 2) & 1) + 4 * ((ng >> 3) & 3) + (ng & 3))
                      : (256 * (ng >> 7) + 128 * ((ng >> 2) & 1) + 32 * ((ng >> 5) & 3) + 16 * (mode == 2 ? 1 : 0) + 4 * ((ng >> 3) & 3) + (ng & 3));
        if constexpr (F8) { u32x2 o; o.x = pk4_fp8(s[0 * 33], s[1 * 33], s[2 * 33], s[3 * 33], f * (float)(1 << F8_SH_W)); o.y = pk4_fp8(s[4 * 33], s[5 * 33], s[6 * 33], s[7 * 33], f * (float)(1 << F8_SH_W));
            *(u32x2*)((unsigned char*)WTv + (size_t)row * Kd + k0 + 8 * c) = o; }
        else { u32x4 o; o.x = pk2(s[0 * 33] * f, s[1 * 33] * f); o.y = pk2(s[2 * 33] * f, s[3 * 33] * f); o.z = pk2(s[4 * 33] * f, s[5 * 33] * f); o.w = pk2(s[6 * 33] * f, s[7 * 33] * f);
            *(u32x4*)(WT + (size_t)row * Kd + k0 + 8 * c) = o; } }
    asm volatile("s_waitcnt lgkmcnt(0)" ::: "memory");
}
__device__ __forceinline__ void phase_p0a(const Ptrs& P, LAS unsigned char* lds) {
    int tid = threadIdx.x; asm volatile("" : "+v"(tid)); const int lane = tid & 63, wave = __builtin_amdgcn_readfirstlane(tid >> 6);
    const int gw = blockIdx.x * NWAVES + wave, NGW = gridDim.x * NWAVES;
    LAS float* sil = (LAS float*)(lds + 73728);
    for (int i = tid; i < 9 * D; i += NTHR) { const int j = i >> 10, k = i & (D - 1); sil[i] = silu_f(j < 8 ? P.c[j * D + k] : P.c_ctx[k]); }
    __syncthreads();
    float* modp = (float*)(P.ws + WS_MODP);
    for (int u = gw; u < DEPTH * 24 * 16; u += NGW) { const int l = u / 384, r = u % 384, nc = r / 16, ks = r % 16;
        const float* w = P.w_mod + ((size_t)l * D + ks * 64) * 6144 + nc * 256 + 4 * lane;
        f32x4 a[9];
#pragma unroll
        for (int j = 0; j < 9; ++j) a[j] = (f32x4){0.f, 0.f, 0.f, 0.f};
#pragma unroll 4
        for (int k = 0; k < 64; ++k) { const f32x4 wv = *(const f32x4*)(w + (size_t)k * 6144);
#pragma unroll
            for (int j = 0; j < 9; ++j) a[j] += wv * sil[j * D + ks * 64 + k]; }
#pragma unroll
        for (int j = 0; j < 9; ++j) *(f32x4*)(modp + (((size_t)l * 16 + ks) * 9 + j) * 6144 + nc * 256 + 4 * lane) = a[j]; }
    { const int gt = blockIdx.x * NTHR + tid, NGT = gridDim.x * NTHR; float* tab = (float*)(P.ws + WS_ROPE);
      if (gt < 2048) { const int i = gt & 15, pos = gt >> 4; const float inv = powf(10000.0f, -(float)i / 16.0f), ang = (float)pos * inv; tab[gt] = cosf(ang); tab[2048 + gt] = sinf(ang); }
      bf16_t* wsb = (bf16_t*)(P.ws + WS_WSB);
      for (int i = gt; i < DEPTH * 4 * 128 * 128; i += NGT) wsb[i] = f2bf(P.w_s[i]); }
    LAS float* scr = (LAS float*)(lds + wave * 8448);
    constexpr int PER_L = 1024 + 512 + NE * 768;
    for (int it = gw; it < DEPTH * PER_L; it += NGW) { const int l = it / PER_L; int r = it % PER_L;
        if (r < 1024) { p0_transpose_item(P.w_in + (size_t)l * D * INC, D, INC, (bf16_t*)(P.ws + WS_WIN) + (size_t)l * INC * D, scr, r, lane, 3, C_Q, C_K, QSCALE); continue; } r -= 1024;
        if (r < 512) { p0_transpose_item<true>(P.w_out + (size_t)l * D * D, D, D, P.ws + WS_WOUT + (size_t)l * D * D, scr, r, lane, 3, 0, 0, 1.f); continue; } r -= 512;
        const int e = r / 768, q = r % 768, which = q >> 8, idx = q & 255; const size_t le = (size_t)l * NE + e;
        if (which == 0) p0_transpose_item<true>(P.w_gate + le * D * DE, D, DE, P.ws + WS_WGU + le * 1024 * 1024, scr, idx, lane, 1, 0, 0, 1.f);
        else if (which == 1) p0_transpose_item<true>(P.w_up + le * D * DE, D, DE, P.ws + WS_WGU + le * 1024 * 1024, scr, idx, lane, 2, 0, 0, 1.f);
        else p0_transpose_item<true>(P.w_down + le * DE * D, DE, D, P.ws + WS_WD + le * 1024 * 512, scr, idx, lane, 3, 0, 0, 1.f); }
}
__device__ __forceinline__ void phase_p0b(const Ptrs& P) {
    const int gt = blockIdx.x * NTHR + threadIdx.x, NGT = gridDim.x * NTHR;
    const float* modp = (const float*)(P.ws + WS_MODP); float* mod = (float*)(P.ws + WS_MOD);
    for (int i = gt; i < DEPTH * 9 * 6144; i += NGT) { const int l = i / (9 * 6144), r = i % (9 * 6144), j = r / 6144, n = r % 6144;
        float s = P.b_mod[l * 6144 + n];
#pragma unroll
        for (int ks = 0; ks < 16; ++ks) s += modp[(((size_t)l * 16 + ks) * 9 + j) * 6144 + n];
        mod[i] = s; }
}

__device__ __forceinline__ void bf8_to_f32(const u32x4 v, float (&o)[8]) {
#pragma unroll
    for (int i = 0; i < 4; ++i) { o[2 * i] = __uint_as_float(v[i] << 16); o[2 * i + 1] = __uint_as_float(v[i] & 0xffff0000u); }
}
template <int R> struct NormRaw { u32x4 a[R][2], b[R][2]; int m0, nv; };
template <int MODE, bool FIRST, bool DRY = false> __device__ __forceinline__ void phase_norm(const Ptrs& P, LAS unsigned char* lds, int l, int Mrows, const bf16_t* Y, const LAS int* tst) {
    constexpr int R = MODE == 2 ? 2 : 4;
    int tid = threadIdx.x; asm volatile("" : "+v"(tid)); const int lane = tid & 63, wave = __builtin_amdgcn_readfirstlane(tid >> 6);
    const int gw = blockIdx.x * NWAVES + wave, NGW = gridDim.x * NWAVES;
    const int rpw = (Mrows + NGW - 1) / NGW;
    const int mBeg = gw * rpw, mEnd = (mBeg + rpw) < Mrows ? (mBeg + rpw) : Mrows;
    LAS float* rwT = (LAS float*)lds;
    constexpr int RPW = 72;
    LAS unsigned* recL = (LAS unsigned*)(lds + 65536);
    LAS unsigned* cntL = (LAS unsigned*)(lds + 65536 + NWAVES * RPW * 16);
    LAS unsigned* baseL = cntL + 32;
    LAS float* logL = (LAS float*)(lds + 65536 + 12288);
    if (MODE == 2) { if (tid < 64) cntL[tid] = 0u; for (int i = tid; i < D * NE; i += NTHR) rwT[(i & 15) * D + (i >> 4)] = P.router_w[i]; __syncthreads(); }
    const float* g = (MODE == 1 ? P.norm1_g + l * D : MODE == 2 ? P.norm2_g + l * D : P.final_g);
    f32x4 gg[2][2];
#pragma unroll
    for (int j = 0; j < 2; ++j) { gg[j][0] = (f32x4){0.f, 0.f, 0.f, 0.f}; gg[j][1] = gg[j][0]; if (MODE == 3) { gg[j][0] = *(const f32x4*)(g + 8 * lane + 512 * j); gg[j][1] = *(const f32x4*)(g + 8 * lane + 512 * j + 4); } }
    bf16_t* XB = (bf16_t*)(P.ws + WS_XB);
    unsigned posreg = 0u;
    if (MODE != 2 && !FIRST) { if (mBeg + lane < mEnd) posreg = ((const unsigned*)(P.ws + WS_POS))[mBeg + lane]; }
    f32x4 gt[2][2], scv[2][2], shv[2][2];
#pragma unroll
    for (int j = 0; j < 2; ++j)
#pragma unroll
        for (int q = 0; q < 2; ++q) { gt[j][q] = (f32x4){0.f, 0.f, 0.f, 0.f}; scv[j][q] = gt[j][q]; shv[j][q] = gt[j][q]; }
#define NR_LOAD(G, mstart) do { (G).m0 = (mstart); { const int bnd_ = (((mstart) >> 13) + 1) << 13; const int ge_ = bnd_ < mEnd ? bnd_ : mEnd; (G).nv = (ge_ - (mstart)) < R ? (ge_ - (mstart)) : R; } \
        _Pragma("unroll") for (int r = 0; r < R; ++r) { const int m = (G).m0 + (r < (G).nv ? r : (G).nv - 1); \
            if (FIRST) { const float* xr = m < ML ? P.x + (size_t)m * D : P.ctx + (size_t)(m - ML) * D; \
                _Pragma("unroll") for (int j = 0; j < 2; ++j) { (G).a[r][j] = *(const u32x4*)(xr + 8 * lane + 512 * j); (G).b[r][j] = *(const u32x4*)(xr + 8 * lane + 512 * j + 4); } \
            } else { size_t yrow = (size_t)m; \
                if (MODE != 2) { const unsigned ps = (unsigned)__builtin_amdgcn_readlane((int)posreg, m - mBeg); yrow = (size_t)tst[ps & 255u] * 256 + (ps >> 8); } \
                const bf16_t* yr = Y + yrow * D; \
                _Pragma("unroll") for (int j = 0; j < 2; ++j) { (G).a[r][j] = *(const u32x4*)(XB + (size_t)m * D + 8 * lane + 512 * j); (G).b[r][j] = *(const u32x4*)(yr + 8 * lane + 512 * j); } } } } while (0)
    NormRaw<R> G; G.m0 = mBeg; G.nv = 0;
    if (mBeg < mEnd) NR_LOAD(G, mBeg);
    bool more = mBeg < mEnd;
    while (more) {
        const int m0 = G.m0, nv = G.nv;
        float xv[R][2][8]; float ss[R];
        { const int mb = modrow(m0);
            {
                const float* modl = (const float*)(P.ws + WS_MOD) + ((size_t)l * 9 + mb) * 6144;
                const float* gate = MODE == 2 ? modl + 2048 : (const float*)(P.ws + WS_MOD) + ((size_t)(MODE == 3 ? 3 : (l > 0 ? l - 1 : 0)) * 9 + mb) * 6144 + 5120;
                const float* sh = modl + (MODE == 1 ? 0 : 3072); const float* sc = modl + (MODE == 1 ? 1024 : 4096);
#pragma unroll
                for (int j = 0; j < 2; ++j)
#pragma unroll
                    for (int q = 0; q < 2; ++q) { const int c = 8 * lane + 512 * j + 4 * q; gt[j][q] = *(const f32x4*)(gate + c); scv[j][q] = (*(const f32x4*)(sc + c) + 1.0f) * *(const f32x4*)(g + c); shv[j][q] = *(const f32x4*)(sh + c); } } }
#pragma unroll
        for (int r = 0; r < R; ++r) { const int m = m0 + (r < nv ? r : nv - 1);
#pragma unroll
            for (int j = 0; j < 2; ++j) {
                if (FIRST) { const f32x4 a = __builtin_bit_cast(f32x4, G.a[r][j]), b = __builtin_bit_cast(f32x4, G.b[r][j]);
                    xv[r][j][0] = a.x; xv[r][j][1] = a.y; xv[r][j][2] = a.z; xv[r][j][3] = a.w; xv[r][j][4] = b.x; xv[r][j][5] = b.y; xv[r][j][6] = b.z; xv[r][j][7] = b.w;
                } else { float xf[8], yf[8]; bf8_to_f32(G.a[r][j], xf); bf8_to_f32(G.b[r][j], yf);
#pragma unroll
                    for (int i = 0; i < 8; ++i) xv[r][j][i] = xf[i] + gt[j][i >> 2][i & 3] * yf[i]; } }
            if (MODE != 3 && r < nv) {
#pragma unroll
                for (int j = 0; j < 2; ++j) { u32x4 w; w.x = cvt_pk_bf16(xv[r][j][0], xv[r][j][1]); w.y = cvt_pk_bf16(xv[r][j][2], xv[r][j][3]); w.z = cvt_pk_bf16(xv[r][j][4], xv[r][j][5]); w.w = cvt_pk_bf16(xv[r][j][6], xv[r][j][7]);
                    *(u32x4*)(XB + (size_t)m * D + 8 * lane + 512 * j) = w; } }
            float s = 0.f;
#pragma unroll
            for (int j = 0; j < 2; ++j)
#pragma unroll
                for (int i = 0; i < 8; ++i) s += xv[r][j][i] * xv[r][j][i];
            ss[r] = s;
            if (MODE != 3) {
#pragma unroll
                for (int j = 0; j < 2; ++j)
#pragma unroll
                    for (int i = 0; i < 8; ++i) xv[r][j][i] = xv[r][j][i] * scv[j][i >> 2][i & 3];
            } }
        { const int nm0 = m0 + nv; more = nm0 < mEnd; if (more) NR_LOAD(G, nm0); }
#pragma unroll
        for (int o = 1; o < 64; o <<= 1) {
#pragma unroll
            for (int r = 0; r < R; ++r) ss[r] += __shfl_xor(ss[r], o); }
#pragma unroll
        for (int r = 0; r < R; ++r) { const int m = m0 + r; const float rinv = rsqrtf(ss[r] * (1.0f / D) + EPS);
            if (MODE == 3) { if (r < nv) { float* orow = P.out + (size_t)m * D;
#pragma unroll
                for (int j = 0; j < 2; ++j) { f32x4 a, b; a.x = xv[r][j][0]; a.y = xv[r][j][1]; a.z = xv[r][j][2]; a.w = xv[r][j][3]; b.x = xv[r][j][4]; b.y = xv[r][j][5]; b.z = xv[r][j][6]; b.w = xv[r][j][7];
                    *(f32x4*)(orow + 8 * lane + 512 * j) = a * rinv * gg[j][0]; *(f32x4*)(orow + 8 * lane + 512 * j + 4) = b * rinv * gg[j][1]; } }
            } else {
#pragma unroll
                for (int j = 0; j < 2; ++j)
#pragma unroll
                    for (int i = 0; i < 8; ++i) xv[r][j][i] = xv[r][j][i] * rinv + shv[j][i >> 2][i & 3];
                if (r < nv) {
                    if (MODE == 2) { unsigned char* H8 = (unsigned char*)(P.ws + WS_H) + (size_t)m * D;
#pragma unroll
                        for (int j = 0; j < 2; ++j) { u32x2 o; o.x = pk4_fp8(xv[r][j][0], xv[r][j][1], xv[r][j][2], xv[r][j][3], (float)(1 << F8_SH_H)); o.y = pk4_fp8(xv[r][j][4], xv[r][j][5], xv[r][j][6], xv[r][j][7], (float)(1 << F8_SH_H)); *(u32x2*)(H8 + 8 * lane + 512 * j) = o; }
                    } else { bf16_t* H = (bf16_t*)(P.ws + WS_H) + (size_t)m * D;
#pragma unroll
                        for (int j = 0; j < 2; ++j) { u32x4 o; o.x = cvt_pk_bf16(xv[r][j][0], xv[r][j][1]); o.y = cvt_pk_bf16(xv[r][j][2], xv[r][j][3]); o.z = cvt_pk_bf16(xv[r][j][4], xv[r][j][5]); o.w = cvt_pk_bf16(xv[r][j][6], xv[r][j][7]); *(u32x4*)(H + 8 * lane + 512 * j) = o; } } }
            } }
        if (MODE == 2) {
            typedef float f32x2r __attribute__((ext_vector_type(2)));
            static_assert(MODE != 2 || R == 2, "the packed router pairs the two rows of a group");
            f32x2r lg2[16];
#pragma unroll
            for (int e = 0; e < 16; ++e) lg2[e] = (f32x2r){0.f, 0.f};
#pragma unroll
            for (int j = 0; j < 2; ++j) { const int c = 8 * lane + 512 * j;
                f32x2r x2[8];
#pragma unroll
                for (int i = 0; i < 8; ++i) x2[i] = (f32x2r){xv[0][j][i], xv[1][j][i]};
#pragma unroll
                for (int e4 = 0; e4 < 4; ++e4) {
#pragma unroll
                    for (int e = 4 * e4; e < 4 * e4 + 4; ++e) { const f32x4 r0 = *(const LAS f32x4*)(rwT + e * D + c), r1 = *(const LAS f32x4*)(rwT + e * D + c + 4);
                        lg2[e] += x2[0] * r0.x + x2[1] * r0.y + x2[2] * r0.z + x2[3] * r0.w + x2[4] * r1.x + x2[5] * r1.y + x2[6] * r1.z + x2[7] * r1.w; }
                    __builtin_amdgcn_sched_barrier(0); } }
#pragma unroll
            for (int r = 0; r < R; ++r) {
                float lg[16];
#pragma unroll
                for (int e = 0; e < 16; ++e) lg[e] = r == 0 ? lg2[e].x : lg2[e].y;
                float v8[8], v4[4], v2[2], v1;
                { const bool up = (lane & 32) != 0;
#pragma unroll
                  for (int i = 0; i < 8; ++i) { const float send = up ? lg[i] : lg[i + 8]; const float keep = up ? lg[i + 8] : lg[i]; v8[i] = keep + __shfl_xor(send, 32); } }
                { const bool up = (lane & 16) != 0;
#pragma unroll
                  for (int i = 0; i < 4; ++i) { const float send = up ? v8[i] : v8[i + 4]; const float keep = up ? v8[i + 4] : v8[i]; v4[i] = keep + __shfl_xor(send, 16); } }
                { const bool up = (lane & 8) != 0;
#pragma unroll
                  for (int i = 0; i < 2; ++i) { const float send = up ? v4[i] : v4[i + 2]; const float keep = up ? v4[i + 2] : v4[i]; v2[i] = keep + __shfl_xor(send, 8); } }
                { const bool up = (lane & 4) != 0; const float send = up ? v2[0] : v2[1]; const float keep = up ? v2[1] : v2[0]; v1 = keep + __shfl_xor(send, 4); }
                v1 += __shfl_xor(v1, 2); v1 += __shfl_xor(v1, 1);
                if ((lane & 3) == 0 && r < nv) logL[(wave * RPW + (m0 - mBeg) + r) * 16 + (lane >> 2)] = v1;
            }
        }
    }
#undef NR_LOAD
    if (MODE == 2 && !DRY) {
        asm volatile("s_waitcnt lgkmcnt(0)" ::: "memory");
        if (lane < mEnd - mBeg) {
            float sco[16], sel[16];
#pragma unroll
            for (int e4 = 0; e4 < 4; ++e4) { const f32x4 v = *(const LAS f32x4*)(logL + (wave * RPW + lane) * 16 + 4 * e4);
#pragma unroll
                for (int i = 0; i < 4; ++i) { const int e = 4 * e4 + i; sco[e] = 1.0f / (1.0f + __expf(-v[i])); sel[e] = sco[e] + P.router_b[e]; } }
            int bg = 0; float bgs = -1e30f; int ba = 0, bb = 1; float sa = 0.f, sb = 0.f;
#pragma unroll
            for (int gI = 0; gI < 4; ++gI) {
                int i1 = 0; float v1 = sel[gI * 4], c1 = sco[gI * 4];
#pragma unroll
                for (int i = 1; i < 4; ++i) if (sel[gI * 4 + i] > v1) { v1 = sel[gI * 4 + i]; c1 = sco[gI * 4 + i]; i1 = i; }
                int i2 = -1; float v2 = -1e30f, c2 = 0.f;
#pragma unroll
                for (int i = 0; i < 4; ++i) if (i != i1 && sel[gI * 4 + i] > v2) { v2 = sel[gI * 4 + i]; c2 = sco[gI * 4 + i]; i2 = i; }
                const float gs = v1 + v2;
                if (gs > bgs) { bgs = gs; bg = gI; ba = i1; bb = i2; sa = c1; sb = c2; }
            }
            const int a = ba < bb ? ba : bb, b = ba < bb ? bb : ba;
            const float wl = ba < bb ? sa : sb, wh = ba < bb ? sb : sa, inv = 1.0f / (wl + wh);
            const int pairidx = (a == 0) ? (b - 1) : (a == 1 ? (b + 1) : 5);
            const int cls = bg * 6 + pairidx;
            const unsigned pl = __hip_atomic_fetch_add(cntL + cls, 1u, __ATOMIC_RELAXED, __HIP_MEMORY_SCOPE_WORKGROUP);
            LAS unsigned* rb = recL + (wave * RPW + lane) * 4; rb[0] = (unsigned)(mBeg + lane); rb[1] = __float_as_uint(wl * inv); rb[2] = __float_as_uint(wh * inv); rb[3] = (unsigned)cls | (pl << 8);
        }
        asm volatile("s_waitcnt lgkmcnt(0)" ::: "memory"); __syncthreads();
        unsigned* ctl = (unsigned*)(P.ws + WS_CTL);
        if (tid < NCLS) { const unsigned n = cntL[tid]; baseL[tid] = n ? atomicAdd(ctl + CW_CNTF + (l * 32 + tid) * 64, n) : 0u; }
        __syncthreads();
        ClsRec* listr = (ClsRec*)(P.ws + WS_LISTR); unsigned* posw = (unsigned*)(P.ws + WS_POS);
        for (int i = tid; i < NWAVES * RPW; i += NTHR) { const int w = i / RPW, r = i % RPW; const int wb = (blockIdx.x * NWAVES + w) * rpw; const int nw = (wb + rpw < Mrows ? wb + rpw : Mrows) - wb;
            if (r < nw) { const LAS unsigned* rb = recL + i * 4; const unsigned cls = rb[3] & 255u, pl = rb[3] >> 8, gp = baseL[cls] + pl;
                ClsRec rc; rc.m = (int)rb[0]; rc.wlo = __uint_as_float(rb[1]); rc.whi = __uint_as_float(rb[2]); rc.pad = 0;
                listr[(size_t)cls * MT + gp] = rc; posw[rb[0]] = cls | (gp << 8); } }
    }
}
__device__ __forceinline__ void build_tile_table(const Ptrs& P, LAS int* tst, int l) {
    if (threadIdx.x < 64) {
        int lane = threadIdx.x; asm volatile("" : "+v"(lane));
        const unsigned* cnt = (const unsigned*)(P.ws + WS_CTL) + CW_CNTF + l * 32 * 64;
        const int tiles = lane < NCLS ? (int)((__hip_atomic_load(cnt + lane * 64, __ATOMIC_RELAXED, __HIP_MEMORY_SCOPE_AGENT) + 255u) >> 8) : 0;
        int incl = tiles;
#pragma unroll
        for (int o = 1; o < 32; o <<= 1) { const int t = __shfl_up(incl, o); if (lane >= o) incl += t; }
        if (lane <= NCLS) tst[lane] = incl - tiles;
    }
    __syncthreads();
}
namespace mx {
typedef float f32x16 __attribute__((ext_vector_type(16)));
typedef short s16x4 __attribute__((ext_vector_type(4)));
constexpr int SLOTB = 8192;
constexpr int L_K = 0, L_V = 2 * SLOTB, L_WS = 4 * SLOTB, L_OST = L_WS + NWAVES * 256, L_END = L_OST + NWAVES * 4096;
constexpr int VT_PITCH = 136;
__device__ __forceinline__ int crow(int r, int hi) { return (r & 3) + 8 * (r >> 2) + 4 * hi; }
__device__ __forceinline__ unsigned cvtpk(float lo, float hi) { unsigned r; asm volatile("v_cvt_pk_bf16_f32 %0, %1, %2" : "=v"(r) : "v"(lo), "v"(hi)); return r; }
__device__ __forceinline__ float gelu_fast(float x) { const float y = x + 0.044715f * x * x * x; return x * __builtin_amdgcn_rcpf(1.0f + __builtin_amdgcn_exp2f(-2.302208198f * y)); }

__device__ __forceinline__ void qkt(f32x16& p0, f32x16& p1, const LAS unsigned char* Kslot, const bf16x8* qr, const f32x16& negm, int r32, int hi) {
    const LAS unsigned char* kb = Kslot + hi * 1024 + r32 * 16;
#pragma unroll
    for (int d0 = 0; d0 < 4; ++d0) {
        const bf16x8 b0 = *(const LAS bf16x8*)(kb + d0 * 2048), b1 = *(const LAS bf16x8*)(kb + d0 * 2048 + 512);
        if (d0 == 0) { p0 = __builtin_amdgcn_mfma_f32_32x32x16_bf16(b0, qr[0], negm, 0, 0, 0); p1 = __builtin_amdgcn_mfma_f32_32x32x16_bf16(b1, qr[0], negm, 0, 0, 0); }
        else { p0 = __builtin_amdgcn_mfma_f32_32x32x16_bf16(b0, qr[d0], p0, 0, 0, 0); p1 = __builtin_amdgcn_mfma_f32_32x32x16_bf16(b1, qr[d0], p1, 0, 0, 0); } }
}
__device__ __forceinline__ void pv(f32x16* o, unsigned vb, bf16x8 pa0, bf16x8 pa1, bf16x8 pa2, bf16x8 pa3) {
#pragma unroll
    for (int d0 = 0; d0 < 2; ++d0) { s16x4 lo[4], hi[4];
#pragma unroll
        for (int ks = 0; ks < 4; ++ks) {
            asm volatile("ds_read_b64_tr_b16 %0, %1 offset:%c2" : "=&v"(lo[ks]) : "v"(vb), "i"(d0 * 4096 + ks * 1024) : "memory");
            asm volatile("ds_read_b64_tr_b16 %0, %1 offset:%c2" : "=&v"(hi[ks]) : "v"(vb), "i"(d0 * 4096 + ks * 1024 + 512) : "memory"); }
        asm volatile("s_waitcnt lgkmcnt(0)" ::: "memory"); __builtin_amdgcn_sched_barrier(0);
#define MX_PK(k) (bf16x8){lo[k][0], lo[k][1], lo[k][2], lo[k][3], hi[k][0], hi[k][1], hi[k][2], hi[k][3]}
        o[d0] = __builtin_amdgcn_mfma_f32_32x32x16_bf16(pa0, MX_PK(0), o[d0], 0, 0, 0);
        o[d0] = __builtin_amdgcn_mfma_f32_32x32x16_bf16(pa1, MX_PK(1), o[d0], 0, 0, 0);
        o[d0] = __builtin_amdgcn_mfma_f32_32x32x16_bf16(pa2, MX_PK(2), o[d0], 0, 0, 0);
        o[d0] = __builtin_amdgcn_mfma_f32_32x32x16_bf16(pa3, MX_PK(3), o[d0], 0, 0, 0);
#undef MX_PK
    }
}
struct ConvRaw { u32x4 bg, c0, c1, c2, z0, z1, z2; };
__device__ __forceinline__ void conv_load(ConvRaw& R, const bf16_t* PROJ, int m0, int tid, int q) {
    const int seqmask = m0 < ML ? SEQ - 1 : CTXL - 1; const int mrel = m0 < ML ? m0 : m0 - ML;
    const int idx = q * NTHR + tid, row = idx >> 5, c = (idx & 31) * 8;
    const int t = (mrel + row) & seqmask; const bf16_t* pr = PROJ + (size_t)(m0 + row) * INC;
    R.bg = *(const u32x4*)(pr + C_BG + c); R.c1 = *(const u32x4*)(pr + C_CG + c); R.z1 = *(const u32x4*)(pr + C_Z + c);
    R.c0 = (u32x4){0u, 0u, 0u, 0u}; R.z0 = R.c0; R.c2 = R.c0; R.z2 = R.c0;
    if (t > 0) { R.c0 = *(const u32x4*)(pr - INC + C_CG + c); R.z0 = *(const u32x4*)(pr - INC + C_Z + c); }
    if (t < seqmask) { R.c2 = *(const u32x4*)(pr + INC + C_CG + c); R.z2 = *(const u32x4*)(pr + INC + C_Z + c); }
}
__device__ __forceinline__ void conv_finish(const ConvRaw& R, const float* cwl, unsigned char* MIXo, int m0, int tid, int q) {
    const int idx = q * NTHR + tid, row = idx >> 5, c = (idx & 31) * 8;
    const float* cw = cwl + c;
    float o[8];
#pragma unroll
    for (int i = 0; i < 8; ++i) { const int wI = i >> 1; const bool up = i & 1;
#define MX_BF(v) (up ? __uint_as_float((v)[wI] & 0xffff0000u) : __uint_as_float((v)[wI] << 16))
        const float y = MX_BF(R.c0) * MX_BF(R.z0) * cw[i] + MX_BF(R.c1) * MX_BF(R.z1) * cw[256 + i] + MX_BF(R.c2) * MX_BF(R.z2) * cw[512 + i];
        o[i] = MX_BF(R.bg) * y;
#undef MX_BF
    }
    u32x2 w; w.x = pk4_fp8(o[0], o[1], o[2], o[3], (float)(1 << F8_SH_M)); w.y = pk4_fp8(o[4], o[5], o[6], o[7], (float)(1 << F8_SH_M));
    *(u32x2*)(MIXo + (size_t)(m0 + row) * D + 256 + c) = w;
}
constexpr int NSLOT = 4;
constexpr int ATT_THR = 8;
typedef float f32x2 __attribute__((ext_vector_type(2)));
#define MX3(a, b, c) __builtin_fmaxf(__builtin_fmaxf((a), (b)), (c))
constexpr int A_K = 0, A_V = NSLOT * SLOTB, A_WS = 2 * NSLOT * SLOTB, A_OST = A_WS + NWAVES * 512, A_END = A_OST + NWAVES * 4096;
template <int NH> __device__ __forceinline__ void attn_unit(const bf16_t* PROJ, unsigned char* MIXo, const float* sink, const float* cwl, LAS unsigned char* shm, int latent, int b, int blk, int kvh, int hp, int tid) {
    const int lane = tid & 63, r32 = lane & 31, hi = lane >> 5; const int wid = __builtin_amdgcn_readfirstlane(tid >> 6);
    const int head0 = NH == 2 ? kvh * 4 + (wid >> 2) * 2 : kvh * 4 + hp * 2 + (wid >> 2), qw = (wid & 3) * 32;
    const int qrow0 = latent ? b * SEQ + blk * 128 : ML + b * CTXL + blk * 128;
    const int ctx0 = ML + b * CTXL;
    const int lt_lo = latent ? (blk > 0 ? 0 : 2) : 0, lt_hi = latent ? (blk < SEQ / 128 - 1 ? 6 : 4) : 0;
    const int NT = 4 + (lt_hi - lt_lo);
    LAS float* wsf = (LAS float*)(shm + A_WS) + wid * 128;
    const bf16_t* kcol = PROJ + C_K + kvh * 64 + wid * 8;
    const bf16_t* vcol = PROJ + C_VV + kvh * 64 + (wid >> 2) * 32 + (lane & 3) * 8;
#define MX_TROW(t) ((t) < 4 ? ctx0 + 64 * (t) : b * SEQ + blk * 128 - 128 + 64 * ((t) - 4 + lt_lo))
#define MX_DMA(t) do { const int _r0 = MX_TROW(t); const int _sl = (t) & (NSLOT - 1); \
        __builtin_amdgcn_global_load_lds((const unsigned*)(kcol + (size_t)(_r0 + lane) * INC), (LAS unsigned*)(shm + A_K + _sl * SLOTB + wid * 1024), 16, 0, 0); \
        __builtin_amdgcn_global_load_lds((const unsigned*)(vcol + (size_t)(_r0 + 16 * (wid & 3) + (lane >> 2)) * INC), (LAS unsigned*)(shm + A_V + _sl * SLOTB + wid * 1024), 16, 0, 0); } while (0)
    static_assert(NH == 1, "the conv slice deal assumes four attention units per chunk");
    const int cm0 = qrow0 + (kvh * 2 + hp) * 32;
    ConvRaw CR; conv_load(CR, PROJ, cm0, tid, 0);
    bf16x8 qr[NH][4];
    { const bf16_t* qp = PROJ + (size_t)(qrow0 + qw + r32) * INC + C_Q + head0 * 64 + hi * 8;
#pragma unroll
      for (int hh = 0; hh < NH; ++hh)
#pragma unroll
          for (int d0 = 0; d0 < 4; ++d0) qr[hh][d0] = *(const bf16x8*)(qp + hh * 64 + d0 * 16); }
    MX_DMA(0); MX_DMA(1); MX_DMA(2);
    float mrun[NH], lsum[NH]; f32x16 o[NH][2], negm[NH];
#pragma unroll
    for (int hh = 0; hh < NH; ++hh) { mrun[hh] = sink[head0 + hh] * LOG2E; lsum[hh] = hi == 0 ? 1.0f : 0.0f;
#pragma unroll
        for (int r = 0; r < 16; ++r) negm[hh][r] = -mrun[hh];
        o[hh][0] = (f32x16){0.f, 0.f, 0.f, 0.f, 0.f, 0.f, 0.f, 0.f, 0.f, 0.f, 0.f, 0.f, 0.f, 0.f, 0.f, 0.f}; o[hh][1] = o[hh][0]; }
    const unsigned vb0 = (unsigned)(size_t)(shm + A_V) + ((lane >> 4) & 1) * 32 + (lane & 3) * 8 + (4 * hi + ((lane & 15) >> 2)) * 64;
    const int qc = qw + r32;
    for (int t = 0; t < NT; ++t) {
        const int slot = t & (NSLOT - 1);
        if (t + 2 < NT) asm volatile("s_waitcnt vmcnt(4)" ::: "memory"); else if (t + 1 < NT) asm volatile("s_waitcnt vmcnt(2)" ::: "memory"); else asm volatile("s_waitcnt vmcnt(0)" ::: "memory");
        asm volatile("s_waitcnt lgkmcnt(0)\n\ts_barrier" ::: "memory");
        if (t + 3 < NT) MX_DMA(t + 3);
        if (t == 3) { conv_finish(CR, cwl, MIXo, cm0, tid, 0); conv_load(CR, PROJ, cm0, tid, 1); }
        bool masked = false; int kb = 0;
        if (t >= 4) { const int lt = t - 4 + lt_lo; masked = (lt < 2 || lt >= 4); kb = -128 + 64 * lt; }
        const bool dead = masked && ((kb == -128 && qw >= 64) || (kb == 192 && qw < 64));
        if (!dead) {
#pragma unroll
        for (int hh = 0; hh < NH; ++hh) {
            f32x16 p0, p1;
            qkt(p0, p1, shm + A_K + slot * SLOTB, qr[hh], negm[hh], r32, hi);
            if (masked) {
#pragma unroll
                for (int r = 0; r < 16; ++r) { const int k0 = kb + crow(r, hi), k1 = k0 + 32;
                    if (k0 < qc - 128 || k0 > qc + 128) p0[r] = -1e30f; if (k1 < qc - 128 || k1 > qc + 128) p1[r] = -1e30f; } }
            float ma = MX3(p0[0], p0[1], p1[0]), mb = MX3(p0[2], p0[3], p1[1]); ma = MX3(ma, p1[2], p1[3]);
#pragma unroll
            for (int r = 4; r < 16; r += 4) { ma = MX3(ma, p0[r], p0[r + 1]); mb = MX3(mb, p0[r + 2], p0[r + 3]); ma = MX3(ma, p1[r], p1[r + 1]); mb = MX3(mb, p1[r + 2], p1[r + 3]); }
            float rm = __builtin_fmaxf(ma, mb);
            { auto rr = __builtin_amdgcn_permlane32_swap(__float_as_uint(rm), __float_as_uint(rm), false, false); rm = __builtin_fmaxf(__uint_as_float(rr[0]), __uint_as_float(rr[1])); }
            if (__any(rm > (float)ATT_THR)) { const float dl = __builtin_fmaxf(rm, 0.f); mrun[hh] += dl;
#pragma unroll
                for (int r = 0; r < 16; ++r) { p0[r] -= dl; p1[r] -= dl; negm[hh][r] = -mrun[hh]; }
                const float f = __builtin_amdgcn_exp2f(-dl); lsum[hh] *= f; if (hi == 0) wsf[hh * 64 + r32] = f;
                asm volatile("s_waitcnt lgkmcnt(0)" ::: "memory");
#pragma unroll
                for (int r = 0; r < 16; ++r) { const float fr_ = *(volatile LAS float*)(wsf + hh * 64 + crow(r, hi)); o[hh][0][r] *= fr_; o[hh][1][r] *= fr_; } }
#pragma unroll
            for (int r = 0; r < 16; ++r) { p0[r] = __builtin_amdgcn_exp2f(p0[r]); p1[r] = __builtin_amdgcn_exp2f(p1[r]); }
            { f32x2 s2 = (f32x2){p0[0], p0[1]} + (f32x2){p1[0], p1[1]};
#pragma unroll
              for (int r = 2; r < 16; r += 2) { s2 += (f32x2){p0[r], p0[r + 1]}; s2 += (f32x2){p1[r], p1[r + 1]}; }
              lsum[hh] += s2.x + s2.y; }
            u32x4 pw0, pw1, pw2, pw3;
#pragma unroll
            for (int i = 0; i < 4; ++i) { pw0[i] = cvtpk(p0[2 * i], p0[2 * i + 1]); pw1[i] = cvtpk(p0[8 + 2 * i], p0[8 + 2 * i + 1]); pw2[i] = cvtpk(p1[2 * i], p1[2 * i + 1]); pw3[i] = cvtpk(p1[8 + 2 * i], p1[8 + 2 * i + 1]); }
            pv(o[hh], vb0 + slot * SLOTB, __builtin_bit_cast(bf16x8, pw0), __builtin_bit_cast(bf16x8, pw1), __builtin_bit_cast(bf16x8, pw2), __builtin_bit_cast(bf16x8, pw3));
            __builtin_amdgcn_sched_barrier(0);
        }
        }
    }
    LAS unsigned char* stg = (LAS unsigned char*)(shm + A_OST) + wid * 2048;
#pragma unroll
    for (int hh = 0; hh < NH; ++hh) {
        float ls = lsum[hh];
        { auto rr = __builtin_amdgcn_permlane32_swap(__float_as_uint(ls), __float_as_uint(ls), false, false); ls = __uint_as_float(rr[0]) + __uint_as_float(rr[1]); }
        if (hi == 0) wsf[hh * 64 + 32 + r32] = ls;
        asm volatile("s_waitcnt lgkmcnt(0)" ::: "memory");
#pragma unroll
        for (int r = 0; r < 16; ++r) { const int orow = crow(r, hi); const float rl = __builtin_amdgcn_rcpf(*(volatile LAS float*)(wsf + hh * 64 + 32 + orow)) * (float)(1 << F8_SH_M);
            const unsigned w = pk4_fp8(o[hh][0][r], o[hh][1][r], 0.f, 0.f, rl); stg[orow * 64 + r32] = (unsigned char)(w & 0xffu); stg[orow * 64 + 32 + r32] = (unsigned char)((w >> 8) & 0xffu); }
        asm volatile("s_waitcnt lgkmcnt(0)" ::: "memory");
        unsigned char* op = MIXo + (size_t)(qrow0 + qw) * D + 512 + (head0 + hh) * 64;
#pragma unroll
        for (int i = 0; i < 2; ++i) { const int row = i * 16 + (lane >> 2), ch = lane & 3; const u32x4 v = *(const LAS u32x4*)(stg + row * 64 + ch * 16); *(u32x4*)(op + (size_t)row * D + ch * 16) = v; }
        asm volatile("s_waitcnt lgkmcnt(0)" ::: "memory");
    }
    conv_finish(CR, cwl, MIXo, cm0, tid, 1);
    asm volatile("s_barrier" ::: "memory");
#undef MX_DMA
#undef MX_TROW
}

__device__ __forceinline__ void gmlp_conv_unit(const Ptrs& P, const bf16_t* PROJ, unsigned char* MIXo, LAS unsigned char* shm, int l, int m0, int tid) {
    const int lane = tid & 63, r32 = lane & 31, hi = lane >> 5; const int wid = __builtin_amdgcn_readfirstlane(tid >> 6);
    LAS bf16_t* vT = (LAS bf16_t*)shm;
    { u32x2 raw[16];
#pragma unroll
      for (int rr = 0; rr < 16; ++rr) raw[rr] = *(const u32x2*)(PROJ + (size_t)(m0 + wid * 16 + rr) * INC + C_V + 4 * lane);
      float gv[4];
#pragma unroll
      for (int i = 0; i < 4; ++i) gv[i] = P.gmlp_g[l * 256 + 4 * lane + i];
#pragma unroll
      for (int r4 = 0; r4 < 4; ++r4) { float g[4][4], ss[4];
#pragma unroll
          for (int q = 0; q < 4; ++q) { const u32x2 w = raw[r4 * 4 + q];
              g[q][0] = gelu_fast(__uint_as_float(w.x << 16)); g[q][1] = gelu_fast(__uint_as_float(w.x & 0xffff0000u)); g[q][2] = gelu_fast(__uint_as_float(w.y << 16)); g[q][3] = gelu_fast(__uint_as_float(w.y & 0xffff0000u));
              ss[q] = g[q][0] * g[q][0] + g[q][1] * g[q][1] + g[q][2] * g[q][2] + g[q][3] * g[q][3]; }
#pragma unroll
          for (int o = 1; o < 64; o <<= 1) {
#pragma unroll
              for (int q = 0; q < 4; ++q) ss[q] += __shfl_xor(ss[q], o); }
          float rinv[4];
#pragma unroll
          for (int q = 0; q < 4; ++q) rinv[q] = rsqrtf(ss[q] * (1.0f / 256.0f) + EPS);
#pragma unroll
          for (int i = 0; i < 4; ++i) { u32x2 w; w.x = cvtpk(g[0][i] * rinv[0] * gv[i], g[1][i] * rinv[1] * gv[i]); w.y = cvtpk(g[2][i] * rinv[2] * gv[i], g[3][i] * rinv[3] * gv[i]);
              *(LAS u32x2*)(vT + (4 * lane + i) * VT_PITCH + wid * 16 + r4 * 4) = w; } } }
    asm volatile("s_waitcnt lgkmcnt(0)\n\ts_barrier" ::: "memory");
    { const int h = wid >> 1, dt = wid & 1;
      const bf16_t* wsb = (const bf16_t*)(P.ws + WS_WSB) + ((size_t)(l * 4 + h) * 128) * 128 + (size_t)r32 * 128 + hi * 8;
      bf16x8 bfr[2][8];
#pragma unroll
      for (int kk = 0; kk < 8; ++kk) bfr[0][kk] = *(const bf16x8*)(wsb + kk * 16);
      u32x2 uraw[4][4];
#pragma unroll
      for (int pt = 0; pt < 4; ++pt)
#pragma unroll
          for (int q4 = 0; q4 < 4; ++q4) uraw[pt][q4] = *(const u32x2*)(PROJ + (size_t)(m0 + pt * 32 + r32) * INC + C_U + h * 64 + dt * 32 + 4 * hi + 8 * q4);
      bf16x8 af[8];
#pragma unroll
      for (int kk = 0; kk < 8; ++kk) af[kk] = *(const LAS bf16x8*)(vT + (h * 64 + dt * 32 + r32) * VT_PITCH + kk * 16 + hi * 8);
      const float* bs = P.b_s + (l * 4 + h) * 128;
#pragma unroll
      for (int pt = 0; pt < 4; ++pt) {
          if (pt < 3) {
#pragma unroll
              for (int kk = 0; kk < 8; ++kk) bfr[(pt + 1) & 1][kk] = *(const bf16x8*)(wsb + (size_t)(pt + 1) * 32 * 128 + kk * 16); }
          f32x16 acc = (f32x16){0.f, 0.f, 0.f, 0.f, 0.f, 0.f, 0.f, 0.f, 0.f, 0.f, 0.f, 0.f, 0.f, 0.f, 0.f, 0.f};
#pragma unroll
          for (int kk = 0; kk < 8; ++kk) acc = __builtin_amdgcn_mfma_f32_32x32x16_bf16(af[kk], bfr[pt & 1][kk], acc, 0, 0, 0);
          const int p = pt * 32 + r32; const float bias = bs[p];
          unsigned char* op = MIXo + (size_t)(m0 + p) * D + h * 64 + dt * 32 + 4 * hi;
#pragma unroll
          for (int q4 = 0; q4 < 4; ++q4) { const u32x2 raw = uraw[pt][q4];
              const float u0 = gelu_fast(__uint_as_float(raw.x << 16)), u1 = gelu_fast(__uint_as_float(raw.x & 0xffff0000u)), u2 = gelu_fast(__uint_as_float(raw.y << 16)), u3 = gelu_fast(__uint_as_float(raw.y & 0xffff0000u));
              *(unsigned*)(op + 8 * q4) = pk4_fp8(u0 * (acc[4 * q4] + bias), u1 * (acc[4 * q4 + 1] + bias), u2 * (acc[4 * q4 + 2] + bias), u3 * (acc[4 * q4 + 3] + bias), (float)(1 << F8_SH_M)); }
      } }
    asm volatile("s_waitcnt lgkmcnt(0)\n\ts_barrier" ::: "memory");
}
}

constexpr int ATT_NH = 1;
__device__ __forceinline__ void phase_mixer(const Ptrs& P, LAS unsigned char* lds, int l, int Mmix) {
    int tid = threadIdx.x; asm volatile("" : "+v"(tid));
    const bf16_t* PROJ = (const bf16_t*)(P.ws + WS_PROJ); unsigned char* MIXo = (unsigned char*)(P.ws + WS_MIX);
    const int G = gridDim.x, c = blockIdx.x;
    constexpr int UPC = ATT_NH == 2 ? 2 : 4;
    const int nLat = (ML / 128) * UPC, nCtx = Mmix > ML ? (MC / 128) * UPC : 0, nG = Mmix / 128;
    const bool gfirst = (c & 1) != 0;
    for (int pass = 0; pass < 2; ++pass) {
        if ((pass == 0) != gfirst) { for (int u = c; u < nLat; u += G) { const int chunk = u / UPC, kvh = (u / (UPC / 2)) & 1, hp = u & 1; mx::attn_unit<ATT_NH>(PROJ, MIXo, P.sink + l * 8, P.conv_w + (size_t)l * 768, lds, 1, chunk >> 6, chunk & 63, kvh, hp, tid); } }
        else { for (int u = c; u < nG + nCtx; u += G) {
            if (u < nG) mx::gmlp_conv_unit(P, PROJ, MIXo, lds, l, u * 128, tid);
            else { const int v = u - nG, chunk = v / UPC, kvh = (v / (UPC / 2)) & 1, hp = v & 1; mx::attn_unit<ATT_NH>(PROJ, MIXo, P.sink + l * 8, P.conv_w + (size_t)l * 768, lds, 0, chunk >> 1, chunk & 1, kvh, hp, tid); } } }
    }
}
constexpr int NPH = 31;
struct KArgs { Ptrs P; int lo, hi; };
__global__ void __launch_bounds__(NTHR, 2) k_fast(KArgs a) {
    extern __shared__ __attribute__((aligned(16))) unsigned char lds_raw[];
    LAS unsigned char* lds = (LAS unsigned char*)lds_raw;
    const int lo = a.lo, hi = a.hi;
#if defined(__HIP_DEVICE_COMPILE__) && defined(USE_KERNARG_RELOAD)
#define LOADP() const __attribute__((address_space(4))) unsigned long long* ap_ = (const __attribute__((address_space(4))) unsigned long long*)__builtin_amdgcn_kernarg_segment_ptr(); asm volatile("" : "+s"(ap_)); \
    Ptrs P; { unsigned long long* d_ = (unsigned long long*)&P; _Pragma("unroll") for (int i_ = 0; i_ < (int)(sizeof(Ptrs) / 8); ++i_) d_[i_] = ap_[i_]; }
#else
#define LOADP() const Ptrs P = a.P
#endif
    unsigned* ctl; { LOADP(); ctl = (unsigned*)(P.ws + WS_CTL); }
    if (threadIdx.x < 4) ((LAS unsigned*)(lds + MISC_OFF))[threadIdx.x] = 0u;
    __syncthreads();
    XcdBarrier bar; bar.bar = ctl + CW_BAR; bar.x = 0; bar.st = (volatile LAS unsigned*)(lds + MISC_OFF);
    if (hi - lo > 1) bar = xcd_barrier_post(ctl + CW_BAR, (volatile LAS unsigned*)(lds + MISC_OFF));
    volatile LAS int* vcw = (volatile LAS int*)(lds + MISC_OFF + 32);
    if (threadIdx.x == 0) { vcw[3] = 0; vcw[0] = (int)blockIdx.x; vcw[1] = (int)xb_xcc_id(); vcw[2] = (hi - lo > 1) ? (int)xb_add(ctl + CW_XR + 64 * xb_xcc_id(), 1u) : 0; }
    __syncthreads();
#define IN(k, kind) (lo <= (k) && (k) < hi)
#define SEAM(k) do { if (lo <= (k) && (k) + 1 < hi) xcd_barrier(bar); } while (0)
    LAS unsigned* idxtab = (LAS unsigned*)(lds + IDX_OFF);
    LAS int* tst = (LAS int*)(lds + TST_OFF);

    if (IN(0, 0)) { LOADP(); phase_p0a(P, lds); }
    SEAM(0);
    if (lo == 0 && hi > 1) {
        if (threadIdx.x == 0) { const int myx = vcw[1], rank = vcw[2]; int npop = 0, xi = 0; bool even = true;
            for (int j = 0; j < 16; ++j) { const unsigned cj = xb_ld(ctl + CW_XR + 64 * j); if (cj) { ++npop; if (j < myx) ++xi; if (cj * 8u != gridDim.x) even = false; } }
            if (even && npop == 8 && rank < (int)(gridDim.x / 8)) { vcw[0] = rank * 8 + xi; vcw[3] = (int)(gridDim.x / 8); }
            }
        __syncthreads(); }
    const int vc = vcw[0];
    if (IN(1, 1)) { LOADP(); phase_p0b(P); }
    SEAM(1);
    for (int l = 0; l < DEPTH; ++l) {
        const int pb = 2 + 7 * l;
        const int Mmix = l < DEPTH - 1 ? MT : ML;
        if (IN(pb + 0, 2)) { LOADP(); if (l > 0) build_tile_table(P, tst, l - 1);
            if (l == 0) phase_norm<1, true>(P, lds, l, MT, (const bf16_t*)P.out, tst); else phase_norm<1, false>(P, lds, l, MT, (const bf16_t*)P.out, tst); }
        SEAM(pb + 0);
        if (IN(pb + 1, 3)) { LOADP();
            SchedDense<INC, 2> S{P.ws + WS_H, P.ws + WS_WIN + (size_t)l * INC * D * 2, MT / 256, (int)gridDim.x, vc};
            EpiProj E{(bf16_t*)(P.ws + WS_PROJ), (const float*)(P.ws + WS_ROPE)};
            pg::gemm_phase(lds + RING_OFF, idxtab, S, E);
        }
        SEAM(pb + 1);
        if (IN(pb + 2, 4)) { LOADP(); phase_mixer(P, lds, l, Mmix); }
        SEAM(pb + 2);
        if (IN(pb + 3, 5)) { LOADP();
            SchedDense<D, 1> S{P.ws + WS_MIX, P.ws + WS_WOUT + (size_t)l * D * D, Mmix / 256, (int)gridDim.x, vc};
            EpiPlain E{(bf16_t*)(P.ws + WS_PROJ), D};
            pg::gemm_phase(lds + RING_OFF, idxtab, S, E);
        }
        SEAM(pb + 3);
        if (IN(pb + 4, 6)) { LOADP(); phase_norm<2, false>(P, lds, l, Mmix, (const bf16_t*)(P.ws + WS_PROJ), tst); }
        SEAM(pb + 4);
        if (IN(pb + 5, 7)) { LOADP(); const ClsRec* listr = (const ClsRec*)(P.ws + WS_LISTR);
            build_tile_table(P, tst, l);
            SchedGU S{(const unsigned char*)(P.ws + WS_H), (const unsigned char*)(P.ws + WS_WGU) + (size_t)l * NE * 1024 * 1024, listr, tst, ctl + CW_CNTF + l * 32 * 64, (int)gridDim.x, vc};
            EpiGU E{(unsigned char*)(P.ws + WS_PROJ), listr, ctl + CW_CNTF + l * 32 * 64};
            pg::gemm_phase(lds + RING_OFF, idxtab, S, E);
        }
        SEAM(pb + 5);
        if (IN(pb + 6, 8)) { LOADP();
            build_tile_table(P, tst, l);
            SchedDown S{(const unsigned char*)(P.ws + WS_PROJ), (const unsigned char*)(P.ws + WS_WD) + (size_t)l * NE * 1024 * 512, tst, (int)gridDim.x, vc};
            EpiPlain E{l < DEPTH - 1 ? (bf16_t*)P.out : (bf16_t*)(P.ws + WS_H), D};
            pg::gemm_phase(lds + RING_OFF, idxtab, S, E);
        }
        SEAM(pb + 6);
    }
    if (IN(30, 9)) { LOADP(); build_tile_table(P, tst, DEPTH - 1); phase_norm<3, false>(P, lds, DEPTH - 1, ML, (const bf16_t*)(P.ws + WS_H), tst); }
#undef IN
#undef SEAM
}
static int g_grid = 256;
static void launch_fast(const Ptrs& P, int lo, int hi, hipStream_t stream) {
    KArgs a{}; a.P = P; a.lo = lo; a.hi = hi;
    hipLaunchKernelGGL(k_fast, dim3(g_grid), dim3(NTHR), LDS_BYTES, stream, a);
}
extern "C" void kernel_launch(void* const* d_in, const int* in_sizes, int n_in, void* d_out, int out_size, void* d_ws, size_t ws_size, hipStream_t stream) {
    static int ready = 0;
    if (!ready) {
        if (n_in != 21 || ws_size < WS_END2) { fprintf(stderr, "kernel_launch: unexpected inputs (%d) or workspace (%zu)\n", n_in, ws_size); ready = -1; return; }
        if (hipFuncSetAttribute((const void*)k_fast, hipFuncAttributeMaxDynamicSharedMemorySize, LDS_BYTES) != hipSuccess) { fprintf(stderr, "kernel_launch: hipFuncSetAttribute failed\n"); ready = -1; return; }
        { int dev = 0, cus = 0, per_cu = 0; (void)hipGetDevice(&dev); (void)hipDeviceGetAttribute(&cus, hipDeviceAttributeMultiprocessorCount, dev);
          if (hipOccupancyMaxActiveBlocksPerMultiprocessor(&per_cu, (const void*)k_fast, NTHR, LDS_BYTES) != hipSuccess || per_cu < 1) { fprintf(stderr, "kernel_launch: occupancy query says %d blocks per CU\n", per_cu); }
          (void)hipGetLastError(); if (cus > 0) g_grid = cus;
          if (g_grid * NWAVES * 64 < MT) { fprintf(stderr, "kernel_launch: %d workgroups are too few for the routing tables\n", g_grid); ready = -1; return; } }
        ready = 1;
    }
    if (ready < 0) return;
    Ptrs P{};
    const float** pp = (const float**)&P;
    for (int i = 0; i < 21; ++i) pp[i] = (const float*)d_in[i];
    P.out = (float*)d_out; P.ws = (unsigned char*)d_ws;
    unsigned char* ws = (unsigned char*)d_ws;
    (void)hipMemsetAsync(ws + WS_CTL, 0, 1 * MiB, stream);
    launch_fast(P, 0, NPH, stream);
}
```

```cpp
#include <hip/hip_runtime.h>
#include <stdint.h>
#include <cstdio>

constexpr int D = 1024, NB = 8, SEQ = 8192, DEPTH = 4, CTXL = 256;
constexpr int ML = NB * SEQ;
constexpr int MC = NB * CTXL;
constexpr int MT = ML + MC;
constexpr int INC = 2048;
constexpr int C_U = 0, C_V = 256, C_BG = 512, C_CG = 768, C_Z = 1024, C_Q = 1280, C_K = 1792, C_VV = 1920;
constexpr int NE = 16, DE = 512, NCLS = 24;
constexpr float EPS = 1e-6f;
constexpr float QSCALE = 0.125f * 1.4426950408889634f;
constexpr float LOG2E = 1.4426950408889634f;

typedef unsigned short bf16_t;
typedef float f32x4 __attribute__((ext_vector_type(4)));
typedef unsigned u32x4 __attribute__((ext_vector_type(4)));
typedef unsigned u32x2 __attribute__((ext_vector_type(2)));

__device__ __forceinline__ float bf2f(bf16_t v) { return __uint_as_float((unsigned)v << 16); }
__device__ __forceinline__ bf16_t f2bf(float f) { unsigned u = __float_as_uint(f); return (bf16_t)((u + 0x7fffu + ((u >> 16) & 1u)) >> 16); }
__device__ __forceinline__ unsigned pk2(float lo, float hi) { return (unsigned)f2bf(lo) | ((unsigned)f2bf(hi) << 16); }
__device__ __forceinline__ float gelu_tanh(float x) { const float y = 0.7978845608028654f * (x + 0.044715f * x * x * x); return x / (1.0f + __expf(-2.0f * y)); }
__device__ __forceinline__ float silu_f(float x) { return x / (1.0f + __expf(-x)); }
template <int CTRL> __device__ __forceinline__ float dppf(float v) { return __int_as_float(__builtin_amdgcn_update_dpp(0, __float_as_int(v), CTRL, 0xF, 0xF, true)); }
__device__ __forceinline__ float xor4f(float v) { int t = __builtin_amdgcn_update_dpp(0, __float_as_int(v), 0x104, 0xF, 0x5, false); t = __builtin_amdgcn_update_dpp(t, __float_as_int(v), 0x114, 0xF, 0xA, false); return __int_as_float(t); }
__device__ __forceinline__ float swsum16(float a, float b) { auto r = __builtin_amdgcn_permlane16_swap(__float_as_uint(a), __float_as_uint(b), false, false); return __uint_as_float(r[0]) + __uint_as_float(r[1]); }
__device__ __forceinline__ float swsum32(float a, float b) { auto r = __builtin_amdgcn_permlane32_swap(__float_as_uint(a), __float_as_uint(b), false, false); return __uint_as_float(r[0]) + __uint_as_float(r[1]); }
__device__ __forceinline__ float wave_sum(float v) { v += dppf<0xB1>(v); v += dppf<0x4E>(v); v += dppf<0x124>(v); v += dppf<0x128>(v); v = swsum16(v, v); return swsum32(v, v); }

constexpr size_t MiB = 1u << 20;
constexpr size_t WS_CTL = 0;
constexpr size_t WS_MOD = 1 * MiB;
constexpr size_t WS_ROPE = 2 * MiB;
constexpr size_t WS_PTAB = 2 * MiB + 65536;
constexpr size_t WS_PAR = 2 * MiB + 131072;
constexpr int PAR_RW = 0, PAR_N1 = 16384, PAR_N2 = 20480, PAR_FG = 24576, PAR_RB = 25600, PAR_BS = 25664, PAR_GG = 27712, PAR_SINK = 28736, PAR_CW = 28800, PAR_END = 31872;
constexpr size_t WS_TOK = 3 * MiB;
constexpr size_t WS_XC = 5 * MiB;
constexpr size_t WS_LISTE = 13 * MiB;
constexpr size_t WS_LISTC = 18 * MiB;
constexpr size_t WS_VN = 25 * MiB;
constexpr size_t WS_WIN = 64 * MiB, WS_WOUT = 80 * MiB, WS_WGU = 88 * MiB, WS_WD = 216 * MiB;
constexpr size_t WS_H = 280 * MiB;
constexpr size_t WS_MIX = 412 * MiB;
constexpr size_t WS_PROJ = 544 * MiB;
constexpr size_t WS_END = 808 * MiB;
constexpr int CW_CNTE = 1024;
constexpr int CW_CNTC = 2048;

struct Tok { unsigned ids; float wlo, whi; unsigned pad; };

struct Ptrs {
    const float *x, *c, *ctx, *c_ctx, *w_mod, *b_mod, *norm1_g, *norm2_g, *w_in, *gmlp_g, *w_s, *b_s, *conv_w, *sink, *w_out, *router_w, *router_b, *w_gate, *w_up, *w_down, *final_g;
    float* out; unsigned char* ws;
};
__device__ __forceinline__ int modrow(int m) { return m < ML ? (m >> 13) : 8; }

#define LAS __attribute__((address_space(3)))
#define XB_TMO      128
#define XB_XCNT(j)  (256  + 64 * (j))
#define XB_XSUB(j)  (1280 + 64 * (j))
#define XB_XGEN(j)  (2304 + 64 * (j))
#define XB_TOP      3328
#define XB_TOPGEN   3392
#define XCD_BAR_WORDS 3456
#define XB_SPIN_CAP (1u << 18)

__device__ __forceinline__ unsigned xb_ld(unsigned* p)              { return __hip_atomic_load(p, __ATOMIC_RELAXED, __HIP_MEMORY_SCOPE_AGENT); }
__device__ __forceinline__ unsigned xb_add(unsigned* p, unsigned v) { return __hip_atomic_fetch_add(p, v, __ATOMIC_RELAXED, __HIP_MEMORY_SCOPE_AGENT); }
__device__ __forceinline__ unsigned xb_xcc_id() { return (unsigned)__builtin_amdgcn_s_getreg((3 << 11) | 20) & 0xFu; }
#define XB_SPIN(cond, bar) do { unsigned _sp = 0; while (cond) { __builtin_amdgcn_s_sleep(1); \
    if ((++_sp & 255u) == 0u) { if (xb_ld(&(bar)[XB_TMO])) break; if (_sp > XB_SPIN_CAP) { atomicAdd(&(bar)[XB_TMO], 1u); break; } } } } while (0)

__device__ __forceinline__ int wg_lane() { int l_; asm volatile("v_mbcnt_lo_u32_b32 %0, -1, 0\n\tv_mbcnt_hi_u32_b32 %0, -1, %0" : "=&v"(l_)); return l_; }
struct XcdBarrier {
    int wid;
    unsigned* bar; unsigned x;
    volatile LAS unsigned* st;
};

__device__ __forceinline__ XcdBarrier xcd_barrier_post(unsigned* bar, volatile LAS unsigned* st) {
    XcdBarrier b; b.bar = bar; b.x = xb_xcc_id(); b.st = st;
    if (threadIdx.x == 0) (void)xb_add(&bar[XB_XCNT(b.x)], 1u);
    return b;
}
__device__ __forceinline__ void xcd_barrier_complete(unsigned* bar, unsigned x, unsigned& nloc, unsigned& nx) {
    const unsigned G = gridDim.x * gridDim.y * gridDim.z;
    unsigned sum, cnt, mine, sp = 0u;
    for (;;) {
        sum = 0u; cnt = 0u; mine = 0u;
#pragma unroll
        for (unsigned j = 0; j < 16; ++j) { const unsigned c = xb_ld(&bar[XB_XCNT(j)]); sum += c; cnt += (c > 0u) ? 1u : 0u; mine = (j == x) ? c : mine; }
        if (sum == G) break;
        __builtin_amdgcn_s_sleep(1);
        if ((++sp & 255u) == 0u) { if (xb_ld(&bar[XB_TMO])) break; if (sp > XB_SPIN_CAP) { atomicAdd(&bar[XB_TMO], 1u); break; } }
    }
    nloc = mine > 0u ? mine : 1u; nx = cnt > 0u ? cnt : 1u;
}

__device__ __forceinline__ void xcd_barrier(const XcdBarrier& b) {
    asm volatile("s_waitcnt vmcnt(0)" ::: "memory");
    __syncthreads();
    int bw_ = b.wid; asm volatile("" : "+s"(bw_));
    if (bw_ == 0 && wg_lane() == 0) {
        unsigned* bar = b.bar;
        __builtin_amdgcn_s_waitcnt(0);
        unsigned nloc = b.st[0], nx = b.st[1];
        if (nloc == 0u) { xcd_barrier_complete(bar, b.x, nloc, nx); b.st[0] = nloc; b.st[1] = nx; }
        const unsigned old = xb_add(&bar[XB_XSUB(b.x)], 1u);
        const unsigned gen = old / nloc;
        if (old + 1u == (gen + 1u) * nloc) {
            __builtin_amdgcn_fence(__ATOMIC_RELEASE, "agent");
            asm volatile("s_waitcnt vmcnt(0)" ::: "memory");
            const unsigned og = xb_add(&bar[XB_TOP], 1u);
            const unsigned tg = og / nx;
            if (og + 1u == (tg + 1u) * nx) xb_add(&bar[XB_TOPGEN], 1u);
            else XB_SPIN(xb_ld(&bar[XB_TOPGEN]) == tg, bar);
            __builtin_amdgcn_fence(__ATOMIC_ACQUIRE, "agent");
            xb_add(&bar[XB_XGEN(b.x)], 1u);
            asm volatile("s_waitcnt vmcnt(0)" ::: "memory");
        } else {
            XB_SPIN(xb_ld(&bar[XB_XGEN(b.x)]) == gen, bar);
            __builtin_amdgcn_fence(__ATOMIC_ACQUIRE, "agent");
            asm volatile("s_waitcnt vmcnt(0)" ::: "memory");
        }
    }
    __syncthreads();
}
typedef short bf16x8 __attribute__((ext_vector_type(8)));
typedef int v4i32 __attribute__((ext_vector_type(4)));
typedef int v8i32 __attribute__((ext_vector_type(8)));
namespace pg {
constexpr int BM = 256, BK = 64, HALF = 128, HTB = HALF * BK * 2  , STAGE_BYTES = 8 * HTB, NXCD = 8, WGM = 8;
__host__ __device__ __forceinline__ int lds_byte(int r, int c) { return (r >> 3) * 1024 + (r & 7) * 128 + (((c >> 3) ^ (r & 7)) << 4); }
__host__ __device__ __forceinline__ void stage_rc(int b, int& R, int& C) { const int piece = b >> 10, p = (b & 1023) >> 4; R = piece * 8 + (p >> 3); C = ((p & 7) ^ (R & 7)) << 3; }

struct Unit { int pm, pn, x0, x1; };

__device__ __forceinline__ void order_unit(int L, int nM, int nN, int& pm, int& pn) {
    const int nwg = nM * nN; int wgid = L;
    { const int q = nwg / NXCD, r = nwg % NXCD, xcd = wgid % NXCD, off = wgid / NXCD; wgid = (xcd < r ? xcd * (q + 1) : r * (q + 1) + (xcd - r) * q) + off; }
    const int nig = WGM * nN, gid = wgid / nig, fm = gid * WGM, gsz = (nM - fm) < WGM ? (nM - fm) : WGM;
    pm = fm + ((wgid % nig) % gsz); pn = (wgid % nig) / gsz;
}

template <class Sched, class Epi>
__device__ __forceinline__ void gemm_phase(LAS unsigned char* lds, LAS unsigned* idxtab, const Sched& S, const Epi& E, int wid_s) {
    constexpr int ESZ = Sched::ESZ;
    constexpr int K = Sched::K, LDA = Sched::LDA, LDB = Sched::LDB, nt = K * ESZ / 128, KS = Sched::KSPLIT; constexpr bool GATHER = Sched::GATHER;
    int tid = wid_s * 64 + wg_lane(); asm volatile("" : "+v"(tid));
    const int wid = __builtin_amdgcn_readfirstlane(tid >> 6), lane = tid & 63, wr = wid >> 2, wc = wid & 3;
    constexpr size_t kstep = (size_t)(BK * 2);
    constexpr size_t hstepA = (size_t)HALF * LDA * ESZ, hstepB = (size_t)HALF * LDB * ESZ;
    const unsigned ldsw = (unsigned)wid * 1024u;
    const int aoff0 = lds_byte(wr * 64 + (lane & 15), (lane >> 4) * 8), boff0 = lds_byte(wc * 32 + (lane & 15), (lane >> 4) * 8);
    unsigned pvoA[2], pvoB[2];
#pragma unroll
    for (int i = 0; i < 2; ++i) { int R_, C_; stage_rc((wid * 64 + lane) * 16 + i * 8192, R_, C_); pvoA[i] = (unsigned)(R_ * LDA * ESZ + C_ * 2); pvoB[i] = (unsigned)(R_ * LDB * ESZ + C_ * 2); }
    unsigned cv[2][2];
#define PG_SA(b, h) (((b) * 2 + (h)) * HTB)
#define PG_SB(b, h) ((4 + (b) * 2 + (h)) * HTB)
#define PG_VOFF(ld, i, dst) do { int _t = wid * 64 + lane; asm volatile("" : "+v"(_t)); int _R, _C; stage_rc(_t * 16 + (i) * 8192, _R, _C); dst = (unsigned)(_R * (ld) * ESZ + _C * 2); } while (0)
#define PG_STAGE_B(bufoff, gbase) do { _Pragma("unroll") for (int _i = 0; _i < 2; ++_i) { unsigned _vo = pvoB[_i]; if constexpr (ESZ == 1) PG_VOFF(LDB, _i, _vo); \
        __builtin_amdgcn_global_load_lds((const unsigned*)((const char*)(gbase) + _vo), (LAS unsigned*)(lds + (bufoff) + ldsw + _i * 8192), 16, 0, 0); } } while (0)
#define PG_STAGE_A(bufoff, gbase, h, V) do { _Pragma("unroll") for (int _i = 0; _i < 2; ++_i) { unsigned _vo = pvoA[_i]; \
        const char* _p = GATHER ? (const char*)(gbase) + V[h][_i] : (const char*)(gbase) + ((h) ? hstepA : 0) + _vo; \
        __builtin_amdgcn_global_load_lds((const unsigned*)_p, (LAS unsigned*)(lds + (bufoff) + ldsw + _i * 8192), 16, 0, 0); } } while (0)
#define PG_LDA(dst, b, h) do { int _a1 = aoff0 ^ 64; asm volatile("" : "+v"(_a1)); _Pragma("unroll") for (int m = 0; m < 4; ++m) _Pragma("unroll") for (int k = 0; k < 2; ++k) dst[m][k] = *(const LAS bf16x8*)(lds + PG_SA(b, h) + (k ? _a1 : aoff0) + m * 2048); } while (0)
#define PG_LDB(dst, b, h) do { int _b1 = boff0 ^ 64; asm volatile("" : "+v"(_b1)); _Pragma("unroll") for (int n = 0; n < 2; ++n) _Pragma("unroll") for (int k = 0; k < 2; ++k) dst[n][k] = *(const LAS bf16x8*)(lds + PG_SB(b, h) + (k ? _b1 : boff0) + n * 2048); } while (0)
#define PG_MMA(ai, bj, At, Bt) do { __builtin_amdgcn_s_setprio(1); _Pragma("unroll") for (int m = 0; m < 4; ++m) _Pragma("unroll") for (int n = 0; n < 2; ++n) { \
        if constexpr (ESZ == 2) { _Pragma("unroll") for (int k = 0; k < 2; ++k) acc[ai][bj][m][n] = __builtin_amdgcn_mfma_f32_16x16x32_bf16(Bt[n][k], At[m][k], acc[ai][bj][m][n], 0, 0, 0); } \
        else {   \
            const v8i32 bw = __builtin_shufflevector(__builtin_bit_cast(v4i32, Bt[n][0]), __builtin_bit_cast(v4i32, Bt[n][1]), 0, 1, 2, 3, 4, 5, 6, 7); \
            const v8i32 aw = __builtin_shufflevector(__builtin_bit_cast(v4i32, At[m][0]), __builtin_bit_cast(v4i32, At[m][1]), 0, 1, 2, 3, 4, 5, 6, 7); \
            acc[ai][bj][m][n] = __builtin_amdgcn_mfma_scale_f32_16x16x128_f8f6f4(bw, aw, acc[ai][bj][m][n], 0, 0, 0, Sched::SCALE_B, 0, Sched::SCALE_A); } } \
        __builtin_amdgcn_s_setprio(0); } while (0)
#define PG_WAIT_V(n) asm volatile("s_waitcnt vmcnt(" #n ")" ::: "memory")
#define PG_WAIT_L(n) asm volatile("s_waitcnt lgkmcnt(" #n ")" ::: "memory")
#define PG_BAR __builtin_amdgcn_s_barrier()
#define PG_SCHED __builtin_amdgcn_sched_barrier(0)
#define PG_IDX_ISSUE(u) do { int _l = lane; asm volatile("" : "+v"(_l)); const int _h = (_l >> 4) & 1, _i = (_l >> 3) & 1, _r = _l & 7; const unsigned _po = (unsigned)(_h * 128 + (wid + 8 * _i) * 8 + _r) * 16u; \
        __builtin_amdgcn_global_load_lds((const unsigned*)((const char*)S.idx_src(u) + _po), (LAS unsigned*)(idxtab + wid * 64), 4, 0, 0); } while (0)
#define PG_IDX_READ(u, V) do { const int _vr = S.valid_rows(u); _Pragma("unroll") for (int _h = 0; _h < 2; ++_h) _Pragma("unroll") for (int _i = 0; _i < 2; ++_i) { \
        const int _pos = _h * 128 + (wid + 8 * _i) * 8 + (lane >> 3); unsigned _tk = *(volatile LAS unsigned*)(idxtab + wid * 64 + _h * 16 + _i * 8 + (lane >> 3)); \
        _tk = _pos < _vr ? _tk : 0u; V[_h][_i] = _tk * (unsigned)(LDA * ESZ) + (unsigned)(((lane & 7) ^ ((lane >> 3) & 7)) << 4); } } while (0)
    Unit cur, nxt; int ui = 0;
    if (!S.next(0, cur)) return;
    f32x4 acc[2][2][4][2];
#pragma unroll
    for (int a = 0; a < 2; ++a)
#pragma unroll
        for (int b = 0; b < 2; ++b)
#pragma unroll
            for (int m = 0; m < 4; ++m)
#pragma unroll
                for (int n = 0; n < 2; ++n) acc[a][b][m][n] = (f32x4){0.f, 0.f, 0.f, 0.f};
    bf16x8 At[4][2], B0[2][2], B1[2][2];
    const char* cA = S.a_base(cur); const char* cB0 = S.b_base(cur, 0); const char* cB1 = S.b_base(cur, 1);
#pragma unroll
    for (int h = 0; h < 2; ++h)
#pragma unroll
        for (int i = 0; i < 2; ++i) cv[h][i] = 0u;
    if constexpr (GATHER) { PG_IDX_ISSUE(cur); PG_WAIT_V(0); PG_IDX_READ(cur, cv); }
    PG_STAGE_B(PG_SB(0, 0), cB0); PG_STAGE_B(PG_SB(0, 1), cB0 + hstepB); PG_STAGE_A(PG_SA(0, 0), cA, 0, cv); PG_STAGE_A(PG_SA(0, 1), cA, 1, cv);
    if (wr == 1) PG_BAR;
    PG_WAIT_V(2); PG_BAR;
    PG_STAGE_B(PG_SB(1, 0), cB0 + kstep); PG_STAGE_A(PG_SA(1, 0), cA + kstep, 0, cv); PG_STAGE_B(PG_SB(1, 1), cB0 + hstepB + kstep);
    PG_WAIT_V(6); PG_BAR;
    for (;;) {
        const bool has_next = S.next(ui + 1, nxt);
        const char* nA = has_next ? S.a_base(nxt) : cA; const char* nB0 = has_next ? S.b_base(nxt, 0) : cB0; const char* nB1 = has_next ? S.b_base(nxt, 1) : cB1;
        if constexpr (GATHER) { if (has_next) PG_IDX_ISSUE(nxt); }
#pragma nounroll
        for (int t = 0; t < nt; t += 2) {
            const bool last = (t == nt - 2);
            const char* a1 = cA + (size_t)(t + 1) * kstep;
            const char* a2 = last ? nA : cA + (size_t)(t + 2) * kstep; const char* a3 = a2 + kstep;
            const char* b2 = last ? nB0 : ((t + 2) < KS ? cB0 : cB1) + (size_t)(t + 2) * kstep;
            const char* b3 = last ? nB0 + kstep : ((t + 3) < KS ? cB0 : cB1) + (size_t)(t + 3) * kstep;
            PG_LDB(B0, 0, 0); PG_LDB(B1, 0, 1); PG_SCHED; PG_LDA(At, 0, 0); PG_STAGE_A(PG_SA(1, 1), a1, 1, cv);
            if constexpr (GATHER) { if (last && has_next) { PG_IDX_READ(nxt, cv); } }
            PG_WAIT_V(8); PG_WAIT_L(0); PG_BAR; PG_MMA(0, 0, At, B0); PG_MMA(0, 1, At, B1); PG_BAR; PG_SCHED;
            PG_LDA(At, 0, 1); PG_STAGE_B(PG_SB(0, 0), b2); PG_STAGE_B(PG_SB(0, 1), b2 + hstepB); PG_STAGE_A(PG_SA(0, 0), a2, 0, cv);
            PG_WAIT_V(8); PG_WAIT_L(0); PG_BAR; PG_MMA(1, 0, At, B0); PG_MMA(1, 1, At, B1); PG_BAR; PG_SCHED;
            PG_LDB(B0, 1, 0); PG_LDB(B1, 1, 1); PG_SCHED; PG_LDA(At, 1, 0); PG_STAGE_A(PG_SA(0, 1), a2, 1, cv);
            PG_WAIT_V(8); PG_WAIT_L(0); PG_BAR; PG_MMA(0, 0, At, B0); PG_MMA(0, 1, At, B1); PG_BAR; PG_SCHED;
            PG_LDA(At, 1, 1); PG_STAGE_B(PG_SB(1, 0), b3); PG_STAGE_B(PG_SB(1, 1), b3 + hstepB); PG_STAGE_A(PG_SA(1, 0), a3, 0, cv);
            PG_WAIT_V(8); PG_WAIT_L(0); PG_BAR; PG_MMA(1, 0, At, B0); PG_MMA(1, 1, At, B1); PG_BAR; PG_SCHED;
        }
        if (wr == 0) PG_BAR;
        { int _l = lane; asm volatile("" : "+v"(_l)); E(acc, cur, wr, wc, _l & 15, _l >> 4); }
        if (!has_next) break;
#pragma unroll
        for (int a = 0; a < 2; ++a)
#pragma unroll
            for (int b = 0; b < 2; ++b)
#pragma unroll
                for (int m = 0; m < 4; ++m)
#pragma unroll
                    for (int n = 0; n < 2; ++n) acc[a][b][m][n] = (f32x4){0.f, 0.f, 0.f, 0.f};
        cur = nxt; cA = nA; cB0 = nB0; cB1 = nB1; ++ui;
        if (wr == 1) PG_BAR;
    }
    PG_WAIT_V(0);
    PG_BAR;
#undef PG_SA
#undef PG_SB
#undef PG_STAGE_A
#undef PG_STAGE_B
#undef PG_VOFF
#undef PG_LDA
#undef PG_LDB
#undef PG_MMA
#undef PG_WAIT_V
#undef PG_WAIT_L
#undef PG_BAR
#undef PG_SCHED
#undef PG_IDX_ISSUE
#undef PG_IDX_READ
}
}
constexpr int NWAVES = 8, NTHR = 512;
constexpr int RING_OFF = 0, RING_BYTES = 131072;
constexpr int IDX_OFF = RING_BYTES;
constexpr int TST_OFF = IDX_OFF + 2048;
constexpr int MISC_OFF = TST_OFF + 128;
constexpr int ROPEL_OFF = MISC_OFF + 512;
constexpr int LDS_BYTES = 147456;
constexpr size_t WS_MODP = WS_VN;
constexpr size_t WS_WSB = 62 * MiB;
constexpr int CW_CNTF = 16384;
constexpr int CW_XR = 12288;
constexpr int CW_MXQ = 13312;
constexpr int CW_BAR = 8192;
constexpr int MAXT = 288;

struct ClsRec { int m; float wlo, whi; int pad; };
constexpr size_t WS_LISTR = 816 * MiB;
constexpr size_t WS_XB = 848 * MiB;
constexpr size_t WS_POS = WS_TOK;
constexpr size_t WS_END2 = 980 * MiB;

__device__ __forceinline__ void cls_experts(int cls, int& elo, int& ehi) {
    const int g = cls / 6, p = cls % 6; const int a = p < 3 ? 0 : (p < 5 ? 1 : 2), b = p < 3 ? p + 1 : (p < 5 ? p - 1 : 3);
    elo = g * 4 + a; ehi = g * 4 + b;
}
#ifndef G1_FP8
#define G1_FP8 1
#endif
constexpr int F8_SH_H = 4, F8_SH_A = 3, F8_SH_W = 5, F8_SH_M = 2;
#define SC_E8(sh) ((127 - (sh)) * 0x01010101)
__device__ __forceinline__ unsigned pk4_fp8(float a, float b, float c, float d, float scale) {
    const float lim = 448.0f; a = fminf(fmaxf(a * scale, -lim), lim); b = fminf(fmaxf(b * scale, -lim), lim); c = fminf(fmaxf(c * scale, -lim), lim); d = fminf(fmaxf(d * scale, -lim), lim);
    int w = __builtin_amdgcn_cvt_pk_fp8_f32(a, b, 0, false); w = __builtin_amdgcn_cvt_pk_fp8_f32(c, d, w, true); return (unsigned)w; }
__device__ __forceinline__ unsigned cvt_pk_bf16(float lo, float hi) { unsigned r; asm volatile("v_cvt_pk_bf16_f32 %0, %1, %2" : "=v"(r) : "v"(lo), "v"(hi)); return r; }

template <int N_, int ESZ_, int SHA_ = 0> struct SchedDense {
    static constexpr int K = 1024, LDA = 1024, LDB = 1024, KSPLIT = K * ESZ_ / 128, ESZ = ESZ_, SCALE_A = ESZ_ == 1 ? SC_E8(SHA_) : 0, SCALE_B = ESZ_ == 1 ? SC_E8(F8_SH_W) : 0; static constexpr bool GATHER = false;
    const void* A; const void* Bt; int nM, G, c;
    __device__ __forceinline__ bool next(int i, pg::Unit& u) const { const long L = (long)i * G + c; if (L >= (long)nM * (N_ / 256)) return false; pg::order_unit((int)L, nM, N_ / 256, u.pm, u.pn); u.x0 = 0; u.x1 = 0;
        return true; }
    __device__ __forceinline__ const char* a_base(const pg::Unit& u) const { return (const char*)A + (size_t)u.pm * 256 * LDA * ESZ; }
    __device__ __forceinline__ const char* b_base(const pg::Unit& u, int) const { return (const char*)Bt + (size_t)u.pn * 256 * LDB * ESZ; }
    __device__ __forceinline__ const unsigned* idx_src(const pg::Unit&) const { return nullptr; }
    __device__ __forceinline__ int valid_rows(const pg::Unit&) const { return 256; }
};
__device__ __forceinline__ void cls_of_tile(const LAS int* tst, int T, int& cls, int& rt) {
    int c = 0;
#pragma unroll
    for (int k = 1; k < NCLS; ++k) c += (T >= tst[k]) ? 1 : 0;
    cls = __builtin_amdgcn_readfirstlane(c); rt = __builtin_amdgcn_readfirstlane(T - tst[c]);
}
struct SchedGU {
    static constexpr int K = 1024, LDA = 1024, LDB = 1024, KSPLIT = 8, ESZ = 1, SCALE_A = SC_E8(F8_SH_H), SCALE_B = SC_E8(F8_SH_W); static constexpr bool GATHER = true;
    const unsigned char* H; const unsigned char* Wgu; const ClsRec* list; const LAS int* tst; const unsigned* cnt; int G, c;
    __device__ __forceinline__ bool next(int i, pg::Unit& u) const { const int TT = __builtin_amdgcn_readfirstlane(tst[NCLS]); const long L = (long)i * G + c; if (L >= (long)TT * 8) return false;
        pg::order_unit((int)L, TT, 8, u.pm, u.pn); cls_of_tile(tst, u.pm, u.x0, u.x1); return true; }
    __device__ __forceinline__ const char* a_base(const pg::Unit&) const { return (const char*)H; }
    __device__ __forceinline__ const char* b_base(const pg::Unit& u, int) const { int elo, ehi; cls_experts(u.x0, elo, ehi); const int e = u.pn < 4 ? elo : ehi;
        return (const char*)Wgu + ((size_t)e * 1024 + (size_t)(u.pn & 3) * 256) * LDB; }
    __device__ __forceinline__ const unsigned* idx_src(const pg::Unit& u) const { return (const unsigned*)(list + (size_t)u.x0 * MT + (size_t)u.x1 * 256); }
    __device__ __forceinline__ int valid_rows(const pg::Unit& u) const { return (int)cnt[u.x0 * 64] - u.x1 * 256; }
};
struct SchedDown {
    static constexpr int K = 1024, LDA = 1024, LDB = 512, KSPLIT = 4, ESZ = 1, SCALE_A = SC_E8(F8_SH_A), SCALE_B = SC_E8(F8_SH_W); static constexpr bool GATHER = false;
    const unsigned char* ACT; const unsigned char* Wd; const LAS int* tst; int G, c;
    __device__ __forceinline__ bool next(int i, pg::Unit& u) const { const int TT = __builtin_amdgcn_readfirstlane(tst[NCLS]); const long L = (long)i * G + c; if (L >= (long)TT * 4) return false;
        pg::order_unit((int)L, TT, 4, u.pm, u.pn); cls_of_tile(tst, u.pm, u.x0, u.x1); return true; }
    __device__ __forceinline__ const char* a_base(const pg::Unit& u) const { return (const char*)ACT + (size_t)u.pm * 256 * LDA; }
    __device__ __forceinline__ const char* b_base(const pg::Unit& u, int part) const { int elo, ehi; cls_experts(u.x0, elo, ehi); const int e = part ? ehi : elo;
        return (const char*)Wd + ((size_t)e * 1024 + (size_t)u.pn * 256) * LDB - (part ? (size_t)KSPLIT * 128 : 0); }
    __device__ __forceinline__ const unsigned* idx_src(const pg::Unit&) const { return nullptr; }
    __device__ __forceinline__ int valid_rows(const pg::Unit&) const { return 256; }
};

#define OPAQUE(x) asm volatile("" : "+v"(x))
#define ROWSTEP(m) ((m) == 3 ? 80 : 16)
__device__ __forceinline__ void bf8_to_f32(const u32x4 v, float (&o)[8]) {
#pragma unroll
    for (int i = 0; i < 4; ++i) { o[2 * i] = __uint_as_float(v[i] << 16); o[2 * i + 1] = __uint_as_float(v[i] & 0xffff0000u); }
}
struct EpiProj {
    bf16_t* O; const LAS _Float16* tab;
    __device__ __forceinline__ void operator()(const f32x4 (&acc)[2][2][4][2], const pg::Unit& u, int wr, int wc, int fr, int fq) const {
        const bool latent = u.pm < ML / 256;
        char* base = (char*)(O + (size_t)u.pm * 256 * INC + u.pn * 256);
        unsigned off = (unsigned)((wr * 64 + fr) * INC + wc * 32 + 8 * fq) * 2u; OPAQUE(off);
        int t = ((u.pm * 256) & (SEQ - 1)) + wr * 64 + fr; OPAQUE(t);
        const bool second = (fq >> 1) != 0;
#pragma unroll
        for (int ai = 0; ai < 2; ++ai)
#pragma unroll
            for (int m = 0; m < 4; ++m) { char* rowp = base + off;
                const int pos = (wc & 1) ? (t & 63) : (t >> 6);
#pragma unroll
                for (int bj = 0; bj < 2; ++bj) { f32x4 v0 = acc[ai][bj][m][0], v1 = acc[ai][bj][m][1];
                    const bool rope = latent && (u.pn == 5 || u.pn == 6 || (u.pn == 7 && bj == 0));
                    if (rope) { const LAS _Float16* tp = tab + pos * 16 + 8 * (fq & 1);
                        typedef _Float16 h8 __attribute__((ext_vector_type(8)));
                        const h8 ch = *(const LAS h8*)tp, sh = *(const LAS h8*)(tp + 2048);
                        const f32x4 cs0 = (f32x4){(float)ch[0], (float)ch[1], (float)ch[2], (float)ch[3]}, cs1 = (f32x4){(float)ch[4], (float)ch[5], (float)ch[6], (float)ch[7]};
                        const f32x4 sn0 = (f32x4){(float)sh[0], (float)sh[1], (float)sh[2], (float)sh[3]}, sn1 = (f32x4){(float)sh[4], (float)sh[5], (float)sh[6], (float)sh[7]};
                        f32x4 p0, p1;
#pragma unroll
                        for (int i = 0; i < 4; ++i) { auto r0 = __builtin_amdgcn_permlane32_swap(__float_as_uint(v0[i]), __float_as_uint(v0[i]), false, false); p0[i] = __uint_as_float(second ? r0[0] : r0[1]);
                                                      auto r1 = __builtin_amdgcn_permlane32_swap(__float_as_uint(v1[i]), __float_as_uint(v1[i]), false, false); p1[i] = __uint_as_float(second ? r1[0] : r1[1]); }
                        if (second) { v0 = v0 * cs0 + p0 * sn0; v1 = v1 * cs1 + p1 * sn1; } else { v0 = v0 * cs0 - p0 * sn0; v1 = v1 * cs1 - p1 * sn1; } }
                    u32x4 w; w.x = cvt_pk_bf16(v0[0], v0[1]); w.y = cvt_pk_bf16(v0[2], v0[3]); w.z = cvt_pk_bf16(v1[0], v1[1]); w.w = cvt_pk_bf16(v1[2], v1[3]);
                    *(u32x4*)(rowp + bj * 256) = w; }
                off += (unsigned)(ROWSTEP(m) * INC * 2); t += ROWSTEP(m); OPAQUE(off); OPAQUE(t); }
    }
};
struct EpiPlain {
    bf16_t* O; int ldo;
    __device__ __forceinline__ void operator()(const f32x4 (&acc)[2][2][4][2], const pg::Unit& u, int wr, int wc, int fr, int fq) const {
        char* base = (char*)(O + (size_t)u.pm * 256 * ldo + u.pn * 256);
        unsigned off = (unsigned)((wr * 64 + fr) * ldo + wc * 32 + 8 * fq) * 2u; OPAQUE(off);
#pragma unroll
        for (int ai = 0; ai < 2; ++ai)
#pragma unroll
            for (int m = 0; m < 4; ++m) {
#pragma unroll
                for (int bj = 0; bj < 2; ++bj) { const f32x4 v0 = acc[ai][bj][m][0], v1 = acc[ai][bj][m][1];
                    u32x4 w; w.x = cvt_pk_bf16(v0[0], v0[1]); w.y = cvt_pk_bf16(v0[2], v0[3]); w.z = cvt_pk_bf16(v1[0], v1[1]); w.w = cvt_pk_bf16(v1[2], v1[3]);
                    *(u32x4*)(base + off + bj * 256) = w; }
                off += (unsigned)(ROWSTEP(m) * ldo * 2); OPAQUE(off); }
    }
};
struct EpiResid {
    bf16_t* XB; const float* gate;
    __device__ __forceinline__ void operator()(const f32x4 (&acc)[2][2][4][2], const pg::Unit& u, int wr, int wc, int fr, int fq) const {
        const int mb = u.pm < ML / 256 ? (u.pm * 256) >> 13 : 8;
        const float* gp = gate + (size_t)mb * 6144 + u.pn * 256 + wc * 32 + 8 * fq;
        f32x4 g[2][2];
#pragma unroll
        for (int bj = 0; bj < 2; ++bj) { g[bj][0] = *(const f32x4*)(gp + 128 * bj); g[bj][1] = *(const f32x4*)(gp + 128 * bj + 4); }
        char* base = (char*)(XB + (size_t)u.pm * 256 * D + u.pn * 256);
        unsigned off = (unsigned)((wr * 64 + fr) * D + wc * 32 + 8 * fq) * 2u; OPAQUE(off);
#pragma unroll
        for (int ai = 0; ai < 2; ++ai) {
            u32x4 xr[4][2]; unsigned lo = off;
#pragma unroll
            for (int m = 0; m < 4; ++m) {
#pragma unroll
                for (int bj = 0; bj < 2; ++bj) { const char* ap = base + lo + bj * 256; asm volatile("global_load_dwordx4 %0, %1, off" : "=&v"(xr[m][bj]) : "v"(ap) : "memory"); }
                lo += (unsigned)(16 * D * 2); }
            asm volatile("s_waitcnt vmcnt(0)" : "+v"(xr[0][0]), "+v"(xr[0][1]), "+v"(xr[1][0]), "+v"(xr[1][1]), "+v"(xr[2][0]), "+v"(xr[2][1]), "+v"(xr[3][0]), "+v"(xr[3][1]) :: "memory");
#pragma unroll
            for (int m = 0; m < 4; ++m) {
#pragma unroll
                for (int bj = 0; bj < 2; ++bj) { const f32x4 v0 = acc[ai][bj][m][0], v1 = acc[ai][bj][m][1]; float xf[8]; bf8_to_f32(xr[m][bj], xf);
                    u32x4 w; w.x = cvt_pk_bf16(xf[0] + g[bj][0][0] * v0[0], xf[1] + g[bj][0][1] * v0[1]); w.y = cvt_pk_bf16(xf[2] + g[bj][0][2] * v0[2], xf[3] + g[bj][0][3] * v0[3]);
                    w.z = cvt_pk_bf16(xf[4] + g[bj][1][0] * v1[0], xf[5] + g[bj][1][1] * v1[1]); w.w = cvt_pk_bf16(xf[6] + g[bj][1][2] * v1[2], xf[7] + g[bj][1][3] * v1[3]);
                    *(u32x4*)(base + off + bj * 256) = w; }
                off += (unsigned)(ROWSTEP(m) * D * 2); OPAQUE(off); } }
    }
};
struct EpiDownResid {
    bf16_t* XB; const float* gate; const ClsRec* list; const unsigned* cnt;
    __device__ __forceinline__ void operator()(const f32x4 (&acc)[2][2][4][2], const pg::Unit& u, int wr, int wc, int fr, int fq) const {
        const int vr = (int)cnt[u.x0 * 64] - u.x1 * 256; const char* rec = (const char*)(list + (size_t)u.x0 * MT + (size_t)u.x1 * 256);
        int r = wr * 64 + fr; OPAQUE(r);
        const unsigned coff = (unsigned)(u.pn * 256 + wc * 32 + 8 * fq);
        int tok[8];
        { const int vm1 = vr - 1;
#pragma unroll
          for (int q = 0; q < 8; ++q) { const int rq = r + 16 * (q & 3) + 128 * (q >> 2); const int rc = rq < vm1 ? rq : vm1; const char* ap = rec + (size_t)rc * 16;
              asm volatile("global_load_dword %0, %1, off" : "=&v"(tok[q]) : "v"(ap) : "memory"); }
          asm volatile("s_waitcnt vmcnt(0)" : "+v"(tok[0]), "+v"(tok[1]), "+v"(tok[2]), "+v"(tok[3]), "+v"(tok[4]), "+v"(tok[5]), "+v"(tok[6]), "+v"(tok[7]) :: "memory"); }
#pragma unroll
        for (int ai = 0; ai < 2; ++ai)
#pragma unroll
            for (int mp = 0; mp < 2; ++mp) {
                u32x4 xr[2][2]; f32x4 g[2][2][2]; char* xp[2];
#pragma unroll
                for (int rr = 0; rr < 2; ++rr) { const int m_ = tok[ai * 4 + 2 * mp + rr]; const int mb = m_ < ML ? (m_ >> 13) : 8;
                    xp[rr] = (char*)(XB + (size_t)m_ * D + coff); const char* gp = (const char*)(gate + (size_t)mb * 6144 + coff);
#pragma unroll
                    for (int bj = 0; bj < 2; ++bj) { const char* a0 = xp[rr] + bj * 256; const char* a1 = gp + bj * 512; const char* a2 = gp + bj * 512 + 16;
                        asm volatile("global_load_dwordx4 %0, %1, off" : "=&v"(xr[rr][bj]) : "v"(a0) : "memory");
                        asm volatile("global_load_dwordx4 %0, %1, off" : "=&v"(g[rr][bj][0]) : "v"(a1) : "memory");
                        asm volatile("global_load_dwordx4 %0, %1, off" : "=&v"(g[rr][bj][1]) : "v"(a2) : "memory"); } }
                asm volatile("s_waitcnt vmcnt(0)" : "+v"(xr[0][0]), "+v"(xr[0][1]), "+v"(xr[1][0]), "+v"(xr[1][1]), "+v"(g[0][0][0]), "+v"(g[0][0][1]), "+v"(g[0][1][0]), "+v"(g[0][1][1]),
                             "+v"(g[1][0][0]), "+v"(g[1][0][1]), "+v"(g[1][1][0]), "+v"(g[1][1][1]) :: "memory");
#pragma unroll
                for (int rr = 0; rr < 2; ++rr) { const int m = 2 * mp + rr; const int rq = r + 16 * m + 128 * ai;
                    if (rq < vr) {
#pragma unroll
                        for (int bj = 0; bj < 2; ++bj) { const f32x4 v0 = acc[ai][bj][m][0], v1 = acc[ai][bj][m][1]; float xf[8]; bf8_to_f32(xr[rr][bj], xf);
                            u32x4 w; w.x = cvt_pk_bf16(xf[0] + g[rr][bj][0][0] * v0[0], xf[1] + g[rr][bj][0][1] * v0[1]); w.y = cvt_pk_bf16(xf[2] + g[rr][bj][0][2] * v0[2], xf[3] + g[rr][bj][0][3] * v0[3]);
                            w.z = cvt_pk_bf16(xf[4] + g[rr][bj][1][0] * v1[0], xf[5] + g[rr][bj][1][1] * v1[1]); w.w = cvt_pk_bf16(xf[6] + g[rr][bj][1][2] * v1[2], xf[7] + g[rr][bj][1][3] * v1[3]);
                            *(u32x4*)(xp[rr] + bj * 256) = w; } } } }
    }
};
struct EpiGU {
    unsigned char* ACT; const ClsRec* list; const unsigned* cnt;
    __device__ __forceinline__ void operator()(const f32x4 (&acc)[2][2][4][2], const pg::Unit& u, int wr, int wc, int fr, int fq) const {
        const int vr = (int)cnt[u.x0 * 64] - u.x1 * 256; const char* rec = (const char*)(list + (size_t)u.x0 * MT + (size_t)u.x1 * 256) + (u.pn >= 4 ? 8 : 4);
        unsigned char* base = ACT + (size_t)u.pm * 256 * 1024 + (u.pn >> 2) * 512 + (u.pn & 3) * 128;
        int r = wr * 64 + fr; OPAQUE(r); unsigned off = (unsigned)(r * 1024 + wc * 32 + 8 * fq); OPAQUE(off);
        float wv[8];
        { const int vm1 = vr - 1;
#pragma unroll
          for (int q = 0; q < 8; ++q) { const int rq = r + 16 * (q & 3) + 128 * (q >> 2); const int rc = rq < vm1 ? rq : vm1; const char* ap = rec + (size_t)rc * 16;
              asm volatile("global_load_dword %0, %1, off" : "=&v"(wv[q]) : "v"(ap) : "memory"); }
          asm volatile("s_waitcnt vmcnt(0)" : "+v"(wv[0]), "+v"(wv[1]), "+v"(wv[2]), "+v"(wv[3]), "+v"(wv[4]), "+v"(wv[5]), "+v"(wv[6]), "+v"(wv[7]) :: "memory"); }
#pragma unroll
        for (int ai = 0; ai < 2; ++ai)
#pragma unroll
            for (int m = 0; m < 4; ++m) { float w = r < vr ? wv[ai * 4 + m] : 0.f;
                w *= (float)(1 << F8_SH_A);
                u32x2 pk;
#pragma unroll
                for (int bj = 0; bj < 2; ++bj) { const f32x4 g = acc[ai][bj][m][0], up = acc[ai][bj][m][1]; float o[4];
#pragma unroll
                    for (int i = 0; i < 4; ++i) o[i] = g[i] * __builtin_amdgcn_rcpf(1.0f + __builtin_amdgcn_exp2f(-LOG2E * g[i])) * up[i];
                    const unsigned v = pk4_fp8(o[0], o[1], o[2], o[3], w); if (bj == 0) pk.x = v; else pk.y = v; }
                *(u32x2*)(base + off) = pk;
                off += (unsigned)(ROWSTEP(m) * 1024); r += ROWSTEP(m); OPAQUE(off); OPAQUE(r); }
    }
};

typedef const __attribute__((address_space(1))) float* gfptr;
template <bool F8 = false, typename WP = const float*> __device__ __forceinline__ void p0_transpose_item(WP W, int Kd, int N, void* WTv, LAS float* scr, int item, int lane, int mode, int sc_lo, int sc_hi, float scale) {
    bf16_t* WT = (bf16_t*)WTv;
    const int nblk = N / 32, kb = item / nblk, nb = item % nblk, k0 = 64 * kb, n0 = 32 * nb;
    f32x4 rv[8];
#pragma unroll
    for (int i = 0; i < 8; ++i) rv[i] = *(const __attribute__((address_space(1))) f32x4*)((gfptr)W + (size_t)(k0 + 8 * i + (lane >> 3)) * N + n0 + 4 * (lane & 7));
#pragma unroll
    for (int i = 0; i < 8; ++i) { LAS float* d = scr + (8 * i + (lane >> 3)) * 33 + 4 * (lane & 7); d[0] = rv[i].x; d[1] = rv[i].y; d[2] = rv[i].z; d[3] = rv[i].w; }
    asm volatile("s_waitcnt lgkmcnt(0)" ::: "memory");
    const int c = lane & 7;
#pragma unroll
    for (int j = 0; j < 4; ++j) { const int n = (lane >> 3) + 8 * j, ng = n0 + n; const LAS float* s = scr + (8 * c) * 33 + n;
        const float f = (ng >= sc_lo && ng < sc_hi) ? scale : 1.0f;
        const int row = mode == 0 ? ng : mode == 3 ? ((ng & ~31) + 16 * ((ng >> 2) & 1) + 4 * ((ng >> 3) & 3) + (ng & 3))
                      : (256 * (ng >> 7) + 128 * ((ng >> 2) & 1) + 32 * ((ng >> 5) & 3) + 16 * (mode == 2 ? 1 : 0) + 4 * ((ng >> 3) & 3) + (ng & 3));
        if constexpr (F8) { u32x2 o; o.x = pk4_fp8(s[0 * 33], s[1 * 33], s[2 * 33], s[3 * 33], f * (float)(1 << F8_SH_W)); o.y = pk4_fp8(s[4 * 33], s[5 * 33], s[6 * 33], s[7 * 33], f * (float)(1 << F8_SH_W));
            *(u32x2*)((unsigned char*)WTv + (size_t)row * Kd + k0 + 8 * c) = o; }
        else { u32x4 o; o.x = pk2(s[0 * 33] * f, s[1 * 33] * f); o.y = pk2(s[2 * 33] * f, s[3 * 33] * f); o.z = pk2(s[4 * 33] * f, s[5 * 33] * f); o.w = pk2(s[6 * 33] * f, s[7 * 33] * f);
            *(u32x4*)(WT + (size_t)row * Kd + k0 + 8 * c) = o; } }
    asm volatile("s_waitcnt lgkmcnt(0)" ::: "memory");
}
constexpr int CONV_PER_L = 1024 + 512 + NE * 768;
__device__ __forceinline__ void convert_item(gfptr w_in, gfptr w_out, gfptr w_gate, gfptr w_up, gfptr w_down, unsigned char* ws, LAS float* scr, int l, int r, int lane) {
    static_assert(G1_FP8 == 1, "w_in is converted to e4m3 only");
    if (r < 1024) { p0_transpose_item<true>(w_in + (size_t)l * D * INC, D, INC, ws + WS_WIN + (size_t)l * INC * D, scr, r, lane, 3, C_Q, C_K, QSCALE); return; } r -= 1024;
    if (r < 512) { p0_transpose_item<true>(w_out + (size_t)l * D * D, D, D, ws + WS_WOUT + (size_t)l * D * D, scr, r, lane, 3, 0, 0, 1.f); return; } r -= 512;
    const int e = r / 768, q = r % 768, which = q >> 8, idx = q & 255; const size_t le = (size_t)l * NE + e;
    if (which == 0) p0_transpose_item<true>(w_gate + le * D * DE, D, DE, ws + WS_WGU + le * 1024 * 1024, scr, idx, lane, 1, 0, 0, 1.f);
    else if (which == 1) p0_transpose_item<true>(w_up + le * D * DE, D, DE, ws + WS_WGU + le * 1024 * 1024, scr, idx, lane, 2, 0, 0, 1.f);
    else p0_transpose_item<true>(w_down + le * DE * D, DE, D, ws + WS_WD + le * 1024 * 512, scr, idx, lane, 3, 0, 0, 1.f);
}
__device__ __forceinline__ void phase_p0a(const Ptrs& P, LAS unsigned char* lds) {
    int tid = threadIdx.x; asm volatile("" : "+v"(tid)); const int lane = tid & 63, wave = __builtin_amdgcn_readfirstlane(tid >> 6);
    const int gw = blockIdx.x * NWAVES + wave, NGW = gridDim.x * NWAVES;
    LAS float* sil = (LAS float*)(lds + 73728);
    for (int i = tid; i < 9 * D; i += NTHR) { const int j = i >> 10, k = i & (D - 1); sil[i] = silu_f(j < 8 ? P.c[j * D + k] : P.c_ctx[k]); }
    __syncthreads();
    float* modp = (float*)(P.ws + WS_MODP);
    for (int u = gw; u < DEPTH * 24 * 16; u += NGW) { const int l = u / 384, r = u % 384, nc = r / 16, ks = r % 16;
        const float* w = P.w_mod + ((size_t)l * D + ks * 64) * 6144 + nc * 256 + 4 * lane;
        f32x4 a[9];
#pragma unroll
        for (int j = 0; j < 9; ++j) a[j] = (f32x4){0.f, 0.f, 0.f, 0.f};
#pragma unroll 4
        for (int k = 0; k < 64; ++k) { const f32x4 wv = *(const f32x4*)(w + (size_t)k * 6144);
#pragma unroll
            for (int j = 0; j < 9; ++j) a[j] += wv * sil[j * D + ks * 64 + k]; }
#pragma unroll
        for (int j = 0; j < 9; ++j) *(f32x4*)(modp + (((size_t)l * 16 + ks) * 9 + j) * 6144 + nc * 256 + 4 * lane) = a[j]; }
    { const int gt = blockIdx.x * NTHR + tid, NGT = gridDim.x * NTHR; float* tab = (float*)(P.ws + WS_ROPE);
      if (gt < 2048) { const int i = gt & 15, pos = gt >> 4; const float inv = powf(10000.0f, -(float)i / 16.0f), ang = (float)pos * inv; tab[gt] = cosf(ang); tab[2048 + gt] = sinf(ang); }
      bf16_t* wsb = (bf16_t*)(P.ws + WS_WSB);
      for (int i = gt; i < DEPTH * 4 * 128 * 128; i += NGT) wsb[i] = f2bf(P.w_s[i]); }
    { float* par = (float*)(P.ws + WS_PAR);
      for (int i = blockIdx.x * NTHR + tid; i < PAR_END; i += (int)gridDim.x * NTHR) { float v = 0.f;
          if (i < PAR_N1) v = P.router_w[i]; else if (i < PAR_N2) v = P.norm1_g[i - PAR_N1]; else if (i < PAR_FG) v = P.norm2_g[i - PAR_N2]; else if (i < PAR_RB) v = P.final_g[i - PAR_FG];
          else if (i < PAR_BS) { if (i - PAR_RB < NE) v = P.router_b[i - PAR_RB]; } else if (i < PAR_GG) v = P.b_s[i - PAR_BS]; else if (i < PAR_SINK) v = P.gmlp_g[i - PAR_GG];
          else if (i < PAR_CW) { if (i - PAR_SINK < DEPTH * 8) v = P.sink[i - PAR_SINK]; } else v = P.conv_w[i - PAR_CW];
          par[i] = v; } }
    if (blockIdx.x == 0 && tid == 0) { unsigned long long* pt = (unsigned long long*)(P.ws + WS_PTAB);
        pt[0] = (unsigned long long)P.w_in; pt[1] = (unsigned long long)P.w_out; pt[2] = (unsigned long long)P.w_gate; pt[3] = (unsigned long long)P.w_up; pt[4] = (unsigned long long)P.w_down; }
    LAS float* scr = (LAS float*)(lds + wave * 8448);
    for (int it = gw; it < CONV_PER_L; it += NGW) convert_item((gfptr)P.w_in, (gfptr)P.w_out, (gfptr)P.w_gate, (gfptr)P.w_up, (gfptr)P.w_down, P.ws, scr, 0, it, lane);
}
__device__ __forceinline__ void convert_tail(unsigned char* ws, LAS unsigned char* lds, int l, int part, int j, int nidle, int wid_s) {
    int tid = wid_s * 64 + wg_lane(); asm volatile("" : "+v"(tid));
    __syncthreads();
    const int lane = tid & 63; LAS float* scr = (LAS float*)(lds + wid_s * 8448);
    const unsigned long long* pt = (const unsigned long long*)(ws + WS_PTAB);
    const gfptr w_in = (gfptr)pt[0], w_out = (gfptr)pt[1], w_gate = (gfptr)pt[2], w_up = (gfptr)pt[3], w_down = (gfptr)pt[4];
    constexpr int QTR = CONV_PER_L / 4;
    for (int it = part * QTR + j * NWAVES + wid_s; it < (part + 1) * QTR; it += nidle * NWAVES) convert_item(w_in, w_out, w_gate, w_up, w_down, ws, scr, l, it, lane);
    __syncthreads();
}
__device__ __forceinline__ void phase_p0b(const Ptrs& P) {
    const int gt = blockIdx.x * NTHR + threadIdx.x, NGT = gridDim.x * NTHR;
    const float* modp = (const float*)(P.ws + WS_MODP); float* mod = (float*)(P.ws + WS_MOD);
    for (int i = gt; i < DEPTH * 9 * 6144; i += NGT) { const int l = i / (9 * 6144), r = i % (9 * 6144), j = r / 6144, n = r % 6144;
        float s = P.b_mod[l * 6144 + n];
#pragma unroll
        for (int ks = 0; ks < 16; ++ks) s += modp[(((size_t)l * 16 + ks) * 9 + j) * 6144 + n];
        mod[i] = s; }
}

template <int R> struct NormRaw { u32x4 a[R][2], b[R][2]; int m0, nv; };
template <int MODE, bool FIRST, bool DRY = false> __device__ __forceinline__ void phase_norm(const Ptrs& P, LAS unsigned char* lds, int l, int Mrows, const bf16_t* Y, const LAS int* tst, int wid_s) {
    constexpr int R = MODE == 2 ? 2 : 4;
    int tid = wid_s * 64 + wg_lane(); asm volatile("" : "+v"(tid)); const int lane = tid & 63, wave = __builtin_amdgcn_readfirstlane(tid >> 6);
    const int gw = blockIdx.x * NWAVES + wave, NGW = gridDim.x * NWAVES;
    const int rpw = (Mrows + NGW - 1) / NGW;
    const int mBeg = gw * rpw, mEnd = (mBeg + rpw) < Mrows ? (mBeg + rpw) : Mrows;
    LAS float* rwT = (LAS float*)lds;
    constexpr int RPW = 72;
    LAS unsigned* recL = (LAS unsigned*)(lds + 65536);
    LAS unsigned* cntL = (LAS unsigned*)(lds + 65536 + NWAVES * RPW * 16);
    LAS unsigned* baseL = cntL + 32;
    LAS float* logL = (LAS float*)(lds + 65536 + 12288);
    if (MODE == 2) { if (tid < 64) cntL[tid] = 0u; for (int i = tid; i < D * NE; i += NTHR) rwT[(i & 15) * D + (i >> 4)] = ((const float*)(P.ws + WS_PAR))[PAR_RW + i]; __syncthreads(); }
    const float* g = (const float*)(P.ws + WS_PAR) + (MODE == 1 ? PAR_N1 + l * D : MODE == 2 ? PAR_N2 + l * D : PAR_FG);
    f32x4 gg[2][2];
#pragma unroll
    for (int j = 0; j < 2; ++j) { gg[j][0] = (f32x4){0.f, 0.f, 0.f, 0.f}; gg[j][1] = gg[j][0]; if (MODE == 3) { gg[j][0] = *(const f32x4*)(g + 8 * lane + 512 * j); gg[j][1] = *(const f32x4*)(g + 8 * lane + 512 * j + 4); } }
    bf16_t* XB = (bf16_t*)(P.ws + WS_XB);
    f32x4 gt[2][2], scv[2][2], shv[2][2];
#pragma unroll
    for (int j = 0; j < 2; ++j)
#pragma unroll
        for (int q = 0; q < 2; ++q) { gt[j][q] = (f32x4){0.f, 0.f, 0.f, 0.f}; scv[j][q] = gt[j][q]; shv[j][q] = gt[j][q]; }
#define NR_LOAD(G, mstart) do { (G).m0 = (mstart); { const int bnd_ = (((mstart) >> 13) + 1) << 13; const int ge_ = bnd_ < mEnd ? bnd_ : mEnd; (G).nv = (ge_ - (mstart)) < R ? (ge_ - (mstart)) : R; } \
        _Pragma("unroll") for (int r = 0; r < R; ++r) { const int m = (G).m0 + (r < (G).nv ? r : (G).nv - 1); \
            if (FIRST) { const float* xr = m < ML ? P.x + (size_t)m * D : P.ctx + (size_t)(m - ML) * D; \
                _Pragma("unroll") for (int j = 0; j < 2; ++j) { (G).a[r][j] = *(const u32x4*)(xr + 8 * lane + 512 * j); (G).b[r][j] = *(const u32x4*)(xr + 8 * lane + 512 * j + 4); } \
            } else { \
                _Pragma("unroll") for (int j = 0; j < 2; ++j) { (G).a[r][j] = *(const u32x4*)(XB + (size_t)m * D + 8 * lane + 512 * j); } } } } while (0)
    NormRaw<R> G; G.m0 = mBeg; G.nv = 0;
    if (mBeg < mEnd) NR_LOAD(G, mBeg);
    bool more = mBeg < mEnd;
    while (more) {
        const int m0 = G.m0, nv = G.nv;
        float xv[R][2][8]; float ss[R];
        { const int mb = modrow(m0);
            {
                const float* modl = (const float*)(P.ws + WS_MOD) + ((size_t)l * 9 + mb) * 6144;
                const float* gate = MODE == 2 ? modl + 2048 : (const float*)(P.ws + WS_MOD) + ((size_t)(MODE == 3 ? 3 : (l > 0 ? l - 1 : 0)) * 9 + mb) * 6144 + 5120;
                const float* sh = modl + (MODE == 1 ? 0 : 3072); const float* sc = modl + (MODE == 1 ? 1024 : 4096);
#pragma unroll
                for (int j = 0; j < 2; ++j)
#pragma unroll
                    for (int q = 0; q < 2; ++q) { const int c = 8 * lane + 512 * j + 4 * q; gt[j][q] = *(const f32x4*)(gate + c); scv[j][q] = (*(const f32x4*)(sc + c) + 1.0f) * *(const f32x4*)(g + c); shv[j][q] = *(const f32x4*)(sh + c); } } }
#pragma unroll
        for (int r = 0; r < R; ++r) { const int m = m0 + (r < nv ? r : nv - 1);
#pragma unroll
            for (int j = 0; j < 2; ++j) {
                if (FIRST) { const f32x4 a = __builtin_bit_cast(f32x4, G.a[r][j]), b = __builtin_bit_cast(f32x4, G.b[r][j]);
                    xv[r][j][0] = a.x; xv[r][j][1] = a.y; xv[r][j][2] = a.z; xv[r][j][3] = a.w; xv[r][j][4] = b.x; xv[r][j][5] = b.y; xv[r][j][6] = b.z; xv[r][j][7] = b.w;
                } else { float xf[8]; bf8_to_f32(G.a[r][j], xf);
#pragma unroll
                    for (int i = 0; i < 8; ++i) xv[r][j][i] = xf[i]; } }
            if (FIRST && r < nv) {
#pragma unroll
                for (int j = 0; j < 2; ++j) { u32x4 w; w.x = cvt_pk_bf16(xv[r][j][0], xv[r][j][1]); w.y = cvt_pk_bf16(xv[r][j][2], xv[r][j][3]); w.z = cvt_pk_bf16(xv[r][j][4], xv[r][j][5]); w.w = cvt_pk_bf16(xv[r][j][6], xv[r][j][7]);
                    *(u32x4*)(XB + (size_t)m * D + 8 * lane + 512 * j) = w; } }
            float s = 0.f;
#pragma unroll
            for (int j = 0; j < 2; ++j)
#pragma unroll
                for (int i = 0; i < 8; ++i) s += xv[r][j][i] * xv[r][j][i];
            ss[r] = s;
            if (MODE != 3) {
#pragma unroll
                for (int j = 0; j < 2; ++j)
#pragma unroll
                    for (int i = 0; i < 8; ++i) xv[r][j][i] = xv[r][j][i] * scv[j][i >> 2][i & 3];
            } }
        { const int nm0 = m0 + nv; more = nm0 < mEnd; if (more) NR_LOAD(G, nm0); }
#pragma unroll
        for (int r = 0; r < R; ++r) ss[r] = wave_sum(ss[r]);
#pragma unroll
        for (int r = 0; r < R; ++r) { const int m = m0 + r; const float rinv = rsqrtf(ss[r] * (1.0f / D) + EPS);
            if (MODE == 3) { if (r < nv) { float* orow = P.out + (size_t)m * D;
#pragma unroll
                for (int j = 0; j < 2; ++j) { f32x4 a, b; a.x = xv[r][j][0]; a.y = xv[r][j][1]; a.z = xv[r][j][2]; a.w = xv[r][j][3]; b.x = xv[r][j][4]; b.y = xv[r][j][5]; b.z = xv[r][j][6]; b.w = xv[r][j][7];
                    *(f32x4*)(orow + 8 * lane + 512 * j) = a * rinv * gg[j][0]; *(f32x4*)(orow + 8 * lane + 512 * j + 4) = b * rinv * gg[j][1]; } }
            } else {
#pragma unroll
                for (int j = 0; j < 2; ++j)
#pragma unroll
                    for (int i = 0; i < 8; ++i) xv[r][j][i] = xv[r][j][i] * rinv + shv[j][i >> 2][i & 3];
                if (r < nv) {
                    if (MODE == 2 || G1_FP8) { unsigned char* H8 = (unsigned char*)(P.ws + WS_H) + (size_t)m * D;
#pragma unroll
                        for (int j = 0; j < 2; ++j) { u32x2 o; o.x = pk4_fp8(xv[r][j][0], xv[r][j][1], xv[r][j][2], xv[r][j][3], (float)(1 << F8_SH_H)); o.y = pk4_fp8(xv[r][j][4], xv[r][j][5], xv[r][j][6], xv[r][j][7], (float)(1 << F8_SH_H)); *(u32x2*)(H8 + 8 * lane + 512 * j) = o; }
                    } else { bf16_t* H = (bf16_t*)(P.ws + WS_H) + (size_t)m * D;
#pragma unroll
                        for (int j = 0; j < 2; ++j) { u32x4 o; o.x = cvt_pk_bf16(xv[r][j][0], xv[r][j][1]); o.y = cvt_pk_bf16(xv[r][j][2], xv[r][j][3]); o.z = cvt_pk_bf16(xv[r][j][4], xv[r][j][5]); o.w = cvt_pk_bf16(xv[r][j][6], xv[r][j][7]); *(u32x4*)(H + 8 * lane + 512 * j) = o; } } }
            } }
        if (MODE == 2) {
            typedef float f32x2r __attribute__((ext_vector_type(2)));
            static_assert(MODE != 2 || R == 2, "the packed router pairs the two rows of a group");
            f32x2r lg2[16];
#pragma unroll
            for (int e = 0; e < 16; ++e) lg2[e] = (f32x2r){0.f, 0.f};
#pragma unroll
            for (int j = 0; j < 2; ++j) { const int c = 8 * lane + 512 * j;
                f32x2r x2[8];
#pragma unroll
                for (int i = 0; i < 8; ++i) x2[i] = (f32x2r){xv[0][j][i], xv[1][j][i]};
#pragma unroll
                for (int e4 = 0; e4 < 4; ++e4) {
#pragma unroll
                    for (int e = 4 * e4; e < 4 * e4 + 4; ++e) { const f32x4 r0 = *(const LAS f32x4*)(rwT + e * D + c), r1 = *(const LAS f32x4*)(rwT + e * D + c + 4);
                        lg2[e] += x2[0] * r0.x + x2[1] * r0.y + x2[2] * r0.z + x2[3] * r0.w + x2[4] * r1.x + x2[5] * r1.y + x2[6] * r1.z + x2[7] * r1.w; }
                    __builtin_amdgcn_sched_barrier(0); } }
#pragma unroll
            for (int r = 0; r < R; ++r) {
                float lg[16];
#pragma unroll
                for (int e = 0; e < 16; ++e) lg[e] = r == 0 ? lg2[e].x : lg2[e].y;
                float v8[8], v4[4], v2[2], v1;
#pragma unroll
                for (int i = 0; i < 8; ++i) v8[i] = swsum32(lg[i], lg[i + 8]);
#pragma unroll
                for (int i = 0; i < 4; ++i) v4[i] = swsum16(v8[i], v8[i + 4]);
                { const bool up = (lane & 8) != 0;
#pragma unroll
                  for (int i = 0; i < 2; ++i) { const float send = up ? v4[i] : v4[i + 2]; const float keep = up ? v4[i + 2] : v4[i]; v2[i] = keep + dppf<0x128>(send); } }
                { const bool up = (lane & 4) != 0; const float send = up ? v2[0] : v2[1]; const float keep = up ? v2[1] : v2[0]; v1 = keep + xor4f(send); }
                v1 += dppf<0x4E>(v1); v1 += dppf<0xB1>(v1);
                if ((lane & 3) == 0 && r < nv) logL[(wave * RPW + (m0 - mBeg) + r) * 16 + (lane >> 2)] = v1;
            }
        }
    }
#undef NR_LOAD
    if (MODE == 2 && !DRY) {
        asm volatile("s_waitcnt lgkmcnt(0)" ::: "memory");
        if (lane < mEnd - mBeg) {
            float sco[16], sel[16];
#pragma unroll
            for (int e4 = 0; e4 < 4; ++e4) { const f32x4 v = *(const LAS f32x4*)(logL + (wave * RPW + lane) * 16 + 4 * e4);
#pragma unroll
                for (int i = 0; i < 4; ++i) { const int e = 4 * e4 + i; sco[e] = 1.0f / (1.0f + __expf(-v[i])); sel[e] = sco[e] + ((const float*)(P.ws + WS_PAR))[PAR_RB + e]; } }
            int bg = 0; float bgs = -1e30f; int ba = 0, bb = 1; float sa = 0.f, sb = 0.f;
#pragma unroll
            for (int gI = 0; gI < 4; ++gI) {
                int i1 = 0; float v1 = sel[gI * 4], c1 = sco[gI * 4];
#pragma unroll
                for (int i = 1; i < 4; ++i) if (sel[gI * 4 + i] > v1) { v1 = sel[gI * 4 + i]; c1 = sco[gI * 4 + i]; i1 = i; }
                int i2 = -1; float v2 = -1e30f, c2 = 0.f;
#pragma unroll
                for (int i = 0; i < 4; ++i) if (i != i1 && sel[gI * 4 + i] > v2) { v2 = sel[gI * 4 + i]; c2 = sco[gI * 4 + i]; i2 = i; }
                const float gs = v1 + v2;
                if (gs > bgs) { bgs = gs; bg = gI; ba = i1; bb = i2; sa = c1; sb = c2; }
            }
            const int a = ba < bb ? ba : bb, b = ba < bb ? bb : ba;
            const float wl = ba < bb ? sa : sb, wh = ba < bb ? sb : sa, inv = 1.0f / (wl + wh);
            const int pairidx = (a == 0) ? (b - 1) : (a == 1 ? (b + 1) : 5);
            const int cls = bg * 6 + pairidx;
            const unsigned pl = __hip_atomic_fetch_add(cntL + cls, 1u, __ATOMIC_RELAXED, __HIP_MEMORY_SCOPE_WORKGROUP);
            LAS unsigned* rb = recL + (wave * RPW + lane) * 4; rb[0] = (unsigned)(mBeg + lane); rb[1] = __float_as_uint(wl * inv); rb[2] = __float_as_uint(wh * inv); rb[3] = (unsigned)cls | (pl << 8);
        }
        asm volatile("s_waitcnt lgkmcnt(0)" ::: "memory"); __syncthreads();
        unsigned* ctl = (unsigned*)(P.ws + WS_CTL);
        if (tid < NCLS) { const unsigned n = cntL[tid]; baseL[tid] = n ? atomicAdd(ctl + CW_CNTF + (l * 32 + tid) * 64, n) : 0u; }
        __syncthreads();
        ClsRec* listr = (ClsRec*)(P.ws + WS_LISTR); unsigned* posw = (unsigned*)(P.ws + WS_POS);
        for (int i = tid; i < NWAVES * RPW; i += NTHR) { const int w = i / RPW, r = i % RPW; const int wb = (blockIdx.x * NWAVES + w) * rpw; const int nw = (wb + rpw < Mrows ? wb + rpw : Mrows) - wb;
            if (r < nw) { const LAS unsigned* rb = recL + i * 4; const unsigned cls = rb[3] & 255u, pl = rb[3] >> 8, gp = baseL[cls] + pl;
                ClsRec rc; rc.m = (int)rb[0]; rc.wlo = __uint_as_float(rb[1]); rc.whi = __uint_as_float(rb[2]); rc.pad = 0;
                listr[(size_t)cls * MT + gp] = rc; posw[rb[0]] = cls | (gp << 8); } }
    }
}
__device__ __forceinline__ void build_tile_table(const Ptrs& P, LAS int* tst, int l, int wid_s) {
    asm volatile("" : "+s"(wid_s));
    if (wid_s == 0) {
        int lane = wg_lane(); asm volatile("" : "+v"(lane));
        const unsigned* cnt = (const unsigned*)(P.ws + WS_CTL) + CW_CNTF + l * 32 * 64;
        const int tiles = lane < NCLS ? (int)((__hip_atomic_load(cnt + lane * 64, __ATOMIC_RELAXED, __HIP_MEMORY_SCOPE_AGENT) + 255u) >> 8) : 0;
        int incl = tiles;
#pragma unroll
        for (int o = 1; o < 32; o <<= 1) { const int t = __shfl_up(incl, o); if (lane >= o) incl += t; }
        if (lane <= NCLS) tst[lane] = incl - tiles;
    }
    __syncthreads();
}
namespace mx {
typedef float f32x16 __attribute__((ext_vector_type(16)));
typedef short s16x4 __attribute__((ext_vector_type(4)));
constexpr int SLOTB = 8192;
constexpr int L_K = 0, L_V = 2 * SLOTB, L_WS = 4 * SLOTB, L_OST = L_WS + NWAVES * 256, L_END = L_OST + NWAVES * 4096;
constexpr int VT_PITCH = 136;
__device__ __forceinline__ int crow(int r, int hi) { return (r & 3) + 8 * (r >> 2) + 4 * hi; }
__device__ __forceinline__ unsigned cvtpk(float lo, float hi) { unsigned r; asm volatile("v_cvt_pk_bf16_f32 %0, %1, %2" : "=v"(r) : "v"(lo), "v"(hi)); return r; }
__device__ __forceinline__ float gelu_fast(float x) { const float y = x + 0.044715f * x * x * x; return x * __builtin_amdgcn_rcpf(1.0f + __builtin_amdgcn_exp2f(-2.302208198f * y)); }

__device__ __forceinline__ void qkt(f32x16& p0, f32x16& p1, const LAS unsigned char* Kslot, const bf16x8* qr, const f32x16& negm, int r32, int hi) {
    const LAS unsigned char* kb = Kslot + hi * 1024 + r32 * 16;
#pragma unroll
    for (int d0 = 0; d0 < 4; ++d0) {
        const bf16x8 b0 = *(const LAS bf16x8*)(kb + d0 * 2048), b1 = *(const LAS bf16x8*)(kb + d0 * 2048 + 512);
        if (d0 == 0) { p0 = __builtin_amdgcn_mfma_f32_32x32x16_bf16(b0, qr[0], negm, 0, 0, 0); p1 = __builtin_amdgcn_mfma_f32_32x32x16_bf16(b1, qr[0], negm, 0, 0, 0); }
        else { p0 = __builtin_amdgcn_mfma_f32_32x32x16_bf16(b0, qr[d0], p0, 0, 0, 0); p1 = __builtin_amdgcn_mfma_f32_32x32x16_bf16(b1, qr[d0], p1, 0, 0, 0); } }
}
__device__ __forceinline__ void qkt2(f32x16& a0, f32x16& a1, f32x16& b0, f32x16& b1, const LAS unsigned char* KslotA, const LAS unsigned char* KslotB, const bf16x8* qr, const f32x16& negm, int r32, int hi) {
    const LAS unsigned char* ka = KslotA + hi * 1024 + r32 * 16; const LAS unsigned char* kb = KslotB + hi * 1024 + r32 * 16;
#pragma unroll
    for (int d0 = 0; d0 < 4; ++d0) {
        const bf16x8 xa0 = *(const LAS bf16x8*)(ka + d0 * 2048), xa1 = *(const LAS bf16x8*)(ka + d0 * 2048 + 512), xb0 = *(const LAS bf16x8*)(kb + d0 * 2048), xb1 = *(const LAS bf16x8*)(kb + d0 * 2048 + 512);
        if (d0 == 0) { a0 = __builtin_amdgcn_mfma_f32_32x32x16_bf16(xa0, qr[0], negm, 0, 0, 0); a1 = __builtin_amdgcn_mfma_f32_32x32x16_bf16(xa1, qr[0], negm, 0, 0, 0);
                       b0 = __builtin_amdgcn_mfma_f32_32x32x16_bf16(xb0, qr[0], negm, 0, 0, 0); b1 = __builtin_amdgcn_mfma_f32_32x32x16_bf16(xb1, qr[0], negm, 0, 0, 0); }
        else { a0 = __builtin_amdgcn_mfma_f32_32x32x16_bf16(xa0, qr[d0], a0, 0, 0, 0); a1 = __builtin_amdgcn_mfma_f32_32x32x16_bf16(xa1, qr[d0], a1, 0, 0, 0);
               b0 = __builtin_amdgcn_mfma_f32_32x32x16_bf16(xb0, qr[d0], b0, 0, 0, 0); b1 = __builtin_amdgcn_mfma_f32_32x32x16_bf16(xb1, qr[d0], b1, 0, 0, 0); } }
}
__device__ __forceinline__ void pv(f32x16* o, unsigned vb, bf16x8 pa0, bf16x8 pa1, bf16x8 pa2, bf16x8 pa3) {
#pragma unroll
    for (int d0 = 0; d0 < 2; ++d0) { s16x4 lo[4], hi[4];
#pragma unroll
        for (int ks = 0; ks < 4; ++ks) {
            asm volatile("ds_read_b64_tr_b16 %0, %1 offset:%c2" : "=&v"(lo[ks]) : "v"(vb), "i"(d0 * 4096 + ks * 1024) : "memory");
            asm volatile("ds_read_b64_tr_b16 %0, %1 offset:%c2" : "=&v"(hi[ks]) : "v"(vb), "i"(d0 * 4096 + ks * 1024 + 512) : "memory"); }
        asm volatile("s_waitcnt lgkmcnt(0)" ::: "memory"); __builtin_amdgcn_sched_barrier(0);
#define MX_PK(k) (bf16x8){lo[k][0], lo[k][1], lo[k][2], lo[k][3], hi[k][0], hi[k][1], hi[k][2], hi[k][3]}
        o[d0] = __builtin_amdgcn_mfma_f32_32x32x16_bf16(pa0, MX_PK(0), o[d0], 0, 0, 0);
        o[d0] = __builtin_amdgcn_mfma_f32_32x32x16_bf16(pa1, MX_PK(1), o[d0], 0, 0, 0);
        o[d0] = __builtin_amdgcn_mfma_f32_32x32x16_bf16(pa2, MX_PK(2), o[d0], 0, 0, 0);
        o[d0] = __builtin_amdgcn_mfma_f32_32x32x16_bf16(pa3, MX_PK(3), o[d0], 0, 0, 0);
#undef MX_PK
    }
}
#define MS_TR(dst, base, off) asm volatile("ds_read_b64_tr_b16 %0, %1 offset:%c2" : "=&v"(dst) : "v"(base), "i"(off) : "memory")
#define MS_VISSUE(R, base, d0) do { MS_TR(R[0], base, (d0) * 4096); MS_TR(R[1], base, (d0) * 4096 + 512); MS_TR(R[2], base, (d0) * 4096 + 1024); MS_TR(R[3], base, (d0) * 4096 + 1536); \
        MS_TR(R[4], base, (d0) * 4096 + 2048); MS_TR(R[5], base, (d0) * 4096 + 2560); MS_TR(R[6], base, (d0) * 4096 + 3072); MS_TR(R[7], base, (d0) * 4096 + 3584); } while (0)
#define MS_VWAIT(n, R) do { asm volatile("s_waitcnt lgkmcnt(" #n ")" : "+v"(R[0]), "+v"(R[1]), "+v"(R[2]), "+v"(R[3]), "+v"(R[4]), "+v"(R[5]), "+v"(R[6]), "+v"(R[7]) :: "memory"); __builtin_amdgcn_sched_barrier(0); } while (0)
#define MS_PK(R, k) (bf16x8){R[2 * (k)][0], R[2 * (k)][1], R[2 * (k)][2], R[2 * (k)][3], R[2 * (k) + 1][0], R[2 * (k) + 1][1], R[2 * (k) + 1][2], R[2 * (k) + 1][3]}
#define MS_PVMMA(acc, R, p0, p1, p2, p3) do { acc = __builtin_amdgcn_mfma_f32_32x32x16_bf16(__builtin_bit_cast(bf16x8, p0), MS_PK(R, 0), acc, 0, 0, 0); acc = __builtin_amdgcn_mfma_f32_32x32x16_bf16(__builtin_bit_cast(bf16x8, p1), MS_PK(R, 1), acc, 0, 0, 0); \
        acc = __builtin_amdgcn_mfma_f32_32x32x16_bf16(__builtin_bit_cast(bf16x8, p2), MS_PK(R, 2), acc, 0, 0, 0); acc = __builtin_amdgcn_mfma_f32_32x32x16_bf16(__builtin_bit_cast(bf16x8, p3), MS_PK(R, 3), acc, 0, 0, 0); __builtin_amdgcn_sched_barrier(0); } while (0)
__device__ __forceinline__ void pv2(f32x16* o, unsigned vbA, unsigned vbB, const u32x4& a0, const u32x4& a1, const u32x4& a2, const u32x4& a3, const u32x4& b0, const u32x4& b1, const u32x4& b2, const u32x4& b3) {
    s16x4 R0[8], R1[8];
    __builtin_amdgcn_sched_barrier(0);
    MS_VISSUE(R0, vbA, 0); MS_VISSUE(R1, vbA, 1);
    MS_VWAIT(8, R0); MS_PVMMA(o[0], R0, a0, a1, a2, a3); MS_VISSUE(R0, vbB, 0);
    MS_VWAIT(8, R1); MS_PVMMA(o[1], R1, a0, a1, a2, a3); MS_VISSUE(R1, vbB, 1);
    MS_VWAIT(8, R0); MS_PVMMA(o[0], R0, b0, b1, b2, b3);
    MS_VWAIT(0, R1); MS_PVMMA(o[1], R1, b0, b1, b2, b3);
}
struct ConvRaw { u32x4 bg, c0, c1, c2, z0, z1, z2; };
__device__ __forceinline__ void conv_load(ConvRaw& R, const bf16_t* PROJ, int m0, int tid, int q) {
    const int seqmask = m0 < ML ? SEQ - 1 : CTXL - 1; const int mrel = m0 < ML ? m0 : m0 - ML;
    const int idx = q * NTHR + tid, row = idx >> 5, c = (idx & 31) * 8;
    const int t = (mrel + row) & seqmask; const bf16_t* pr = PROJ + (size_t)(m0 + row) * INC;
    R.bg = *(const u32x4*)(pr + C_BG + c); R.c1 = *(const u32x4*)(pr + C_CG + c); R.z1 = *(const u32x4*)(pr + C_Z + c);
    R.c0 = (u32x4){0u, 0u, 0u, 0u}; R.z0 = R.c0; R.c2 = R.c0; R.z2 = R.c0;
    if (t > 0) { R.c0 = *(const u32x4*)(pr - INC + C_CG + c); R.z0 = *(const u32x4*)(pr - INC + C_Z + c); }
    if (t < seqmask) { R.c2 = *(const u32x4*)(pr + INC + C_CG + c); R.z2 = *(const u32x4*)(pr + INC + C_Z + c); }
}
__device__ __forceinline__ void conv_finish(const ConvRaw& R, const float* cwl, unsigned char* MIXo, int m0, int tid, int q) {
    const int idx = q * NTHR + tid, row = idx >> 5, c = (idx & 31) * 8;
    const float* cw = cwl + c;
    float o[8];
#pragma unroll
    for (int i = 0; i < 8; ++i) { const int wI = i >> 1; const bool up = i & 1;
#define MX_BF(v) (up ? __uint_as_float((v)[wI] & 0xffff0000u) : __uint_as_float((v)[wI] << 16))
        const float y = MX_BF(R.c0) * MX_BF(R.z0) * cw[i] + MX_BF(R.c1) * MX_BF(R.z1) * cw[256 + i] + MX_BF(R.c2) * MX_BF(R.z2) * cw[512 + i];
        o[i] = MX_BF(R.bg) * y;
#undef MX_BF
    }
    u32x2 w; w.x = pk4_fp8(o[0], o[1], o[2], o[3], (float)(1 << F8_SH_M)); w.y = pk4_fp8(o[4], o[5], o[6], o[7], (float)(1 << F8_SH_M));
    *(u32x2*)(MIXo + (size_t)(m0 + row) * D + 256 + c) = w;
}
constexpr int NSLOT = 4;
constexpr int ATT_THR = 8;
typedef float f32x2 __attribute__((ext_vector_type(2)));
#define MX3(a, b, c) __builtin_fmaxf(__builtin_fmaxf((a), (b)), (c))
constexpr int A_K = 0, A_V = NSLOT * SLOTB, A_WS = 2 * NSLOT * SLOTB, A_OST = A_WS + NWAVES * 512, A_END = A_OST + NWAVES * 4096;
template <int NH> __device__ __forceinline__ void attn_unit(const bf16_t* PROJ, unsigned char* MIXo, const float* sink, const float* cwl, LAS unsigned char* shm, int latent, int b, int blk, int kvh, int hp, int tid) {
    const int lane = tid & 63, r32 = lane & 31, hi = lane >> 5; const int wid = __builtin_amdgcn_readfirstlane(tid >> 6);
    const int head0 = NH == 2 ? kvh * 4 + (wid >> 2) * 2 : kvh * 4 + hp * 2 + (wid >> 2), qw = (wid & 3) * 32;
    const int qrow0 = latent ? b * SEQ + blk * 128 : ML + b * CTXL + blk * 128;
    const int ctx0 = ML + b * CTXL;
    const int lt_lo = latent ? (blk > 0 ? 0 : 2) : 0, lt_hi = latent ? (blk < SEQ / 128 - 1 ? 6 : 4) : 0;
    const int NT = 4 + (lt_hi - lt_lo);
    LAS float* wsf = (LAS float*)(shm + A_WS) + wid * 128;
    const bf16_t* kcol = PROJ + C_K + kvh * 64 + wid * 8;
    const bf16_t* vcol = PROJ + C_VV + kvh * 64 + (wid >> 2) * 32 + (lane & 3) * 8;
#define MX_LT(t) (NT == 10 ? ((t) < 8 ? (t) - 3 : ((t) == 8 ? 0 : 5)) : (t) - 4 + lt_lo)
#define MX_TROW(t) ((t) < 4 ? ctx0 + 64 * (t) : b * SEQ + blk * 128 - 128 + 64 * MX_LT(t))
#define MX_DMA(t) do { const int _r0 = MX_TROW(t); const int _sl = (t) & (NSLOT - 1); \
        __builtin_amdgcn_global_load_lds((const unsigned*)(kcol + (size_t)(_r0 + lane) * INC), (LAS unsigned*)(shm + A_K + _sl * SLOTB + wid * 1024), 16, 0, 0); \
        __builtin_amdgcn_global_load_lds((const unsigned*)(vcol + (size_t)(_r0 + 16 * (wid & 3) + (lane >> 2)) * INC), (LAS unsigned*)(shm + A_V + _sl * SLOTB + wid * 1024), 16, 0, 0); } while (0)
    static_assert(NH == 1, "the conv slice deal assumes four attention units per chunk");
    const int cm0 = qrow0 + (kvh * 2 + hp) * 32;
    ConvRaw CR; conv_load(CR, PROJ, cm0, tid, 0);
    bf16x8 qr[NH][4];
    { const bf16_t* qp = PROJ + (size_t)(qrow0 + qw + r32) * INC + C_Q + head0 * 64 + hi * 8;
#pragma unroll
      for (int hh = 0; hh < NH; ++hh)
#pragma unroll
          for (int d0 = 0; d0 < 4; ++d0) qr[hh][d0] = *(const bf16x8*)(qp + hh * 64 + d0 * 16); }
    MX_DMA(0); MX_DMA(1);
    float mrun[NH], lsum[NH]; f32x16 o[NH][2], negm[NH];
#pragma unroll
    for (int hh = 0; hh < NH; ++hh) { mrun[hh] = sink[head0 + hh] * LOG2E; lsum[hh] = hi == 0 ? 1.0f : 0.0f;
#pragma unroll
        for (int r = 0; r < 16; ++r) negm[hh][r] = -mrun[hh];
        o[hh][0] = (f32x16){0.f, 0.f, 0.f, 0.f, 0.f, 0.f, 0.f, 0.f, 0.f, 0.f, 0.f, 0.f, 0.f, 0.f, 0.f, 0.f}; o[hh][1] = o[hh][0]; }
    const unsigned vb0 = (unsigned)(size_t)(shm + A_V) + ((lane >> 4) & 1) * 32 + (lane & 3) * 8 + (4 * hi + ((lane & 15) >> 2)) * 64;
    const int qc = qw + r32;
    const int NTP = NT == 10 ? 8 : NT;
    for (int t = 0; t < NTP; t += 2) {
        asm volatile("s_waitcnt vmcnt(0) lgkmcnt(0)\n\ts_barrier" ::: "memory");
        if (t + 2 < NT) { MX_DMA(t + 2); MX_DMA(t + 3); }
        if (t == 2) { conv_finish(CR, cwl, MIXo, cm0, tid, 0); conv_load(CR, PROJ, cm0, tid, 1); }
        const int sa = t & (NSLOT - 1), sb = (t + 1) & (NSLOT - 1);
        f32x16 pa0, pa1, pb0, pb1;
        { f32x16 ng; float nm = -mrun[0]; asm volatile("" : "+v"(nm));
#pragma unroll
          for (int r = 0; r < 16; ++r) ng[r] = nm;
          qkt2(pa0, pa1, pb0, pb1, shm + A_K + sa * SLOTB, shm + A_K + sb * SLOTB, qr[0], ng, r32, hi); }
        if (t >= 4) {
#pragma unroll
            for (int q = 0; q < 2; ++q) { const int lt = MX_LT(t + q); if (lt < 2 || lt >= 4) { const int kb = -128 + 64 * lt;
#pragma unroll
                for (int r = 0; r < 16; ++r) { const int k0 = kb + crow(r, hi), k1 = k0 + 32; const bool m0_ = (k0 < qc - 128 || k0 > qc + 128), m1_ = (k1 < qc - 128 || k1 > qc + 128);
                    if (q == 0) { if (m0_) pa0[r] = -1e30f; if (m1_) pa1[r] = -1e30f; } else { if (m0_) pb0[r] = -1e30f; if (m1_) pb1[r] = -1e30f; } } } } }
        float ma = MX3(pa0[0], pa1[0], pb0[0]), mb = MX3(pb1[0], pa0[1], pa1[1]); ma = MX3(ma, pb0[1], pb1[1]);
#pragma unroll
        for (int r = 2; r < 16; r += 2) { ma = MX3(ma, pa0[r], pa1[r]); mb = MX3(mb, pb0[r], pb1[r]); ma = MX3(ma, pa0[r + 1], pa1[r + 1]); mb = MX3(mb, pb0[r + 1], pb1[r + 1]); }
        float rm = __builtin_fmaxf(ma, mb);
        { auto rr = __builtin_amdgcn_permlane32_swap(__float_as_uint(rm), __float_as_uint(rm), false, false); rm = __builtin_fmaxf(__uint_as_float(rr[0]), __uint_as_float(rr[1])); }
        if (__any(rm > (float)ATT_THR)) { const float dl = __builtin_fmaxf(rm, 0.f); mrun[0] += dl;
#pragma unroll
            for (int r = 0; r < 16; ++r) { pa0[r] -= dl; pa1[r] -= dl; pb0[r] -= dl; pb1[r] -= dl; }
            const float f = __builtin_amdgcn_exp2f(-dl); lsum[0] *= f; if (hi == 0) wsf[r32] = f;
            asm volatile("s_waitcnt lgkmcnt(0)" ::: "memory");
#pragma unroll
            for (int r = 0; r < 16; ++r) { const float fr_ = *(volatile LAS float*)(wsf + crow(r, hi)); o[0][0][r] *= fr_; o[0][1][r] *= fr_; } }
#pragma unroll
        for (int r = 0; r < 16; ++r) { pa0[r] = __builtin_amdgcn_exp2f(pa0[r]); pa1[r] = __builtin_amdgcn_exp2f(pa1[r]); pb0[r] = __builtin_amdgcn_exp2f(pb0[r]); pb1[r] = __builtin_amdgcn_exp2f(pb1[r]); }
        { f32x2 s2 = (f32x2){pa0[0], pa0[1]} + (f32x2){pa1[0], pa1[1]}, s3 = (f32x2){pb0[0], pb0[1]} + (f32x2){pb1[0], pb1[1]};
#pragma unroll
          for (int r = 2; r < 16; r += 2) { s2 += (f32x2){pa0[r], pa0[r + 1]}; s3 += (f32x2){pb0[r], pb0[r + 1]}; s2 += (f32x2){pa1[r], pa1[r + 1]}; s3 += (f32x2){pb1[r], pb1[r + 1]}; }
          s2 += s3; lsum[0] += s2.x + s2.y; }
        { u32x4 pw0, pw1, pw2, pw3, pw4, pw5, pw6, pw7;
#pragma unroll
          for (int i = 0; i < 4; ++i) { pw0[i] = cvtpk(pa0[2 * i], pa0[2 * i + 1]); pw1[i] = cvtpk(pa0[8 + 2 * i], pa0[8 + 2 * i + 1]); pw2[i] = cvtpk(pa1[2 * i], pa1[2 * i + 1]); pw3[i] = cvtpk(pa1[8 + 2 * i], pa1[8 + 2 * i + 1]);
                                        pw4[i] = cvtpk(pb0[2 * i], pb0[2 * i + 1]); pw5[i] = cvtpk(pb0[8 + 2 * i], pb0[8 + 2 * i + 1]); pw6[i] = cvtpk(pb1[2 * i], pb1[2 * i + 1]); pw7[i] = cvtpk(pb1[8 + 2 * i], pb1[8 + 2 * i + 1]); }
          pv2(o[0], vb0 + sa * SLOTB, vb0 + sb * SLOTB, pw0, pw1, pw2, pw3, pw4, pw5, pw6, pw7); }
    }
    if (NT == 10) {
        asm volatile("s_waitcnt vmcnt(0) lgkmcnt(0)\n\ts_barrier" ::: "memory");
        const int ss = qw < 64 ? 0 : 1, kb = qw < 64 ? -128 : 192;
        f32x16 p0, p1;
        { f32x16 ng; float nm = -mrun[0]; asm volatile("" : "+v"(nm));
#pragma unroll
          for (int r = 0; r < 16; ++r) ng[r] = nm;
          qkt(p0, p1, shm + A_K + ss * SLOTB, qr[0], ng, r32, hi); }
#pragma unroll
        for (int r = 0; r < 16; ++r) { const int k0 = kb + crow(r, hi), k1 = k0 + 32; if (k0 < qc - 128 || k0 > qc + 128) p0[r] = -1e30f; if (k1 < qc - 128 || k1 > qc + 128) p1[r] = -1e30f; }
        float ma = MX3(p0[0], p1[0], p0[1]), mb = MX3(p1[1], p0[2], p1[2]);
#pragma unroll
        for (int r = 3; r < 15; r += 2) { ma = MX3(ma, p0[r], p1[r]); mb = MX3(mb, p0[r + 1], p1[r + 1]); }
        float rm = MX3(ma, mb, __builtin_fmaxf(p0[15], p1[15]));
        { auto rr = __builtin_amdgcn_permlane32_swap(__float_as_uint(rm), __float_as_uint(rm), false, false); rm = __builtin_fmaxf(__uint_as_float(rr[0]), __uint_as_float(rr[1])); }
        if (__any(rm > (float)ATT_THR)) { const float dl = __builtin_fmaxf(rm, 0.f); mrun[0] += dl;
#pragma unroll
            for (int r = 0; r < 16; ++r) { p0[r] -= dl; p1[r] -= dl; }
            const float f = __builtin_amdgcn_exp2f(-dl); lsum[0] *= f; if (hi == 0) wsf[r32] = f;
            asm volatile("s_waitcnt lgkmcnt(0)" ::: "memory");
#pragma unroll
            for (int r = 0; r < 16; ++r) { const float fr_ = *(volatile LAS float*)(wsf + crow(r, hi)); o[0][0][r] *= fr_; o[0][1][r] *= fr_; } }
#pragma unroll
        for (int r = 0; r < 16; ++r) { p0[r] = __builtin_amdgcn_exp2f(p0[r]); p1[r] = __builtin_amdgcn_exp2f(p1[r]); }
        { f32x2 s2 = (f32x2){p0[0], p0[1]} + (f32x2){p1[0], p1[1]};
#pragma unroll
          for (int r = 2; r < 16; r += 2) { s2 += (f32x2){p0[r], p0[r + 1]}; s2 += (f32x2){p1[r], p1[r + 1]}; }
          lsum[0] += s2.x + s2.y; }
        { u32x4 pw0, pw1, pw2, pw3;
#pragma unroll
          for (int i = 0; i < 4; ++i) { pw0[i] = cvtpk(p0[2 * i], p0[2 * i + 1]); pw1[i] = cvtpk(p0[8 + 2 * i], p0[8 + 2 * i + 1]); pw2[i] = cvtpk(p1[2 * i], p1[2 * i + 1]); pw3[i] = cvtpk(p1[8 + 2 * i], p1[8 + 2 * i + 1]); }
          pv(o[0], vb0 + ss * SLOTB, __builtin_bit_cast(bf16x8, pw0), __builtin_bit_cast(bf16x8, pw1), __builtin_bit_cast(bf16x8, pw2), __builtin_bit_cast(bf16x8, pw3)); }
    }
    LAS unsigned char* stg = (LAS unsigned char*)(shm + A_OST) + wid * 2048;
#pragma unroll
    for (int hh = 0; hh < NH; ++hh) {
        float ls = lsum[hh];
        { auto rr = __builtin_amdgcn_permlane32_swap(__float_as_uint(ls), __float_as_uint(ls), false, false); ls = __uint_as_float(rr[0]) + __uint_as_float(rr[1]); }
        if (hi == 0) wsf[hh * 64 + 32 + r32] = ls;
        asm volatile("s_waitcnt lgkmcnt(0)" ::: "memory");
#pragma unroll
        for (int r = 0; r < 16; ++r) { const int orow = crow(r, hi); const float rl = __builtin_amdgcn_rcpf(*(volatile LAS float*)(wsf + hh * 64 + 32 + orow)) * (float)(1 << F8_SH_M);
            const unsigned w = pk4_fp8(o[hh][0][r], o[hh][1][r], 0.f, 0.f, rl); stg[orow * 64 + r32] = (unsigned char)(w & 0xffu); stg[orow * 64 + 32 + r32] = (unsigned char)((w >> 8) & 0xffu); }
        asm volatile("s_waitcnt lgkmcnt(0)" ::: "memory");
        unsigned char* op = MIXo + (size_t)(qrow0 + qw) * D + 512 + (head0 + hh) * 64;
#pragma unroll
        for (int i = 0; i < 2; ++i) { const int row = i * 16 + (lane >> 2), ch = lane & 3; const u32x4 v = *(const LAS u32x4*)(stg + row * 64 + ch * 16); *(u32x4*)(op + (size_t)row * D + ch * 16) = v; }
        asm volatile("s_waitcnt lgkmcnt(0)" ::: "memory");
    }
    conv_finish(CR, cwl, MIXo, cm0, tid, 1);
    asm volatile("s_barrier" ::: "memory");
#undef MX_DMA
#undef MX_TROW
}

__device__ __forceinline__ void gmlp_conv_unit(const Ptrs& P, const bf16_t* PROJ, unsigned char* MIXo, LAS unsigned char* shm, int l, int m0, int tid) {
    const int lane = tid & 63, r32 = lane & 31, hi = lane >> 5; const int wid = __builtin_amdgcn_readfirstlane(tid >> 6);
    LAS bf16_t* vT = (LAS bf16_t*)shm;
    { u32x2 raw[16];
#pragma unroll
      for (int rr = 0; rr < 16; ++rr) raw[rr] = *(const u32x2*)(PROJ + (size_t)(m0 + wid * 16 + rr) * INC + C_V + 4 * lane);
      float gv[4];
#pragma unroll
      for (int i = 0; i < 4; ++i) gv[i] = ((const float*)(P.ws + WS_PAR))[PAR_GG + l * 256 + 4 * lane + i];
#pragma unroll
      for (int r4 = 0; r4 < 4; ++r4) { float g[4][4], ss[4];
#pragma unroll
          for (int q = 0; q < 4; ++q) { const u32x2 w = raw[r4 * 4 + q];
              g[q][0] = gelu_fast(__uint_as_float(w.x << 16)); g[q][1] = gelu_fast(__uint_as_float(w.x & 0xffff0000u)); g[q][2] = gelu_fast(__uint_as_float(w.y << 16)); g[q][3] = gelu_fast(__uint_as_float(w.y & 0xffff0000u));
              ss[q] = g[q][0] * g[q][0] + g[q][1] * g[q][1] + g[q][2] * g[q][2] + g[q][3] * g[q][3]; }
#pragma unroll
          for (int q = 0; q < 4; ++q) ss[q] = wave_sum(ss[q]);
          float rinv[4];
#pragma unroll
          for (int q = 0; q < 4; ++q) rinv[q] = rsqrtf(ss[q] * (1.0f / 256.0f) + EPS);
#pragma unroll
          for (int i = 0; i < 4; ++i) { u32x2 w; w.x = cvtpk(g[0][i] * rinv[0] * gv[i], g[1][i] * rinv[1] * gv[i]); w.y = cvtpk(g[2][i] * rinv[2] * gv[i], g[3][i] * rinv[3] * gv[i]);
              *(LAS u32x2*)(vT + (4 * lane + i) * VT_PITCH + wid * 16 + r4 * 4) = w; } } }
    asm volatile("s_waitcnt lgkmcnt(0)\n\ts_barrier" ::: "memory");
    { const int h = wid >> 1, dt = wid & 1;
      const bf16_t* wsb = (const bf16_t*)(P.ws + WS_WSB) + ((size_t)(l * 4 + h) * 128) * 128 + (size_t)r32 * 128 + hi * 8;
      bf16x8 bfr[2][8];
#pragma unroll
      for (int kk = 0; kk < 8; ++kk) bfr[0][kk] = *(const bf16x8*)(wsb + kk * 16);
      u32x2 uraw[4][4];
#pragma unroll
      for (int pt = 0; pt < 4; ++pt)
#pragma unroll
          for (int q4 = 0; q4 < 4; ++q4) uraw[pt][q4] = *(const u32x2*)(PROJ + (size_t)(m0 + pt * 32 + r32) * INC + C_U + h * 64 + dt * 32 + 4 * hi + 8 * q4);
      bf16x8 af[8];
#pragma unroll
      for (int kk = 0; kk < 8; ++kk) af[kk] = *(const LAS bf16x8*)(vT + (h * 64 + dt * 32 + r32) * VT_PITCH + kk * 16 + hi * 8);
      const float* bs = (const float*)(P.ws + WS_PAR) + PAR_BS + (l * 4 + h) * 128;
#pragma unroll
      for (int pt = 0; pt < 4; ++pt) {
          if (pt < 3) {
#pragma unroll
              for (int kk = 0; kk < 8; ++kk) bfr[(pt + 1) & 1][kk] = *(const bf16x8*)(wsb + (size_t)(pt + 1) * 32 * 128 + kk * 16); }
          f32x16 acc = (f32x16){0.f, 0.f, 0.f, 0.f, 0.f, 0.f, 0.f, 0.f, 0.f, 0.f, 0.f, 0.f, 0.f, 0.f, 0.f, 0.f};
#pragma unroll
          for (int kk = 0; kk < 8; ++kk) acc = __builtin_amdgcn_mfma_f32_32x32x16_bf16(af[kk], bfr[pt & 1][kk], acc, 0, 0, 0);
          const int p = pt * 32 + r32; const float bias = bs[p];
          unsigned char* op = MIXo + (size_t)(m0 + p) * D + h * 64 + dt * 32 + 4 * hi;
#pragma unroll
          for (int q4 = 0; q4 < 4; ++q4) { const u32x2 raw = uraw[pt][q4];
              const float u0 = gelu_fast(__uint_as_float(raw.x << 16)), u1 = gelu_fast(__uint_as_float(raw.x & 0xffff0000u)), u2 = gelu_fast(__uint_as_float(raw.y << 16)), u3 = gelu_fast(__uint_as_float(raw.y & 0xffff0000u));
              *(unsigned*)(op + 8 * q4) = pk4_fp8(u0 * (acc[4 * q4] + bias), u1 * (acc[4 * q4 + 1] + bias), u2 * (acc[4 * q4 + 2] + bias), u3 * (acc[4 * q4 + 3] + bias), (float)(1 << F8_SH_M)); }
      } }
    asm volatile("s_waitcnt lgkmcnt(0)\n\ts_barrier" ::: "memory");
}
}

#ifdef STAMPS
#define MXT(kind, op) do { if ((kind) == STAMP_K1) tacc_ op##= __builtin_amdgcn_s_memrealtime(); } while (0)
#else
#define MXT(kind, op) do { } while (0)
#endif
constexpr int ATT_NH = 1;
__device__ __forceinline__ void phase_mixer(const Ptrs& P, LAS unsigned char* lds, int l, int Mmix, unsigned long long& tacc_, int wid_s) {
    int tid = wid_s * 64 + wg_lane(); asm volatile("" : "+v"(tid));
    const bf16_t* PROJ = (const bf16_t*)(P.ws + WS_PROJ); unsigned char* MIXo = (unsigned char*)(P.ws + WS_MIX);
    const int G = gridDim.x, c = blockIdx.x;
    constexpr int UPC = ATT_NH == 2 ? 2 : 4;
    const int nLat = (ML / 128) * UPC, nCtx = Mmix > ML ? (MC / 128) * UPC : 0, nG = Mmix / 128;
    const bool gfirst = (c & 1) != 0;
    for (int pass = 0; pass < 2; ++pass) {
        if ((pass == 0) != gfirst) { MXT(20, -); for (int u = c; u < nLat; u += G) { const int chunk = u / UPC, kvh = (u / (UPC / 2)) & 1, hp = u & 1; mx::attn_unit<ATT_NH>(PROJ, MIXo, (const float*)(P.ws + WS_PAR) + PAR_SINK + l * 8, (const float*)(P.ws + WS_PAR) + PAR_CW + l * 768, lds, 1, chunk >> 6, chunk & 63, kvh, hp, tid); } MXT(20, +); }
        else { MXT(21, -); for (int u = c; u < nG + nCtx; u += G) {
            if (u < nG) mx::gmlp_conv_unit(P, PROJ, MIXo, lds, l, u * 128, tid);
            else { const int v = u - nG, chunk = v / UPC, kvh = (v / (UPC / 2)) & 1, hp = v & 1; mx::attn_unit<ATT_NH>(PROJ, MIXo, (const float*)(P.ws + WS_PAR) + PAR_SINK + l * 8, (const float*)(P.ws + WS_PAR) + PAR_CW + l * 768, lds, 0, chunk >> 1, chunk & 1, kvh, hp, tid); } } MXT(21, +); }
    }
}
constexpr int NPH = 31;
struct KArgs { Ptrs P; int lo, hi; };
__global__ void __launch_bounds__(NTHR, 2) k_fast(KArgs a) {
    extern __shared__ __attribute__((aligned(16))) unsigned char lds_raw[];
    LAS unsigned char* lds = (LAS unsigned char*)lds_raw;
    const int lo = a.lo, hi = a.hi;
#if defined(__HIP_DEVICE_COMPILE__) && defined(USE_KERNARG_RELOAD)
#define LOADP() const __attribute__((address_space(4))) unsigned long long* ap_ = (const __attribute__((address_space(4))) unsigned long long*)__builtin_amdgcn_kernarg_segment_ptr(); asm volatile("" : "+s"(ap_)); \
    Ptrs P; { unsigned long long* d_ = (unsigned long long*)&P; _Pragma("unroll") for (int i_ = 0; i_ < (int)(sizeof(Ptrs) / 8); ++i_) d_[i_] = ap_[i_]; }
#else
#define LOADP() const Ptrs P = a.P
#endif
    unsigned* ctl; { LOADP(); ctl = (unsigned*)(P.ws + WS_CTL); }
    if (threadIdx.x < 4) ((LAS unsigned*)(lds + MISC_OFF))[threadIdx.x] = 0u;
    __syncthreads();
    XcdBarrier bar; bar.bar = ctl + CW_BAR; bar.x = 0; bar.st = (volatile LAS unsigned*)(lds + MISC_OFF);
    if (hi - lo > 1) bar = xcd_barrier_post(ctl + CW_BAR, (volatile LAS unsigned*)(lds + MISC_OFF));
    const int wid_s = __builtin_amdgcn_readfirstlane((int)(threadIdx.x >> 6)); bar.wid = wid_s;
    volatile LAS int* vcw = (volatile LAS int*)(lds + MISC_OFF + 32);
    if (threadIdx.x == 0) { vcw[3] = 0; vcw[0] = (int)blockIdx.x; vcw[1] = (int)xb_xcc_id(); vcw[2] = (hi - lo > 1) ? (int)xb_add(ctl + CW_XR + 64 * xb_xcc_id(), 1u) : 0; }
    __syncthreads();
#define IN(k, kind) (lo <= (k) && (k) < hi)
#ifdef STAMPS
#define TSTART(kind) do { if ((kind) == STAMP_K1) tacc_ -= __builtin_amdgcn_s_memrealtime(); } while (0)
#define TSTOP(kind) do { if ((kind) == STAMP_K1) tacc_ += __builtin_amdgcn_s_memrealtime(); } while (0)
    unsigned long long tacc_ = 0;
#else
#define TSTART(kind) do { } while (0)
#define TSTOP(kind) do { } while (0)
    unsigned long long tacc_ = 0;
#endif
#define SEAM(k) do { if (lo <= (k) && (k) + 1 < hi) xcd_barrier(bar); } while (0)

    LAS unsigned* idxtab = (LAS unsigned*)(lds + IDX_OFF);
    LAS int* tst = (LAS int*)(lds + TST_OFF);

    TSTART(0);
    if (IN(0, 0)) { LOADP(); phase_p0a(P, lds); }
    SEAM(0); TSTOP(0);
    if (lo == 0 && hi > 1) {
        if (threadIdx.x == 0) { const int myx = vcw[1], rank = vcw[2]; int npop = 0, xi = 0; bool even = true;
            for (int j = 0; j < 16; ++j) { const unsigned cj = xb_ld(ctl + CW_XR + 64 * j); if (cj) { ++npop; if (j < myx) ++xi; if (cj * 8u != gridDim.x) even = false; } }
            if (even && npop == 8 && rank < (int)(gridDim.x / 8)) { vcw[0] = rank * 8 + xi; vcw[3] = (int)(gridDim.x / 8); }
            }
        __syncthreads(); }
    const int vc = vcw[0];
    if (IN(1, 1)) { LOADP(); phase_p0b(P); }
    SEAM(1);
    for (int l = 0; l < DEPTH; ++l) {
        const int pb = 2 + 7 * l;
        const int Mmix = l < DEPTH - 1 ? MT : ML;
        TSTART(2);
        if (IN(pb + 0, 2)) { LOADP();
            if (l == 0) phase_norm<1, true>(P, lds, l, MT, (const bf16_t*)P.out, tst, wid_s); else phase_norm<1, false>(P, lds, l, MT, (const bf16_t*)P.out, tst, wid_s); }
        SEAM(pb + 0); TSTOP(2);
        TSTART(3);
        if (IN(pb + 1, 3)) { LOADP();
            SchedDense<INC, G1_FP8 ? 1 : 2, F8_SH_H> S{P.ws + WS_H, P.ws + WS_WIN + (size_t)l * INC * D * (G1_FP8 ? 1 : 2), MT / 256, (int)gridDim.x, vc};
            { const float* rt = (const float*)(P.ws + WS_ROPE); LAS _Float16* rl = (LAS _Float16*)(lds + ROPEL_OFF);
              for (int i = wid_s * 64 + wg_lane(); i < 4096; i += NTHR) rl[i] = (_Float16)rt[i];
              __syncthreads(); }
            EpiProj E{(bf16_t*)(P.ws + WS_PROJ), (const LAS _Float16*)(lds + ROPEL_OFF)};
            pg::gemm_phase(lds + RING_OFF, idxtab, S, E, wid_s);
            if (l + 1 < DEPTH) { const int um = (int)(((MT / 256) * (INC / 256)) % (int)gridDim.x); if (vc >= um) convert_tail(P.ws, lds, l + 1, 0, vc - um, (int)gridDim.x - um, wid_s); }
        }
        SEAM(pb + 1); TSTOP(3);
        TSTART(4);
        if (IN(pb + 2, 4)) { LOADP(); phase_mixer(P, lds, l, Mmix, tacc_, wid_s); }
        SEAM(pb + 2); TSTOP(4);
        TSTART(5);
        if (IN(pb + 3, 5)) { LOADP();
            SchedDense<D, 1, F8_SH_M> S{P.ws + WS_MIX, P.ws + WS_WOUT + (size_t)l * D * D, Mmix / 256, (int)gridDim.x, vc};
            EpiResid E{(bf16_t*)(P.ws + WS_XB), (const float*)(P.ws + WS_MOD) + (size_t)l * 9 * 6144 + 2048};
            pg::gemm_phase(lds + RING_OFF, idxtab, S, E, wid_s);
            if (l + 1 < DEPTH) { const int um = (int)(((Mmix / 256) * (D / 256)) % (int)gridDim.x); if (vc >= um) convert_tail(P.ws, lds, l + 1, 1, vc - um, (int)gridDim.x - um, wid_s); }
        }
        SEAM(pb + 3); TSTOP(5);
        TSTART(6);
        if (IN(pb + 4, 6)) { LOADP(); phase_norm<2, false>(P, lds, l, Mmix, (const bf16_t*)(P.ws + WS_PROJ), tst, wid_s); }
        SEAM(pb + 4); TSTOP(6);
        TSTART(7);
        if (IN(pb + 5, 7)) { LOADP(); const ClsRec* listr = (const ClsRec*)(P.ws + WS_LISTR);
            build_tile_table(P, tst, l, wid_s);
            SchedGU S{(const unsigned char*)(P.ws + WS_H), (const unsigned char*)(P.ws + WS_WGU) + (size_t)l * NE * 1024 * 1024, listr, tst, ctl + CW_CNTF + l * 32 * 64, (int)gridDim.x, vc};
            EpiGU E{(unsigned char*)(P.ws + WS_PROJ), listr, ctl + CW_CNTF + l * 32 * 64};
            pg::gemm_phase(lds + RING_OFF, idxtab, S, E, wid_s);
            if (l + 1 < DEPTH) { const int um = (int)((__builtin_amdgcn_readfirstlane(tst[NCLS]) * 8) % (int)gridDim.x); if (vc >= um) convert_tail(P.ws, lds, l + 1, 2, vc - um, (int)gridDim.x - um, wid_s); }
        }
        SEAM(pb + 5); TSTOP(7);
        TSTART(8);
        if (IN(pb + 6, 8)) { LOADP();
            build_tile_table(P, tst, l, wid_s);
            SchedDown S{(const unsigned char*)(P.ws + WS_PROJ), (const unsigned char*)(P.ws + WS_WD) + (size_t)l * NE * 1024 * 512, tst, (int)gridDim.x, vc};
            EpiDownResid E{(bf16_t*)(P.ws + WS_XB), (const float*)(P.ws + WS_MOD) + (size_t)l * 9 * 6144 + 5120, (const ClsRec*)(P.ws + WS_LISTR), ctl + CW_CNTF + l * 32 * 64};
            pg::gemm_phase(lds + RING_OFF, idxtab, S, E, wid_s);
            if (l + 1 < DEPTH) { const int um = (int)((__builtin_amdgcn_readfirstlane(tst[NCLS]) * 4) % (int)gridDim.x); if (vc >= um) convert_tail(P.ws, lds, l + 1, 3, vc - um, (int)gridDim.x - um, wid_s); }
        }
        SEAM(pb + 6); TSTOP(8);
    }
    TSTART(9);
    if (IN(30, 9)) { LOADP(); phase_norm<3, false>(P, lds, DEPTH - 1, ML, (const bf16_t*)(P.ws + WS_H), tst, wid_s); }
#ifdef STAMPS
    TSTOP(9);
    if (blockIdx.x == 0) { const unsigned long long t1 = __builtin_amdgcn_s_memrealtime(); while (__builtin_amdgcn_s_memrealtime() - t1 < (unsigned long long)(SPINK) * tacc_) __builtin_amdgcn_s_sleep(8); }
#endif
#undef IN
#undef SEAM
}
static int g_grid = 256;
static void launch_fast(const Ptrs& P, int lo, int hi, hipStream_t stream) {
    KArgs a{}; a.P = P; a.lo = lo; a.hi = hi;
    hipLaunchKernelGGL(k_fast, dim3(g_grid), dim3(NTHR), LDS_BYTES, stream, a);
}
extern "C" void kernel_launch(void* const* d_in, const int* in_sizes, int n_in, void* d_out, int out_size, void* d_ws, size_t ws_size, hipStream_t stream) {
    static int ready = 0;
    if (!ready) {
        if (n_in != 21 || ws_size < WS_END2) { fprintf(stderr, "kernel_launch: unexpected inputs (%d) or workspace (%zu)\n", n_in, ws_size); ready = -1; return; }
        if (hipFuncSetAttribute((const void*)k_fast, hipFuncAttributeMaxDynamicSharedMemorySize, LDS_BYTES) != hipSuccess) { fprintf(stderr, "kernel_launch: hipFuncSetAttribute failed\n"); ready = -1; return; }
        { int dev = 0, cus = 0, per_cu = 0; (void)hipGetDevice(&dev); (void)hipDeviceGetAttribute(&cus, hipDeviceAttributeMultiprocessorCount, dev);
          if (hipOccupancyMaxActiveBlocksPerMultiprocessor(&per_cu, (const void*)k_fast, NTHR, LDS_BYTES) != hipSuccess || per_cu < 1) { fprintf(stderr, "kernel_launch: occupancy query says %d blocks per CU\n", per_cu); }
          (void)hipGetLastError(); if (cus > 0) g_grid = cus;
          if (g_grid * NWAVES * 64 < MT) { fprintf(stderr, "kernel_launch: %d workgroups are too few for the routing tables\n", g_grid); ready = -1; return; } }
        ready = 1;
    }
    if (ready < 0) return;
    Ptrs P{};
    const float** pp = (const float**)&P;
    for (int i = 0; i < 21; ++i) pp[i] = (const float*)d_in[i];
    P.out = (float*)d_out; P.ws = (unsigned char*)d_ws;
    unsigned char* ws = (unsigned char*)d_ws;
    (void)hipMemsetAsync(ws + WS_CTL, 0, 1 * MiB, stream);
    launch_fast(P, 0, NPH, stream);
}
```

```cpp
#include <hip/hip_runtime.h>
#include <stdint.h>
#include <cstdio>

constexpr int D = 1024, NB = 8, SEQ = 8192, DEPTH = 4, CTXL = 256;
constexpr int ML = NB * SEQ;
constexpr int MC = NB * CTXL;
constexpr int MT = ML + MC;
constexpr int INC = 2048;
constexpr int C_U = 0, C_V = 256, C_BG = 512, C_CG = 768, C_Z = 1024, C_Q = 1280, C_K = 1792, C_VV = 1920;
constexpr int NE = 16, DE = 512, NCLS = 24;
constexpr float EPS = 1e-6f;
constexpr float QSCALE = 0.125f * 1.4426950408889634f;
constexpr float LOG2E = 1.4426950408889634f;

typedef unsigned short bf16_t;
typedef float f32x4 __attribute__((ext_vector_type(4)));
typedef unsigned u32x4 __attribute__((ext_vector_type(4)));
typedef unsigned u32x2 __attribute__((ext_vector_type(2)));

__device__ __forceinline__ float bf2f(bf16_t v) { return __uint_as_float((unsigned)v << 16); }
__device__ __forceinline__ bf16_t f2bf(float f) { unsigned u = __float_as_uint(f); return (bf16_t)((u + 0x7fffu + ((u >> 16) & 1u)) >> 16); }
__device__ __forceinline__ unsigned pk2(float lo, float hi) { return (unsigned)f2bf(lo) | ((unsigned)f2bf(hi) << 16); }
__device__ __forceinline__ float gelu_tanh(float x) { const float y = 0.7978845608028654f * (x + 0.044715f * x * x * x); return x / (1.0f + __expf(-2.0f * y)); }
__device__ __forceinline__ float silu_f(float x) { return x / (1.0f + __expf(-x)); }
template <int CTRL> __device__ __forceinline__ float dppf(float v) { return __int_as_float(__builtin_amdgcn_update_dpp(0, __float_as_int(v), CTRL, 0xF, 0xF, true)); }
__device__ __forceinline__ float xor4f(float v) { int t = __builtin_amdgcn_update_dpp(0, __float_as_int(v), 0x104, 0xF, 0x5, false); t = __builtin_amdgcn_update_dpp(t, __float_as_int(v), 0x114, 0xF, 0xA, false); return __int_as_float(t); }
__device__ __forceinline__ float swsum16(float a, float b) { auto r = __builtin_amdgcn_permlane16_swap(__float_as_uint(a), __float_as_uint(b), false, false); return __uint_as_float(r[0]) + __uint_as_float(r[1]); }
__device__ __forceinline__ float swsum32(float a, float b) { auto r = __builtin_amdgcn_permlane32_swap(__float_as_uint(a), __float_as_uint(b), false, false); return __uint_as_float(r[0]) + __uint_as_float(r[1]); }
__device__ __forceinline__ float wave_sum(float v) { v += dppf<0xB1>(v); v += dppf<0x4E>(v); v += dppf<0x124>(v); v += dppf<0x128>(v); v = swsum16(v, v); return swsum32(v, v); }

constexpr size_t MiB = 1u << 20;
constexpr size_t WS_CTL = 0;
constexpr size_t WS_MOD = 1 * MiB;
constexpr size_t WS_ROPE = 2 * MiB;
constexpr size_t WS_PTAB = 2 * MiB + 65536;
constexpr size_t WS_PAR = 2 * MiB + 131072;
constexpr int PAR_RW = 0, PAR_N1 = 16384, PAR_N2 = 20480, PAR_FG = 24576, PAR_RB = 25600, PAR_BS = 25664, PAR_GG = 27712, PAR_SINK = 28736, PAR_CW = 28800, PAR_END = 31872;
constexpr size_t WS_TOK = 3 * MiB;
constexpr size_t WS_XC = 5 * MiB;
constexpr size_t WS_LISTE = 13 * MiB;
constexpr size_t WS_LISTC = 18 * MiB;
constexpr size_t WS_VN = 25 * MiB;
constexpr size_t WS_WIN = 64 * MiB, WS_WOUT = 80 * MiB, WS_WGU = 88 * MiB, WS_WD = 216 * MiB;
constexpr size_t WS_H = 280 * MiB;
constexpr size_t WS_MIX = 412 * MiB;
constexpr size_t WS_PROJ = 544 * MiB;
constexpr size_t WS_END = 808 * MiB;
constexpr int CW_CNTE = 1024;
constexpr int CW_CNTC = 2048;

struct Tok { unsigned ids; float wlo, whi; unsigned pad; };

struct Ptrs {
    const float *x, *c, *ctx, *c_ctx, *w_mod, *b_mod, *norm1_g, *norm2_g, *w_in, *gmlp_g, *w_s, *b_s, *conv_w, *sink, *w_out, *router_w, *router_b, *w_gate, *w_up, *w_down, *final_g;
    float* out; unsigned char* ws;
};
__device__ __forceinline__ int modrow(int m) { return m < ML ? (m >> 13) : 8; }

#define LAS __attribute__((address_space(3)))
#define XB_TMO      128
#define XB_XCNT(j)  (256  + 64 * (j))
#define XB_XSUB(j)  (1280 + 64 * (j))
#define XB_XGEN(j)  (2304 + 64 * (j))
#define XB_TOP      3328
#define XB_TOPGEN   3392
#define XCD_BAR_WORDS 3456
#define XB_SPIN_CAP (1u << 18)

__device__ __forceinline__ unsigned xb_ld(unsigned* p)              { return __hip_atomic_load(p, __ATOMIC_RELAXED, __HIP_MEMORY_SCOPE_AGENT); }
__device__ __forceinline__ unsigned xb_add(unsigned* p, unsigned v) { return __hip_atomic_fetch_add(p, v, __ATOMIC_RELAXED, __HIP_MEMORY_SCOPE_AGENT); }
__device__ __forceinline__ unsigned xb_xcc_id() { return (unsigned)__builtin_amdgcn_s_getreg((3 << 11) | 20) & 0xFu; }
#define XB_SPIN(cond, bar) do { unsigned _sp = 0; while (cond) { __builtin_amdgcn_s_sleep(1); \
    if ((++_sp & 255u) == 0u) { if (xb_ld(&(bar)[XB_TMO])) break; if (_sp > XB_SPIN_CAP) { atomicAdd(&(bar)[XB_TMO], 1u); break; } } } } while (0)

__device__ __forceinline__ int wg_lane() { int l_; asm volatile("v_mbcnt_lo_u32_b32 %0, -1, 0\n\tv_mbcnt_hi_u32_b32 %0, -1, %0" : "=&v"(l_)); return l_; }
struct XcdBarrier {
    int wid;
    unsigned* bar; unsigned x;
    volatile LAS unsigned* st;
};

__device__ __forceinline__ XcdBarrier xcd_barrier_post(unsigned* bar, volatile LAS unsigned* st) {
    XcdBarrier b; b.bar = bar; b.x = xb_xcc_id(); b.st = st;
    if (threadIdx.x == 0) (void)xb_add(&bar[XB_XCNT(b.x)], 1u);
    return b;
}
__device__ __forceinline__ void xcd_barrier_complete(unsigned* bar, unsigned x, unsigned& nloc, unsigned& nx) {
    const unsigned G = gridDim.x * gridDim.y * gridDim.z;
    unsigned sum, cnt, mine, sp = 0u;
    for (;;) {
        sum = 0u; cnt = 0u; mine = 0u;
#pragma unroll
        for (unsigned j = 0; j < 16; ++j) { const unsigned c = xb_ld(&bar[XB_XCNT(j)]); sum += c; cnt += (c > 0u) ? 1u : 0u; mine = (j == x) ? c : mine; }
        if (sum == G) break;
        __builtin_amdgcn_s_sleep(1);
        if ((++sp & 255u) == 0u) { if (xb_ld(&bar[XB_TMO])) break; if (sp > XB_SPIN_CAP) { atomicAdd(&bar[XB_TMO], 1u); break; } }
    }
    nloc = mine > 0u ? mine : 1u; nx = cnt > 0u ? cnt : 1u;
}

__device__ __forceinline__ void xcd_barrier(const XcdBarrier& b) {
    asm volatile("s_waitcnt vmcnt(0)" ::: "memory");
    __syncthreads();
    int bw_ = b.wid; asm volatile("" : "+s"(bw_));
    if (bw_ == 0 && wg_lane() == 0) {
        unsigned* bar = b.bar;
        __builtin_amdgcn_s_waitcnt(0);
        unsigned nloc = b.st[0], nx = b.st[1];
        if (nloc == 0u) { xcd_barrier_complete(bar, b.x, nloc, nx); b.st[0] = nloc; b.st[1] = nx; }
        const unsigned old = xb_add(&bar[XB_XSUB(b.x)], 1u);
        const unsigned gen = old / nloc;
        if (old + 1u == (gen + 1u) * nloc) {
            __builtin_amdgcn_fence(__ATOMIC_RELEASE, "agent");
            asm volatile("s_waitcnt vmcnt(0)" ::: "memory");
            const unsigned og = xb_add(&bar[XB_TOP], 1u);
            const unsigned tg = og / nx;
            if (og + 1u == (tg + 1u) * nx) xb_add(&bar[XB_TOPGEN], 1u);
            else XB_SPIN(xb_ld(&bar[XB_TOPGEN]) == tg, bar);
            __builtin_amdgcn_fence(__ATOMIC_ACQUIRE, "agent");
            xb_add(&bar[XB_XGEN(b.x)], 1u);
            asm volatile("s_waitcnt vmcnt(0)" ::: "memory");
        } else {
            XB_SPIN(xb_ld(&bar[XB_XGEN(b.x)]) == gen, bar);
            __builtin_amdgcn_fence(__ATOMIC_ACQUIRE, "agent");
            asm volatile("s_waitcnt vmcnt(0)" ::: "memory");
        }
    }
    __syncthreads();
}
typedef short bf16x8 __attribute__((ext_vector_type(8)));
typedef int v4i32 __attribute__((ext_vector_type(4)));
typedef int v8i32 __attribute__((ext_vector_type(8)));
namespace pg {
constexpr int BM = 256, BK = 64, HALF = 128, HTB = HALF * BK * 2  , STAGE_BYTES = 8 * HTB, NXCD = 8, WGM = 8;
__host__ __device__ __forceinline__ int lds_byte(int r, int c) { return (r >> 3) * 1024 + (r & 7) * 128 + (((c >> 3) ^ (r & 7)) << 4); }
__host__ __device__ __forceinline__ void stage_rc(int b, int& R, int& C) { const int piece = b >> 10, p = (b & 1023) >> 4; R = piece * 8 + (p >> 3); C = ((p & 7) ^ (R & 7)) << 3; }

struct Unit { int pm, pn, x0, x1; };

__device__ __forceinline__ void order_unit(int L, int nM, int nN, int& pm, int& pn) {
    const int nwg = nM * nN; int wgid = L;
    { const int q = nwg / NXCD, r = nwg % NXCD, xcd = wgid % NXCD, off = wgid / NXCD; wgid = (xcd < r ? xcd * (q + 1) : r * (q + 1) + (xcd - r) * q) + off; }
    const int nig = WGM * nN, gid = wgid / nig, fm = gid * WGM, gsz = (nM - fm) < WGM ? (nM - fm) : WGM;
    pm = fm + ((wgid % nig) % gsz); pn = (wgid % nig) / gsz;
}

template <class Sched, class Epi>
__device__ __forceinline__ void gemm_phase(LAS unsigned char* lds, LAS unsigned* idxtab, const Sched& S, const Epi& E, int wid_s) {
    constexpr int ESZ = Sched::ESZ;
    constexpr int K = Sched::K, LDA = Sched::LDA, LDB = Sched::LDB, nt = K * ESZ / 128, KS = Sched::KSPLIT; constexpr bool GATHER = Sched::GATHER;
    int tid = wid_s * 64 + wg_lane(); asm volatile("" : "+v"(tid));
    const int wid = __builtin_amdgcn_readfirstlane(tid >> 6), lane = tid & 63, wr = wid >> 2, wc = wid & 3;
    constexpr size_t kstep = (size_t)(BK * 2);
    constexpr size_t hstepA = (size_t)HALF * LDA * ESZ, hstepB = (size_t)HALF * LDB * ESZ;
    const unsigned ldsw = (unsigned)wid * 1024u;
    const int aoff0 = lds_byte(wr * 64 + (lane & 15), (lane >> 4) * 8), boff0 = lds_byte(wc * 32 + (lane & 15), (lane >> 4) * 8);
    unsigned pvoA[2], pvoB[2];
#pragma unroll
    for (int i = 0; i < 2; ++i) { int R_, C_; stage_rc((wid * 64 + lane) * 16 + i * 8192, R_, C_); pvoA[i] = (unsigned)(R_ * LDA * ESZ + C_ * 2); pvoB[i] = (unsigned)(R_ * LDB * ESZ + C_ * 2); }
    unsigned cv[2][2];
#define PG_SA(b, h) (((b) * 2 + (h)) * HTB)
#define PG_SB(b, h) ((4 + (b) * 2 + (h)) * HTB)
#define PG_VOFF(ld, i, dst) do { int _t = wid * 64 + lane; asm volatile("" : "+v"(_t)); int _R, _C; stage_rc(_t * 16 + (i) * 8192, _R, _C); dst = (unsigned)(_R * (ld) * ESZ + _C * 2); } while (0)
#define PG_STAGE_B(bufoff, gbase) do { _Pragma("unroll") for (int _i = 0; _i < 2; ++_i) { unsigned _vo = pvoB[_i]; if constexpr (ESZ == 1) PG_VOFF(LDB, _i, _vo); \
        __builtin_amdgcn_global_load_lds((const unsigned*)((const char*)(gbase) + _vo), (LAS unsigned*)(lds + (bufoff) + ldsw + _i * 8192), 16, 0, 0); } } while (0)
#define PG_STAGE_A(bufoff, gbase, h, V) do { _Pragma("unroll") for (int _i = 0; _i < 2; ++_i) { unsigned _vo = pvoA[_i]; \
        const char* _p = GATHER ? (const char*)(gbase) + V[h][_i] : (const char*)(gbase) + ((h) ? hstepA : 0) + _vo; \
        __builtin_amdgcn_global_load_lds((const unsigned*)_p, (LAS unsigned*)(lds + (bufoff) + ldsw + _i * 8192), 16, 0, 0); } } while (0)
#define PG_LDA(dst, b, h) do { int _a1 = aoff0 ^ 64; asm volatile("" : "+v"(_a1)); _Pragma("unroll") for (int m = 0; m < 4; ++m) _Pragma("unroll") for (int k = 0; k < 2; ++k) dst[m][k] = *(const LAS bf16x8*)(lds + PG_SA(b, h) + (k ? _a1 : aoff0) + m * 2048); } while (0)
#define PG_LDB(dst, b, h) do { int _b1 = boff0 ^ 64; asm volatile("" : "+v"(_b1)); _Pragma("unroll") for (int n = 0; n < 2; ++n) _Pragma("unroll") for (int k = 0; k < 2; ++k) dst[n][k] = *(const LAS bf16x8*)(lds + PG_SB(b, h) + (k ? _b1 : boff0) + n * 2048); } while (0)
#define PG_MMA(ai, bj, At, Bt) do { __builtin_amdgcn_s_setprio(1); _Pragma("unroll") for (int m = 0; m < 4; ++m) _Pragma("unroll") for (int n = 0; n < 2; ++n) { \
        if constexpr (ESZ == 2) { _Pragma("unroll") for (int k = 0; k < 2; ++k) acc[ai][bj][m][n] = __builtin_amdgcn_mfma_f32_16x16x32_bf16(Bt[n][k], At[m][k], acc[ai][bj][m][n], 0, 0, 0); } \
        else {   \
            const v8i32 bw = __builtin_shufflevector(__builtin_bit_cast(v4i32, Bt[n][0]), __builtin_bit_cast(v4i32, Bt[n][1]), 0, 1, 2, 3, 4, 5, 6, 7); \
            const v8i32 aw = __builtin_shufflevector(__builtin_bit_cast(v4i32, At[m][0]), __builtin_bit_cast(v4i32, At[m][1]), 0, 1, 2, 3, 4, 5, 6, 7); \
            acc[ai][bj][m][n] = __builtin_amdgcn_mfma_scale_f32_16x16x128_f8f6f4(bw, aw, acc[ai][bj][m][n], 0, 0, 0, Sched::SCALE_B, 0, Sched::SCALE_A); } } \
        __builtin_amdgcn_s_setprio(0); } while (0)
#define PG_WAIT_V(n) asm volatile("s_waitcnt vmcnt(" #n ")" ::: "memory")
#define PG_WAIT_L(n) asm volatile("s_waitcnt lgkmcnt(" #n ")" ::: "memory")
#define PG_BAR __builtin_amdgcn_s_barrier()
#define PG_SCHED __builtin_amdgcn_sched_barrier(0)
#define PG_IDX_ISSUE(u) do { int _l = lane; asm volatile("" : "+v"(_l)); const int _h = (_l >> 4) & 1, _i = (_l >> 3) & 1, _r = _l & 7; const unsigned _po = (unsigned)(_h * 128 + (wid + 8 * _i) * 8 + _r) * 16u; \
        __builtin_amdgcn_global_load_lds((const unsigned*)((const char*)S.idx_src(u) + _po), (LAS unsigned*)(idxtab + wid * 64), 4, 0, 0); } while (0)
#define PG_IDX_READ(u, V) do { const int _vr = S.valid_rows(u); _Pragma("unroll") for (int _h = 0; _h < 2; ++_h) _Pragma("unroll") for (int _i = 0; _i < 2; ++_i) { \
        const int _pos = _h * 128 + (wid + 8 * _i) * 8 + (lane >> 3); unsigned _tk = *(volatile LAS unsigned*)(idxtab + wid * 64 + _h * 16 + _i * 8 + (lane >> 3)); \
        _tk = _pos < _vr ? _tk : 0u; V[_h][_i] = _tk * (unsigned)(LDA * ESZ) + (unsigned)(((lane & 7) ^ ((lane >> 3) & 7)) << 4); } } while (0)
    Unit cur, nxt; int ui = 0;
    if (!S.next(0, cur)) return;
    f32x4 acc[2][2][4][2];
#pragma unroll
    for (int a = 0; a < 2; ++a)
#pragma unroll
        for (int b = 0; b < 2; ++b)
#pragma unroll
            for (int m = 0; m < 4; ++m)
#pragma unroll
                for (int n = 0; n < 2; ++n) acc[a][b][m][n] = (f32x4){0.f, 0.f, 0.f, 0.f};
    bf16x8 At[4][2], B0[2][2], B1[2][2];
    const char* cA = S.a_base(cur); const char* cB0 = S.b_base(cur, 0); const char* cB1 = S.b_base(cur, 1);
#pragma unroll
    for (int h = 0; h < 2; ++h)
#pragma unroll
        for (int i = 0; i < 2; ++i) cv[h][i] = 0u;
    if constexpr (GATHER) { PG_IDX_ISSUE(cur); PG_WAIT_V(0); PG_IDX_READ(cur, cv); }
    PG_STAGE_B(PG_SB(0, 0), cB0); PG_STAGE_B(PG_SB(0, 1), cB0 + hstepB); PG_STAGE_A(PG_SA(0, 0), cA, 0, cv); PG_STAGE_A(PG_SA(0, 1), cA, 1, cv);
    if (wr == 1) PG_BAR;
    PG_WAIT_V(2); PG_BAR;
    PG_STAGE_B(PG_SB(1, 0), cB0 + kstep); PG_STAGE_A(PG_SA(1, 0), cA + kstep, 0, cv); PG_STAGE_B(PG_SB(1, 1), cB0 + hstepB + kstep);
    PG_WAIT_V(6); PG_BAR;
    for (;;) {
        const bool has_next = S.next(ui + 1, nxt);
        const char* nA = has_next ? S.a_base(nxt) : cA; const char* nB0 = has_next ? S.b_base(nxt, 0) : cB0; const char* nB1 = has_next ? S.b_base(nxt, 1) : cB1;
        if constexpr (GATHER) { if (has_next) PG_IDX_ISSUE(nxt); }
#pragma nounroll
        for (int t = 0; t < nt; t += 2) {
            const bool last = (t == nt - 2);
            const char* a1 = cA + (size_t)(t + 1) * kstep;
            const char* a2 = last ? nA : cA + (size_t)(t + 2) * kstep; const char* a3 = a2 + kstep;
            const char* b2 = last ? nB0 : ((t + 2) < KS ? cB0 : cB1) + (size_t)(t + 2) * kstep;
            const char* b3 = last ? nB0 + kstep : ((t + 3) < KS ? cB0 : cB1) + (size_t)(t + 3) * kstep;
            PG_LDB(B0, 0, 0); PG_LDB(B1, 0, 1); PG_SCHED; PG_LDA(At, 0, 0); PG_STAGE_A(PG_SA(1, 1), a1, 1, cv);
            if constexpr (GATHER) { if (last && has_next) { PG_IDX_READ(nxt, cv); } }
            PG_WAIT_V(8); PG_WAIT_L(0); PG_BAR; PG_MMA(0, 0, At, B0); PG_MMA(0, 1, At, B1); PG_BAR; PG_SCHED;
            PG_LDA(At, 0, 1); PG_STAGE_B(PG_SB(0, 0), b2); PG_STAGE_B(PG_SB(0, 1), b2 + hstepB); PG_STAGE_A(PG_SA(0, 0), a2, 0, cv);
            PG_WAIT_V(8); PG_WAIT_L(0); PG_BAR; PG_MMA(1, 0, At, B0); PG_MMA(1, 1, At, B1); PG_BAR; PG_SCHED;
            PG_LDB(B0, 1, 0); PG_LDB(B1, 1, 1); PG_SCHED; PG_LDA(At, 1, 0); PG_STAGE_A(PG_SA(0, 1), a2, 1, cv);
            PG_WAIT_V(8); PG_WAIT_L(0); PG_BAR; PG_MMA(0, 0, At, B0); PG_MMA(0, 1, At, B1); PG_BAR; PG_SCHED;
            PG_LDA(At, 1, 1); PG_STAGE_B(PG_SB(1, 0), b3); PG_STAGE_B(PG_SB(1, 1), b3 + hstepB); PG_STAGE_A(PG_SA(1, 0), a3, 0, cv);
            PG_WAIT_V(8); PG_WAIT_L(0); PG_BAR; PG_MMA(1, 0, At, B0); PG_MMA(1, 1, At, B1); PG_BAR; PG_SCHED;
        }
        if (wr == 0) PG_BAR;
        { int _l = lane; asm volatile("" : "+v"(_l)); E(acc, cur, wr, wc, _l & 15, _l >> 4); }
        if (!has_next) break;
#pragma unroll
        for (int a = 0; a < 2; ++a)
#pragma unroll
            for (int b = 0; b < 2; ++b)
#pragma unroll
                for (int m = 0; m < 4; ++m)
#pragma unroll
                    for (int n = 0; n < 2; ++n) acc[a][b][m][n] = (f32x4){0.f, 0.f, 0.f, 0.f};
        cur = nxt; cA = nA; cB0 = nB0; cB1 = nB1; ++ui;
        if (wr == 1) PG_BAR;
    }
    PG_WAIT_V(0);
    PG_BAR;
#undef PG_SA
#undef PG_SB
#undef PG_STAGE_A
#undef PG_STAGE_B
#undef PG_VOFF
#undef PG_LDA
#undef PG_LDB
#undef PG_MMA
#undef PG_WAIT_V
#undef PG_WAIT_L
#undef PG_BAR
#undef PG_SCHED
#undef PG_IDX_ISSUE
#undef PG_IDX_READ
}
}
constexpr int NWAVES = 8, NTHR = 512;
constexpr int RING_OFF = 0, RING_BYTES = 131072;
constexpr int IDX_OFF = RING_BYTES;
constexpr int TST_OFF = IDX_OFF + 2048;
constexpr int MISC_OFF = TST_OFF + 128;
constexpr int ROPEL_OFF = MISC_OFF + 512;
constexpr int LDS_BYTES = 147456;
constexpr size_t WS_MODP = WS_VN;
constexpr size_t WS_WSB = 62 * MiB;
constexpr int CW_CNTF = 16384;
constexpr int CW_XR = 12288;
constexpr int CW_MXQ = 13312;
constexpr int CW_BAR = 8192;
constexpr int MAXT = 288;

struct ClsRec { int m; float wlo, whi; int pad; };
constexpr size_t WS_LISTR = 816 * MiB;
constexpr size_t WS_XB = 848 * MiB;
constexpr size_t WS_POS = WS_TOK;
constexpr size_t WS_END2 = 980 * MiB;

__device__ __forceinline__ void cls_experts(int cls, int& elo, int& ehi) {
    const int g = cls / 6, p = cls % 6; const int a = p < 3 ? 0 : (p < 5 ? 1 : 2), b = p < 3 ? p + 1 : (p < 5 ? p - 1 : 3);
    elo = g * 4 + a; ehi = g * 4 + b;
}
#ifndef G1_FP8
#define G1_FP8 1
#endif
constexpr int F8_SH_H = 4, F8_SH_A = 3, F8_SH_W = 5, F8_SH_M = 2;
#define SC_E8(sh) ((127 - (sh)) * 0x01010101)
__device__ __forceinline__ unsigned pk4_fp8(float a, float b, float c, float d, float scale) {
    const float lim = 448.0f; a = fminf(fmaxf(a * scale, -lim), lim); b = fminf(fmaxf(b * scale, -lim), lim); c = fminf(fmaxf(c * scale, -lim), lim); d = fminf(fmaxf(d * scale, -lim), lim);
    int w = __builtin_amdgcn_cvt_pk_fp8_f32(a, b, 0, false); w = __builtin_amdgcn_cvt_pk_fp8_f32(c, d, w, true); return (unsigned)w; }
__device__ __forceinline__ unsigned cvt_pk_bf16(float lo, float hi) { unsigned r; asm volatile("v_cvt_pk_bf16_f32 %0, %1, %2" : "=v"(r) : "v"(lo), "v"(hi)); return r; }

template <int N_, int ESZ_, int SHA_ = 0> struct SchedDense {
    static constexpr int K = 1024, LDA = 1024, LDB = 1024, KSPLIT = K * ESZ_ / 128, ESZ = ESZ_, SCALE_A = ESZ_ == 1 ? SC_E8(SHA_) : 0, SCALE_B = ESZ_ == 1 ? SC_E8(F8_SH_W) : 0; static constexpr bool GATHER = false;
    const void* A; const void* Bt; int nM, G, c;
    __device__ __forceinline__ bool next(int i, pg::Unit& u) const { const long L = (long)i * G + c; if (L >= (long)nM * (N_ / 256)) return false; pg::order_unit((int)L, nM, N_ / 256, u.pm, u.pn); u.x0 = 0; u.x1 = 0;
        return true; }
    __device__ __forceinline__ const char* a_base(const pg::Unit& u) const { return (const char*)A + (size_t)u.pm * 256 * LDA * ESZ; }
    __device__ __forceinline__ const char* b_base(const pg::Unit& u, int) const { return (const char*)Bt + (size_t)u.pn * 256 * LDB * ESZ; }
    __device__ __forceinline__ const unsigned* idx_src(const pg::Unit&) const { return nullptr; }
    __device__ __forceinline__ int valid_rows(const pg::Unit&) const { return 256; }
};
__device__ __forceinline__ void cls_of_tile(const LAS int* tst, int T, int& cls, int& rt) {
    int c = 0;
#pragma unroll
    for (int k = 1; k < NCLS; ++k) c += (T >= tst[k]) ? 1 : 0;
    cls = __builtin_amdgcn_readfirstlane(c); rt = __builtin_amdgcn_readfirstlane(T - tst[c]);
}
struct SchedGU {
    static constexpr int K = 1024, LDA = 1024, LDB = 1024, KSPLIT = 8, ESZ = 1, SCALE_A = SC_E8(F8_SH_H), SCALE_B = SC_E8(F8_SH_W); static constexpr bool GATHER = true;
    const unsigned char* H; const unsigned char* Wgu; const ClsRec* list; const LAS int* tst; const unsigned* cnt; int G, c;
    __device__ __forceinline__ bool next(int i, pg::Unit& u) const { const int TT = __builtin_amdgcn_readfirstlane(tst[NCLS]); const long L = (long)i * G + c; if (L >= (long)TT * 8) return false;
        pg::order_unit((int)L, TT, 8, u.pm, u.pn); cls_of_tile(tst, u.pm, u.x0, u.x1); return true; }
    __device__ __forceinline__ const char* a_base(const pg::Unit&) const { return (const char*)H; }
    __device__ __forceinline__ const char* b_base(const pg::Unit& u, int) const { int elo, ehi; cls_experts(u.x0, elo, ehi); const int e = u.pn < 4 ? elo : ehi;
        return (const char*)Wgu + ((size_t)e * 1024 + (size_t)(u.pn & 3) * 256) * LDB; }
    __device__ __forceinline__ const unsigned* idx_src(const pg::Unit& u) const { return (const unsigned*)(list + (size_t)u.x0 * MT + (size_t)u.x1 * 256); }
    __device__ __forceinline__ int valid_rows(const pg::Unit& u) const { return (int)cnt[u.x0 * 64] - u.x1 * 256; }
};
struct SchedDown {
    static constexpr int K = 1024, LDA = 1024, LDB = 512, KSPLIT = 4, ESZ = 1, SCALE_A = SC_E8(F8_SH_A), SCALE_B = SC_E8(F8_SH_W); static constexpr bool GATHER = false;
    const unsigned char* ACT; const unsigned char* Wd; const LAS int* tst; int G, c;
    __device__ __forceinline__ bool next(int i, pg::Unit& u) const { const int TT = __builtin_amdgcn_readfirstlane(tst[NCLS]); const long L = (long)i * G + c; if (L >= (long)TT * 4) return false;
        pg::order_unit((int)L, TT, 4, u.pm, u.pn); cls_of_tile(tst, u.pm, u.x0, u.x1); return true; }
    __device__ __forceinline__ const char* a_base(const pg::Unit& u) const { return (const char*)ACT + (size_t)u.pm * 256 * LDA; }
    __device__ __forceinline__ const char* b_base(const pg::Unit& u, int part) const { int elo, ehi; cls_experts(u.x0, elo, ehi); const int e = part ? ehi : elo;
        return (const char*)Wd + ((size_t)e * 1024 + (size_t)u.pn * 256) * LDB - (part ? (size_t)KSPLIT * 128 : 0); }
    __device__ __forceinline__ const unsigned* idx_src(const pg::Unit&) const { return nullptr; }
    __device__ __forceinline__ int valid_rows(const pg::Unit&) const { return 256; }
};

#define OPAQUE(x) asm volatile("" : "+v"(x))
#define ROWSTEP(m) ((m) == 3 ? 80 : 16)
__device__ __forceinline__ void bf8_to_f32(const u32x4 v, float (&o)[8]) {
#pragma unroll
    for (int i = 0; i < 4; ++i) { o[2 * i] = __uint_as_float(v[i] << 16); o[2 * i + 1] = __uint_as_float(v[i] & 0xffff0000u); }
}
struct EpiProj {
    bf16_t* O; const LAS _Float16* tab;
    __device__ __forceinline__ void operator()(const f32x4 (&acc)[2][2][4][2], const pg::Unit& u, int wr, int wc, int fr, int fq) const {
        const bool latent = u.pm < ML / 256;
        char* base = (char*)(O + (size_t)u.pm * 256 * INC + u.pn * 256);
        unsigned off = (unsigned)((wr * 64 + fr) * INC + wc * 32 + 8 * fq) * 2u; OPAQUE(off);
        int t = ((u.pm * 256) & (SEQ - 1)) + wr * 64 + fr; OPAQUE(t);
        const bool second = (fq >> 1) != 0;
#pragma unroll
        for (int ai = 0; ai < 2; ++ai)
#pragma unroll
            for (int m = 0; m < 4; ++m) { char* rowp = base + off;
                const int pos = (wc & 1) ? (t & 63) : (t >> 6);
#pragma unroll
                for (int bj = 0; bj < 2; ++bj) { f32x4 v0 = acc[ai][bj][m][0], v1 = acc[ai][bj][m][1];
                    const bool rope = latent && (u.pn == 5 || u.pn == 6 || (u.pn == 7 && bj == 0));
                    if (rope) { const LAS _Float16* tp = tab + pos * 16 + 8 * (fq & 1);
                        typedef _Float16 h8 __attribute__((ext_vector_type(8)));
                        const h8 ch = *(const LAS h8*)tp, sh = *(const LAS h8*)(tp + 2048);
                        const f32x4 cs0 = (f32x4){(float)ch[0], (float)ch[1], (float)ch[2], (float)ch[3]}, cs1 = (f32x4){(float)ch[4], (float)ch[5], (float)ch[6], (float)ch[7]};
                        const f32x4 sn0 = (f32x4){(float)sh[0], (float)sh[1], (float)sh[2], (float)sh[3]}, sn1 = (f32x4){(float)sh[4], (float)sh[5], (float)sh[6], (float)sh[7]};
                        f32x4 p0, p1;
#pragma unroll
                        for (int i = 0; i < 4; ++i) { auto r0 = __builtin_amdgcn_permlane32_swap(__float_as_uint(v0[i]), __float_as_uint(v0[i]), false, false); p0[i] = __uint_as_float(second ? r0[0] : r0[1]);
                                                      auto r1 = __builtin_amdgcn_permlane32_swap(__float_as_uint(v1[i]), __float_as_uint(v1[i]), false, false); p1[i] = __uint_as_float(second ? r1[0] : r1[1]); }
                        if (second) { v0 = v0 * cs0 + p0 * sn0; v1 = v1 * cs1 + p1 * sn1; } else { v0 = v0 * cs0 - p0 * sn0; v1 = v1 * cs1 - p1 * sn1; } }
                    u32x4 w; w.x = cvt_pk_bf16(v0[0], v0[1]); w.y = cvt_pk_bf16(v0[2], v0[3]); w.z = cvt_pk_bf16(v1[0], v1[1]); w.w = cvt_pk_bf16(v1[2], v1[3]);
                    *(u32x4*)(rowp + bj * 256) = w; }
                off += (unsigned)(ROWSTEP(m) * INC * 2); t += ROWSTEP(m); OPAQUE(off); OPAQUE(t); }
    }
};
struct EpiPlain {
    bf16_t* O; int ldo;
    __device__ __forceinline__ void operator()(const f32x4 (&acc)[2][2][4][2], const pg::Unit& u, int wr, int wc, int fr, int fq) const {
        char* base = (char*)(O + (size_t)u.pm * 256 * ldo + u.pn * 256);
        unsigned off = (unsigned)((wr * 64 + fr) * ldo + wc * 32 + 8 * fq) * 2u; OPAQUE(off);
#pragma unroll
        for (int ai = 0; ai < 2; ++ai)
#pragma unroll
            for (int m = 0; m < 4; ++m) {
#pragma unroll
                for (int bj = 0; bj < 2; ++bj) { const f32x4 v0 = acc[ai][bj][m][0], v1 = acc[ai][bj][m][1];
                    u32x4 w; w.x = cvt_pk_bf16(v0[0], v0[1]); w.y = cvt_pk_bf16(v0[2], v0[3]); w.z = cvt_pk_bf16(v1[0], v1[1]); w.w = cvt_pk_bf16(v1[2], v1[3]);
                    *(u32x4*)(base + off + bj * 256) = w; }
                off += (unsigned)(ROWSTEP(m) * ldo * 2); OPAQUE(off); }
    }
};
struct EpiResid {
    bf16_t* XB; const float* gate;
    __device__ __forceinline__ void operator()(const f32x4 (&acc)[2][2][4][2], const pg::Unit& u, int wr, int wc, int fr, int fq) const {
        const int mb = u.pm < ML / 256 ? (u.pm * 256) >> 13 : 8;
        const float* gp = gate + (size_t)mb * 6144 + u.pn * 256 + wc * 32 + 8 * fq;
        f32x4 g[2][2];
#pragma unroll
        for (int bj = 0; bj < 2; ++bj) { g[bj][0] = *(const f32x4*)(gp + 128 * bj); g[bj][1] = *(const f32x4*)(gp + 128 * bj + 4); }
        char* base = (char*)(XB + (size_t)u.pm * 256 * D + u.pn * 256);
        unsigned off = (unsigned)((wr * 64 + fr) * D + wc * 32 + 8 * fq) * 2u; OPAQUE(off);
        u32x4 xr[2][4][2];
        { unsigned lo = off;
#pragma unroll
          for (int ai = 0; ai < 2; ++ai)
#pragma unroll
            for (int m = 0; m < 4; ++m) {
#pragma unroll
                for (int bj = 0; bj < 2; ++bj) { const char* ap = base + lo + bj * 256; asm volatile("global_load_dwordx4 %0, %1, off" : "=&v"(xr[ai][m][bj]) : "v"(ap) : "memory"); }
                lo += (unsigned)(ROWSTEP(m) * D * 2); } }
#pragma unroll
        for (int ai = 0; ai < 2; ++ai) {
            if (ai == 0) asm volatile("s_waitcnt vmcnt(8)" : "+v"(xr[0][0][0]), "+v"(xr[0][0][1]), "+v"(xr[0][1][0]), "+v"(xr[0][1][1]), "+v"(xr[0][2][0]), "+v"(xr[0][2][1]), "+v"(xr[0][3][0]), "+v"(xr[0][3][1]) :: "memory");
            else asm volatile("s_waitcnt vmcnt(0)" : "+v"(xr[1][0][0]), "+v"(xr[1][0][1]), "+v"(xr[1][1][0]), "+v"(xr[1][1][1]), "+v"(xr[1][2][0]), "+v"(xr[1][2][1]), "+v"(xr[1][3][0]), "+v"(xr[1][3][1]) :: "memory");
#pragma unroll
            for (int m = 0; m < 4; ++m) {
#pragma unroll
                for (int bj = 0; bj < 2; ++bj) { const f32x4 v0 = acc[ai][bj][m][0], v1 = acc[ai][bj][m][1]; float xf[8]; bf8_to_f32(xr[ai][m][bj], xf);
                    u32x4 w; w.x = cvt_pk_bf16(xf[0] + g[bj][0][0] * v0[0], xf[1] + g[bj][0][1] * v0[1]); w.y = cvt_pk_bf16(xf[2] + g[bj][0][2] * v0[2], xf[3] + g[bj][0][3] * v0[3]);
                    w.z = cvt_pk_bf16(xf[4] + g[bj][1][0] * v1[0], xf[5] + g[bj][1][1] * v1[1]); w.w = cvt_pk_bf16(xf[6] + g[bj][1][2] * v1[2], xf[7] + g[bj][1][3] * v1[3]);
                    *(u32x4*)(base + off + bj * 256) = w; }
                off += (unsigned)(ROWSTEP(m) * D * 2); OPAQUE(off); } }
    }
};
struct EpiGU {
    unsigned char* ACT; const ClsRec* list; const unsigned* cnt;
    __device__ __forceinline__ void operator()(const f32x4 (&acc)[2][2][4][2], const pg::Unit& u, int wr, int wc, int fr, int fq) const {
        const int vr = (int)cnt[u.x0 * 64] - u.x1 * 256; const char* rec = (const char*)(list + (size_t)u.x0 * MT + (size_t)u.x1 * 256) + (u.pn >= 4 ? 8 : 4);
        unsigned char* base = ACT + (size_t)u.pm * 256 * 1024 + (u.pn >> 2) * 512 + (u.pn & 3) * 128;
        int r = wr * 64 + fr; OPAQUE(r); unsigned off = (unsigned)(r * 1024 + wc * 32 + 8 * fq); OPAQUE(off);
        float wv[8];
        { const int vm1 = vr - 1;
#pragma unroll
          for (int q = 0; q < 8; ++q) { const int rq = r + 16 * (q & 3) + 128 * (q >> 2); const int rc = rq < vm1 ? rq : vm1; const char* ap = rec + (size_t)rc * 16;
              asm volatile("global_load_dword %0, %1, off" : "=&v"(wv[q]) : "v"(ap) : "memory"); }
          asm volatile("s_waitcnt vmcnt(0)" : "+v"(wv[0]), "+v"(wv[1]), "+v"(wv[2]), "+v"(wv[3]), "+v"(wv[4]), "+v"(wv[5]), "+v"(wv[6]), "+v"(wv[7]) :: "memory"); }
#pragma unroll
        for (int ai = 0; ai < 2; ++ai)
#pragma unroll
            for (int m = 0; m < 4; ++m) { float w = r < vr ? wv[ai * 4 + m] : 0.f;
                w *= (float)(1 << F8_SH_A);
                u32x2 pk;
#pragma unroll
                for (int bj = 0; bj < 2; ++bj) { const f32x4 g = acc[ai][bj][m][0], up = acc[ai][bj][m][1]; float o[4];
#pragma unroll
                    for (int i = 0; i < 4; ++i) o[i] = g[i] * __builtin_amdgcn_rcpf(1.0f + __builtin_amdgcn_exp2f(-LOG2E * g[i])) * up[i];
                    const unsigned v = pk4_fp8(o[0], o[1], o[2], o[3], w); if (bj == 0) pk.x = v; else pk.y = v; }
                *(u32x2*)(base + off) = pk;
                off += (unsigned)(ROWSTEP(m) * 1024); r += ROWSTEP(m); OPAQUE(off); OPAQUE(r); }
    }
};

typedef const __attribute__((address_space(1))) float* gfptr;
template <bool F8 = false, typename WP = const float*> __device__ __forceinline__ void p0_transpose_item(WP W, int Kd, int N, void* WTv, LAS float* scr, int item, int lane, int mode, int sc_lo, int sc_hi, float scale) {
    bf16_t* WT = (bf16_t*)WTv;
    const int nblk = N / 32, kb = item / nblk, nb = item % nblk, k0 = 64 * kb, n0 = 32 * nb;
    f32x4 rv[8];
#pragma unroll
    for (int i = 0; i < 8; ++i) rv[i] = *(const __attribute__((address_space(1))) f32x4*)((gfptr)W + (size_t)(k0 + 8 * i + (lane >> 3)) * N + n0 + 4 * (lane & 7));
#pragma unroll
    for (int i = 0; i < 8; ++i) { LAS float* d = scr + (8 * i + (lane >> 3)) * 33 + 4 * (lane & 7); d[0] = rv[i].x; d[1] = rv[i].y; d[2] = rv[i].z; d[3] = rv[i].w; }
    asm volatile("s_waitcnt lgkmcnt(0)" ::: "memory");
    const int c = lane & 7;
#pragma unroll
    for (int j = 0; j < 4; ++j) { const int n = (lane >> 3) + 8 * j, ng = n0 + n; const LAS float* s = scr + (8 * c) * 33 + n;
        const float f = (ng >= sc_lo && ng < sc_hi) ? scale : 1.0f;
        const int row = mode == 0 ? ng : mode == 3 ? ((ng & ~31) + 16 * ((ng >> 2) & 1) + 4 * ((ng >> 3) & 3) + (ng & 3))
                      : (256 * (ng >> 7) + 128 * ((ng >> 2) & 1) + 32 * ((ng >> 5) & 3) + 16 * (mode == 2 ? 1 : 0) + 4 * ((ng >> 3) & 3) + (ng & 3));
        if constexpr (F8) { u32x2 o; o.x = pk4_fp8(s[0 * 33], s[1 * 33], s[2 * 33], s[3 * 33], f * (float)(1 << F8_SH_W)); o.y = pk4_fp8(s[4 * 33], s[5 * 33], s[6 * 33], s[7 * 33], f * (float)(1 << F8_SH_W));
            *(u32x2*)((unsigned char*)WTv + (size_t)row * Kd + k0 + 8 * c) = o; }
        else { u32x4 o; o.x = pk2(s[0 * 33] * f, s[1 * 33] * f); o.y = pk2(s[2 * 33] * f, s[3 * 33] * f); o.z = pk2(s[4 * 33] * f, s[5 * 33] * f); o.w = pk2(s[6 * 33] * f, s[7 * 33] * f);
            *(u32x4*)(WT + (size_t)row * Kd + k0 + 8 * c) = o; } }
    asm volatile("s_waitcnt lgkmcnt(0)" ::: "memory");
}
constexpr int CONV_PER_L = 1024 + 512 + NE * 768;
__device__ __forceinline__ void convert_item(gfptr w_in, gfptr w_out, gfptr w_gate, gfptr w_up, gfptr w_down, unsigned char* ws, LAS float* scr, int l, int r, int lane) {
    static_assert(G1_FP8 == 1, "w_in is converted to e4m3 only");
    if (r < 1024) { p0_transpose_item<true>(w_in + (size_t)l * D * INC, D, INC, ws + WS_WIN + (size_t)l * INC * D, scr, r, lane, 3, C_Q, C_K, QSCALE); return; } r -= 1024;
    if (r < 512) { p0_transpose_item<true>(w_out + (size_t)l * D * D, D, D, ws + WS_WOUT + (size_t)l * D * D, scr, r, lane, 3, 0, 0, 1.f); return; } r -= 512;
    const int e = r / 768, q = r % 768, which = q >> 8, idx = q & 255; const size_t le = (size_t)l * NE + e;
    if (which == 0) p0_transpose_item<true>(w_gate + le * D * DE, D, DE, ws + WS_WGU + le * 1024 * 1024, scr, idx, lane, 1, 0, 0, 1.f);
    else if (which == 1) p0_transpose_item<true>(w_up + le * D * DE, D, DE, ws + WS_WGU + le * 1024 * 1024, scr, idx, lane, 2, 0, 0, 1.f);
    else p0_transpose_item<true>(w_down + le * DE * D, DE, D, ws + WS_WD + le * 1024 * 512, scr, idx, lane, 3, 0, 0, 1.f);
}
__device__ __forceinline__ void phase_p0a(const Ptrs& P, LAS unsigned char* lds) {
    int tid = threadIdx.x; asm volatile("" : "+v"(tid)); const int lane = tid & 63, wave = __builtin_amdgcn_readfirstlane(tid >> 6);
    const int gw = blockIdx.x * NWAVES + wave, NGW = gridDim.x * NWAVES;
    LAS float* sil = (LAS float*)(lds + 73728);
    for (int i = tid; i < 9 * D; i += NTHR) { const int j = i >> 10, k = i & (D - 1); sil[i] = silu_f(j < 8 ? P.c[j * D + k] : P.c_ctx[k]); }
    __syncthreads();
    float* modp = (float*)(P.ws + WS_MODP);
    for (int u = gw; u < DEPTH * 24 * 16; u += NGW) { const int l = u / 384, r = u % 384, nc = r / 16, ks = r % 16;
        const float* w = P.w_mod + ((size_t)l * D + ks * 64) * 6144 + nc * 256 + 4 * lane;
        f32x4 a[9];
#pragma unroll
        for (int j = 0; j < 9; ++j) a[j] = (f32x4){0.f, 0.f, 0.f, 0.f};
#pragma unroll 4
        for (int k = 0; k < 64; ++k) { const f32x4 wv = *(const f32x4*)(w + (size_t)k * 6144);
#pragma unroll
            for (int j = 0; j < 9; ++j) a[j] += wv * sil[j * D + ks * 64 + k]; }
#pragma unroll
        for (int j = 0; j < 9; ++j) *(f32x4*)(modp + (((size_t)l * 16 + ks) * 9 + j) * 6144 + nc * 256 + 4 * lane) = a[j]; }
    { const int gt = blockIdx.x * NTHR + tid, NGT = gridDim.x * NTHR; float* tab = (float*)(P.ws + WS_ROPE);
      if (gt < 2048) { const int i = gt & 15, pos = gt >> 4; const float inv = powf(10000.0f, -(float)i / 16.0f), ang = (float)pos * inv; tab[gt] = cosf(ang); tab[2048 + gt] = sinf(ang); }
      bf16_t* wsb = (bf16_t*)(P.ws + WS_WSB);
      for (int i = gt; i < DEPTH * 4 * 128 * 128; i += NGT) wsb[i] = f2bf(P.w_s[i]); }
    { float* par = (float*)(P.ws + WS_PAR);
      for (int i = blockIdx.x * NTHR + tid; i < PAR_END; i += (int)gridDim.x * NTHR) { float v = 0.f;
          if (i < PAR_N1) v = P.router_w[i]; else if (i < PAR_N2) v = P.norm1_g[i - PAR_N1]; else if (i < PAR_FG) v = P.norm2_g[i - PAR_N2]; else if (i < PAR_RB) v = P.final_g[i - PAR_FG];
          else if (i < PAR_BS) { if (i - PAR_RB < NE) v = P.router_b[i - PAR_RB]; } else if (i < PAR_GG) v = P.b_s[i - PAR_BS]; else if (i < PAR_SINK) v = P.gmlp_g[i - PAR_GG];
          else if (i < PAR_CW) { if (i - PAR_SINK < DEPTH * 8) v = P.sink[i - PAR_SINK]; } else v = P.conv_w[i - PAR_CW];
          par[i] = v; } }
    if (blockIdx.x == 0 && tid == 0) { unsigned long long* pt = (unsigned long long*)(P.ws + WS_PTAB);
        pt[0] = (unsigned long long)P.w_in; pt[1] = (unsigned long long)P.w_out; pt[2] = (unsigned long long)P.w_gate; pt[3] = (unsigned long long)P.w_up; pt[4] = (unsigned long long)P.w_down; }
    LAS float* scr = (LAS float*)(lds + wave * 8448);
    for (int it = gw; it < CONV_PER_L; it += NGW) convert_item((gfptr)P.w_in, (gfptr)P.w_out, (gfptr)P.w_gate, (gfptr)P.w_up, (gfptr)P.w_down, P.ws, scr, 0, it, lane);
}
__device__ __forceinline__ void convert_tail(unsigned char* ws, LAS unsigned char* lds, int l, int part, int j, int nidle, int wid_s) {
    int tid = wid_s * 64 + wg_lane(); asm volatile("" : "+v"(tid));
    __syncthreads();
    const int lane = tid & 63; LAS float* scr = (LAS float*)(lds + wid_s * 8448);
    const unsigned long long* pt = (const unsigned long long*)(ws + WS_PTAB);
    const gfptr w_in = (gfptr)pt[0], w_out = (gfptr)pt[1], w_gate = (gfptr)pt[2], w_up = (gfptr)pt[3], w_down = (gfptr)pt[4];
    constexpr int QTR = CONV_PER_L / 4;
    for (int it = part * QTR + j * NWAVES + wid_s; it < (part + 1) * QTR; it += nidle * NWAVES) convert_item(w_in, w_out, w_gate, w_up, w_down, ws, scr, l, it, lane);
    __syncthreads();
}
__device__ __forceinline__ void phase_p0b(const Ptrs& P) {
    const int gt = blockIdx.x * NTHR + threadIdx.x, NGT = gridDim.x * NTHR;
    const float* modp = (const float*)(P.ws + WS_MODP); float* mod = (float*)(P.ws + WS_MOD);
    for (int i = gt; i < DEPTH * 9 * 6144; i += NGT) { const int l = i / (9 * 6144), r = i % (9 * 6144), j = r / 6144, n = r % 6144;
        float s = P.b_mod[l * 6144 + n];
#pragma unroll
        for (int ks = 0; ks < 16; ++ks) s += modp[(((size_t)l * 16 + ks) * 9 + j) * 6144 + n];
        mod[i] = s; }
}

template <int R> struct NormRaw { u32x4 a[R][2], b[R][2]; int m0, nv; };
template <int MODE, bool FIRST, bool DRY = false> __device__ __forceinline__ void phase_norm(const Ptrs& P, LAS unsigned char* lds, int l, int Mrows, const bf16_t* Y, const LAS int* tst, int wid_s) {
    constexpr int R = MODE == 2 ? 2 : 4;
    int tid = wid_s * 64 + wg_lane(); asm volatile("" : "+v"(tid)); const int lane = tid & 63, wave = __builtin_amdgcn_readfirstlane(tid >> 6);
    const int gw = blockIdx.x * NWAVES + wave, NGW = gridDim.x * NWAVES;
    const int rpw = (Mrows + NGW - 1) / NGW;
    const int mBeg = gw * rpw, mEnd = (mBeg + rpw) < Mrows ? (mBeg + rpw) : Mrows;
    LAS float* rwT = (LAS float*)lds;
    constexpr int RPW = 72;
    LAS unsigned* recL = (LAS unsigned*)(lds + 65536);
    LAS unsigned* cntL = (LAS unsigned*)(lds + 65536 + NWAVES * RPW * 16);
    LAS unsigned* baseL = cntL + 32;
    LAS float* logL = (LAS float*)(lds + 65536 + 12288);
    if (MODE == 2) { if (tid < 64) cntL[tid] = 0u; for (int i = tid; i < D * NE; i += NTHR) rwT[(i & 15) * D + (i >> 4)] = ((const float*)(P.ws + WS_PAR))[PAR_RW + i]; __syncthreads(); }
    const float* g = (const float*)(P.ws + WS_PAR) + (MODE == 1 ? PAR_N1 + l * D : MODE == 2 ? PAR_N2 + l * D : PAR_FG);
    f32x4 gg[2][2];
#pragma unroll
    for (int j = 0; j < 2; ++j) { gg[j][0] = (f32x4){0.f, 0.f, 0.f, 0.f}; gg[j][1] = gg[j][0]; if (MODE == 3) { gg[j][0] = *(const f32x4*)(g + 8 * lane + 512 * j); gg[j][1] = *(const f32x4*)(g + 8 * lane + 512 * j + 4); } }
    bf16_t* XB = (bf16_t*)(P.ws + WS_XB);
    unsigned posreg = 0u;
    if (MODE != 2 && !FIRST) { if (mBeg + lane < mEnd) posreg = ((const unsigned*)(P.ws + WS_POS))[mBeg + lane]; }
    f32x4 gt[2][2], scv[2][2], shv[2][2];
#pragma unroll
    for (int j = 0; j < 2; ++j)
#pragma unroll
        for (int q = 0; q < 2; ++q) { gt[j][q] = (f32x4){0.f, 0.f, 0.f, 0.f}; scv[j][q] = gt[j][q]; shv[j][q] = gt[j][q]; }
#define NR_LOAD(G, mstart) do { (G).m0 = (mstart); { const int bnd_ = (((mstart) >> 13) + 1) << 13; const int ge_ = bnd_ < mEnd ? bnd_ : mEnd; (G).nv = (ge_ - (mstart)) < R ? (ge_ - (mstart)) : R; } \
        _Pragma("unroll") for (int r = 0; r < R; ++r) { const int m = (G).m0 + (r < (G).nv ? r : (G).nv - 1); \
            if (FIRST) { const float* xr = m < ML ? P.x + (size_t)m * D : P.ctx + (size_t)(m - ML) * D; \
                _Pragma("unroll") for (int j = 0; j < 2; ++j) { (G).a[r][j] = *(const u32x4*)(xr + 8 * lane + 512 * j); (G).b[r][j] = *(const u32x4*)(xr + 8 * lane + 512 * j + 4); } \
            } else { size_t yrow = (size_t)m; \
                if (MODE != 2) { const unsigned ps = (unsigned)__builtin_amdgcn_readlane((int)posreg, m - mBeg); yrow = (size_t)tst[ps & 255u] * 256 + (ps >> 8); } \
                const bf16_t* yr = Y + yrow * D; \
                _Pragma("unroll") for (int j = 0; j < 2; ++j) { (G).a[r][j] = *(const u32x4*)(XB + (size_t)m * D + 8 * lane + 512 * j); if (MODE != 2) (G).b[r][j] = *(const u32x4*)(yr + 8 * lane + 512 * j); } } } } while (0)
    NormRaw<R> G; G.m0 = mBeg; G.nv = 0;
    if (mBeg < mEnd) NR_LOAD(G, mBeg);
    bool more = mBeg < mEnd;
    while (more) {
        const int m0 = G.m0, nv = G.nv;
        float xv[R][2][8]; float ss[R];
        { const int mb = modrow(m0);
            {
                const float* modl = (const float*)(P.ws + WS_MOD) + ((size_t)l * 9 + mb) * 6144;
                const float* gate = MODE == 2 ? modl + 2048 : (const float*)(P.ws + WS_MOD) + ((size_t)(MODE == 3 ? 3 : (l > 0 ? l - 1 : 0)) * 9 + mb) * 6144 + 5120;
                const float* sh = modl + (MODE == 1 ? 0 : 3072); const float* sc = modl + (MODE == 1 ? 1024 : 4096);
#pragma unroll
                for (int j = 0; j < 2; ++j)
#pragma unroll
                    for (int q = 0; q < 2; ++q) { const int c = 8 * lane + 512 * j + 4 * q; gt[j][q] = *(const f32x4*)(gate + c); scv[j][q] = (*(const f32x4*)(sc + c) + 1.0f) * *(const f32x4*)(g + c); shv[j][q] = *(const f32x4*)(sh + c); } } }
#pragma unroll
        for (int r = 0; r < R; ++r) { const int m = m0 + (r < nv ? r : nv - 1);
#pragma unroll
            for (int j = 0; j < 2; ++j) {
                if (FIRST) { const f32x4 a = __builtin_bit_cast(f32x4, G.a[r][j]), b = __builtin_bit_cast(f32x4, G.b[r][j]);
                    xv[r][j][0] = a.x; xv[r][j][1] = a.y; xv[r][j][2] = a.z; xv[r][j][3] = a.w; xv[r][j][4] = b.x; xv[r][j][5] = b.y; xv[r][j][6] = b.z; xv[r][j][7] = b.w;
                } else if (MODE == 2) { float xf[8]; bf8_to_f32(G.a[r][j], xf);
#pragma unroll
                    for (int i = 0; i < 8; ++i) xv[r][j][i] = xf[i];
                } else { float xf[8], yf[8]; bf8_to_f32(G.a[r][j], xf); bf8_to_f32(G.b[r][j], yf);
#pragma unroll
                    for (int i = 0; i < 8; ++i) xv[r][j][i] = xf[i] + gt[j][i >> 2][i & 3] * yf[i]; } }
            if (MODE == 1 && r < nv) {
#pragma unroll
                for (int j = 0; j < 2; ++j) { u32x4 w; w.x = cvt_pk_bf16(xv[r][j][0], xv[r][j][1]); w.y = cvt_pk_bf16(xv[r][j][2], xv[r][j][3]); w.z = cvt_pk_bf16(xv[r][j][4], xv[r][j][5]); w.w = cvt_pk_bf16(xv[r][j][6], xv[r][j][7]);
                    *(u32x4*)(XB + (size_t)m * D + 8 * lane + 512 * j) = w; } }
            float s = 0.f;
#pragma unroll
            for (int j = 0; j < 2; ++j)
#pragma unroll
                for (int i = 0; i < 8; ++i) s += xv[r][j][i] * xv[r][j][i];
            ss[r] = s;
            if (MODE != 3) {
#pragma unroll
                for (int j = 0; j < 2; ++j)
#pragma unroll
                    for (int i = 0; i < 8; ++i) xv[r][j][i] = xv[r][j][i] * scv[j][i >> 2][i & 3];
            } }
        { const int nm0 = m0 + nv; more = nm0 < mEnd; if (more) NR_LOAD(G, nm0); }
#pragma unroll
        for (int r = 0; r < R; ++r) ss[r] = wave_sum(ss[r]);
#pragma unroll
        for (int r = 0; r < R; ++r) { const int m = m0 + r; const float rinv = rsqrtf(ss[r] * (1.0f / D) + EPS);
            if (MODE == 3) { if (r < nv) { float* orow = P.out + (size_t)m * D;
#pragma unroll
                for (int j = 0; j < 2; ++j) { f32x4 a, b; a.x = xv[r][j][0]; a.y = xv[r][j][1]; a.z = xv[r][j][2]; a.w = xv[r][j][3]; b.x = xv[r][j][4]; b.y = xv[r][j][5]; b.z = xv[r][j][6]; b.w = xv[r][j][7];
                    *(f32x4*)(orow + 8 * lane + 512 * j) = a * rinv * gg[j][0]; *(f32x4*)(orow + 8 * lane + 512 * j + 4) = b * rinv * gg[j][1]; } }
            } else {
#pragma unroll
                for (int j = 0; j < 2; ++j)
#pragma unroll
                    for (int i = 0; i < 8; ++i) xv[r][j][i] = xv[r][j][i] * rinv + shv[j][i >> 2][i & 3];
                if (r < nv) {
                    if (MODE == 2 || G1_FP8) { unsigned char* H8 = (unsigned char*)(P.ws + WS_H) + (size_t)m * D;
#pragma unroll
                        for (int j = 0; j < 2; ++j) { u32x2 o; o.x = pk4_fp8(xv[r][j][0], xv[r][j][1], xv[r][j][2], xv[r][j][3], (float)(1 << F8_SH_H)); o.y = pk4_fp8(xv[r][j][4], xv[r][j][5], xv[r][j][6], xv[r][j][7], (float)(1 << F8_SH_H)); *(u32x2*)(H8 + 8 * lane + 512 * j) = o; }
                    } else { bf16_t* H = (bf16_t*)(P.ws + WS_H) + (size_t)m * D;
#pragma unroll
                        for (int j = 0; j < 2; ++j) { u32x4 o; o.x = cvt_pk_bf16(xv[r][j][0], xv[r][j][1]); o.y = cvt_pk_bf16(xv[r][j][2], xv[r][j][3]); o.z = cvt_pk_bf16(xv[r][j][4], xv[r][j][5]); o.w = cvt_pk_bf16(xv[r][j][6], xv[r][j][7]); *(u32x4*)(H + 8 * lane + 512 * j) = o; } } }
            } }
        if (MODE == 2) {
            typedef float f32x2r __attribute__((ext_vector_type(2)));
            static_assert(MODE != 2 || R == 2, "the packed router pairs the two rows of a group");
            f32x2r lg2[16];
#pragma unroll
            for (int e = 0; e < 16; ++e) lg2[e] = (f32x2r){0.f, 0.f};
#pragma unroll
            for (int j = 0; j < 2; ++j) { const int c = 8 * lane + 512 * j;
                f32x2r x2[8];
#pragma unroll
                for (int i = 0; i < 8; ++i) x2[i] = (f32x2r){xv[0][j][i], xv[1][j][i]};
#pragma unroll
                for (int e4 = 0; e4 < 4; ++e4) {
#pragma unroll
                    for (int e = 4 * e4; e < 4 * e4 + 4; ++e) { const f32x4 r0 = *(const LAS f32x4*)(rwT + e * D + c), r1 = *(const LAS f32x4*)(rwT + e * D + c + 4);
                        lg2[e] += x2[0] * r0.x + x2[1] * r0.y + x2[2] * r0.z + x2[3] * r0.w + x2[4] * r1.x + x2[5] * r1.y + x2[6] * r1.z + x2[7] * r1.w; }
                    __builtin_amdgcn_sched_barrier(0); } }
#pragma unroll
            for (int r = 0; r < R; ++r) {
                float lg[16];
#pragma unroll
                for (int e = 0; e < 16; ++e) lg[e] = r == 0 ? lg2[e].x : lg2[e].y;
                float v8[8], v4[4], v2[2], v1;
#pragma unroll
                for (int i = 0; i < 8; ++i) v8[i] = swsum32(lg[i], lg[i + 8]);
#pragma unroll
                for (int i = 0; i < 4; ++i) v4[i] = swsum16(v8[i], v8[i + 4]);
                { const bool up = (lane & 8) != 0;
#pragma unroll
                  for (int i = 0; i < 2; ++i) { const float send = up ? v4[i] : v4[i + 2]; const float keep = up ? v4[i + 2] : v4[i]; v2[i] = keep + dppf<0x128>(send); } }
                { const bool up = (lane & 4) != 0; const float send = up ? v2[0] : v2[1]; const float keep = up ? v2[1] : v2[0]; v1 = keep + xor4f(send); }
                v1 += dppf<0x4E>(v1); v1 += dppf<0xB1>(v1);
                if ((lane & 3) == 0 && r < nv) logL[(wave * RPW + (m0 - mBeg) + r) * 16 + (lane >> 2)] = v1;
            }
        }
    }
#undef NR_LOAD
    if (MODE == 2 && !DRY) {
        asm volatile("s_waitcnt lgkmcnt(0)" ::: "memory");
        if (lane < mEnd - mBeg) {
            float sco[16], sel[16];
#pragma unroll
            for (int e4 = 0; e4 < 4; ++e4) { const f32x4 v = *(const LAS f32x4*)(logL + (wave * RPW + lane) * 16 + 4 * e4);
#pragma unroll
                for (int i = 0; i < 4; ++i) { const int e = 4 * e4 + i; sco[e] = 1.0f / (1.0f + __expf(-v[i])); sel[e] = sco[e] + ((const float*)(P.ws + WS_PAR))[PAR_RB + e]; } }
            int bg = 0; float bgs = -1e30f; int ba = 0, bb = 1; float sa = 0.f, sb = 0.f;
#pragma unroll
            for (int gI = 0; gI < 4; ++gI) {
                int i1 = 0; float v1 = sel[gI * 4], c1 = sco[gI * 4];
#pragma unroll
                for (int i = 1; i < 4; ++i) if (sel[gI * 4 + i] > v1) { v1 = sel[gI * 4 + i]; c1 = sco[gI * 4 + i]; i1 = i; }
                int i2 = -1; float v2 = -1e30f, c2 = 0.f;
#pragma unroll
                for (int i = 0; i < 4; ++i) if (i != i1 && sel[gI * 4 + i] > v2) { v2 = sel[gI * 4 + i]; c2 = sco[gI * 4 + i]; i2 = i; }
                const float gs = v1 + v2;
                if (gs > bgs) { bgs = gs; bg = gI; ba = i1; bb = i2; sa = c1; sb = c2; }
            }
            const int a = ba < bb ? ba : bb, b = ba < bb ? bb : ba;
            const float wl = ba < bb ? sa : sb, wh = ba < bb ? sb : sa, inv = 1.0f / (wl + wh);
            const int pairidx = (a == 0) ? (b - 1) : (a == 1 ? (b + 1) : 5);
            const int cls = bg * 6 + pairidx;
            const unsigned pl = __hip_atomic_fetch_add(cntL + cls, 1u, __ATOMIC_RELAXED, __HIP_MEMORY_SCOPE_WORKGROUP);
            LAS unsigned* rb = recL + (wave * RPW + lane) * 4; rb[0] = (unsigned)(mBeg + lane); rb[1] = __float_as_uint(wl * inv); rb[2] = __float_as_uint(wh * inv); rb[3] = (unsigned)cls | (pl << 8);
        }
        asm volatile("s_waitcnt lgkmcnt(0)" ::: "memory"); __syncthreads();
        unsigned* ctl = (unsigned*)(P.ws + WS_CTL);
        if (tid < NCLS) { const unsigned n = cntL[tid]; baseL[tid] = n ? atomicAdd(ctl + CW_CNTF + (l * 32 + tid) * 64, n) : 0u; }
        __syncthreads();
        ClsRec* listr = (ClsRec*)(P.ws + WS_LISTR); unsigned* posw = (unsigned*)(P.ws + WS_POS);
        for (int i = tid; i < NWAVES * RPW; i += NTHR) { const int w = i / RPW, r = i % RPW; const int wb = (blockIdx.x * NWAVES + w) * rpw; const int nw = (wb + rpw < Mrows ? wb + rpw : Mrows) - wb;
            if (r < nw) { const LAS unsigned* rb = recL + i * 4; const unsigned cls = rb[3] & 255u, pl = rb[3] >> 8, gp = baseL[cls] + pl;
                ClsRec rc; rc.m = (int)rb[0]; rc.wlo = __uint_as_float(rb[1]); rc.whi = __uint_as_float(rb[2]); rc.pad = 0;
                listr[(size_t)cls * MT + gp] = rc; posw[rb[0]] = cls | (gp << 8); } }
    }
}
__device__ __forceinline__ void build_tile_table(const Ptrs& P, LAS int* tst, int l, int wid_s) {
    asm volatile("" : "+s"(wid_s));
    if (wid_s == 0) {
        int lane = wg_lane(); asm volatile("" : "+v"(lane));
        const unsigned* cnt = (const unsigned*)(P.ws + WS_CTL) + CW_CNTF + l * 32 * 64;
        const int tiles = lane < NCLS ? (int)((__hip_atomic_load(cnt + lane * 64, __ATOMIC_RELAXED, __HIP_MEMORY_SCOPE_AGENT) + 255u) >> 8) : 0;
        int incl = tiles;
#pragma unroll
        for (int o = 1; o < 32; o <<= 1) { const int t = __shfl_up(incl, o); if (lane >= o) incl += t; }
        if (lane <= NCLS) tst[lane] = incl - tiles;
    }
    __syncthreads();
}
namespace mx {
typedef float f32x16 __attribute__((ext_vector_type(16)));
typedef short s16x4 __attribute__((ext_vector_type(4)));
constexpr int SLOTB = 8192;
constexpr int L_K = 0, L_V = 2 * SLOTB, L_WS = 4 * SLOTB, L_OST = L_WS + NWAVES * 256, L_END = L_OST + NWAVES * 4096;
constexpr int VT_PITCH = 136;
__device__ __forceinline__ int crow(int r, int hi) { return (r & 3) + 8 * (r >> 2) + 4 * hi; }
__device__ __forceinline__ unsigned cvtpk(float lo, float hi) { unsigned r; asm volatile("v_cvt_pk_bf16_f32 %0, %1, %2" : "=v"(r) : "v"(lo), "v"(hi)); return r; }
__device__ __forceinline__ float gelu_fast(float x) { const float y = x + 0.044715f * x * x * x; return x * __builtin_amdgcn_rcpf(1.0f + __builtin_amdgcn_exp2f(-2.302208198f * y)); }

__device__ __forceinline__ void qkt(f32x16& p0, f32x16& p1, const LAS unsigned char* Kslot, const bf16x8* qr, const f32x16& negm, int r32, int hi) {
    const LAS unsigned char* kb = Kslot + hi * 1024 + r32 * 16;
#pragma unroll
    for (int d0 = 0; d0 < 4; ++d0) {
        const bf16x8 b0 = *(const LAS bf16x8*)(kb + d0 * 2048), b1 = *(const LAS bf16x8*)(kb + d0 * 2048 + 512);
        if (d0 == 0) { p0 = __builtin_amdgcn_mfma_f32_32x32x16_bf16(b0, qr[0], negm, 0, 0, 0); p1 = __builtin_amdgcn_mfma_f32_32x32x16_bf16(b1, qr[0], negm, 0, 0, 0); }
        else { p0 = __builtin_amdgcn_mfma_f32_32x32x16_bf16(b0, qr[d0], p0, 0, 0, 0); p1 = __builtin_amdgcn_mfma_f32_32x32x16_bf16(b1, qr[d0], p1, 0, 0, 0); } }
}
__device__ __forceinline__ void qkt2(f32x16& a0, f32x16& a1, f32x16& b0, f32x16& b1, const LAS unsigned char* KslotA, const LAS unsigned char* KslotB, const bf16x8* qr, const f32x16& negm, int r32, int hi) {
    const LAS unsigned char* ka = KslotA + hi * 1024 + r32 * 16; const LAS unsigned char* kb = KslotB + hi * 1024 + r32 * 16;
#pragma unroll
    for (int d0 = 0; d0 < 4; ++d0) {
        const bf16x8 xa0 = *(const LAS bf16x8*)(ka + d0 * 2048), xa1 = *(const LAS bf16x8*)(ka + d0 * 2048 + 512), xb0 = *(const LAS bf16x8*)(kb + d0 * 2048), xb1 = *(const LAS bf16x8*)(kb + d0 * 2048 + 512);
        if (d0 == 0) { a0 = __builtin_amdgcn_mfma_f32_32x32x16_bf16(xa0, qr[0], negm, 0, 0, 0); a1 = __builtin_amdgcn_mfma_f32_32x32x16_bf16(xa1, qr[0], negm, 0, 0, 0);
                       b0 = __builtin_amdgcn_mfma_f32_32x32x16_bf16(xb0, qr[0], negm, 0, 0, 0); b1 = __builtin_amdgcn_mfma_f32_32x32x16_bf16(xb1, qr[0], negm, 0, 0, 0); }
        else { a0 = __builtin_amdgcn_mfma_f32_32x32x16_bf16(xa0, qr[d0], a0, 0, 0, 0); a1 = __builtin_amdgcn_mfma_f32_32x32x16_bf16(xa1, qr[d0], a1, 0, 0, 0);
               b0 = __builtin_amdgcn_mfma_f32_32x32x16_bf16(xb0, qr[d0], b0, 0, 0, 0); b1 = __builtin_amdgcn_mfma_f32_32x32x16_bf16(xb1, qr[d0], b1, 0, 0, 0); } }
}
__device__ __forceinline__ void pv(f32x16* o, unsigned vb, bf16x8 pa0, bf16x8 pa1, bf16x8 pa2, bf16x8 pa3) {
#pragma unroll
    for (int d0 = 0; d0 < 2; ++d0) { s16x4 lo[4], hi[4];
#pragma unroll
        for (int ks = 0; ks < 4; ++ks) {
            asm volatile("ds_read_b64_tr_b16 %0, %1 offset:%c2" : "=&v"(lo[ks]) : "v"(vb), "i"(d0 * 4096 + ks * 1024) : "memory");
            asm volatile("ds_read_b64_tr_b16 %0, %1 offset:%c2" : "=&v"(hi[ks]) : "v"(vb), "i"(d0 * 4096 + ks * 1024 + 512) : "memory"); }
        asm volatile("s_waitcnt lgkmcnt(0)" ::: "memory"); __builtin_amdgcn_sched_barrier(0);
#define MX_PK(k) (bf16x8){lo[k][0], lo[k][1], lo[k][2], lo[k][3], hi[k][0], hi[k][1], hi[k][2], hi[k][3]}
        o[d0] = __builtin_amdgcn_mfma_f32_32x32x16_bf16(pa0, MX_PK(0), o[d0], 0, 0, 0);
        o[d0] = __builtin_amdgcn_mfma_f32_32x32x16_bf16(pa1, MX_PK(1), o[d0], 0, 0, 0);
        o[d0] = __builtin_amdgcn_mfma_f32_32x32x16_bf16(pa2, MX_PK(2), o[d0], 0, 0, 0);
        o[d0] = __builtin_amdgcn_mfma_f32_32x32x16_bf16(pa3, MX_PK(3), o[d0], 0, 0, 0);
#undef MX_PK
    }
}
#define MS_TR(dst, base, off) asm volatile("ds_read_b64_tr_b16 %0, %1 offset:%c2" : "=&v"(dst) : "v"(base), "i"(off) : "memory")
#define MS_VISSUE(R, base, d0) do { MS_TR(R[0], base, (d0) * 4096); MS_TR(R[1], base, (d0) * 4096 + 512); MS_TR(R[2], base, (d0) * 4096 + 1024); MS_TR(R[3], base, (d0) * 4096 + 1536); \
        MS_TR(R[4], base, (d0) * 4096 + 2048); MS_TR(R[5], base, (d0) * 4096 + 2560); MS_TR(R[6], base, (d0) * 4096 + 3072); MS_TR(R[7], base, (d0) * 4096 + 3584); } while (0)
#define MS_VWAIT(n, R) do { asm volatile("s_waitcnt lgkmcnt(" #n ")" : "+v"(R[0]), "+v"(R[1]), "+v"(R[2]), "+v"(R[3]), "+v"(R[4]), "+v"(R[5]), "+v"(R[6]), "+v"(R[7]) :: "memory"); __builtin_amdgcn_sched_barrier(0); } while (0)
#define MS_PK(R, k) (bf16x8){R[2 * (k)][0], R[2 * (k)][1], R[2 * (k)][2], R[2 * (k)][3], R[2 * (k) + 1][0], R[2 * (k) + 1][1], R[2 * (k) + 1][2], R[2 * (k) + 1][3]}
#define MS_PVMMA(acc, R, p0, p1, p2, p3) do { acc = __builtin_amdgcn_mfma_f32_32x32x16_bf16(__builtin_bit_cast(bf16x8, p0), MS_PK(R, 0), acc, 0, 0, 0); acc = __builtin_amdgcn_mfma_f32_32x32x16_bf16(__builtin_bit_cast(bf16x8, p1), MS_PK(R, 1), acc, 0, 0, 0); \
        acc = __builtin_amdgcn_mfma_f32_32x32x16_bf16(__builtin_bit_cast(bf16x8, p2), MS_PK(R, 2), acc, 0, 0, 0); acc = __builtin_amdgcn_mfma_f32_32x32x16_bf16(__builtin_bit_cast(bf16x8, p3), MS_PK(R, 3), acc, 0, 0, 0); __builtin_amdgcn_sched_barrier(0); } while (0)
__device__ __forceinline__ void pv2(f32x16* o, unsigned vbA, unsigned vbB, const u32x4& a0, const u32x4& a1, const u32x4& a2, const u32x4& a3, const u32x4& b0, const u32x4& b1, const u32x4& b2, const u32x4& b3) {
    s16x4 R0[8], R1[8];
    __builtin_amdgcn_sched_barrier(0);
    MS_VISSUE(R0, vbA, 0); MS_VISSUE(R1, vbA, 1);
    MS_VWAIT(8, R0); MS_PVMMA(o[0], R0, a0, a1, a2, a3); MS_VISSUE(R0, vbB, 0);
    MS_VWAIT(8, R1); MS_PVMMA(o[1], R1, a0, a1, a2, a3); MS_VISSUE(R1, vbB, 1);
    MS_VWAIT(8, R0); MS_PVMMA(o[0], R0, b0, b1, b2, b3);
    MS_VWAIT(0, R1); MS_PVMMA(o[1], R1, b0, b1, b2, b3);
}
struct ConvRaw { u32x4 bg, c0, c1, c2, z0, z1, z2; };
__device__ __forceinline__ void conv_load(ConvRaw& R, const bf16_t* PROJ, int m0, int tid, int q) {
    const int seqmask = m0 < ML ? SEQ - 1 : CTXL - 1; const int mrel = m0 < ML ? m0 : m0 - ML;
    const int idx = q * NTHR + tid, row = idx >> 5, c = (idx & 31) * 8;
    const int t = (mrel + row) & seqmask; const bf16_t* pr = PROJ + (size_t)(m0 + row) * INC;
    R.bg = *(const u32x4*)(pr + C_BG + c); R.c1 = *(const u32x4*)(pr + C_CG + c); R.z1 = *(const u32x4*)(pr + C_Z + c);
    R.c0 = (u32x4){0u, 0u, 0u, 0u}; R.z0 = R.c0; R.c2 = R.c0; R.z2 = R.c0;
    if (t > 0) { R.c0 = *(const u32x4*)(pr - INC + C_CG + c); R.z0 = *(const u32x4*)(pr - INC + C_Z + c); }
    if (t < seqmask) { R.c2 = *(const u32x4*)(pr + INC + C_CG + c); R.z2 = *(const u32x4*)(pr + INC + C_Z + c); }
}
__device__ __forceinline__ void conv_finish(const ConvRaw& R, const float* cwl, unsigned char* MIXo, int m0, int tid, int q) {
    const int idx = q * NTHR + tid, row = idx >> 5, c = (idx & 31) * 8;
    const float* cw = cwl + c;
    float o[8];
#pragma unroll
    for (int i = 0; i < 8; ++i) { const int wI = i >> 1; const bool up = i & 1;
#define MX_BF(v) (up ? __uint_as_float((v)[wI] & 0xffff0000u) : __uint_as_float((v)[wI] << 16))
        const float y = MX_BF(R.c0) * MX_BF(R.z0) * cw[i] + MX_BF(R.c1) * MX_BF(R.z1) * cw[256 + i] + MX_BF(R.c2) * MX_BF(R.z2) * cw[512 + i];
        o[i] = MX_BF(R.bg) * y;
#undef MX_BF
    }
    u32x2 w; w.x = pk4_fp8(o[0], o[1], o[2], o[3], (float)(1 << F8_SH_M)); w.y = pk4_fp8(o[4], o[5], o[6], o[7], (float)(1 << F8_SH_M));
    *(u32x2*)(MIXo + (size_t)(m0 + row) * D + 256 + c) = w;
}
constexpr int NSLOT = 4;
constexpr int ATT_THR = 8;
typedef float f32x2 __attribute__((ext_vector_type(2)));
#define MX3(a, b, c) __builtin_fmaxf(__builtin_fmaxf((a), (b)), (c))
constexpr int A_K = 0, A_V = NSLOT * SLOTB, A_WS = 2 * NSLOT * SLOTB, A_OST = A_WS + NWAVES * 512, A_END = A_OST + NWAVES * 4096;
template <int NH> __device__ __forceinline__ void attn_unit(const bf16_t* PROJ, unsigned char* MIXo, const float* sink, const float* cwl, LAS unsigned char* shm, int latent, int b, int blk, int kvh, int hp, int tid) {
    const int lane = tid & 63, r32 = lane & 31, hi = lane >> 5; const int wid = __builtin_amdgcn_readfirstlane(tid >> 6);
    const int head0 = NH == 2 ? kvh * 4 + (wid >> 2) * 2 : kvh * 4 + hp * 2 + (wid >> 2), qw = (wid & 3) * 32;
    const int qrow0 = latent ? b * SEQ + blk * 128 : ML + b * CTXL + blk * 128;
    const int ctx0 = ML + b * CTXL;
    const int lt_lo = latent ? (blk > 0 ? 0 : 2) : 0, lt_hi = latent ? (blk < SEQ / 128 - 1 ? 6 : 4) : 0;
    const int NT = 4 + (lt_hi - lt_lo);
    LAS float* wsf = (LAS float*)(shm + A_WS) + wid * 128;
    const bf16_t* kcol = PROJ + C_K + kvh * 64 + wid * 8;
    const bf16_t* vcol = PROJ + C_VV + kvh * 64 + (wid >> 2) * 32 + (lane & 3) * 8;
#define MX_LT(t) (NT == 10 ? ((t) < 8 ? (t) - 3 : ((t) == 8 ? 0 : 5)) : (t) - 4 + lt_lo)
#define MX_TROW(t) ((t) < 4 ? ctx0 + 64 * (t) : b * SEQ + blk * 128 - 128 + 64 * MX_LT(t))
#define MX_DMA(t) do { const int _r0 = MX_TROW(t); const int _sl = (t) & (NSLOT - 1); \
        __builtin_amdgcn_global_load_lds((const unsigned*)(kcol + (size_t)(_r0 + lane) * INC), (LAS unsigned*)(shm + A_K + _sl * SLOTB + wid * 1024), 16, 0, 0); \
        __builtin_amdgcn_global_load_lds((const unsigned*)(vcol + (size_t)(_r0 + 16 * (wid & 3) + (lane >> 2)) * INC), (LAS unsigned*)(shm + A_V + _sl * SLOTB + wid * 1024), 16, 0, 0); } while (0)
    static_assert(NH == 1, "the conv slice deal assumes four attention units per chunk");
    const int cm0 = qrow0 + (kvh * 2 + hp) * 32;
    ConvRaw CR; conv_load(CR, PROJ, cm0, tid, 0);
    bf16x8 qr[NH][4];
    { const bf16_t* qp = PROJ + (size_t)(qrow0 + qw + r32) * INC + C_Q + head0 * 64 + hi * 8;
#pragma unroll
      for (int hh = 0; hh < NH; ++hh)
#pragma unroll
          for (int d0 = 0; d0 < 4; ++d0) qr[hh][d0] = *(const bf16x8*)(qp + hh * 64 + d0 * 16); }
    MX_DMA(0); MX_DMA(1);
    float mrun[NH], lsum[NH]; f32x16 o[NH][2], negm[NH];
#pragma unroll
    for (int hh = 0; hh < NH; ++hh) { mrun[hh] = sink[head0 + hh] * LOG2E; lsum[hh] = hi == 0 ? 1.0f : 0.0f;
#pragma unroll
        for (int r = 0; r < 16; ++r) negm[hh][r] = -mrun[hh];
        o[hh][0] = (f32x16){0.f, 0.f, 0.f, 0.f, 0.f, 0.f, 0.f, 0.f, 0.f, 0.f, 0.f, 0.f, 0.f, 0.f, 0.f, 0.f}; o[hh][1] = o[hh][0]; }
    const unsigned vb0 = (unsigned)(size_t)(shm + A_V) + ((lane >> 4) & 1) * 32 + (lane & 3) * 8 + (4 * hi + ((lane & 15) >> 2)) * 64;
    const int qc = qw + r32;
    const int NTP = NT == 10 ? 8 : NT;
    for (int t = 0; t < NTP; t += 2) {
        asm volatile("s_waitcnt vmcnt(0) lgkmcnt(0)\n\ts_barrier" ::: "memory");
        if (t + 2 < NT) { MX_DMA(t + 2); MX_DMA(t + 3); }
        if (t == 2) { conv_finish(CR, cwl, MIXo, cm0, tid, 0); conv_load(CR, PROJ, cm0, tid, 1); }
        const int sa = t & (NSLOT - 1), sb = (t + 1) & (NSLOT - 1);
        f32x16 pa0, pa1, pb0, pb1;
        { f32x16 ng; float nm = -mrun[0]; asm volatile("" : "+v"(nm));
#pragma unroll
          for (int r = 0; r < 16; ++r) ng[r] = nm;
          qkt2(pa0, pa1, pb0, pb1, shm + A_K + sa * SLOTB, shm + A_K + sb * SLOTB, qr[0], ng, r32, hi); }
        if (t >= 4) {
#pragma unroll
            for (int q = 0; q < 2; ++q) { const int lt = MX_LT(t + q); if (lt < 2 || lt >= 4) { const int kb = -128 + 64 * lt;
#pragma unroll
                for (int r = 0; r < 16; ++r) { const int k0 = kb + crow(r, hi), k1 = k0 + 32; const bool m0_ = (k0 < qc - 128 || k0 > qc + 128), m1_ = (k1 < qc - 128 || k1 > qc + 128);
                    if (q == 0) { if (m0_) pa0[r] = -1e30f; if (m1_) pa1[r] = -1e30f; } else { if (m0_) pb0[r] = -1e30f; if (m1_) pb1[r] = -1e30f; } } } } }
        float ma = MX3(pa0[0], pa1[0], pb0[0]), mb = MX3(pb1[0], pa0[1], pa1[1]); ma = MX3(ma, pb0[1], pb1[1]);
#pragma unroll
        for (int r = 2; r < 16; r += 2) { ma = MX3(ma, pa0[r], pa1[r]); mb = MX3(mb, pb0[r], pb1[r]); ma = MX3(ma, pa0[r + 1], pa1[r + 1]); mb = MX3(mb, pb0[r + 1], pb1[r + 1]); }
        float rm = __builtin_fmaxf(ma, mb);
        { auto rr = __builtin_amdgcn_permlane32_swap(__float_as_uint(rm), __float_as_uint(rm), false, false); rm = __builtin_fmaxf(__uint_as_float(rr[0]), __uint_as_float(rr[1])); }
        if (__any(rm > (float)ATT_THR)) { const float dl = __builtin_fmaxf(rm, 0.f); mrun[0] += dl;
#pragma unroll
            for (int r = 0; r < 16; ++r) { pa0[r] -= dl; pa1[r] -= dl; pb0[r] -= dl; pb1[r] -= dl; }
            const float f = __builtin_amdgcn_exp2f(-dl); lsum[0] *= f; if (hi == 0) wsf[r32] = f;
            asm volatile("s_waitcnt lgkmcnt(0)" ::: "memory");
#pragma unroll
            for (int r = 0; r < 16; ++r) { const float fr_ = *(volatile LAS float*)(wsf + crow(r, hi)); o[0][0][r] *= fr_; o[0][1][r] *= fr_; } }
#pragma unroll
        for (int r = 0; r < 16; ++r) { pa0[r] = __builtin_amdgcn_exp2f(pa0[r]); pa1[r] = __builtin_amdgcn_exp2f(pa1[r]); pb0[r] = __builtin_amdgcn_exp2f(pb0[r]); pb1[r] = __builtin_amdgcn_exp2f(pb1[r]); }
        { f32x2 s2 = (f32x2){pa0[0], pa0[1]} + (f32x2){pa1[0], pa1[1]}, s3 = (f32x2){pb0[0], pb0[1]} + (f32x2){pb1[0], pb1[1]};
#pragma unroll
          for (int r = 2; r < 16; r += 2) { s2 += (f32x2){pa0[r], pa0[r + 1]}; s3 += (f32x2){pb0[r], pb0[r + 1]}; s2 += (f32x2){pa1[r], pa1[r + 1]}; s3 += (f32x2){pb1[r], pb1[r + 1]}; }
          s2 += s3; lsum[0] += s2.x + s2.y; }
        { u32x4 pw0, pw1, pw2, pw3, pw4, pw5, pw6, pw7;
#pragma unroll
          for (int i = 0; i < 4; ++i) { pw0[i] = cvtpk(pa0[2 * i], pa0[2 * i + 1]); pw1[i] = cvtpk(pa0[8 + 2 * i], pa0[8 + 2 * i + 1]); pw2[i] = cvtpk(pa1[2 * i], pa1[2 * i + 1]); pw3[i] = cvtpk(pa1[8 + 2 * i], pa1[8 + 2 * i + 1]);
                                        pw4[i] = cvtpk(pb0[2 * i], pb0[2 * i + 1]); pw5[i] = cvtpk(pb0[8 + 2 * i], pb0[8 + 2 * i + 1]); pw6[i] = cvtpk(pb1[2 * i], pb1[2 * i + 1]); pw7[i] = cvtpk(pb1[8 + 2 * i], pb1[8 + 2 * i + 1]); }
          pv2(o[0], vb0 + sa * SLOTB, vb0 + sb * SLOTB, pw0, pw1, pw2, pw3, pw4, pw5, pw6, pw7); }
    }
    if (NT == 10) {
        asm volatile("s_waitcnt vmcnt(0) lgkmcnt(0)\n\ts_barrier" ::: "memory");
        const int ss = qw < 64 ? 0 : 1, kb = qw < 64 ? -128 : 192;
        f32x16 p0, p1;
        { f32x16 ng; float nm = -mrun[0]; asm volatile("" : "+v"(nm));
#pragma unroll
          for (int r = 0; r < 16; ++r) ng[r] = nm;
          qkt(p0, p1, shm + A_K + ss * SLOTB, qr[0], ng, r32, hi); }
#pragma unroll
        for (int r = 0; r < 16; ++r) { const int k0 = kb + crow(r, hi), k1 = k0 + 32; if (k0 < qc - 128 || k0 > qc + 128) p0[r] = -1e30f; if (k1 < qc - 128 || k1 > qc + 128) p1[r] = -1e30f; }
        float ma = MX3(p0[0], p1[0], p0[1]), mb = MX3(p1[1], p0[2], p1[2]);
#pragma unroll
        for (int r = 3; r < 15; r += 2) { ma = MX3(ma, p0[r], p1[r]); mb = MX3(mb, p0[r + 1], p1[r + 1]); }
        float rm = MX3(ma, mb, __builtin_fmaxf(p0[15], p1[15]));
        { auto rr = __builtin_amdgcn_permlane32_swap(__float_as_uint(rm), __float_as_uint(rm), false, false); rm = __builtin_fmaxf(__uint_as_float(rr[0]), __uint_as_float(rr[1])); }
        if (__any(rm > (float)ATT_THR)) { const float dl = __builtin_fmaxf(rm, 0.f); mrun[0] += dl;
#pragma unroll
            for (int r = 0; r < 16; ++r) { p0[r] -= dl; p1[r] -= dl; }
            const float f = __builtin_amdgcn_exp2f(-dl); lsum[0] *= f; if (hi == 0) wsf[r32] = f;
            asm volatile("s_waitcnt lgkmcnt(0)" ::: "memory");
#pragma unroll
            for (int r = 0; r < 16; ++r) { const float fr_ = *(volatile LAS float*)(wsf + crow(r, hi)); o[0][0][r] *= fr_; o[0][1][r] *= fr_; } }
#pragma unroll
        for (int r = 0; r < 16; ++r) { p0[r] = __builtin_amdgcn_exp2f(p0[r]); p1[r] = __builtin_amdgcn_exp2f(p1[r]); }
        { f32x2 s2 = (f32x2){p0[0], p0[1]} + (f32x2){p1[0], p1[1]};
#pragma unroll
          for (int r = 2; r < 16; r += 2) { s2 += (f32x2){p0[r], p0[r + 1]}; s2 += (f32x2){p1[r], p1[r + 1]}; }
          lsum[0] += s2.x + s2.y; }
        { u32x4 pw0, pw1, pw2, pw3;
#pragma unroll
          for (int i = 0; i < 4; ++i) { pw0[i] = cvtpk(p0[2 * i], p0[2 * i + 1]); pw1[i] = cvtpk(p0[8 + 2 * i], p0[8 + 2 * i + 1]); pw2[i] = cvtpk(p1[2 * i], p1[2 * i + 1]); pw3[i] = cvtpk(p1[8 + 2 * i], p1[8 + 2 * i + 1]); }
          pv(o[0], vb0 + ss * SLOTB, __builtin_bit_cast(bf16x8, pw0), __builtin_bit_cast(bf16x8, pw1), __builtin_bit_cast(bf16x8, pw2), __builtin_bit_cast(bf16x8, pw3)); }
    }
    LAS unsigned char* stg = (LAS unsigned char*)(shm + A_OST) + wid * 2048;
#pragma unroll
    for (int hh = 0; hh < NH; ++hh) {
        float ls = lsum[hh];
        { auto rr = __builtin_amdgcn_permlane32_swap(__float_as_uint(ls), __float_as_uint(ls), false, false); ls = __uint_as_float(rr[0]) + __uint_as_float(rr[1]); }
        if (hi == 0) wsf[hh * 64 + 32 + r32] = ls;
        asm volatile("s_waitcnt lgkmcnt(0)" ::: "memory");
#pragma unroll
        for (int r = 0; r < 16; ++r) { const int orow = crow(r, hi); const float rl = __builtin_amdgcn_rcpf(*(volatile LAS float*)(wsf + hh * 64 + 32 + orow)) * (float)(1 << F8_SH_M);
            const unsigned w = pk4_fp8(o[hh][0][r], o[hh][1][r], 0.f, 0.f, rl); stg[orow * 64 + r32] = (unsigned char)(w & 0xffu); stg[orow * 64 + 32 + r32] = (unsigned char)((w >> 8) & 0xffu); }
        asm volatile("s_waitcnt lgkmcnt(0)" ::: "memory");
        unsigned char* op = MIXo + (size_t)(qrow0 + qw) * D + 512 + (head0 + hh) * 64;
#pragma unroll
        for (int i = 0; i < 2; ++i) { const int row = i * 16 + (lane >> 2), ch = lane & 3; const u32x4 v = *(const LAS u32x4*)(stg + row * 64 + ch * 16); *(u32x4*)(op + (size_t)row * D + ch * 16) = v; }
        asm volatile("s_waitcnt lgkmcnt(0)" ::: "memory");
    }
    conv_finish(CR, cwl, MIXo, cm0, tid, 1);
    asm volatile("s_barrier" ::: "memory");
#undef MX_DMA
#undef MX_TROW
}

__device__ __forceinline__ void gmlp_conv_unit(const Ptrs& P, const bf16_t* PROJ, unsigned char* MIXo, LAS unsigned char* shm, int l, int m0, int tid) {
    const int lane = tid & 63, r32 = lane & 31, hi = lane >> 5; const int wid = __builtin_amdgcn_readfirstlane(tid >> 6);
    LAS bf16_t* vT = (LAS bf16_t*)shm;
    { u32x2 raw[16];
#pragma unroll
      for (int rr = 0; rr < 16; ++rr) raw[rr] = *(const u32x2*)(PROJ + (size_t)(m0 + wid * 16 + rr) * INC + C_V + 4 * lane);
      float gv[4];
#pragma unroll
      for (int i = 0; i < 4; ++i) gv[i] = ((const float*)(P.ws + WS_PAR))[PAR_GG + l * 256 + 4 * lane + i];
#pragma unroll
      for (int r4 = 0; r4 < 4; ++r4) { float g[4][4], ss[4];
#pragma unroll
          for (int q = 0; q < 4; ++q) { const u32x2 w = raw[r4 * 4 + q];
              g[q][0] = gelu_fast(__uint_as_float(w.x << 16)); g[q][1] = gelu_fast(__uint_as_float(w.x & 0xffff0000u)); g[q][2] = gelu_fast(__uint_as_float(w.y << 16)); g[q][3] = gelu_fast(__uint_as_float(w.y & 0xffff0000u));
              ss[q] = g[q][0] * g[q][0] + g[q][1] * g[q][1] + g[q][2] * g[q][2] + g[q][3] * g[q][3]; }
#pragma unroll
          for (int q = 0; q < 4; ++q) ss[q] = wave_sum(ss[q]);
          float rinv[4];
#pragma unroll
          for (int q = 0; q < 4; ++q) rinv[q] = rsqrtf(ss[q] * (1.0f / 256.0f) + EPS);
#pragma unroll
          for (int i = 0; i < 4; ++i) { u32x2 w; w.x = cvtpk(g[0][i] * rinv[0] * gv[i], g[1][i] * rinv[1] * gv[i]); w.y = cvtpk(g[2][i] * rinv[2] * gv[i], g[3][i] * rinv[3] * gv[i]);
              *(LAS u32x2*)(vT + (4 * lane + i) * VT_PITCH + wid * 16 + r4 * 4) = w; } } }
    asm volatile("s_waitcnt lgkmcnt(0)\n\ts_barrier" ::: "memory");
    { const int h = wid >> 1, dt = wid & 1;
      const bf16_t* wsb = (const bf16_t*)(P.ws + WS_WSB) + ((size_t)(l * 4 + h) * 128) * 128 + (size_t)r32 * 128 + hi * 8;
      bf16x8 bfr[2][8];
#pragma unroll
      for (int kk = 0; kk < 8; ++kk) bfr[0][kk] = *(const bf16x8*)(wsb + kk * 16);
      u32x2 uraw[4][4];
#pragma unroll
      for (int pt = 0; pt < 4; ++pt)
#pragma unroll
          for (int q4 = 0; q4 < 4; ++q4) uraw[pt][q4] = *(const u32x2*)(PROJ + (size_t)(m0 + pt * 32 + r32) * INC + C_U + h * 64 + dt * 32 + 4 * hi + 8 * q4);
      bf16x8 af[8];
#pragma unroll
      for (int kk = 0; kk < 8; ++kk) af[kk] = *(const LAS bf16x8*)(vT + (h * 64 + dt * 32 + r32) * VT_PITCH + kk * 16 + hi * 8);
      const float* bs = (const float*)(P.ws + WS_PAR) + PAR_BS + (l * 4 + h) * 128;
#pragma unroll
      for (int pt = 0; pt < 4; ++pt) {
          if (pt < 3) {
#pragma unroll
              for (int kk = 0; kk < 8; ++kk) bfr[(pt + 1) & 1][kk] = *(const bf16x8*)(wsb + (size_t)(pt + 1) * 32 * 128 + kk * 16); }
          f32x16 acc = (f32x16){0.f, 0.f, 0.f, 0.f, 0.f, 0.f, 0.f, 0.f, 0.f, 0.f, 0.f, 0.f, 0.f, 0.f, 0.f, 0.f};
#pragma unroll
          for (int kk = 0; kk < 8; ++kk) acc = __builtin_amdgcn_mfma_f32_32x32x16_bf16(af[kk], bfr[pt & 1][kk], acc, 0, 0, 0);
          const int p = pt * 32 + r32; const float bias = bs[p];
          unsigned char* op = MIXo + (size_t)(m0 + p) * D + h * 64 + dt * 32 + 4 * hi;
#pragma unroll
          for (int q4 = 0; q4 < 4; ++q4) { const u32x2 raw = uraw[pt][q4];
              const float u0 = gelu_fast(__uint_as_float(raw.x << 16)), u1 = gelu_fast(__uint_as_float(raw.x & 0xffff0000u)), u2 = gelu_fast(__uint_as_float(raw.y << 16)), u3 = gelu_fast(__uint_as_float(raw.y & 0xffff0000u));
              *(unsigned*)(op + 8 * q4) = pk4_fp8(u0 * (acc[4 * q4] + bias), u1 * (acc[4 * q4 + 1] + bias), u2 * (acc[4 * q4 + 2] + bias), u3 * (acc[4 * q4 + 3] + bias), (float)(1 << F8_SH_M)); }
      } }
    asm volatile("s_waitcnt lgkmcnt(0)\n\ts_barrier" ::: "memory");
}
}

#ifdef STAMPS
#define MXT(kind, op) do { if ((kind) == STAMP_K1) tacc_ op##= __builtin_amdgcn_s_memrealtime(); } while (0)
#else
#define MXT(kind, op) do { } while (0)
#endif
constexpr int ATT_NH = 1;
__device__ __forceinline__ void phase_mixer(const Ptrs& P, LAS unsigned char* lds, int l, int Mmix, unsigned long long& tacc_, int wid_s) {
    int tid = wid_s * 64 + wg_lane(); asm volatile("" : "+v"(tid));
    const bf16_t* PROJ = (const bf16_t*)(P.ws + WS_PROJ); unsigned char* MIXo = (unsigned char*)(P.ws + WS_MIX);
    const int G = gridDim.x, c = blockIdx.x;
    constexpr int UPC = ATT_NH == 2 ? 2 : 4;
    const int nLat = (ML / 128) * UPC, nCtx = Mmix > ML ? (MC / 128) * UPC : 0, nG = Mmix / 128;
    const bool gfirst = (c & 1) != 0;
    for (int pass = 0; pass < 2; ++pass) {
        if ((pass == 0) != gfirst) { MXT(20, -); for (int u = c; u < nLat; u += G) { const int chunk = u / UPC, kvh = (u / (UPC / 2)) & 1, hp = u & 1; mx::attn_unit<ATT_NH>(PROJ, MIXo, (const float*)(P.ws + WS_PAR) + PAR_SINK + l * 8, (const float*)(P.ws + WS_PAR) + PAR_CW + l * 768, lds, 1, chunk >> 6, chunk & 63, kvh, hp, tid); } MXT(20, +); }
        else { MXT(21, -); for (int u = c; u < nG + nCtx; u += G) {
            if (u < nG) mx::gmlp_conv_unit(P, PROJ, MIXo, lds, l, u * 128, tid);
            else { const int v = u - nG, chunk = v / UPC, kvh = (v / (UPC / 2)) & 1, hp = v & 1; mx::attn_unit<ATT_NH>(PROJ, MIXo, (const float*)(P.ws + WS_PAR) + PAR_SINK + l * 8, (const float*)(P.ws + WS_PAR) + PAR_CW + l * 768, lds, 0, chunk >> 1, chunk & 1, kvh, hp, tid); } } MXT(21, +); }
    }
}
constexpr int NPH = 31;
struct KArgs { Ptrs P; int lo, hi; };
__global__ void __launch_bounds__(NTHR, 2) k_fast(KArgs a) {
    extern __shared__ __attribute__((aligned(16))) unsigned char lds_raw[];
    LAS unsigned char* lds = (LAS unsigned char*)lds_raw;
    const int lo = a.lo, hi = a.hi;
#if defined(__HIP_DEVICE_COMPILE__) && defined(USE_KERNARG_RELOAD)
#define LOADP() const __attribute__((address_space(4))) unsigned long long* ap_ = (const __attribute__((address_space(4))) unsigned long long*)__builtin_amdgcn_kernarg_segment_ptr(); asm volatile("" : "+s"(ap_)); \
    Ptrs P; { unsigned long long* d_ = (unsigned long long*)&P; _Pragma("unroll") for (int i_ = 0; i_ < (int)(sizeof(Ptrs) / 8); ++i_) d_[i_] = ap_[i_]; }
#else
#define LOADP() const Ptrs P = a.P
#endif
    unsigned* ctl; { LOADP(); ctl = (unsigned*)(P.ws + WS_CTL); }
    if (threadIdx.x < 4) ((LAS unsigned*)(lds + MISC_OFF))[threadIdx.x] = 0u;
    __syncthreads();
    XcdBarrier bar; bar.bar = ctl + CW_BAR; bar.x = 0; bar.st = (volatile LAS unsigned*)(lds + MISC_OFF);
    if (hi - lo > 1) bar = xcd_barrier_post(ctl + CW_BAR, (volatile LAS unsigned*)(lds + MISC_OFF));
    const int wid_s = __builtin_amdgcn_readfirstlane((int)(threadIdx.x >> 6)); bar.wid = wid_s;
    volatile LAS int* vcw = (volatile LAS int*)(lds + MISC_OFF + 32);
    if (threadIdx.x == 0) { vcw[3] = 0; vcw[0] = (int)blockIdx.x; vcw[1] = (int)xb_xcc_id(); vcw[2] = (hi - lo > 1) ? (int)xb_add(ctl + CW_XR + 64 * xb_xcc_id(), 1u) : 0; }
    __syncthreads();
#define IN(k, kind) (lo <= (k) && (k) < hi)
#ifdef STAMPS
#define TSTART(kind) do { if ((kind) == STAMP_K1) tacc_ -= __builtin_amdgcn_s_memrealtime(); } while (0)
#define TSTOP(kind) do { if ((kind) == STAMP_K1) tacc_ += __builtin_amdgcn_s_memrealtime(); } while (0)
    unsigned long long tacc_ = 0;
#else
#define TSTART(kind) do { } while (0)
#define TSTOP(kind) do { } while (0)
    unsigned long long tacc_ = 0;
#endif
#define SEAM(k) do { if (lo <= (k) && (k) + 1 < hi) xcd_barrier(bar); } while (0)

    LAS unsigned* idxtab = (LAS unsigned*)(lds + IDX_OFF);
    LAS int* tst = (LAS int*)(lds + TST_OFF);

    TSTART(0);
    if (IN(0, 0)) { LOADP(); phase_p0a(P, lds); }
    SEAM(0); TSTOP(0);
    if (lo == 0 && hi > 1) {
        if (threadIdx.x == 0) { const int myx = vcw[1], rank = vcw[2]; int npop = 0, xi = 0; bool even = true;
            for (int j = 0; j < 16; ++j) { const unsigned cj = xb_ld(ctl + CW_XR + 64 * j); if (cj) { ++npop; if (j < myx) ++xi; if (cj * 8u != gridDim.x) even = false; } }
            if (even && npop == 8 && rank < (int)(gridDim.x / 8)) { vcw[0] = rank * 8 + xi; vcw[3] = (int)(gridDim.x / 8); }
            }
        __syncthreads(); }
    const int vc = vcw[0];
    if (IN(1, 1)) { LOADP(); phase_p0b(P); }
    SEAM(1);
    for (int l = 0; l < DEPTH; ++l) {
        const int pb = 2 + 7 * l;
        const int Mmix = l < DEPTH - 1 ? MT : ML;
        TSTART(2);
        if (IN(pb + 0, 2)) { LOADP(); if (l > 0) build_tile_table(P, tst, l - 1, wid_s);
            if (l == 0) phase_norm<1, true>(P, lds, l, MT, (const bf16_t*)P.out, tst, wid_s); else phase_norm<1, false>(P, lds, l, MT, (const bf16_t*)P.out, tst, wid_s); }
        SEAM(pb + 0); TSTOP(2);
        TSTART(3);
        if (IN(pb + 1, 3)) { LOADP();
            SchedDense<INC, G1_FP8 ? 1 : 2, F8_SH_H> S{P.ws + WS_H, P.ws + WS_WIN + (size_t)l * INC * D * (G1_FP8 ? 1 : 2), MT / 256, (int)gridDim.x, vc};
            { const float* rt = (const float*)(P.ws + WS_ROPE); LAS _Float16* rl = (LAS _Float16*)(lds + ROPEL_OFF);
              for (int i = wid_s * 64 + wg_lane(); i < 4096; i += NTHR) rl[i] = (_Float16)rt[i];
              __syncthreads(); }
            EpiProj E{(bf16_t*)(P.ws + WS_PROJ), (const LAS _Float16*)(lds + ROPEL_OFF)};
            pg::gemm_phase(lds + RING_OFF, idxtab, S, E, wid_s);
            if (l + 1 < DEPTH) { const int um = (int)(((MT / 256) * (INC / 256)) % (int)gridDim.x); if (vc >= um) convert_tail(P.ws, lds, l + 1, 0, vc - um, (int)gridDim.x - um, wid_s); }
        }
        SEAM(pb + 1); TSTOP(3);
        TSTART(4);
        if (IN(pb + 2, 4)) { LOADP(); phase_mixer(P, lds, l, Mmix, tacc_, wid_s); }
        SEAM(pb + 2); TSTOP(4);
        TSTART(5);
        if (IN(pb + 3, 5)) { LOADP();
            SchedDense<D, 1, F8_SH_M> S{P.ws + WS_MIX, P.ws + WS_WOUT + (size_t)l * D * D, Mmix / 256, (int)gridDim.x, vc};
            EpiResid E{(bf16_t*)(P.ws + WS_XB), (const float*)(P.ws + WS_MOD) + (size_t)l * 9 * 6144 + 2048};
            pg::gemm_phase(lds + RING_OFF, idxtab, S, E, wid_s);
            if (l + 1 < DEPTH) { const int um = (int)(((Mmix / 256) * (D / 256)) % (int)gridDim.x); if (vc >= um) convert_tail(P.ws, lds, l + 1, 1, vc - um, (int)gridDim.x - um, wid_s); }
        }
        SEAM(pb + 3); TSTOP(5);
        TSTART(6);
        if (IN(pb + 4, 6)) { LOADP(); phase_norm<2, false>(P, lds, l, Mmix, (const bf16_t*)(P.ws + WS_PROJ), tst, wid_s); }
        SEAM(pb + 4); TSTOP(6);
        TSTART(7);
        if (IN(pb + 5, 7)) { LOADP(); const ClsRec* listr = (const ClsRec*)(P.ws + WS_LISTR);
            build_tile_table(P, tst, l, wid_s);
            SchedGU S{(const unsigned char*)(P.ws + WS_H), (const unsigned char*)(P.ws + WS_WGU) + (size_t)l * NE * 1024 * 1024, listr, tst, ctl + CW_CNTF + l * 32 * 64, (int)gridDim.x, vc};
            EpiGU E{(unsigned char*)(P.ws + WS_PROJ), listr, ctl + CW_CNTF + l * 32 * 64};
            pg::gemm_phase(lds + RING_OFF, idxtab, S, E, wid_s);
            if (l + 1 < DEPTH) { const int um = (int)((__builtin_amdgcn_readfirstlane(tst[NCLS]) * 8) % (int)gridDim.x); if (vc >= um) convert_tail(P.ws, lds, l + 1, 2, vc - um, (int)gridDim.x - um, wid_s); }
        }
        SEAM(pb + 5); TSTOP(7);
        TSTART(8);
        if (IN(pb + 6, 8)) { LOADP();
            build_tile_table(P, tst, l, wid_s);
            SchedDown S{(const unsigned char*)(P.ws + WS_PROJ), (const unsigned char*)(P.ws + WS_WD) + (size_t)l * NE * 1024 * 512, tst, (int)gridDim.x, vc};
            EpiPlain E{l < DEPTH - 1 ? (bf16_t*)P.out : (bf16_t*)(P.ws + WS_H), D};
            pg::gemm_phase(lds + RING_OFF, idxtab, S, E, wid_s);
            if (l + 1 < DEPTH) { const int um = (int)((__builtin_amdgcn_readfirstlane(tst[NCLS]) * 4) % (int)gridDim.x); if (vc >= um) convert_tail(P.ws, lds, l + 1, 3, vc - um, (int)gridDim.x - um, wid_s); }
        }
        SEAM(pb + 6); TSTOP(8);
    }
    TSTART(9);
    if (IN(30, 9)) { LOADP(); build_tile_table(P, tst, DEPTH - 1, wid_s); phase_norm<3, false>(P, lds, DEPTH - 1, ML, (const bf16_t*)(P.ws + WS_H), tst, wid_s); }
#ifdef STAMPS
    TSTOP(9);
    if (blockIdx.x == 0) { const unsigned long long t1 = __builtin_amdgcn_s_memrealtime(); while (__builtin_amdgcn_s_memrealtime() - t1 < (unsigned long long)(SPINK) * tacc_) __builtin_amdgcn_s_sleep(8); }
#endif
#undef IN
#undef SEAM
}
static int g_grid = 256;
static void launch_fast(const Ptrs& P, int lo, int hi, hipStream_t stream) {
    KArgs a{}; a.P = P; a.lo = lo; a.hi = hi;
    hipLaunchKernelGGL(k_fast, dim3(g_grid), dim3(NTHR), LDS_BYTES, stream, a);
}
extern "C" void kernel_launch(void* const* d_in, const int* in_sizes, int n_in, void* d_out, int out_size, void* d_ws, size_t ws_size, hipStream_t stream) {
    static int ready = 0;
    if (!ready) {
        if (n_in != 21 || ws_size < WS_END2) { fprintf(stderr, "kernel_launch: unexpected inputs (%d) or workspace (%zu)\n", n_in, ws_size); ready = -1; return; }
        if (hipFuncSetAttribute((const void*)k_fast, hipFuncAttributeMaxDynamicSharedMemorySize, LDS_BYTES) != hipSuccess) { fprintf(stderr, "kernel_launch: hipFuncSetAttribute failed\n"); ready = -1; return; }
        { int dev = 0, cus = 0, per_cu = 0; (void)hipGetDevice(&dev); (void)hipDeviceGetAttribute(&cus, hipDeviceAttributeMultiprocessorCount, dev);
          if (hipOccupancyMaxActiveBlocksPerMultiprocessor(&per_cu, (const void*)k_fast, NTHR, LDS_BYTES) != hipSuccess || per_cu < 1) { fprintf(stderr, "kernel_launch: occupancy query says %d blocks per CU\n", per_cu); }
          (void)hipGetLastError(); if (cus > 0) g_grid = cus;
          if (g_grid * NWAVES * 64 < MT) { fprintf(stderr, "kernel_launch: %d workgroups are too few for the routing tables\n", g_grid); ready = -1; return; } }
        ready = 1;
    }
    if (ready < 0) return;
    Ptrs P{};
    const float** pp = (const float**)&P;
    for (int i = 0; i < 21; ++i) pp[i] = (const float*)d_in[i];
    P.out = (float*)d_out; P.ws = (unsigned char*)d_ws;
    unsigned char* ws = (unsigned char*)d_ws;
    (void)hipMemsetAsync(ws + WS_CTL, 0, 1 * MiB, stream);
    launch_fast(P, 0, NPH, stream);
}
```

```cpp
#include <hip/hip_runtime.h>
#include <stdint.h>
#include <cstdio>

constexpr int D = 1024, NB = 8, SEQ = 8192, DEPTH = 4, CTXL = 256;
constexpr int ML = NB * SEQ;
constexpr int MC = NB * CTXL;
constexpr int MT = ML + MC;
constexpr int INC = 2048;
constexpr int C_U = 0, C_V = 256, C_BG = 512, C_CG = 768, C_Z = 1024, C_Q = 1280, C_K = 1792, C_VV = 1920;
constexpr int NE = 16, DE = 512, NCLS = 24;
constexpr float EPS = 1e-6f;
constexpr float QSCALE = 0.125f * 1.4426950408889634f;
constexpr float LOG2E = 1.4426950408889634f;

typedef unsigned short bf16_t;
typedef float f32x4 __attribute__((ext_vector_type(4)));
typedef unsigned u32x4 __attribute__((ext_vector_type(4)));
typedef unsigned u32x2 __attribute__((ext_vector_type(2)));

__device__ __forceinline__ float bf2f(bf16_t v) { return __uint_as_float((unsigned)v << 16); }
__device__ __forceinline__ bf16_t f2bf(float f) { unsigned u = __float_as_uint(f); return (bf16_t)((u + 0x7fffu + ((u >> 16) & 1u)) >> 16); }
__device__ __forceinline__ unsigned pk2(float lo, float hi) { return (unsigned)f2bf(lo) | ((unsigned)f2bf(hi) << 16); }
__device__ __forceinline__ float gelu_tanh(float x) { const float y = 0.7978845608028654f * (x + 0.044715f * x * x * x); return x / (1.0f + __expf(-2.0f * y)); }
__device__ __forceinline__ float silu_f(float x) { return x / (1.0f + __expf(-x)); }
template <int CTRL> __device__ __forceinline__ float dppf(float v) { return __int_as_float(__builtin_amdgcn_update_dpp(0, __float_as_int(v), CTRL, 0xF, 0xF, true)); }
__device__ __forceinline__ float xor4f(float v) { int t = __builtin_amdgcn_update_dpp(0, __float_as_int(v), 0x104, 0xF, 0x5, false); t = __builtin_amdgcn_update_dpp(t, __float_as_int(v), 0x114, 0xF, 0xA, false); return __int_as_float(t); }
__device__ __forceinline__ float swsum16(float a, float b) { auto r = __builtin_amdgcn_permlane16_swap(__float_as_uint(a), __float_as_uint(b), false, false); return __uint_as_float(r[0]) + __uint_as_float(r[1]); }
__device__ __forceinline__ float swsum32(float a, float b) { auto r = __builtin_amdgcn_permlane32_swap(__float_as_uint(a), __float_as_uint(b), false, false); return __uint_as_float(r[0]) + __uint_as_float(r[1]); }
__device__ __forceinline__ float wave_sum(float v) { v += dppf<0xB1>(v); v += dppf<0x4E>(v); v += dppf<0x124>(v); v += dppf<0x128>(v); v = swsum16(v, v); return swsum32(v, v); }

constexpr size_t MiB = 1u << 20;
constexpr size_t WS_CTL = 0;
constexpr size_t WS_MOD = 1 * MiB;
constexpr size_t WS_ROPE = 2 * MiB;
constexpr size_t WS_PTAB = 2 * MiB + 65536;
constexpr size_t WS_PAR = 2 * MiB + 131072;
constexpr int PAR_RW = 0, PAR_N1 = 16384, PAR_N2 = 20480, PAR_FG = 24576, PAR_RB = 25600, PAR_BS = 25664, PAR_GG = 27712, PAR_SINK = 28736, PAR_CW = 28800, PAR_END = 31872;
constexpr size_t WS_TOK = 3 * MiB;
constexpr size_t WS_XC = 5 * MiB;
constexpr size_t WS_LISTE = 13 * MiB;
constexpr size_t WS_LISTC = 18 * MiB;
constexpr size_t WS_VN = 25 * MiB;
constexpr size_t WS_WIN = 64 * MiB, WS_WOUT = 80 * MiB, WS_WGU = 88 * MiB, WS_WD = 216 * MiB;
constexpr size_t WS_H = 280 * MiB;
constexpr size_t WS_MIX = 412 * MiB;
constexpr size_t WS_PROJ = 544 * MiB;
constexpr size_t WS_END = 808 * MiB;
constexpr int CW_CNTE = 1024;
constexpr int CW_CNTC = 2048;

struct Tok { unsigned ids; float wlo, whi; unsigned pad; };

struct Ptrs {
    const float *x, *c, *ctx, *c_ctx, *w_mod, *b_mod, *norm1_g, *norm2_g, *w_in, *gmlp_g, *w_s, *b_s, *conv_w, *sink, *w_out, *router_w, *router_b, *w_gate, *w_up, *w_down, *final_g;
    float* out; unsigned char* ws;
};
__device__ __forceinline__ int modrow(int m) { return m < ML ? (m >> 13) : 8; }

#define LAS __attribute__((address_space(3)))
#define XB_TMO      128
#define XB_XCNT(j)  (256  + 64 * (j))
#define XB_XSUB(j)  (1280 + 64 * (j))
#define XB_XGEN(j)  (2304 + 64 * (j))
#define XB_TOP      3328
#define XB_TOPGEN   3392
#define XCD_BAR_WORDS 3456
#define XB_SPIN_CAP (1u << 18)

__device__ __forceinline__ unsigned xb_ld(unsigned* p)              { return __hip_atomic_load(p, __ATOMIC_RELAXED, __HIP_MEMORY_SCOPE_AGENT); }
__device__ __forceinline__ unsigned xb_add(unsigned* p, unsigned v) { return __hip_atomic_fetch_add(p, v, __ATOMIC_RELAXED, __HIP_MEMORY_SCOPE_AGENT); }
__device__ __forceinline__ unsigned xb_xcc_id() { return (unsigned)__builtin_amdgcn_s_getreg((3 << 11) | 20) & 0xFu; }
#define XB_SPIN(cond, bar) do { unsigned _sp = 0; while (cond) { __builtin_amdgcn_s_sleep(1); \
    if ((++_sp & 255u) == 0u) { if (xb_ld(&(bar)[XB_TMO])) break; if (_sp > XB_SPIN_CAP) { atomicAdd(&(bar)[XB_TMO], 1u); break; } } } } while (0)

__device__ __forceinline__ int wg_lane() { int l_; asm volatile("v_mbcnt_lo_u32_b32 %0, -1, 0\n\tv_mbcnt_hi_u32_b32 %0, -1, %0" : "=&v"(l_)); return l_; }
struct XcdBarrier {
    int wid;
    unsigned* bar; unsigned x;
    volatile LAS unsigned* st;
};

__device__ __forceinline__ XcdBarrier xcd_barrier_post(unsigned* bar, volatile LAS unsigned* st) {
    XcdBarrier b; b.bar = bar; b.x = xb_xcc_id(); b.st = st;
    if (threadIdx.x == 0) (void)xb_add(&bar[XB_XCNT(b.x)], 1u);
    return b;
}
__device__ __forceinline__ void xcd_barrier_complete(unsigned* bar, unsigned x, unsigned& nloc, unsigned& nx) {
    const unsigned G = gridDim.x * gridDim.y * gridDim.z;
    unsigned sum, cnt, mine, sp = 0u;
    for (;;) {
        sum = 0u; cnt = 0u; mine = 0u;
        unsigned c16[16];
#pragma unroll
        for (unsigned j = 0; j < 16; ++j) { const unsigned* ap_ = &bar[XB_XCNT(j)]; asm volatile("global_load_dword %0, %1, off sc1" : "=&v"(c16[j]) : "v"(ap_) : "memory"); }
        asm volatile("s_waitcnt vmcnt(0)" : "+v"(c16[0]), "+v"(c16[1]), "+v"(c16[2]), "+v"(c16[3]), "+v"(c16[4]), "+v"(c16[5]), "+v"(c16[6]), "+v"(c16[7]), "+v"(c16[8]), "+v"(c16[9]), "+v"(c16[10]), "+v"(c16[11]), "+v"(c16[12]), "+v"(c16[13]), "+v"(c16[14]), "+v"(c16[15]) :: "memory");
#pragma unroll
        for (unsigned j = 0; j < 16; ++j) { const unsigned c = c16[j]; sum += c; cnt += (c > 0u) ? 1u : 0u; mine = (j == x) ? c : mine; }
        if (sum == G) break;
        __builtin_amdgcn_s_sleep(1);
        if ((++sp & 255u) == 0u) { if (xb_ld(&bar[XB_TMO])) break; if (sp > XB_SPIN_CAP) { atomicAdd(&bar[XB_TMO], 1u); break; } }
    }
    nloc = mine > 0u ? mine : 1u; nx = cnt > 0u ? cnt : 1u;
}

__device__ __forceinline__ void xcd_barrier(const XcdBarrier& b) {
    asm volatile("s_waitcnt vmcnt(0)" ::: "memory");
    __syncthreads();
    int bw_ = b.wid; asm volatile("" : "+s"(bw_));
    if (bw_ == 0 && wg_lane() == 0) {
        unsigned* bar = b.bar;
        __builtin_amdgcn_s_waitcnt(0);
        unsigned nloc = b.st[0], nx = b.st[1];
        if (nloc == 0u) { xcd_barrier_complete(bar, b.x, nloc, nx); b.st[0] = nloc; b.st[1] = nx; }
        const unsigned old = xb_add(&bar[XB_XSUB(b.x)], 1u);
        const unsigned gen = old / nloc;
        if (old + 1u == (gen + 1u) * nloc) {
            __builtin_amdgcn_fence(__ATOMIC_RELEASE, "agent");
            asm volatile("s_waitcnt vmcnt(0)" ::: "memory");
            const unsigned og = xb_add(&bar[XB_TOP], 1u);
            const unsigned tg = og / nx;
            if (og + 1u == (tg + 1u) * nx) xb_add(&bar[XB_TOPGEN], 1u);
            else XB_SPIN(xb_ld(&bar[XB_TOPGEN]) == tg, bar);
            __builtin_amdgcn_fence(__ATOMIC_ACQUIRE, "agent");
            xb_add(&bar[XB_XGEN(b.x)], 1u);
            asm volatile("s_waitcnt vmcnt(0)" ::: "memory");
        } else {
            XB_SPIN(xb_ld(&bar[XB_XGEN(b.x)]) == gen, bar);
            __builtin_amdgcn_fence(__ATOMIC_ACQUIRE, "agent");
            asm volatile("s_waitcnt vmcnt(0)" ::: "memory");
        }
    }
    __syncthreads();
}
typedef short bf16x8 __attribute__((ext_vector_type(8)));
typedef int v4i32 __attribute__((ext_vector_type(4)));
typedef int v8i32 __attribute__((ext_vector_type(8)));
namespace pg {
constexpr int BM = 256, BK = 64, HALF = 128, HTB = HALF * BK * 2  , STAGE_BYTES = 8 * HTB, NXCD = 8, WGM = 8;
__host__ __device__ __forceinline__ int lds_byte(int r, int c) { return (r >> 3) * 1024 + (r & 7) * 128 + (((c >> 3) ^ (r & 7)) << 4); }
__host__ __device__ __forceinline__ void stage_rc(int b, int& R, int& C) { const int piece = b >> 10, p = (b & 1023) >> 4; R = piece * 8 + (p >> 3); C = ((p & 7) ^ (R & 7)) << 3; }

struct Unit { int pm, pn, x0, x1; };

__device__ __forceinline__ void order_unit(int L, int nM, int nN, int& pm, int& pn) {
    const int nwg = nM * nN; int wgid = L;
    { const int q = nwg / NXCD, r = nwg % NXCD, xcd = wgid % NXCD, off = wgid / NXCD; wgid = (xcd < r ? xcd * (q + 1) : r * (q + 1) + (xcd - r) * q) + off; }
    const int nig = WGM * nN, gid = wgid / nig, fm = gid * WGM, gsz = (nM - fm) < WGM ? (nM - fm) : WGM;
    pm = fm + ((wgid % nig) % gsz); pn = (wgid % nig) / gsz;
}

template <class Sched, class Epi>
__device__ __forceinline__ void gemm_phase(LAS unsigned char* lds, LAS unsigned* idxtab, const Sched& S, const Epi& E, int wid_s) {
    constexpr int ESZ = Sched::ESZ;
    constexpr int K = Sched::K, LDA = Sched::LDA, LDB = Sched::LDB, nt = K * ESZ / 128, KS = Sched::KSPLIT; constexpr bool GATHER = Sched::GATHER;
    int tid = wid_s * 64 + wg_lane(); asm volatile("" : "+v"(tid));
    const int wid = __builtin_amdgcn_readfirstlane(tid >> 6), lane = tid & 63, wr = wid >> 2, wc = wid & 3;
    constexpr size_t kstep = (size_t)(BK * 2);
    constexpr size_t hstepA = (size_t)HALF * LDA * ESZ, hstepB = (size_t)HALF * LDB * ESZ;
    const unsigned ldsw = (unsigned)wid * 1024u;
    const int aoff0 = lds_byte(wr * 64 + (lane & 15), (lane >> 4) * 8), boff0 = lds_byte(wc * 32 + (lane & 15), (lane >> 4) * 8);
    unsigned pvoA[2], pvoB[2];
#pragma unroll
    for (int i = 0; i < 2; ++i) { int R_, C_; stage_rc((wid * 64 + lane) * 16 + i * 8192, R_, C_); pvoA[i] = (unsigned)(R_ * LDA * ESZ + C_ * 2); pvoB[i] = (unsigned)(R_ * LDB * ESZ + C_ * 2); }
    unsigned cv[2][2];
#define PG_SA(b, h) (((b) * 2 + (h)) * HTB)
#define PG_SB(b, h) ((4 + (b) * 2 + (h)) * HTB)
#define PG_VOFF(ld, i, dst) do { int _t = wid * 64 + lane; asm volatile("" : "+v"(_t)); int _R, _C; stage_rc(_t * 16 + (i) * 8192, _R, _C); dst = (unsigned)(_R * (ld) * ESZ + _C * 2); } while (0)
#define PG_STAGE_B(bufoff, gbase) do { _Pragma("unroll") for (int _i = 0; _i < 2; ++_i) { unsigned _vo = pvoB[_i]; if constexpr (ESZ == 1) PG_VOFF(LDB, _i, _vo); \
        __builtin_amdgcn_global_load_lds((const unsigned*)((const char*)(gbase) + _vo), (LAS unsigned*)(lds + (bufoff) + ldsw + _i * 8192), 16, 0, 0); } } while (0)
#define PG_STAGE_A(bufoff, gbase, h, V) do { _Pragma("unroll") for (int _i = 0; _i < 2; ++_i) { unsigned _vo = pvoA[_i]; \
        const char* _p = GATHER ? (const char*)(gbase) + V[h][_i] : (const char*)(gbase) + ((h) ? hstepA : 0) + _vo; \
        __builtin_amdgcn_global_load_lds((const unsigned*)_p, (LAS unsigned*)(lds + (bufoff) + ldsw + _i * 8192), 16, 0, 0); } } while (0)
#define PG_LDA(dst, b, h) do { int _a1 = aoff0 ^ 64; asm volatile("" : "+v"(_a1)); _Pragma("unroll") for (int m = 0; m < 4; ++m) _Pragma("unroll") for (int k = 0; k < 2; ++k) dst[m][k] = *(const LAS bf16x8*)(lds + PG_SA(b, h) + (k ? _a1 : aoff0) + m * 2048); } while (0)
#define PG_LDB(dst, b, h) do { int _b1 = boff0 ^ 64; asm volatile("" : "+v"(_b1)); _Pragma("unroll") for (int n = 0; n < 2; ++n) _Pragma("unroll") for (int k = 0; k < 2; ++k) dst[n][k] = *(const LAS bf16x8*)(lds + PG_SB(b, h) + (k ? _b1 : boff0) + n * 2048); } while (0)
#define PG_MMA(ai, bj, At, Bt) do { __builtin_amdgcn_s_setprio(1); _Pragma("unroll") for (int m = 0; m < 4; ++m) _Pragma("unroll") for (int n = 0; n < 2; ++n) { \
        if constexpr (ESZ == 2) { _Pragma("unroll") for (int k = 0; k < 2; ++k) acc[ai][bj][m][n] = __builtin_amdgcn_mfma_f32_16x16x32_bf16(Bt[n][k], At[m][k], acc[ai][bj][m][n], 0, 0, 0); } \
        else {   \
            const v8i32 bw = __builtin_shufflevector(__builtin_bit_cast(v4i32, Bt[n][0]), __builtin_bit_cast(v4i32, Bt[n][1]), 0, 1, 2, 3, 4, 5, 6, 7); \
            const v8i32 aw = __builtin_shufflevector(__builtin_bit_cast(v4i32, At[m][0]), __builtin_bit_cast(v4i32, At[m][1]), 0, 1, 2, 3, 4, 5, 6, 7); \
            acc[ai][bj][m][n] = __builtin_amdgcn_mfma_scale_f32_16x16x128_f8f6f4(bw, aw, acc[ai][bj][m][n], 0, 0, 0, Sched::SCALE_B, 0, Sched::SCALE_A); } } \
        __builtin_amdgcn_s_setprio(0); } while (0)
#define PG_WAIT_V(n) asm volatile("s_waitcnt vmcnt(" #n ")" ::: "memory")
#define PG_WAIT_L(n) asm volatile("s_waitcnt lgkmcnt(" #n ")" ::: "memory")
#define PG_BAR __builtin_amdgcn_s_barrier()
#define PG_SCHED __builtin_amdgcn_sched_barrier(0)
#define PG_IDX_ISSUE(u) do { int _l = lane; asm volatile("" : "+v"(_l)); const int _h = (_l >> 4) & 1, _i = (_l >> 3) & 1, _r = _l & 7; const unsigned _po = (unsigned)(_h * 128 + (wid + 8 * _i) * 8 + _r) * 16u; \
        __builtin_amdgcn_global_load_lds((const unsigned*)((const char*)S.idx_src(u) + _po), (LAS unsigned*)(idxtab + wid * 64), 4, 0, 0); } while (0)
#define PG_IDX_READ(u, V) do { const int _vr = S.valid_rows(u); _Pragma("unroll") for (int _h = 0; _h < 2; ++_h) _Pragma("unroll") for (int _i = 0; _i < 2; ++_i) { \
        const int _pos = _h * 128 + (wid + 8 * _i) * 8 + (lane >> 3); unsigned _tk = *(volatile LAS unsigned*)(idxtab + wid * 64 + _h * 16 + _i * 8 + (lane >> 3)); \
        _tk = _pos < _vr ? _tk : 0u; V[_h][_i] = _tk * (unsigned)(LDA * ESZ) + (unsigned)(((lane & 7) ^ ((lane >> 3) & 7)) << 4); } } while (0)
    Unit cur, nxt; int ui = 0;
    if (!S.next(0, cur)) return;
    f32x4 acc[2][2][4][2];
#pragma unroll
    for (int a = 0; a < 2; ++a)
#pragma unroll
        for (int b = 0; b < 2; ++b)
#pragma unroll
            for (int m = 0; m < 4; ++m)
#pragma unroll
                for (int n = 0; n < 2; ++n) acc[a][b][m][n] = (f32x4){0.f, 0.f, 0.f, 0.f};
    bf16x8 At[4][2], B0[2][2], B1[2][2];
    const char* cA = S.a_base(cur); const char* cB0 = S.b_base(cur, 0); const char* cB1 = S.b_base(cur, 1);
#pragma unroll
    for (int h = 0; h < 2; ++h)
#pragma unroll
        for (int i = 0; i < 2; ++i) cv[h][i] = 0u;
    if constexpr (GATHER) { PG_IDX_ISSUE(cur); PG_WAIT_V(0); PG_IDX_READ(cur, cv); }
    PG_STAGE_B(PG_SB(0, 0), cB0); PG_STAGE_B(PG_SB(0, 1), cB0 + hstepB); PG_STAGE_A(PG_SA(0, 0), cA, 0, cv); PG_STAGE_A(PG_SA(0, 1), cA, 1, cv);
    if (wr == 1) PG_BAR;
    PG_WAIT_V(2); PG_BAR;
    PG_STAGE_B(PG_SB(1, 0), cB0 + kstep); PG_STAGE_A(PG_SA(1, 0), cA + kstep, 0, cv); PG_STAGE_B(PG_SB(1, 1), cB0 + hstepB + kstep);
    PG_WAIT_V(6); PG_BAR;
    for (;;) {
        const bool has_next = S.next(ui + 1, nxt);
        const char* nA = has_next ? S.a_base(nxt) : cA; const char* nB0 = has_next ? S.b_base(nxt, 0) : cB0; const char* nB1 = has_next ? S.b_base(nxt, 1) : cB1;
        if constexpr (GATHER) { if (has_next) PG_IDX_ISSUE(nxt); }
#pragma nounroll
        for (int t = 0; t < nt; t += 2) {
            const bool last = (t == nt - 2);
            const char* a1 = cA + (size_t)(t + 1) * kstep;
            const char* a2 = last ? nA : cA + (size_t)(t + 2) * kstep; const char* a3 = a2 + kstep;
            const char* b2 = last ? nB0 : ((t + 2) < KS ? cB0 : cB1) + (size_t)(t + 2) * kstep;
            const char* b3 = last ? nB0 + kstep : ((t + 3) < KS ? cB0 : cB1) + (size_t)(t + 3) * kstep;
            PG_LDB(B0, 0, 0); PG_LDB(B1, 0, 1); PG_SCHED; PG_LDA(At, 0, 0); PG_STAGE_A(PG_SA(1, 1), a1, 1, cv);
            if constexpr (GATHER) { if (last && has_next) { PG_IDX_READ(nxt, cv); } }
            PG_WAIT_V(8); PG_WAIT_L(0); PG_BAR; PG_MMA(0, 0, At, B0); PG_MMA(0, 1, At, B1); PG_BAR; PG_SCHED;
            PG_LDA(At, 0, 1); PG_STAGE_B(PG_SB(0, 0), b2); PG_STAGE_B(PG_SB(0, 1), b2 + hstepB); PG_STAGE_A(PG_SA(0, 0), a2, 0, cv);
            PG_WAIT_V(8); PG_WAIT_L(0); PG_BAR; PG_MMA(1, 0, At, B0); PG_MMA(1, 1, At, B1); PG_BAR; PG_SCHED;
            PG_LDB(B0, 1, 0); PG_LDB(B1, 1, 1); PG_SCHED; PG_LDA(At, 1, 0); PG_STAGE_A(PG_SA(0, 1), a2, 1, cv);
            PG_WAIT_V(8); PG_WAIT_L(0); PG_BAR; PG_MMA(0, 0, At, B0); PG_MMA(0, 1, At, B1); PG_BAR; PG_SCHED;
            PG_LDA(At, 1, 1); PG_STAGE_B(PG_SB(1, 0), b3); PG_STAGE_B(PG_SB(1, 1), b3 + hstepB); PG_STAGE_A(PG_SA(1, 0), a3, 0, cv);
            PG_WAIT_V(8); PG_WAIT_L(0); PG_BAR; PG_MMA(1, 0, At, B0); PG_MMA(1, 1, At, B1); PG_BAR; PG_SCHED;
        }
        if (wr == 0) PG_BAR;
        { int _l = lane; asm volatile("" : "+v"(_l)); E(acc, cur, wr, wc, _l & 15, _l >> 4); }
        if (!has_next) break;
#pragma unroll
        for (int a = 0; a < 2; ++a)
#pragma unroll
            for (int b = 0; b < 2; ++b)
#pragma unroll
                for (int m = 0; m < 4; ++m)
#pragma unroll
                    for (int n = 0; n < 2; ++n) acc[a][b][m][n] = (f32x4){0.f, 0.f, 0.f, 0.f};
        cur = nxt; cA = nA; cB0 = nB0; cB1 = nB1; ++ui;
        if (wr == 1) PG_BAR;
    }
    PG_WAIT_V(0);
    PG_BAR;
#undef PG_SA
#undef PG_SB
#undef PG_STAGE_A
#undef PG_STAGE_B
#undef PG_VOFF
#undef PG_LDA
#undef PG_LDB
#undef PG_MMA
#undef PG_WAIT_V
#undef PG_WAIT_L
#undef PG_BAR
#undef PG_SCHED
#undef PG_IDX_ISSUE
#undef PG_IDX_READ
}
}
constexpr int NWAVES = 8, NTHR = 512;
constexpr int RING_OFF = 0, RING_BYTES = 131072;
constexpr int IDX_OFF = RING_BYTES;
constexpr int TST_OFF = IDX_OFF + 2048;
constexpr int MISC_OFF = TST_OFF + 128;
constexpr int ROPEL_OFF = MISC_OFF + 512;
constexpr int LDS_BYTES = 147456;
constexpr size_t WS_MODP = WS_VN;
constexpr size_t WS_WSB = 62 * MiB;
constexpr int CW_CNTF = 16384;
constexpr int CW_XR = 12288;
constexpr int CW_MXQ = 13312;
constexpr int CW_BAR = 8192;
constexpr int MAXT = 288;

struct ClsRec { int m; float wlo, whi; int pad; };
constexpr size_t WS_LISTR = 816 * MiB;
constexpr size_t WS_XB = 848 * MiB;
constexpr size_t WS_POS = WS_TOK;
constexpr size_t WS_END2 = 980 * MiB;

__device__ __forceinline__ void cls_experts(int cls, int& elo, int& ehi) {
    const int g = cls / 6, p = cls % 6; const int a = p < 3 ? 0 : (p < 5 ? 1 : 2), b = p < 3 ? p + 1 : (p < 5 ? p - 1 : 3);
    elo = g * 4 + a; ehi = g * 4 + b;
}
#ifndef G1_FP8
#define G1_FP8 1
#endif
constexpr int F8_SH_H = 4, F8_SH_A = 3, F8_SH_W = 5, F8_SH_M = 2;
#define SC_E8(sh) ((127 - (sh)) * 0x01010101)
__device__ __forceinline__ unsigned pk4_fp8(float a, float b, float c, float d, float scale) {
    const float lim = 448.0f; a = fminf(fmaxf(a * scale, -lim), lim); b = fminf(fmaxf(b * scale, -lim), lim); c = fminf(fmaxf(c * scale, -lim), lim); d = fminf(fmaxf(d * scale, -lim), lim);
    int w = __builtin_amdgcn_cvt_pk_fp8_f32(a, b, 0, false); w = __builtin_amdgcn_cvt_pk_fp8_f32(c, d, w, true); return (unsigned)w; }
__device__ __forceinline__ unsigned cvt_pk_bf16(float lo, float hi) { unsigned r; asm volatile("v_cvt_pk_bf16_f32 %0, %1, %2" : "=v"(r) : "v"(lo), "v"(hi)); return r; }

template <int N_, int ESZ_, int SHA_ = 0> struct SchedDense {
    static constexpr int K = 1024, LDA = 1024, LDB = 1024, KSPLIT = K * ESZ_ / 128, ESZ = ESZ_, SCALE_A = ESZ_ == 1 ? SC_E8(SHA_) : 0, SCALE_B = ESZ_ == 1 ? SC_E8(F8_SH_W) : 0; static constexpr bool GATHER = false;
    const void* A; const void* Bt; int nM, G, c;
    __device__ __forceinline__ bool next(int i, pg::Unit& u) const { const long L = (long)i * G + c; if (L >= (long)nM * (N_ / 256)) return false; pg::order_unit((int)L, nM, N_ / 256, u.pm, u.pn); u.x0 = 0; u.x1 = 0;
        return true; }
    __device__ __forceinline__ const char* a_base(const pg::Unit& u) const { return (const char*)A + (size_t)u.pm * 256 * LDA * ESZ; }
    __device__ __forceinline__ const char* b_base(const pg::Unit& u, int) const { return (const char*)Bt + (size_t)u.pn * 256 * LDB * ESZ; }
    __device__ __forceinline__ const unsigned* idx_src(const pg::Unit&) const { return nullptr; }
    __device__ __forceinline__ int valid_rows(const pg::Unit&) const { return 256; }
};
__device__ __forceinline__ void cls_of_tile(const LAS int* tst, int T, int& cls, int& rt) {
    int c = 0;
#pragma unroll
    for (int k = 1; k < NCLS; ++k) c += (T >= tst[k]) ? 1 : 0;
    cls = __builtin_amdgcn_readfirstlane(c); rt = __builtin_amdgcn_readfirstlane(T - tst[c]);
}
struct SchedGU {
    static constexpr int K = 1024, LDA = 1024, LDB = 1024, KSPLIT = 8, ESZ = 1, SCALE_A = SC_E8(F8_SH_H), SCALE_B = SC_E8(F8_SH_W); static constexpr bool GATHER = true;
    const unsigned char* H; const unsigned char* Wgu; const ClsRec* list; const LAS int* tst; const unsigned* cnt; int G, c;
    __device__ __forceinline__ bool next(int i, pg::Unit& u) const { const int TT = __builtin_amdgcn_readfirstlane(tst[NCLS]); const long L = (long)i * G + c; if (L >= (long)TT * 8) return false;
        pg::order_unit((int)L, TT, 8, u.pm, u.pn); cls_of_tile(tst, u.pm, u.x0, u.x1); return true; }
    __device__ __forceinline__ const char* a_base(const pg::Unit&) const { return (const char*)H; }
    __device__ __forceinline__ const char* b_base(const pg::Unit& u, int) const { int elo, ehi; cls_experts(u.x0, elo, ehi); const int e = u.pn < 4 ? elo : ehi;
        return (const char*)Wgu + ((size_t)e * 1024 + (size_t)(u.pn & 3) * 256) * LDB; }
    __device__ __forceinline__ const unsigned* idx_src(const pg::Unit& u) const { return (const unsigned*)(list + (size_t)u.x0 * MT + (size_t)u.x1 * 256); }
    __device__ __forceinline__ int valid_rows(const pg::Unit& u) const { return (int)cnt[u.x0 * 64] - u.x1 * 256; }
};
struct SchedDown {
    static constexpr int K = 1024, LDA = 1024, LDB = 512, KSPLIT = 4, ESZ = 1, SCALE_A = SC_E8(F8_SH_A), SCALE_B = SC_E8(F8_SH_W); static constexpr bool GATHER = false;
    const unsigned char* ACT; const unsigned char* Wd; const LAS int* tst; int G, c;
    __device__ __forceinline__ bool next(int i, pg::Unit& u) const { const int TT = __builtin_amdgcn_readfirstlane(tst[NCLS]); const long L = (long)i * G + c; if (L >= (long)TT * 4) return false;
        pg::order_unit((int)L, TT, 4, u.pm, u.pn); cls_of_tile(tst, u.pm, u.x0, u.x1); return true; }
    __device__ __forceinline__ const char* a_base(const pg::Unit& u) const { return (const char*)ACT + (size_t)u.pm * 256 * LDA; }
    __device__ __forceinline__ const char* b_base(const pg::Unit& u, int part) const { int elo, ehi; cls_experts(u.x0, elo, ehi); const int e = part ? ehi : elo;
        return (const char*)Wd + ((size_t)e * 1024 + (size_t)u.pn * 256) * LDB - (part ? (size_t)KSPLIT * 128 : 0); }
    __device__ __forceinline__ const unsigned* idx_src(const pg::Unit&) const { return nullptr; }
    __device__ __forceinline__ int valid_rows(const pg::Unit&) const { return 256; }
};

#define OPAQUE(x) asm volatile("" : "+v"(x))
#define ROWSTEP(m) ((m) == 3 ? 80 : 16)
__device__ __forceinline__ void bf8_to_f32(const u32x4 v, float (&o)[8]) {
#pragma unroll
    for (int i = 0; i < 4; ++i) { o[2 * i] = __uint_as_float(v[i] << 16); o[2 * i + 1] = __uint_as_float(v[i] & 0xffff0000u); }
}
struct EpiProj {
    bf16_t* O; const LAS _Float16* tab;
    __device__ __forceinline__ void operator()(const f32x4 (&acc)[2][2][4][2], const pg::Unit& u, int wr, int wc, int fr, int fq) const {
        const bool latent = u.pm < ML / 256;
        char* base = (char*)(O + (size_t)u.pm * 256 * INC + u.pn * 256);
        unsigned off = (unsigned)((wr * 64 + fr) * INC + wc * 32 + 8 * fq) * 2u; OPAQUE(off);
        int t = ((u.pm * 256) & (SEQ - 1)) + wr * 64 + fr; OPAQUE(t);
        const bool second = (fq >> 1) != 0;
#pragma unroll
        for (int ai = 0; ai < 2; ++ai)
#pragma unroll
            for (int m = 0; m < 4; ++m) { char* rowp = base + off;
                const int pos = (wc & 1) ? (t & 63) : (t >> 6);
#pragma unroll
                for (int bj = 0; bj < 2; ++bj) { f32x4 v0 = acc[ai][bj][m][0], v1 = acc[ai][bj][m][1];
                    const bool rope = latent && (u.pn == 5 || u.pn == 6 || (u.pn == 7 && bj == 0));
                    if (rope) { const LAS _Float16* tp = tab + pos * 16 + 8 * (fq & 1);
                        typedef _Float16 h8 __attribute__((ext_vector_type(8)));
                        const h8 ch = *(const LAS h8*)tp, sh = *(const LAS h8*)(tp + 2048);
                        const f32x4 cs0 = (f32x4){(float)ch[0], (float)ch[1], (float)ch[2], (float)ch[3]}, cs1 = (f32x4){(float)ch[4], (float)ch[5], (float)ch[6], (float)ch[7]};
                        const f32x4 sn0 = (f32x4){(float)sh[0], (float)sh[1], (float)sh[2], (float)sh[3]}, sn1 = (f32x4){(float)sh[4], (float)sh[5], (float)sh[6], (float)sh[7]};
                        f32x4 p0, p1;
#pragma unroll
                        for (int i = 0; i < 4; ++i) { auto r0 = __builtin_amdgcn_permlane32_swap(__float_as_uint(v0[i]), __float_as_uint(v0[i]), false, false); p0[i] = __uint_as_float(second ? r0[0] : r0[1]);
                                                      auto r1 = __builtin_amdgcn_permlane32_swap(__float_as_uint(v1[i]), __float_as_uint(v1[i]), false, false); p1[i] = __uint_as_float(second ? r1[0] : r1[1]); }
                        if (second) { v0 = v0 * cs0 + p0 * sn0; v1 = v1 * cs1 + p1 * sn1; } else { v0 = v0 * cs0 - p0 * sn0; v1 = v1 * cs1 - p1 * sn1; } }
                    u32x4 w; w.x = cvt_pk_bf16(v0[0], v0[1]); w.y = cvt_pk_bf16(v0[2], v0[3]); w.z = cvt_pk_bf16(v1[0], v1[1]); w.w = cvt_pk_bf16(v1[2], v1[3]);
                    *(u32x4*)(rowp + bj * 256) = w; }
                off += (unsigned)(ROWSTEP(m) * INC * 2); t += ROWSTEP(m); OPAQUE(off); OPAQUE(t); }
    }
};
struct EpiPlain {
    bf16_t* O; int ldo;
    __device__ __forceinline__ void operator()(const f32x4 (&acc)[2][2][4][2], const pg::Unit& u, int wr, int wc, int fr, int fq) const {
        char* base = (char*)(O + (size_t)u.pm * 256 * ldo + u.pn * 256);
        unsigned off = (unsigned)((wr * 64 + fr) * ldo + wc * 32 + 8 * fq) * 2u; OPAQUE(off);
#pragma unroll
        for (int ai = 0; ai < 2; ++ai)
#pragma unroll
            for (int m = 0; m < 4; ++m) {
#pragma unroll
                for (int bj = 0; bj < 2; ++bj) { const f32x4 v0 = acc[ai][bj][m][0], v1 = acc[ai][bj][m][1];
                    u32x4 w; w.x = cvt_pk_bf16(v0[0], v0[1]); w.y = cvt_pk_bf16(v0[2], v0[3]); w.z = cvt_pk_bf16(v1[0], v1[1]); w.w = cvt_pk_bf16(v1[2], v1[3]);
                    *(u32x4*)(base + off + bj * 256) = w; }
                off += (unsigned)(ROWSTEP(m) * ldo * 2); OPAQUE(off); }
    }
};
struct EpiResid {
    bf16_t* XB; const float* gate;
    __device__ __forceinline__ void operator()(const f32x4 (&acc)[2][2][4][2], const pg::Unit& u, int wr, int wc, int fr, int fq) const {
        const int mb = u.pm < ML / 256 ? (u.pm * 256) >> 13 : 8;
        const float* gp = gate + (size_t)mb * 6144 + u.pn * 256 + wc * 32 + 8 * fq;
        f32x4 g[2][2];
#pragma unroll
        for (int bj = 0; bj < 2; ++bj) { g[bj][0] = *(const f32x4*)(gp + 128 * bj); g[bj][1] = *(const f32x4*)(gp + 128 * bj + 4); }
        char* base = (char*)(XB + (size_t)u.pm * 256 * D + u.pn * 256);
        unsigned off = (unsigned)((wr * 64 + fr) * D + wc * 32 + 8 * fq) * 2u; OPAQUE(off);
#pragma unroll
        for (int ai = 0; ai < 2; ++ai) {
            u32x4 xr[4][2]; unsigned lo = off;
#pragma unroll
            for (int m = 0; m < 4; ++m) {
#pragma unroll
                for (int bj = 0; bj < 2; ++bj) { const char* ap = base + lo + bj * 256; asm volatile("global_load_dwordx4 %0, %1, off" : "=&v"(xr[m][bj]) : "v"(ap) : "memory"); }
                lo += (unsigned)(16 * D * 2); }
            asm volatile("s_waitcnt vmcnt(0)" : "+v"(xr[0][0]), "+v"(xr[0][1]), "+v"(xr[1][0]), "+v"(xr[1][1]), "+v"(xr[2][0]), "+v"(xr[2][1]), "+v"(xr[3][0]), "+v"(xr[3][1]) :: "memory");
#pragma unroll
            for (int m = 0; m < 4; ++m) {
#pragma unroll
                for (int bj = 0; bj < 2; ++bj) { const f32x4 v0 = acc[ai][bj][m][0], v1 = acc[ai][bj][m][1]; float xf[8]; bf8_to_f32(xr[m][bj], xf);
                    u32x4 w; w.x = cvt_pk_bf16(xf[0] + g[bj][0][0] * v0[0], xf[1] + g[bj][0][1] * v0[1]); w.y = cvt_pk_bf16(xf[2] + g[bj][0][2] * v0[2], xf[3] + g[bj][0][3] * v0[3]);
                    w.z = cvt_pk_bf16(xf[4] + g[bj][1][0] * v1[0], xf[5] + g[bj][1][1] * v1[1]); w.w = cvt_pk_bf16(xf[6] + g[bj][1][2] * v1[2], xf[7] + g[bj][1][3] * v1[3]);
                    *(u32x4*)(base + off + bj * 256) = w; }
                off += (unsigned)(ROWSTEP(m) * D * 2); OPAQUE(off); } }
    }
};
struct EpiGU {
    unsigned char* ACT; const ClsRec* list; const unsigned* cnt;
    __device__ __forceinline__ void operator()(const f32x4 (&acc)[2][2][4][2], const pg::Unit& u, int wr, int wc, int fr, int fq) const {
        const int vr = (int)cnt[u.x0 * 64] - u.x1 * 256; const char* rec = (const char*)(list + (size_t)u.x0 * MT + (size_t)u.x1 * 256) + (u.pn >= 4 ? 8 : 4);
        unsigned char* base = ACT + (size_t)u.pm * 256 * 1024 + (u.pn >> 2) * 512 + (u.pn & 3) * 128;
        int r = wr * 64 + fr; OPAQUE(r); unsigned off = (unsigned)(r * 1024 + wc * 32 + 8 * fq); OPAQUE(off);
        float wv[8];
        {
#pragma unroll
          for (int q = 0; q < 8; ++q) { const int rq = r + 16 * (q & 3) + 128 * (q >> 2); const char* ap = rec + (size_t)rq * 16;
              asm volatile("global_load_dword %0, %1, off" : "=&v"(wv[q]) : "v"(ap) : "memory"); }
          asm volatile("s_waitcnt vmcnt(0)" : "+v"(wv[0]), "+v"(wv[1]), "+v"(wv[2]), "+v"(wv[3]), "+v"(wv[4]), "+v"(wv[5]), "+v"(wv[6]), "+v"(wv[7]) :: "memory"); }
#pragma unroll
        for (int ai = 0; ai < 2; ++ai)
#pragma unroll
            for (int m = 0; m < 4; ++m) { float w = r < vr ? wv[ai * 4 + m] : 0.f;
                w *= (float)(1 << F8_SH_A);
                u32x2 pk;
#pragma unroll
                for (int bj = 0; bj < 2; ++bj) { const f32x4 g = acc[ai][bj][m][0], up = acc[ai][bj][m][1]; float o[4];
                    typedef float f32x2e __attribute__((ext_vector_type(2)));
#pragma unroll
                    for (int i = 0; i < 4; i += 2) { const f32x2e g2 = (f32x2e){g[i], g[i + 1]}, u2 = (f32x2e){up[i], up[i + 1]}; const f32x2e t = g2 * (-LOG2E);
                        f32x2e d = (f32x2e){__builtin_amdgcn_exp2f(t.x), __builtin_amdgcn_exp2f(t.y)} + 1.0f; d = (f32x2e){__builtin_amdgcn_rcpf(d.x), __builtin_amdgcn_rcpf(d.y)};
                        const f32x2e q2 = g2 * d * u2; o[i] = q2.x; o[i + 1] = q2.y; }
                    const unsigned v = pk4_fp8(o[0], o[1], o[2], o[3], w); if (bj == 0) pk.x = v; else pk.y = v; }
                *(u32x2*)(base + off) = pk;
                off += (unsigned)(ROWSTEP(m) * 1024); r += ROWSTEP(m); OPAQUE(off); OPAQUE(r); }
    }
};

typedef const __attribute__((address_space(1))) float* gfptr;
template <bool F8 = false, typename WP = const float*> __device__ __forceinline__ void p0_transpose_item(WP W, int Kd, int N, void* WTv, LAS float* scr, int item, int lane, int mode, int sc_lo, int sc_hi, float scale) {
    bf16_t* WT = (bf16_t*)WTv;
    const int nblk = N / 32, kb = item / nblk, nb = item % nblk, k0 = 64 * kb, n0 = 32 * nb;
    f32x4 rv[8];
#pragma unroll
    for (int i = 0; i < 8; ++i) rv[i] = *(const __attribute__((address_space(1))) f32x4*)((gfptr)W + (size_t)(k0 + 8 * i + (lane >> 3)) * N + n0 + 4 * (lane & 7));
#pragma unroll
    for (int i = 0; i < 8; ++i) { LAS float* d = scr + (8 * i + (lane >> 3)) * 33 + 4 * (lane & 7); d[0] = rv[i].x; d[1] = rv[i].y; d[2] = rv[i].z; d[3] = rv[i].w; }
    asm volatile("s_waitcnt lgkmcnt(0)" ::: "memory");
    const int c = lane & 7;
#pragma unroll
    for (int j = 0; j < 4; ++j) { const int n = (lane >> 3) + 8 * j, ng = n0 + n; const LAS float* s = scr + (8 * c) * 33 + n;
        const float f = (ng >= sc_lo && ng < sc_hi) ? scale : 1.0f;
        const int row = mode == 0 ? ng : mode == 3 ? ((ng & ~31) + 16 * ((ng >> 2) & 1) + 4 * ((ng >> 3) & 3) + (ng & 3))
                      : (256 * (ng >> 7) + 128 * ((ng >> 2) & 1) + 32 * ((ng >> 5) & 3) + 16 * (mode == 2 ? 1 : 0) + 4 * ((ng >> 3) & 3) + (ng & 3));
        if constexpr (F8) { u32x2 o; o.x = pk4_fp8(s[0 * 33], s[1 * 33], s[2 * 33], s[3 * 33], f * (float)(1 << F8_SH_W)); o.y = pk4_fp8(s[4 * 33], s[5 * 33], s[6 * 33], s[7 * 33], f * (float)(1 << F8_SH_W));
            *(u32x2*)((unsigned char*)WTv + (size_t)row * Kd + k0 + 8 * c) = o; }
        else { u32x4 o; o.x = pk2(s[0 * 33] * f, s[1 * 33] * f); o.y = pk2(s[2 * 33] * f, s[3 * 33] * f); o.z = pk2(s[4 * 33] * f, s[5 * 33] * f); o.w = pk2(s[6 * 33] * f, s[7 * 33] * f);
            *(u32x4*)(WT + (size_t)row * Kd + k0 + 8 * c) = o; } }
    asm volatile("s_waitcnt lgkmcnt(0)" ::: "memory");
}
constexpr int CONV_PER_L = 1024 + 512 + NE * 768;
__device__ __forceinline__ void convert_item(gfptr w_in, gfptr w_out, gfptr w_gate, gfptr w_up, gfptr w_down, unsigned char* ws, LAS float* scr, int l, int r, int lane) {
    static_assert(G1_FP8 == 1, "w_in is converted to e4m3 only");
    if (r < 1024) { p0_transpose_item<true>(w_in + (size_t)l * D * INC, D, INC, ws + WS_WIN + (size_t)l * INC * D, scr, r, lane, 3, C_Q, C_K, QSCALE); return; } r -= 1024;
    if (r < 512) { p0_transpose_item<true>(w_out + (size_t)l * D * D, D, D, ws + WS_WOUT + (size_t)l * D * D, scr, r, lane, 3, 0, 0, 1.f); return; } r -= 512;
    const int e = r / 768, q = r % 768, which = q >> 8, idx = q & 255; const size_t le = (size_t)l * NE + e;
    if (which == 0) p0_transpose_item<true>(w_gate + le * D * DE, D, DE, ws + WS_WGU + le * 1024 * 1024, scr, idx, lane, 1, 0, 0, 1.f);
    else if (which == 1) p0_transpose_item<true>(w_up + le * D * DE, D, DE, ws + WS_WGU + le * 1024 * 1024, scr, idx, lane, 2, 0, 0, 1.f);
    else p0_transpose_item<true>(w_down + le * DE * D, DE, D, ws + WS_WD + le * 1024 * 512, scr, idx, lane, 3, 0, 0, 1.f);
}
__device__ __forceinline__ void phase_p0a(const Ptrs& P, LAS unsigned char* lds) {
    int tid = threadIdx.x; asm volatile("" : "+v"(tid)); const int lane = tid & 63, wave = __builtin_amdgcn_readfirstlane(tid >> 6);
    const int gw = blockIdx.x * NWAVES + wave, NGW = gridDim.x * NWAVES;
    LAS float* sil = (LAS float*)(lds + 73728);
    { float cv_[9 * D / NTHR];
      static_assert(NTHR == 512 && D == 1024, "element e of thread tid: i = tid + 512 e, row e >> 1");
#pragma unroll
      for (int e = 0; e < 9 * D / NTHR; ++e) { const int k = tid + NTHR * (e & 1); cv_[e] = (e >> 1) < 8 ? P.c[(e >> 1) * D + k] : P.c_ctx[k]; }
#pragma unroll
      for (int e = 0; e < 9 * D / NTHR; ++e) sil[tid + NTHR * e] = silu_f(cv_[e]); }
    __syncthreads();
    float* modp = (float*)(P.ws + WS_MODP);
    for (int u = gw; u < DEPTH * 24 * 16; u += NGW) { const int l = u / 384, r = u % 384, nc = r / 16, ks = r % 16;
        const float* w = P.w_mod + ((size_t)l * D + ks * 64) * 6144 + nc * 256 + 4 * lane;
        f32x4 a[9];
#pragma unroll
        for (int j = 0; j < 9; ++j) a[j] = (f32x4){0.f, 0.f, 0.f, 0.f};
        for (int k0 = 0; k0 < 64; k0 += 8) { f32x4 wv[8];
            const unsigned vo = 16u * (unsigned)lane; const float* wb = P.w_mod + ((size_t)l * D + ks * 64 + k0) * 6144 + nc * 256;
#pragma unroll
            for (int k = 0; k < 8; ++k) asm volatile("global_load_dwordx4 %0, %1, %2" : "=&v"(wv[k]) : "v"(vo), "s"(wb + (size_t)k * 6144) : "memory");
            asm volatile("s_waitcnt vmcnt(0)" : "+v"(wv[0]), "+v"(wv[1]), "+v"(wv[2]), "+v"(wv[3]), "+v"(wv[4]), "+v"(wv[5]), "+v"(wv[6]), "+v"(wv[7]) :: "memory");
#pragma unroll
            for (int k = 0; k < 8; ++k)
#pragma unroll
                for (int j = 0; j < 9; ++j) a[j] += wv[k] * sil[j * D + ks * 64 + k0 + k]; }
#pragma unroll
        for (int j = 0; j < 9; ++j) *(f32x4*)(modp + (((size_t)l * 16 + ks) * 9 + j) * 6144 + nc * 256 + 4 * lane) = a[j]; }
    { const int gt = blockIdx.x * NTHR + tid, NGT = gridDim.x * NTHR; float* tab = (float*)(P.ws + WS_ROPE);
      if (gt < 2048) { const int i = gt & 15, pos = gt >> 4; const float inv = powf(10000.0f, -(float)i / 16.0f), ang = (float)pos * inv; tab[gt] = cosf(ang); tab[2048 + gt] = sinf(ang); }
      bf16_t* wsb = (bf16_t*)(P.ws + WS_WSB);
      for (int i = gt; i < DEPTH * 4 * 128 * 128; i += NGT) wsb[i] = f2bf(P.w_s[i]); }
    { float* par = (float*)(P.ws + WS_PAR);
      for (int i = blockIdx.x * NTHR + tid; i < PAR_END; i += (int)gridDim.x * NTHR) { float v = 0.f;
          if (i < PAR_N1) v = P.router_w[i]; else if (i < PAR_N2) v = P.norm1_g[i - PAR_N1]; else if (i < PAR_FG) v = P.norm2_g[i - PAR_N2]; else if (i < PAR_RB) v = P.final_g[i - PAR_FG];
          else if (i < PAR_BS) { if (i - PAR_RB < NE) v = P.router_b[i - PAR_RB]; } else if (i < PAR_GG) v = P.b_s[i - PAR_BS]; else if (i < PAR_SINK) v = P.gmlp_g[i - PAR_GG];
          else if (i < PAR_CW) { if (i - PAR_SINK < DEPTH * 8) v = P.sink[i - PAR_SINK]; } else v = P.conv_w[i - PAR_CW];
          par[i] = v; } }
    if (blockIdx.x == 0 && tid == 0) { unsigned long long* pt = (unsigned long long*)(P.ws + WS_PTAB);
        pt[0] = (unsigned long long)P.w_in; pt[1] = (unsigned long long)P.w_out; pt[2] = (unsigned long long)P.w_gate; pt[3] = (unsigned long long)P.w_up; pt[4] = (unsigned long long)P.w_down; }
    LAS float* scr = (LAS float*)(lds + wave * 8448);
    for (int it = gw; it < CONV_PER_L; it += NGW) convert_item((gfptr)P.w_in, (gfptr)P.w_out, (gfptr)P.w_gate, (gfptr)P.w_up, (gfptr)P.w_down, P.ws, scr, 0, it, lane);
}
__device__ __forceinline__ void convert_tail(unsigned char* ws, LAS unsigned char* lds, int l, int part, int j, int nidle, int wid_s) {
    int tid = wid_s * 64 + wg_lane(); asm volatile("" : "+v"(tid));
    __syncthreads();
    const int lane = tid & 63; LAS float* scr = (LAS float*)(lds + wid_s * 8448);
    const unsigned long long* pt = (const unsigned long long*)(ws + WS_PTAB);
    const gfptr w_in = (gfptr)pt[0], w_out = (gfptr)pt[1], w_gate = (gfptr)pt[2], w_up = (gfptr)pt[3], w_down = (gfptr)pt[4];
    constexpr int QTR = CONV_PER_L / 4;
    for (int it = part * QTR + j * NWAVES + wid_s; it < (part + 1) * QTR; it += nidle * NWAVES) convert_item(w_in, w_out, w_gate, w_up, w_down, ws, scr, l, it, lane);
    __syncthreads();
}
__device__ __forceinline__ void phase_p0b(const Ptrs& P) {
    const int gt = blockIdx.x * NTHR + threadIdx.x, NGT = gridDim.x * NTHR;
    const float* modp = (const float*)(P.ws + WS_MODP); float* mod = (float*)(P.ws + WS_MOD);
    for (int i = gt; i < DEPTH * 9 * 6144; i += NGT) { const int l = i / (9 * 6144), r = i % (9 * 6144), j = r / 6144, n = r % 6144;
        float s = P.b_mod[l * 6144 + n];
#pragma unroll
        for (int ks = 0; ks < 16; ++ks) s += modp[(((size_t)l * 16 + ks) * 9 + j) * 6144 + n];
        mod[i] = s; }
}

template <int R> struct NormRaw { u32x4 a[R][2], b[R][2]; int m0, nv; };
template <int MODE, bool FIRST, bool DRY = false> __device__ __forceinline__ void phase_norm(const Ptrs& P, LAS unsigned char* lds, int l, int Mrows, const bf16_t* Y, const LAS int* tst, int wid_s) {
    constexpr int R = MODE == 2 ? 2 : 4;
    int tid = wid_s * 64 + wg_lane(); asm volatile("" : "+v"(tid)); const int lane = tid & 63, wave = __builtin_amdgcn_readfirstlane(tid >> 6);
    const int gw = blockIdx.x * NWAVES + wave, NGW = gridDim.x * NWAVES;
    const int rpw = (Mrows + NGW - 1) / NGW;
    const int mBeg = gw * rpw, mEnd = (mBeg + rpw) < Mrows ? (mBeg + rpw) : Mrows;
    LAS float* rwT = (LAS float*)lds;
    constexpr int RPW = 72;
    LAS unsigned* recL = (LAS unsigned*)(lds + 65536);
    LAS unsigned* cntL = (LAS unsigned*)(lds + 65536 + NWAVES * RPW * 16);
    LAS unsigned* baseL = cntL + 32;
    LAS float* logL = (LAS float*)(lds + 65536 + 12288);
    if (MODE == 2) { if (tid < 64) cntL[tid] = 0u; { float rv_[D * NE / NTHR];
#pragma unroll
        for (int e = 0; e < D * NE / NTHR; ++e) rv_[e] = ((const float*)(P.ws + WS_PAR))[PAR_RW + tid + NTHR * e];
#pragma unroll
        for (int e = 0; e < D * NE / NTHR; ++e) { const int i = tid + NTHR * e, col = i >> 4; rwT[(i & 15) * D + (col >> 9) * 512 + ((col >> 2) & 1) * 256 + ((col & 511) >> 3) * 4 + (col & 3)] = rv_[e]; } }   __syncthreads(); }
    const float* g = (const float*)(P.ws + WS_PAR) + (MODE == 1 ? PAR_N1 + l * D : MODE == 2 ? PAR_N2 + l * D : PAR_FG);
    f32x4 gg[2][2];
#pragma unroll
    for (int j = 0; j < 2; ++j) { gg[j][0] = (f32x4){0.f, 0.f, 0.f, 0.f}; gg[j][1] = gg[j][0]; if (MODE == 3) { gg[j][0] = *(const f32x4*)(g + 8 * lane + 512 * j); gg[j][1] = *(const f32x4*)(g + 8 * lane + 512 * j + 4); } }
    bf16_t* XB = (bf16_t*)(P.ws + WS_XB);
    unsigned posreg = 0u;
    if (MODE != 2 && !FIRST) { if (mBeg + lane < mEnd) posreg = ((const unsigned*)(P.ws + WS_POS))[mBeg + lane]; }
    f32x4 gt[2][2], scv[2][2], shv[2][2];
#pragma unroll
    for (int j = 0; j < 2; ++j)
#pragma unroll
        for (int q = 0; q < 2; ++q) { gt[j][q] = (f32x4){0.f, 0.f, 0.f, 0.f}; scv[j][q] = gt[j][q]; shv[j][q] = gt[j][q]; }
#define NR_LOAD(G, mstart) do { (G).m0 = (mstart); { const int bnd_ = (((mstart) >> 13) + 1) << 13; const int ge_ = bnd_ < mEnd ? bnd_ : mEnd; (G).nv = (ge_ - (mstart)) < R ? (ge_ - (mstart)) : R; } \
        _Pragma("unroll") for (int r = 0; r < R; ++r) { const int m = (G).m0 + (r < (G).nv ? r : (G).nv - 1); \
            if (FIRST) { const float* xr = m < ML ? P.x + (size_t)m * D : P.ctx + (size_t)(m - ML) * D; \
                _Pragma("unroll") for (int j = 0; j < 2; ++j) { (G).a[r][j] = *(const u32x4*)(xr + 8 * lane + 512 * j); (G).b[r][j] = *(const u32x4*)(xr + 8 * lane + 512 * j + 4); } \
            } else { size_t yrow = (size_t)m; \
                if (MODE != 2) { const unsigned ps = (unsigned)__builtin_amdgcn_readlane((int)posreg, m - mBeg); yrow = (size_t)tst[ps & 255u] * 256 + (ps >> 8); } \
                const bf16_t* yr = Y + yrow * D; \
                _Pragma("unroll") for (int j = 0; j < 2; ++j) { (G).a[r][j] = *(const u32x4*)(XB + (size_t)m * D + 8 * lane + 512 * j); if (MODE != 2) (G).b[r][j] = *(const u32x4*)(yr + 8 * lane + 512 * j); } } } } while (0)
    NormRaw<R> G; G.m0 = mBeg; G.nv = 0;
    if (mBeg < mEnd) NR_LOAD(G, mBeg);
    bool more = mBeg < mEnd; int mbprev = -1;
    while (more) {
        const int m0 = G.m0, nv = G.nv;
        float xv[R][2][8]; float ss[R];
        { const int mb = modrow(m0);
            if (mb != mbprev) { mbprev = mb;
                const float* modl = (const float*)(P.ws + WS_MOD) + ((size_t)l * 9 + mb) * 6144;
                const float* gate = MODE == 2 ? modl + 2048 : (const float*)(P.ws + WS_MOD) + ((size_t)(MODE == 3 ? 3 : (l > 0 ? l - 1 : 0)) * 9 + mb) * 6144 + 5120;
                const float* sh = modl + (MODE == 1 ? 0 : 3072); const float* sc = modl + (MODE == 1 ? 1024 : 4096);
#pragma unroll
                for (int j = 0; j < 2; ++j)
#pragma unroll
                    for (int q = 0; q < 2; ++q) { const int c = 8 * lane + 512 * j + 4 * q; gt[j][q] = *(const f32x4*)(gate + c); scv[j][q] = (*(const f32x4*)(sc + c) + 1.0f) * *(const f32x4*)(g + c); shv[j][q] = *(const f32x4*)(sh + c); } } }
#pragma unroll
        for (int r = 0; r < R; ++r) { const int m = m0 + (r < nv ? r : nv - 1);
#pragma unroll
            for (int j = 0; j < 2; ++j) {
                if (FIRST) { const f32x4 a = __builtin_bit_cast(f32x4, G.a[r][j]), b = __builtin_bit_cast(f32x4, G.b[r][j]);
                    xv[r][j][0] = a.x; xv[r][j][1] = a.y; xv[r][j][2] = a.z; xv[r][j][3] = a.w; xv[r][j][4] = b.x; xv[r][j][5] = b.y; xv[r][j][6] = b.z; xv[r][j][7] = b.w;
                } else if (MODE == 2) { float xf[8]; bf8_to_f32(G.a[r][j], xf);
#pragma unroll
                    for (int i = 0; i < 8; ++i) xv[r][j][i] = xf[i];
                } else { float xf[8], yf[8]; bf8_to_f32(G.a[r][j], xf); bf8_to_f32(G.b[r][j], yf);
#pragma unroll
                    for (int i = 0; i < 8; ++i) xv[r][j][i] = xf[i] + gt[j][i >> 2][i & 3] * yf[i]; } }
            if (MODE == 1 && r < nv) {
#pragma unroll
                for (int j = 0; j < 2; ++j) { u32x4 w; w.x = cvt_pk_bf16(xv[r][j][0], xv[r][j][1]); w.y = cvt_pk_bf16(xv[r][j][2], xv[r][j][3]); w.z = cvt_pk_bf16(xv[r][j][4], xv[r][j][5]); w.w = cvt_pk_bf16(xv[r][j][6], xv[r][j][7]);
                    *(u32x4*)(XB + (size_t)m * D + 8 * lane + 512 * j) = w; } }
            float s = 0.f;
#pragma unroll
            for (int j = 0; j < 2; ++j)
#pragma unroll
                for (int i = 0; i < 8; ++i) s += xv[r][j][i] * xv[r][j][i];
            ss[r] = s;
            if (MODE != 3) {
#pragma unroll
                for (int j = 0; j < 2; ++j)
#pragma unroll
                    for (int i = 0; i < 8; ++i) xv[r][j][i] = xv[r][j][i] * scv[j][i >> 2][i & 3];
            } }
        { const int nm0 = m0 + nv; more = nm0 < mEnd; if (more) NR_LOAD(G, nm0); }
#pragma unroll
        for (int r = 0; r < R; ++r) ss[r] = wave_sum(ss[r]);
#pragma unroll
        for (int r = 0; r < R; ++r) { const int m = m0 + r; const float rinv = rsqrtf(ss[r] * (1.0f / D) + EPS);
            if (MODE == 3) { if (r < nv) { float* orow = P.out + (size_t)m * D;
#pragma unroll
                for (int j = 0; j < 2; ++j) { f32x4 a, b; a.x = xv[r][j][0]; a.y = xv[r][j][1]; a.z = xv[r][j][2]; a.w = xv[r][j][3]; b.x = xv[r][j][4]; b.y = xv[r][j][5]; b.z = xv[r][j][6]; b.w = xv[r][j][7];
                    *(f32x4*)(orow + 8 * lane + 512 * j) = a * rinv * gg[j][0]; *(f32x4*)(orow + 8 * lane + 512 * j + 4) = b * rinv * gg[j][1]; } }
            } else {
#pragma unroll
                for (int j = 0; j < 2; ++j)
#pragma unroll
                    for (int i = 0; i < 8; ++i) xv[r][j][i] = xv[r][j][i] * rinv + shv[j][i >> 2][i & 3];
                if (r < nv) {
                    if (MODE == 2 || G1_FP8) { unsigned char* H8 = (unsigned char*)(P.ws + WS_H) + (size_t)m * D;
#pragma unroll
                        for (int j = 0; j < 2; ++j) { u32x2 o; o.x = pk4_fp8(xv[r][j][0], xv[r][j][1], xv[r][j][2], xv[r][j][3], (float)(1 << F8_SH_H)); o.y = pk4_fp8(xv[r][j][4], xv[r][j][5], xv[r][j][6], xv[r][j][7], (float)(1 << F8_SH_H)); *(u32x2*)(H8 + 8 * lane + 512 * j) = o; }
                    } else { bf16_t* H = (bf16_t*)(P.ws + WS_H) + (size_t)m * D;
#pragma unroll
                        for (int j = 0; j < 2; ++j) { u32x4 o; o.x = cvt_pk_bf16(xv[r][j][0], xv[r][j][1]); o.y = cvt_pk_bf16(xv[r][j][2], xv[r][j][3]); o.z = cvt_pk_bf16(xv[r][j][4], xv[r][j][5]); o.w = cvt_pk_bf16(xv[r][j][6], xv[r][j][7]); *(u32x4*)(H + 8 * lane + 512 * j) = o; } } }
            } }
        if (MODE == 2) {
            typedef float f32x2r __attribute__((ext_vector_type(2)));
            static_assert(MODE != 2 || R == 2, "the packed router pairs the two rows of a group");
            f32x2r lg2[16];
#pragma unroll
            for (int e = 0; e < 16; ++e) lg2[e] = (f32x2r){0.f, 0.f};
#pragma unroll
            for (int j = 0; j < 2; ++j) { const int c = 8 * lane + 512 * j;
                f32x2r x2[8];
#pragma unroll
                for (int i = 0; i < 8; ++i) x2[i] = (f32x2r){xv[0][j][i], xv[1][j][i]};
#pragma unroll
                for (int e4 = 0; e4 < 4; ++e4) {
#pragma unroll
                    for (int e = 4 * e4; e < 4 * e4 + 4; ++e) { const f32x4 r0 = *(const LAS f32x4*)(rwT + e * D + 512 * j + 4 * lane), r1 = *(const LAS f32x4*)(rwT + e * D + 512 * j + 256 + 4 * lane);
                        lg2[e] += x2[0] * r0.x + x2[1] * r0.y + x2[2] * r0.z + x2[3] * r0.w + x2[4] * r1.x + x2[5] * r1.y + x2[6] * r1.z + x2[7] * r1.w; }
                    } }
#pragma unroll
            for (int r = 0; r < R; ++r) {
                float lg[16];
#pragma unroll
                for (int e = 0; e < 16; ++e) lg[e] = r == 0 ? lg2[e].x : lg2[e].y;
                float v8[8], v4[4], v2[2], v1;
#pragma unroll
                for (int i = 0; i < 8; ++i) v8[i] = swsum32(lg[i], lg[i + 8]);
#pragma unroll
                for (int i = 0; i < 4; ++i) v4[i] = swsum16(v8[i], v8[i + 4]);
                { const bool up = (lane & 8) != 0;
#pragma unroll
                  for (int i = 0; i < 2; ++i) { const float send = up ? v4[i] : v4[i + 2]; const float keep = up ? v4[i + 2] : v4[i]; v2[i] = keep + dppf<0x128>(send); } }
                { const bool up = (lane & 4) != 0; const float send = up ? v2[0] : v2[1]; const float keep = up ? v2[1] : v2[0]; v1 = keep + xor4f(send); }
                v1 += dppf<0x4E>(v1); v1 += dppf<0xB1>(v1);
                if ((lane & 3) == 0 && r < nv) logL[(wave * RPW + (m0 - mBeg) + r) * 16 + (lane >> 2)] = v1;
            }
        }
    }
#undef NR_LOAD
    if (MODE == 2 && !DRY) {
        asm volatile("s_waitcnt lgkmcnt(0)" ::: "memory");
        if (lane < mEnd - mBeg) {
            float sco[16], sel[16];
#pragma unroll
            for (int e4 = 0; e4 < 4; ++e4) { const f32x4 v = *(const LAS f32x4*)(logL + (wave * RPW + lane) * 16 + 4 * e4);
#pragma unroll
                for (int i = 0; i < 4; ++i) { const int e = 4 * e4 + i; sco[e] = 1.0f / (1.0f + __expf(-v[i])); sel[e] = sco[e] + ((const float*)(P.ws + WS_PAR))[PAR_RB + e]; } }
            int bg = 0; float bgs = -1e30f; int ba = 0, bb = 1; float sa = 0.f, sb = 0.f;
#pragma unroll
            for (int gI = 0; gI < 4; ++gI) {
                int i1 = 0; float v1 = sel[gI * 4], c1 = sco[gI * 4];
#pragma unroll
                for (int i = 1; i < 4; ++i) if (sel[gI * 4 + i] > v1) { v1 = sel[gI * 4 + i]; c1 = sco[gI * 4 + i]; i1 = i; }
                int i2 = -1; float v2 = -1e30f, c2 = 0.f;
#pragma unroll
                for (int i = 0; i < 4; ++i) if (i != i1 && sel[gI * 4 + i] > v2) { v2 = sel[gI * 4 + i]; c2 = sco[gI * 4 + i]; i2 = i; }
                const float gs = v1 + v2;
                if (gs > bgs) { bgs = gs; bg = gI; ba = i1; bb = i2; sa = c1; sb = c2; }
            }
            const int a = ba < bb ? ba : bb, b = ba < bb ? bb : ba;
            const float wl = ba < bb ? sa : sb, wh = ba < bb ? sb : sa, inv = 1.0f / (wl + wh);
            const int pairidx = (a == 0) ? (b - 1) : (a == 1 ? (b + 1) : 5);
            const int cls = bg * 6 + pairidx;
            const unsigned pl = __hip_atomic_fetch_add(cntL + cls, 1u, __ATOMIC_RELAXED, __HIP_MEMORY_SCOPE_WORKGROUP);
            LAS unsigned* rb = recL + (wave * RPW + lane) * 4; rb[0] = (unsigned)(mBeg + lane); rb[1] = __float_as_uint(wl * inv); rb[2] = __float_as_uint(wh * inv); rb[3] = (unsigned)cls | (pl << 8);
        }
        asm volatile("s_waitcnt lgkmcnt(0)" ::: "memory"); __syncthreads();
        unsigned* ctl = (unsigned*)(P.ws + WS_CTL);
        if (tid < NCLS) { const unsigned n = cntL[tid]; baseL[tid] = n ? atomicAdd(ctl + CW_CNTF + (l * 32 + tid) * 64, n) : 0u; }
        __syncthreads();
        ClsRec* listr = (ClsRec*)(P.ws + WS_LISTR); unsigned* posw = (unsigned*)(P.ws + WS_POS);
        for (int i = tid; i < NWAVES * RPW; i += NTHR) { const int w = i / RPW, r = i % RPW; const int wb = (blockIdx.x * NWAVES + w) * rpw; const int nw = (wb + rpw < Mrows ? wb + rpw : Mrows) - wb;
            if (r < nw) { const LAS unsigned* rb = recL + i * 4; const unsigned cls = rb[3] & 255u, pl = rb[3] >> 8, gp = baseL[cls] + pl;
                ClsRec rc; rc.m = (int)rb[0]; rc.wlo = __uint_as_float(rb[1]); rc.whi = __uint_as_float(rb[2]); rc.pad = 0;
                listr[(size_t)cls * MT + gp] = rc; posw[rb[0]] = cls | (gp << 8); } }
    }
}
__device__ __forceinline__ void build_tile_table(const Ptrs& P, LAS int* tst, int l, int wid_s) {
    asm volatile("" : "+s"(wid_s));
    if (wid_s == 0) {
        int lane = wg_lane(); asm volatile("" : "+v"(lane));
        const unsigned* cnt = (const unsigned*)(P.ws + WS_CTL) + CW_CNTF + l * 32 * 64;
        const int tiles = lane < NCLS ? (int)((__hip_atomic_load(cnt + lane * 64, __ATOMIC_RELAXED, __HIP_MEMORY_SCOPE_AGENT) + 255u) >> 8) : 0;
        int incl = tiles;
#pragma unroll
        for (int o = 1; o < 32; o <<= 1) { const int t = __shfl_up(incl, o); if (lane >= o) incl += t; }
        if (lane <= NCLS) tst[lane] = incl - tiles;
    }
    __syncthreads();
}
namespace mx {
typedef float f32x16 __attribute__((ext_vector_type(16)));
typedef short s16x4 __attribute__((ext_vector_type(4)));
constexpr int SLOTB = 8192;
constexpr int L_K = 0, L_V = 2 * SLOTB, L_WS = 4 * SLOTB, L_OST = L_WS + NWAVES * 256, L_END = L_OST + NWAVES * 4096;
constexpr int CWL_OFF = 122880;
constexpr int VT_PITCH = 136;
__device__ __forceinline__ int crow(int r, int hi) { return (r & 3) + 8 * (r >> 2) + 4 * hi; }
__device__ __forceinline__ unsigned cvtpk(float lo, float hi) { unsigned r; asm volatile("v_cvt_pk_bf16_f32 %0, %1, %2" : "=v"(r) : "v"(lo), "v"(hi)); return r; }
__device__ __forceinline__ float gelu_fast(float x) { const float y = x + 0.044715f * x * x * x; return x * __builtin_amdgcn_rcpf(1.0f + __builtin_amdgcn_exp2f(-2.302208198f * y)); }

__device__ __forceinline__ void qkt(f32x16& p0, f32x16& p1, const LAS unsigned char* Kslot, const bf16x8* qr, const f32x16& negm, int r32, int hi) {
    const LAS unsigned char* kb = Kslot + hi * 1024 + r32 * 16;
#pragma unroll
    for (int d0 = 0; d0 < 4; ++d0) {
        const bf16x8 b0 = *(const LAS bf16x8*)(kb + d0 * 2048), b1 = *(const LAS bf16x8*)(kb + d0 * 2048 + 512);
        if (d0 == 0) { p0 = __builtin_amdgcn_mfma_f32_32x32x16_bf16(b0, qr[0], negm, 0, 0, 0); p1 = __builtin_amdgcn_mfma_f32_32x32x16_bf16(b1, qr[0], negm, 0, 0, 0); }
        else { p0 = __builtin_amdgcn_mfma_f32_32x32x16_bf16(b0, qr[d0], p0, 0, 0, 0); p1 = __builtin_amdgcn_mfma_f32_32x32x16_bf16(b1, qr[d0], p1, 0, 0, 0); } }
}
__device__ __forceinline__ void qkt2(f32x16& a0, f32x16& a1, f32x16& b0, f32x16& b1, const LAS unsigned char* KslotA, const LAS unsigned char* KslotB, const bf16x8* qr, const f32x16& negm, int r32, int hi) {
    const LAS unsigned char* ka = KslotA + hi * 1024 + r32 * 16; const LAS unsigned char* kb = KslotB + hi * 1024 + r32 * 16;
#pragma unroll
    for (int d0 = 0; d0 < 4; ++d0) {
        const bf16x8 xa0 = *(const LAS bf16x8*)(ka + d0 * 2048), xa1 = *(const LAS bf16x8*)(ka + d0 * 2048 + 512), xb0 = *(const LAS bf16x8*)(kb + d0 * 2048), xb1 = *(const LAS bf16x8*)(kb + d0 * 2048 + 512);
        if (d0 == 0) { a0 = __builtin_amdgcn_mfma_f32_32x32x16_bf16(xa0, qr[0], negm, 0, 0, 0); a1 = __builtin_amdgcn_mfma_f32_32x32x16_bf16(xa1, qr[0], negm, 0, 0, 0);
                       b0 = __builtin_amdgcn_mfma_f32_32x32x16_bf16(xb0, qr[0], negm, 0, 0, 0); b1 = __builtin_amdgcn_mfma_f32_32x32x16_bf16(xb1, qr[0], negm, 0, 0, 0); }
        else { a0 = __builtin_amdgcn_mfma_f32_32x32x16_bf16(xa0, qr[d0], a0, 0, 0, 0); a1 = __builtin_amdgcn_mfma_f32_32x32x16_bf16(xa1, qr[d0], a1, 0, 0, 0);
               b0 = __builtin_amdgcn_mfma_f32_32x32x16_bf16(xb0, qr[d0], b0, 0, 0, 0); b1 = __builtin_amdgcn_mfma_f32_32x32x16_bf16(xb1, qr[d0], b1, 0, 0, 0); } }
}
__device__ __forceinline__ void pv(f32x16* o, unsigned vb, bf16x8 pa0, bf16x8 pa1, bf16x8 pa2, bf16x8 pa3) {
#pragma unroll
    for (int d0 = 0; d0 < 2; ++d0) { s16x4 lo[4], hi[4];
#pragma unroll
        for (int ks = 0; ks < 4; ++ks) {
            asm volatile("ds_read_b64_tr_b16 %0, %1 offset:%c2" : "=&v"(lo[ks]) : "v"(vb), "i"(d0 * 4096 + ks * 1024) : "memory");
            asm volatile("ds_read_b64_tr_b16 %0, %1 offset:%c2" : "=&v"(hi[ks]) : "v"(vb), "i"(d0 * 4096 + ks * 1024 + 512) : "memory"); }
        asm volatile("s_waitcnt lgkmcnt(0)" ::: "memory"); __builtin_amdgcn_sched_barrier(0);
#define MX_PK(k) (bf16x8){lo[k][0], lo[k][1], lo[k][2], lo[k][3], hi[k][0], hi[k][1], hi[k][2], hi[k][3]}
        o[d0] = __builtin_amdgcn_mfma_f32_32x32x16_bf16(pa0, MX_PK(0), o[d0], 0, 0, 0);
        o[d0] = __builtin_amdgcn_mfma_f32_32x32x16_bf16(pa1, MX_PK(1), o[d0], 0, 0, 0);
        o[d0] = __builtin_amdgcn_mfma_f32_32x32x16_bf16(pa2, MX_PK(2), o[d0], 0, 0, 0);
        o[d0] = __builtin_amdgcn_mfma_f32_32x32x16_bf16(pa3, MX_PK(3), o[d0], 0, 0, 0);
#undef MX_PK
    }
}
#define MS_TR(dst, base, off) asm volatile("ds_read_b64_tr_b16 %0, %1 offset:%c2" : "=&v"(dst) : "v"(base), "i"(off) : "memory")
#define MS_VISSUE(R, base, d0) do { MS_TR(R[0], base, (d0) * 4096); MS_TR(R[1], base, (d0) * 4096 + 512); MS_TR(R[2], base, (d0) * 4096 + 1024); MS_TR(R[3], base, (d0) * 4096 + 1536); \
        MS_TR(R[4], base, (d0) * 4096 + 2048); MS_TR(R[5], base, (d0) * 4096 + 2560); MS_TR(R[6], base, (d0) * 4096 + 3072); MS_TR(R[7], base, (d0) * 4096 + 3584); } while (0)
#define MS_VWAIT(n, R) do { asm volatile("s_waitcnt lgkmcnt(" #n ")" : "+v"(R[0]), "+v"(R[1]), "+v"(R[2]), "+v"(R[3]), "+v"(R[4]), "+v"(R[5]), "+v"(R[6]), "+v"(R[7]) :: "memory"); __builtin_amdgcn_sched_barrier(0); } while (0)
#define MS_PK(R, k) (bf16x8){R[2 * (k)][0], R[2 * (k)][1], R[2 * (k)][2], R[2 * (k)][3], R[2 * (k) + 1][0], R[2 * (k) + 1][1], R[2 * (k) + 1][2], R[2 * (k) + 1][3]}
#define MS_PVMMA(acc, R, p0, p1, p2, p3) do { acc = __builtin_amdgcn_mfma_f32_32x32x16_bf16(__builtin_bit_cast(bf16x8, p0), MS_PK(R, 0), acc, 0, 0, 0); acc = __builtin_amdgcn_mfma_f32_32x32x16_bf16(__builtin_bit_cast(bf16x8, p1), MS_PK(R, 1), acc, 0, 0, 0); \
        acc = __builtin_amdgcn_mfma_f32_32x32x16_bf16(__builtin_bit_cast(bf16x8, p2), MS_PK(R, 2), acc, 0, 0, 0); acc = __builtin_amdgcn_mfma_f32_32x32x16_bf16(__builtin_bit_cast(bf16x8, p3), MS_PK(R, 3), acc, 0, 0, 0); __builtin_amdgcn_sched_barrier(0); } while (0)
__device__ __forceinline__ void pv2(f32x16* o, unsigned vbA, unsigned vbB, const u32x4& a0, const u32x4& a1, const u32x4& a2, const u32x4& a3, const u32x4& b0, const u32x4& b1, const u32x4& b2, const u32x4& b3) {
    s16x4 R0[8], R1[8];
    __builtin_amdgcn_sched_barrier(0);
    MS_VISSUE(R0, vbA, 0); MS_VISSUE(R1, vbA, 1);
    MS_VWAIT(8, R0); MS_PVMMA(o[0], R0, a0, a1, a2, a3); MS_VISSUE(R0, vbB, 0);
    MS_VWAIT(8, R1); MS_PVMMA(o[1], R1, a0, a1, a2, a3); MS_VISSUE(R1, vbB, 1);
    MS_VWAIT(8, R0); MS_PVMMA(o[0], R0, b0, b1, b2, b3);
    MS_VWAIT(0, R1); MS_PVMMA(o[1], R1, b0, b1, b2, b3);
}
struct ConvRaw { u32x4 bg, c0, c1, c2, z0, z1, z2; };
__device__ __forceinline__ void conv_load(ConvRaw& R, const bf16_t* PROJ, int m0, int tid, int q) {
    const int seqmask = m0 < ML ? SEQ - 1 : CTXL - 1; const int mrel = m0 < ML ? m0 : m0 - ML;
    const int idx = q * NTHR + tid, row = idx >> 5, c = (idx & 31) * 8;
    const int t = (mrel + row) & seqmask; const bf16_t* pr = PROJ + (size_t)(m0 + row) * INC;
    R.bg = *(const u32x4*)(pr + C_BG + c); R.c1 = *(const u32x4*)(pr + C_CG + c); R.z1 = *(const u32x4*)(pr + C_Z + c);
    R.c0 = (u32x4){0u, 0u, 0u, 0u}; R.z0 = R.c0; R.c2 = R.c0; R.z2 = R.c0;
    if (t > 0) { R.c0 = *(const u32x4*)(pr - INC + C_CG + c); R.z0 = *(const u32x4*)(pr - INC + C_Z + c); }
    if (t < seqmask) { R.c2 = *(const u32x4*)(pr + INC + C_CG + c); R.z2 = *(const u32x4*)(pr + INC + C_Z + c); }
}
__device__ __forceinline__ void conv_finish(const ConvRaw& R, const LAS float* cwl, unsigned char* MIXo, int m0, int tid, int q) {
    const int idx = q * NTHR + tid, row = idx >> 5, c = (idx & 31) * 8;
    const LAS float* cw = cwl + c;
    float o[8];
#pragma unroll
    for (int i = 0; i < 8; ++i) { const int wI = i >> 1; const bool up = i & 1;
#define MX_BF(v) (up ? __uint_as_float((v)[wI] & 0xffff0000u) : __uint_as_float((v)[wI] << 16))
        const float y = MX_BF(R.c0) * MX_BF(R.z0) * cw[i] + MX_BF(R.c1) * MX_BF(R.z1) * cw[256 + i] + MX_BF(R.c2) * MX_BF(R.z2) * cw[512 + i];
        o[i] = MX_BF(R.bg) * y;
#undef MX_BF
    }
    u32x2 w; w.x = pk4_fp8(o[0], o[1], o[2], o[3], (float)(1 << F8_SH_M)); w.y = pk4_fp8(o[4], o[5], o[6], o[7], (float)(1 << F8_SH_M));
    *(u32x2*)(MIXo + (size_t)(m0 + row) * D + 256 + c) = w;
}
constexpr int NSLOT = 4;
constexpr int ATT_THR = 8;
typedef float f32x2 __attribute__((ext_vector_type(2)));
#define MX3(a, b, c) __builtin_fmaxf(__builtin_fmaxf((a), (b)), (c))
constexpr int A_K = 0, A_V = NSLOT * SLOTB, A_WS = 2 * NSLOT * SLOTB, A_OST = A_WS + NWAVES * 512, A_END = A_OST + NWAVES * 4096;
template <int NH> __device__ __forceinline__ void attn_unit(const bf16_t* PROJ, unsigned char* MIXo, const float* sink, const LAS float* cwl, LAS unsigned char* shm, int latent, int b, int blk, int kvh, int hp, int tid, int& sbase, bool& pref, int bnext) {
    const int lane = tid & 63, r32 = lane & 31, hi = lane >> 5; const int wid = __builtin_amdgcn_readfirstlane(tid >> 6);
    const int head0 = NH == 2 ? kvh * 4 + (wid >> 2) * 2 : kvh * 4 + hp * 2 + (wid >> 2), qw = (wid & 3) * 32;
    const int qrow0 = latent ? b * SEQ + blk * 128 : ML + b * CTXL + blk * 128;
    const int ctx0 = ML + b * CTXL;
    const int lt_lo = latent ? (blk > 0 ? 0 : 2) : 0, lt_hi = latent ? (blk < SEQ / 128 - 1 ? 6 : 4) : 0;
    const int NT = 4 + (lt_hi - lt_lo);
    LAS float* wsf = (LAS float*)(shm + A_WS) + wid * 128;
    const bf16_t* kcol = PROJ + C_K + kvh * 64 + wid * 8;
    const bf16_t* vcol = PROJ + C_VV + kvh * 64 + (wid >> 2) * 32 + (lane & 3) * 8;
#define MX_LT(t) (NT == 10 ? ((t) < 8 ? (t) - 3 : ((t) == 8 ? 0 : 5)) : (t) - 4 + lt_lo)
#define MX_TROW(t) ((t) < 4 ? ctx0 + 64 * (t) : b * SEQ + blk * 128 - 128 + 64 * MX_LT(t))
#define MX_DMA(t) MX_DMAR(MX_TROW(t), ((t) + sbase) & (NSLOT - 1))
#define MX_DMAR(row0, slot) do { const int _r0 = (row0); const int _sl = (slot); \
        __builtin_amdgcn_global_load_lds((const unsigned*)(kcol + (size_t)(_r0 + lane) * INC), (LAS unsigned*)(shm + A_K + _sl * SLOTB + wid * 1024), 16, 0, 0); \
        __builtin_amdgcn_global_load_lds((const unsigned*)(vcol + (size_t)(_r0 + 16 * (wid & 3) + (lane >> 2)) * INC), (LAS unsigned*)(shm + A_V + _sl * SLOTB + wid * 1024), 16, 0, 0); } while (0)
    static_assert(NH == 1, "the conv slice deal assumes four attention units per chunk");
    const int cm0 = qrow0 + (kvh * 2 + hp) * 32;
    ConvRaw CR; conv_load(CR, PROJ, cm0, tid, 0);
    bf16x8 qr[NH][4];
    { const bf16_t* qp = PROJ + (size_t)(qrow0 + qw + r32) * INC + C_Q + head0 * 64 + hi * 8;
#pragma unroll
      for (int hh = 0; hh < NH; ++hh)
#pragma unroll
          for (int d0 = 0; d0 < 4; ++d0) qr[hh][d0] = *(const bf16x8*)(qp + hh * 64 + d0 * 16); }
    if (!pref) { MX_DMA(0); MX_DMA(1); }
    float mrun[NH], lsum[NH]; f32x16 o[NH][2], negm[NH];
#pragma unroll
    for (int hh = 0; hh < NH; ++hh) { mrun[hh] = sink[head0 + hh] * LOG2E; lsum[hh] = hi == 0 ? 1.0f : 0.0f;
#pragma unroll
        for (int r = 0; r < 16; ++r) negm[hh][r] = -mrun[hh];
        o[hh][0] = (f32x16){0.f, 0.f, 0.f, 0.f, 0.f, 0.f, 0.f, 0.f, 0.f, 0.f, 0.f, 0.f, 0.f, 0.f, 0.f, 0.f}; o[hh][1] = o[hh][0]; }
    const unsigned vb0 = (unsigned)(size_t)(shm + A_V) + ((lane >> 4) & 1) * 32 + (lane & 3) * 8 + (4 * hi + ((lane & 15) >> 2)) * 64;
    const int qc = qw + r32;
    const int NTP = NT == 10 ? 8 : NT;
    for (int t = 0; t < NTP; t += 2) {
        asm volatile("s_waitcnt vmcnt(0) lgkmcnt(0)\n\ts_barrier" ::: "memory");
        if (t + 2 < NT) { MX_DMA(t + 2); MX_DMA(t + 3); }
        if (t == 2) { conv_finish(CR, cwl, MIXo, cm0, tid, 0); conv_load(CR, PROJ, cm0, tid, 1); }
        const int sa = (t + sbase) & (NSLOT - 1), sb = (t + 1 + sbase) & (NSLOT - 1);
        f32x16 pa0, pa1, pb0, pb1;
        { f32x16 ng; float nm = -mrun[0]; asm volatile("" : "+v"(nm));
#pragma unroll
          for (int r = 0; r < 16; ++r) ng[r] = nm;
          __builtin_amdgcn_s_setprio(1); qkt2(pa0, pa1, pb0, pb1, shm + A_K + sa * SLOTB, shm + A_K + sb * SLOTB, qr[0], ng, r32, hi); __builtin_amdgcn_s_setprio(0); }
        if (t >= 4) {
#pragma unroll
            for (int q = 0; q < 2; ++q) { const int lt = MX_LT(t + q); if (lt < 2 || lt >= 4) { const int kb = -128 + 64 * lt;
#pragma unroll
                for (int r = 0; r < 16; ++r) { const int k0 = kb + crow(r, hi), k1 = k0 + 32; const bool m0_ = (k0 < qc - 128 || k0 > qc + 128), m1_ = (k1 < qc - 128 || k1 > qc + 128);
                    if (q == 0) { if (m0_) pa0[r] = -1e30f; if (m1_) pa1[r] = -1e30f; } else { if (m0_) pb0[r] = -1e30f; if (m1_) pb1[r] = -1e30f; } } } } }
        float ma = MX3(pa0[0], pa1[0], pb0[0]), mb = MX3(pb1[0], pa0[1], pa1[1]); ma = MX3(ma, pb0[1], pb1[1]);
#pragma unroll
        for (int r = 2; r < 16; r += 2) { ma = MX3(ma, pa0[r], pa1[r]); mb = MX3(mb, pb0[r], pb1[r]); ma = MX3(ma, pa0[r + 1], pa1[r + 1]); mb = MX3(mb, pb0[r + 1], pb1[r + 1]); }
        float rm = __builtin_fmaxf(ma, mb);
        { auto rr = __builtin_amdgcn_permlane32_swap(__float_as_uint(rm), __float_as_uint(rm), false, false); rm = __builtin_fmaxf(__uint_as_float(rr[0]), __uint_as_float(rr[1])); }
        if (__any(rm > (float)ATT_THR)) { const float dl = __builtin_fmaxf(rm, 0.f); mrun[0] += dl;
#pragma unroll
            for (int r = 0; r < 16; ++r) { pa0[r] -= dl; pa1[r] -= dl; pb0[r] -= dl; pb1[r] -= dl; }
            const float f = __builtin_amdgcn_exp2f(-dl); lsum[0] *= f; if (hi == 0) wsf[r32] = f;
            asm volatile("s_waitcnt lgkmcnt(0)" ::: "memory");
#pragma unroll
            for (int r = 0; r < 16; ++r) { const float fr_ = *(volatile LAS float*)(wsf + crow(r, hi)); o[0][0][r] *= fr_; o[0][1][r] *= fr_; } }
#pragma unroll
        for (int r = 0; r < 16; ++r) { pa0[r] = __builtin_amdgcn_exp2f(pa0[r]); pa1[r] = __builtin_amdgcn_exp2f(pa1[r]); pb0[r] = __builtin_amdgcn_exp2f(pb0[r]); pb1[r] = __builtin_amdgcn_exp2f(pb1[r]); }
        { f32x2 s2 = (f32x2){pa0[0], pa0[1]} + (f32x2){pa1[0], pa1[1]}, s3 = (f32x2){pb0[0], pb0[1]} + (f32x2){pb1[0], pb1[1]};
#pragma unroll
          for (int r = 2; r < 16; r += 2) { s2 += (f32x2){pa0[r], pa0[r + 1]}; s3 += (f32x2){pb0[r], pb0[r + 1]}; s2 += (f32x2){pa1[r], pa1[r + 1]}; s3 += (f32x2){pb1[r], pb1[r + 1]}; }
          s2 += s3; lsum[0] += s2.x + s2.y; }
        { u32x4 pw0, pw1, pw2, pw3, pw4, pw5, pw6, pw7;
#pragma unroll
          for (int i = 0; i < 4; ++i) { pw0[i] = cvtpk(pa0[2 * i], pa0[2 * i + 1]); pw1[i] = cvtpk(pa0[8 + 2 * i], pa0[8 + 2 * i + 1]); pw2[i] = cvtpk(pa1[2 * i], pa1[2 * i + 1]); pw3[i] = cvtpk(pa1[8 + 2 * i], pa1[8 + 2 * i + 1]);
                                        pw4[i] = cvtpk(pb0[2 * i], pb0[2 * i + 1]); pw5[i] = cvtpk(pb0[8 + 2 * i], pb0[8 + 2 * i + 1]); pw6[i] = cvtpk(pb1[2 * i], pb1[2 * i + 1]); pw7[i] = cvtpk(pb1[8 + 2 * i], pb1[8 + 2 * i + 1]); }
          __builtin_amdgcn_s_setprio(1); pv2(o[0], vb0 + sa * SLOTB, vb0 + sb * SLOTB, pw0, pw1, pw2, pw3, pw4, pw5, pw6, pw7); __builtin_amdgcn_s_setprio(0); }
    }
    if (NT == 10) {
        asm volatile("s_waitcnt vmcnt(0) lgkmcnt(0)\n\ts_barrier" ::: "memory");
        if (bnext >= 0) { const int cn = ML + bnext * CTXL; MX_DMAR(cn, (6 + sbase) & (NSLOT - 1)); MX_DMAR(cn + 64, (7 + sbase) & (NSLOT - 1)); }
        const int ss = ((qw < 64 ? 8 : 9) + sbase) & (NSLOT - 1), kb = qw < 64 ? -128 : 192;
        f32x16 p0, p1;
        { f32x16 ng; float nm = -mrun[0]; asm volatile("" : "+v"(nm));
#pragma unroll
          for (int r = 0; r < 16; ++r) ng[r] = nm;
          qkt(p0, p1, shm + A_K + ss * SLOTB, qr[0], ng, r32, hi); }
#pragma unroll
        for (int r = 0; r < 16; ++r) { const int k0 = kb + crow(r, hi), k1 = k0 + 32; if (k0 < qc - 128 || k0 > qc + 128) p0[r] = -1e30f; if (k1 < qc - 128 || k1 > qc + 128) p1[r] = -1e30f; }
        float ma = MX3(p0[0], p1[0], p0[1]), mb = MX3(p1[1], p0[2], p1[2]);
#pragma unroll
        for (int r = 3; r < 15; r += 2) { ma = MX3(ma, p0[r], p1[r]); mb = MX3(mb, p0[r + 1], p1[r + 1]); }
        float rm = MX3(ma, mb, __builtin_fmaxf(p0[15], p1[15]));
        { auto rr = __builtin_amdgcn_permlane32_swap(__float_as_uint(rm), __float_as_uint(rm), false, false); rm = __builtin_fmaxf(__uint_as_float(rr[0]), __uint_as_float(rr[1])); }
        if (__any(rm > (float)ATT_THR)) { const float dl = __builtin_fmaxf(rm, 0.f); mrun[0] += dl;
#pragma unroll
            for (int r = 0; r < 16; ++r) { p0[r] -= dl; p1[r] -= dl; }
            const float f = __builtin_amdgcn_exp2f(-dl); lsum[0] *= f; if (hi == 0) wsf[r32] = f;
            asm volatile("s_waitcnt lgkmcnt(0)" ::: "memory");
#pragma unroll
            for (int r = 0; r < 16; ++r) { const float fr_ = *(volatile LAS float*)(wsf + crow(r, hi)); o[0][0][r] *= fr_; o[0][1][r] *= fr_; } }
#pragma unroll
        for (int r = 0; r < 16; ++r) { p0[r] = __builtin_amdgcn_exp2f(p0[r]); p1[r] = __builtin_amdgcn_exp2f(p1[r]); }
        { f32x2 s2 = (f32x2){p0[0], p0[1]} + (f32x2){p1[0], p1[1]};
#pragma unroll
          for (int r = 2; r < 16; r += 2) { s2 += (f32x2){p0[r], p0[r + 1]}; s2 += (f32x2){p1[r], p1[r + 1]}; }
          lsum[0] += s2.x + s2.y; }
        { u32x4 pw0, pw1, pw2, pw3;
#pragma unroll
          for (int i = 0; i < 4; ++i) { pw0[i] = cvtpk(p0[2 * i], p0[2 * i + 1]); pw1[i] = cvtpk(p0[8 + 2 * i], p0[8 + 2 * i + 1]); pw2[i] = cvtpk(p1[2 * i], p1[2 * i + 1]); pw3[i] = cvtpk(p1[8 + 2 * i], p1[8 + 2 * i + 1]); }
          pv(o[0], vb0 + ss * SLOTB, __builtin_bit_cast(bf16x8, pw0), __builtin_bit_cast(bf16x8, pw1), __builtin_bit_cast(bf16x8, pw2), __builtin_bit_cast(bf16x8, pw3)); }
    }
    LAS unsigned char* stg = (LAS unsigned char*)(shm + A_OST) + wid * 2048;
#pragma unroll
    for (int hh = 0; hh < NH; ++hh) {
        float ls = lsum[hh];
        { auto rr = __builtin_amdgcn_permlane32_swap(__float_as_uint(ls), __float_as_uint(ls), false, false); ls = __uint_as_float(rr[0]) + __uint_as_float(rr[1]); }
        if (hi == 0) wsf[hh * 64 + 32 + r32] = ls;
        asm volatile("s_waitcnt lgkmcnt(0)" ::: "memory");
#pragma unroll
        for (int r = 0; r < 16; ++r) { const int orow = crow(r, hi); const float rl = __builtin_amdgcn_rcpf(*(volatile LAS float*)(wsf + hh * 64 + 32 + orow)) * (float)(1 << F8_SH_M);
            const unsigned w = pk4_fp8(o[hh][0][r], o[hh][1][r], 0.f, 0.f, rl); stg[orow * 64 + r32] = (unsigned char)(w & 0xffu); stg[orow * 64 + 32 + r32] = (unsigned char)((w >> 8) & 0xffu); }
        asm volatile("s_waitcnt lgkmcnt(0)" ::: "memory");
        unsigned char* op = MIXo + (size_t)(qrow0 + qw) * D + 512 + (head0 + hh) * 64;
#pragma unroll
        for (int i = 0; i < 2; ++i) { const int row = i * 16 + (lane >> 2), ch = lane & 3; const u32x4 v = *(const LAS u32x4*)(stg + row * 64 + ch * 16); *(u32x4*)(op + (size_t)row * D + ch * 16) = v; }
        asm volatile("s_waitcnt lgkmcnt(0)" ::: "memory");
    }
    conv_finish(CR, cwl, MIXo, cm0, tid, 1);
    if (!(NT == 10 && bnext >= 0)) asm volatile("s_barrier" ::: "memory");
    if (NT == 10 && bnext >= 0) { pref = true; sbase = (sbase + 2) & (NSLOT - 1); } else pref = false;
#undef MX_DMAR
#undef MX_DMA
#undef MX_TROW
}

__device__ __forceinline__ void gmlp_conv_unit(const Ptrs& P, const bf16_t* PROJ, unsigned char* MIXo, LAS unsigned char* shm, int l, int m0, int tid) {
    const int lane = tid & 63, r32 = lane & 31, hi = lane >> 5; const int wid = __builtin_amdgcn_readfirstlane(tid >> 6);
    LAS bf16_t* vT = (LAS bf16_t*)shm;
    u32x2 uraw[4][4];
    bf16x8 bfr[2][8];
    { const bf16_t* wsb0 = (const bf16_t*)(P.ws + WS_WSB) + ((size_t)(l * 4 + (wid >> 1)) * 128) * 128 + (size_t)r32 * 128 + hi * 8;
#pragma unroll
      for (int kk = 0; kk < 8; ++kk) bfr[0][kk] = *(const bf16x8*)(wsb0 + kk * 16); }
    { u32x2 raw[16];
#pragma unroll
      for (int rr = 0; rr < 16; ++rr) raw[rr] = *(const u32x2*)(PROJ + (size_t)(m0 + wid * 16 + rr) * INC + C_V + 4 * lane);
      { const int h = wid >> 1, dt = wid & 1;
#pragma unroll
        for (int pt = 0; pt < 4; ++pt)
#pragma unroll
            for (int q4 = 0; q4 < 4; ++q4) uraw[pt][q4] = *(const u32x2*)(PROJ + (size_t)(m0 + pt * 32 + r32) * INC + C_U + h * 64 + dt * 32 + 4 * hi + 8 * q4); }
      float gv[4];
#pragma unroll
      for (int i = 0; i < 4; ++i) gv[i] = ((const float*)(P.ws + WS_PAR))[PAR_GG + l * 256 + 4 * lane + i];
#pragma unroll
      for (int r4 = 0; r4 < 4; ++r4) { float g[4][4], ss[4];
#pragma unroll
          for (int q = 0; q < 4; ++q) { const u32x2 w = raw[r4 * 4 + q];
              g[q][0] = gelu_fast(__uint_as_float(w.x << 16)); g[q][1] = gelu_fast(__uint_as_float(w.x & 0xffff0000u)); g[q][2] = gelu_fast(__uint_as_float(w.y << 16)); g[q][3] = gelu_fast(__uint_as_float(w.y & 0xffff0000u));
              ss[q] = g[q][0] * g[q][0] + g[q][1] * g[q][1] + g[q][2] * g[q][2] + g[q][3] * g[q][3]; }
#pragma unroll
          for (int q = 0; q < 4; ++q) ss[q] = wave_sum(ss[q]);
          float rinv[4];
#pragma unroll
          for (int q = 0; q < 4; ++q) rinv[q] = rsqrtf(ss[q] * (1.0f / 256.0f) + EPS);
#pragma unroll
          for (int i = 0; i < 4; ++i) { u32x2 w; w.x = cvtpk(g[0][i] * rinv[0] * gv[i], g[1][i] * rinv[1] * gv[i]); w.y = cvtpk(g[2][i] * rinv[2] * gv[i], g[3][i] * rinv[3] * gv[i]);
              *(LAS u32x2*)(vT + (4 * lane + i) * VT_PITCH + 4 * ((wid * 4 + r4) ^ (2 * (lane & 15)))) = w; } } }
    asm volatile("s_waitcnt lgkmcnt(0)\n\ts_barrier" ::: "memory");
    { const int h = wid >> 1, dt = wid & 1;
      const bf16_t* wsb = (const bf16_t*)(P.ws + WS_WSB) + ((size_t)(l * 4 + h) * 128) * 128 + (size_t)r32 * 128 + hi * 8;
      bf16x8 af[8];
#pragma unroll
      for (int kk = 0; kk < 8; ++kk) af[kk] = *(const LAS bf16x8*)(vT + (h * 64 + dt * 32 + r32) * VT_PITCH + 4 * ((kk * 4 + hi * 2) ^ (2 * (dt * 8 + (r32 >> 2)))));
      const float* bs = (const float*)(P.ws + WS_PAR) + PAR_BS + (l * 4 + h) * 128;
      float biasv[4];
#pragma unroll
      for (int pt = 0; pt < 4; ++pt) biasv[pt] = bs[pt * 32 + r32];
#pragma unroll
      for (int pt = 0; pt < 4; ++pt) {
          if (pt < 3) {
#pragma unroll
              for (int kk = 0; kk < 8; ++kk) bfr[(pt + 1) & 1][kk] = *(const bf16x8*)(wsb + (size_t)(pt + 1) * 32 * 128 + kk * 16); }
          f32x16 acc = (f32x16){0.f, 0.f, 0.f, 0.f, 0.f, 0.f, 0.f, 0.f, 0.f, 0.f, 0.f, 0.f, 0.f, 0.f, 0.f, 0.f};
#pragma unroll
          for (int kk = 0; kk < 8; ++kk) acc = __builtin_amdgcn_mfma_f32_32x32x16_bf16(af[kk], bfr[pt & 1][kk], acc, 0, 0, 0);
          const int p = pt * 32 + r32; const float bias = biasv[pt];
          unsigned char* op = MIXo + (size_t)(m0 + p) * D + h * 64 + dt * 32 + 8 * hi;
          unsigned w4[4];
#pragma unroll
          for (int q4 = 0; q4 < 4; ++q4) { const u32x2 raw = uraw[pt][q4];
              const float u0 = gelu_fast(__uint_as_float(raw.x << 16)), u1 = gelu_fast(__uint_as_float(raw.x & 0xffff0000u)), u2 = gelu_fast(__uint_as_float(raw.y << 16)), u3 = gelu_fast(__uint_as_float(raw.y & 0xffff0000u));
              w4[q4] = pk4_fp8(u0 * (acc[4 * q4] + bias), u1 * (acc[4 * q4 + 1] + bias), u2 * (acc[4 * q4 + 2] + bias), u3 * (acc[4 * q4 + 3] + bias), (float)(1 << F8_SH_M)); }
#pragma unroll
          for (int q4 = 0; q4 < 4; q4 += 2) { auto rr = __builtin_amdgcn_permlane32_swap(w4[q4], w4[q4 + 1], false, false);
              u32x2 o2; o2.x = rr[0]; o2.y = rr[1]; *(u32x2*)(op + 8 * q4) = o2; }
      } }
    asm volatile("s_waitcnt lgkmcnt(0)\n\ts_barrier" ::: "memory");
}
}

#ifdef STAMPS
#define MXT(kind, op) do { if ((kind) == STAMP_K1) tacc_ op##= __builtin_amdgcn_s_memrealtime(); } while (0)
#else
#define MXT(kind, op) do { } while (0)
#endif
constexpr int ATT_NH = 1;
__device__ __forceinline__ void phase_mixer(const Ptrs& P, LAS unsigned char* lds, int l, int Mmix, unsigned long long& tacc_, int wid_s) {
    int tid = wid_s * 64 + wg_lane(); asm volatile("" : "+v"(tid));
    const bf16_t* PROJ = (const bf16_t*)(P.ws + WS_PROJ); unsigned char* MIXo = (unsigned char*)(P.ws + WS_MIX);
    for (int i = tid; i < 768; i += NTHR) ((LAS float*)(lds + mx::CWL_OFF))[i] = ((const float*)(P.ws + WS_PAR))[PAR_CW + l * 768 + i];
    __syncthreads();
    const int G = gridDim.x, c = blockIdx.x;
    constexpr int UPC = ATT_NH == 2 ? 2 : 4;
    const int nLat = (ML / 128) * UPC, nCtx = Mmix > ML ? (MC / 128) * UPC : 0, nG = Mmix / 128;
    const bool gfirst = (c & 1) != 0;
    for (int pass = 0; pass < 2; ++pass) {
        if ((pass == 0) != gfirst) { MXT(20, -); int sbl = 0; bool pfl = false; for (int u = c; u < nLat; u += G) { const int chunk = u / UPC, kvh = (u / (UPC / 2)) & 1, hp = u & 1; mx::attn_unit<ATT_NH>(PROJ, MIXo, (const float*)(P.ws + WS_PAR) + PAR_SINK + l * 8, (const LAS float*)(lds + mx::CWL_OFF), lds, 1, chunk >> 6, chunk & 63, kvh, hp, tid, sbl, pfl, (u + G < nLat && (G & 3) == 0) ? ((u + G) / UPC) >> 6 : -1); } MXT(20, +); }
        else { MXT(21, -); int sbc = 0; bool pfc = false; for (int u = c; u < nG + nCtx; u += G) {
            if (u < nG) mx::gmlp_conv_unit(P, PROJ, MIXo, lds, l, u * 128, tid);
            else { const int v = u - nG, chunk = v / UPC, kvh = (v / (UPC / 2)) & 1, hp = v & 1; mx::attn_unit<ATT_NH>(PROJ, MIXo, (const float*)(P.ws + WS_PAR) + PAR_SINK + l * 8, (const LAS float*)(lds + mx::CWL_OFF), lds, 0, chunk >> 1, chunk & 1, kvh, hp, tid, sbc, pfc, -1); } } MXT(21, +); }
    }
}
constexpr int NPH = 31;
struct KArgs { Ptrs P; int lo, hi; };
__global__ void __launch_bounds__(NTHR, 2) k_fast(KArgs a) {
    extern __shared__ __attribute__((aligned(16))) unsigned char lds_raw[];
    LAS unsigned char* lds = (LAS unsigned char*)lds_raw;
    const int lo = a.lo, hi = a.hi;
#if defined(__HIP_DEVICE_COMPILE__) && defined(USE_KERNARG_RELOAD)
#define LOADP() const __attribute__((address_space(4))) unsigned long long* ap_ = (const __attribute__((address_space(4))) unsigned long long*)__builtin_amdgcn_kernarg_segment_ptr(); asm volatile("" : "+s"(ap_)); \
    Ptrs P; { unsigned long long* d_ = (unsigned long long*)&P; _Pragma("unroll") for (int i_ = 0; i_ < (int)(sizeof(Ptrs) / 8); ++i_) d_[i_] = ap_[i_]; }
#else
#define LOADP() const Ptrs P = a.P
#endif
    unsigned* ctl; { LOADP(); ctl = (unsigned*)(P.ws + WS_CTL); }
    if (threadIdx.x < 4) ((LAS unsigned*)(lds + MISC_OFF))[threadIdx.x] = 0u;
    __syncthreads();
    XcdBarrier bar; bar.bar = ctl + CW_BAR; bar.x = 0; bar.st = (volatile LAS unsigned*)(lds + MISC_OFF);
    if (hi - lo > 1) bar = xcd_barrier_post(ctl + CW_BAR, (volatile LAS unsigned*)(lds + MISC_OFF));
    const int wid_s = __builtin_amdgcn_readfirstlane((int)(threadIdx.x >> 6)); bar.wid = wid_s;
    volatile LAS int* vcw = (volatile LAS int*)(lds + MISC_OFF + 32);
    if (threadIdx.x == 0) { vcw[3] = 0; vcw[0] = (int)blockIdx.x; vcw[1] = (int)xb_xcc_id(); vcw[2] = (hi - lo > 1) ? (int)xb_add(ctl + CW_XR + 64 * xb_xcc_id(), 1u) : 0; }
    __syncthreads();
#define IN(k, kind) (lo <= (k) && (k) < hi)
#ifdef STAMPS
#define TSTART(kind) do { if ((kind) == STAMP_K1) tacc_ -= __builtin_amdgcn_s_memrealtime(); } while (0)
#define TSTOP(kind) do { if ((kind) == STAMP_K1) tacc_ += __builtin_amdgcn_s_memrealtime(); } while (0)
    unsigned long long tacc_ = 0;
#else
#define TSTART(kind) do { } while (0)
#define TSTOP(kind) do { } while (0)
    unsigned long long tacc_ = 0;
#endif
#define SEAM(k) do { if (lo <= (k) && (k) + 1 < hi) xcd_barrier(bar); } while (0)

    LAS unsigned* idxtab = (LAS unsigned*)(lds + IDX_OFF);
    LAS int* tst = (LAS int*)(lds + TST_OFF);

    TSTART(0);
    if (IN(0, 0)) { LOADP(); phase_p0a(P, lds); }
    SEAM(0); TSTOP(0);
    if (lo == 0 && hi > 1) {
        if (threadIdx.x == 0) { const int myx = vcw[1], rank = vcw[2]; int npop = 0, xi = 0; bool even = true;
            for (int j = 0; j < 16; ++j) { const unsigned cj = xb_ld(ctl + CW_XR + 64 * j); if (cj) { ++npop; if (j < myx) ++xi; if (cj * 8u != gridDim.x) even = false; } }
            if (even && npop == 8 && rank < (int)(gridDim.x / 8)) { vcw[0] = rank * 8 + xi; vcw[3] = (int)(gridDim.x / 8); }
            }
        __syncthreads(); }
    const int vc = vcw[0];
    if (IN(1, 1)) { LOADP(); phase_p0b(P); }
    SEAM(1);
    for (int l = 0; l < DEPTH; ++l) {
        const int pb = 2 + 7 * l;
        const int Mmix = l < DEPTH - 1 ? MT : ML;
        TSTART(2);
        if (IN(pb + 0, 2)) { LOADP(); if (l > 0) build_tile_table(P, tst, l - 1, wid_s);
            if (l == 0) phase_norm<1, true>(P, lds, l, MT, (const bf16_t*)P.out, tst, wid_s); else phase_norm<1, false>(P, lds, l, MT, (const bf16_t*)P.out, tst, wid_s); }
        SEAM(pb + 0); TSTOP(2);
        TSTART(3);
        if (IN(pb + 1, 3)) { LOADP();
            SchedDense<INC, G1_FP8 ? 1 : 2, F8_SH_H> S{P.ws + WS_H, P.ws + WS_WIN + (size_t)l * INC * D * (G1_FP8 ? 1 : 2), MT / 256, (int)gridDim.x, vc};
            { const float* rt = (const float*)(P.ws + WS_ROPE); LAS _Float16* rl = (LAS _Float16*)(lds + ROPEL_OFF);
              { const int t0 = wid_s * 64 + wg_lane(); float rv_[4096 / NTHR];
#pragma unroll
                for (int e = 0; e < 4096 / NTHR; ++e) rv_[e] = rt[t0 + NTHR * e];
#pragma unroll
                for (int e = 0; e < 4096 / NTHR; ++e) rl[t0 + NTHR * e] = (_Float16)rv_[e]; }
              __syncthreads(); }
            EpiProj E{(bf16_t*)(P.ws + WS_PROJ), (const LAS _Float16*)(lds + ROPEL_OFF)};
            pg::gemm_phase(lds + RING_OFF, idxtab, S, E, wid_s);
            if (l + 1 < DEPTH) { const int um = (int)(((MT / 256) * (INC / 256)) % (int)gridDim.x); if (vc >= um) convert_tail(P.ws, lds, l + 1, 0, vc - um, (int)gridDim.x - um, wid_s); }
        }
        SEAM(pb + 1); TSTOP(3);
        TSTART(4);
        if (IN(pb + 2, 4)) { LOADP(); phase_mixer(P, lds, l, Mmix, tacc_, wid_s); }
        SEAM(pb + 2); TSTOP(4);
        TSTART(5);
        if (IN(pb + 3, 5)) { LOADP();
            SchedDense<D, 1, F8_SH_M> S{P.ws + WS_MIX, P.ws + WS_WOUT + (size_t)l * D * D, Mmix / 256, (int)gridDim.x, vc};
            EpiResid E{(bf16_t*)(P.ws + WS_XB), (const float*)(P.ws + WS_MOD) + (size_t)l * 9 * 6144 + 2048};
            pg::gemm_phase(lds + RING_OFF, idxtab, S, E, wid_s);
            if (l + 1 < DEPTH) { const int um = (int)(((Mmix / 256) * (D / 256)) % (int)gridDim.x); if (vc >= um) convert_tail(P.ws, lds, l + 1, 1, vc - um, (int)gridDim.x - um, wid_s); }
        }
        SEAM(pb + 3); TSTOP(5);
        TSTART(6);
        if (IN(pb + 4, 6)) { LOADP(); phase_norm<2, false>(P, lds, l, Mmix, (const bf16_t*)(P.ws + WS_PROJ), tst, wid_s); }
        SEAM(pb + 4); TSTOP(6);
        TSTART(7);
        if (IN(pb + 5, 7)) { LOADP(); const ClsRec* listr = (const ClsRec*)(P.ws + WS_LISTR);
            build_tile_table(P, tst, l, wid_s);
            SchedGU S{(const unsigned char*)(P.ws + WS_H), (const unsigned char*)(P.ws + WS_WGU) + (size_t)l * NE * 1024 * 1024, listr, tst, ctl + CW_CNTF + l * 32 * 64, (int)gridDim.x, vc};
            EpiGU E{(unsigned char*)(P.ws + WS_PROJ), listr, ctl + CW_CNTF + l * 32 * 64};
            pg::gemm_phase(lds + RING_OFF, idxtab, S, E, wid_s);
            if (l + 1 < DEPTH) { const int um = (int)((__builtin_amdgcn_readfirstlane(tst[NCLS]) * 8) % (int)gridDim.x); if (vc >= um) convert_tail(P.ws, lds, l + 1, 2, vc - um, (int)gridDim.x - um, wid_s); }
        }
        SEAM(pb + 5); TSTOP(7);
        TSTART(8);
        if (IN(pb + 6, 8)) { LOADP();
            SchedDown S{(const unsigned char*)(P.ws + WS_PROJ), (const unsigned char*)(P.ws + WS_WD) + (size_t)l * NE * 1024 * 512, tst, (int)gridDim.x, vc};
            EpiPlain E{l < DEPTH - 1 ? (bf16_t*)P.out : (bf16_t*)(P.ws + WS_H), D};
            pg::gemm_phase(lds + RING_OFF, idxtab, S, E, wid_s);
            if (l + 1 < DEPTH) { const int um = (int)((__builtin_amdgcn_readfirstlane(tst[NCLS]) * 4) % (int)gridDim.x); if (vc >= um) convert_tail(P.ws, lds, l + 1, 3, vc - um, (int)gridDim.x - um, wid_s); }
        }
        SEAM(pb + 6); TSTOP(8);
    }
    TSTART(9);
    if (IN(30, 9)) { LOADP(); phase_norm<3, false>(P, lds, DEPTH - 1, ML, (const bf16_t*)(P.ws + WS_H), tst, wid_s); }
#ifdef STAMPS
    TSTOP(9);
    if (blockIdx.x == 0) { const unsigned long long t1 = __builtin_amdgcn_s_memrealtime(); while (__builtin_amdgcn_s_memrealtime() - t1 < (unsigned long long)(SPINK) * tacc_) __builtin_amdgcn_s_sleep(8); }
#endif
#undef IN
#undef SEAM
}
static int g_grid = 256;
static void launch_fast(const Ptrs& P, int lo, int hi, hipStream_t stream) {
    KArgs a{}; a.P = P; a.lo = lo; a.hi = hi;
    hipLaunchKernelGGL(k_fast, dim3(g_grid), dim3(NTHR), LDS_BYTES, stream, a);
}
extern "C" void kernel_launch(void* const* d_in, const int* in_sizes, int n_in, void* d_out, int out_size, void* d_ws, size_t ws_size, hipStream_t stream) {
    static int ready = 0;
    if (!ready) {
        if (n_in != 21 || ws_size < WS_END2) { fprintf(stderr, "kernel_launch: unexpected inputs (%d) or workspace (%zu)\n", n_in, ws_size); ready = -1; return; }
        if (hipFuncSetAttribute((const void*)k_fast, hipFuncAttributeMaxDynamicSharedMemorySize, LDS_BYTES) != hipSuccess) { fprintf(stderr, "kernel_launch: hipFuncSetAttribute failed\n"); ready = -1; return; }
        { int dev = 0, cus = 0, per_cu = 0; (void)hipGetDevice(&dev); (void)hipDeviceGetAttribute(&cus, hipDeviceAttributeMultiprocessorCount, dev);
          if (hipOccupancyMaxActiveBlocksPerMultiprocessor(&per_cu, (const void*)k_fast, NTHR, LDS_BYTES) != hipSuccess || per_cu < 1) { fprintf(stderr, "kernel_launch: occupancy query says %d blocks per CU\n", per_cu); }
          (void)hipGetLastError(); if (cus > 0) g_grid = cus;
          if (g_grid * NWAVES * 64 < MT) { fprintf(stderr, "kernel_launch: %d workgroups are too few for the routing tables\n", g_grid); ready = -1; return; } }
        ready = 1;
    }
    if (ready < 0) return;
    Ptrs P{};
    const float** pp = (const float**)&P;
    for (int i = 0; i < 21; ++i) pp[i] = (const float*)d_in[i];
    P.out = (float*)d_out; P.ws = (unsigned char*)d_ws;
    unsigned char* ws = (unsigned char*)d_ws;
    (void)hipMemsetAsync(ws + WS_CTL, 0, 1 * MiB, stream);
    launch_fast(P, 0, NPH, stream);
}
```
